# Optimizing an MI355X kernel written in HIP

```python
import math
import jax, jax.numpy as jnp
from jax import lax
import numpy as np

D_MODEL = 2048
BATCH = 32
SEQ = 256
DEPTH = 4
DEC_BATCH = 4
DEC_SEQ = 2048
PAST_LEN = 512

GRID_W = 64
N_MIXERS = 3
N_DN = (DEPTH + 2) // 3
N_GLA = (DEPTH + 1) // 3
N_HGRN = DEPTH // 3
EPS = 1e-6
D_FF = 4 * D_MODEL

DN_HK = 16
DN_HV = 32
DN_DK = 128
DN_DV = 128
DN_KD = DN_HK * DN_DK
DN_VD = DN_HV * DN_DV
CONV_K = 5
DELTA_CHUNK = 64

GLA_H = 4
GLA_KD = D_MODEL // 2
GLA_VD = D_MODEL
GLA_DK = GLA_KD // GLA_H
GLA_DV = GLA_VD // GLA_H
GLA_RANK = 16
GLA_TAU = 16.0
GATED_CHUNK = 32

HGRN_EXPAND = 128
HGRN_H = D_MODEL // HGRN_EXPAND
HGRN_DK = HGRN_EXPAND
HGRN_DV = D_MODEL // HGRN_H

kernel_name = 'bidir_deltanet_gla_hgrn2_flow_step'


def rms_norm(x, w):
    xf = x.astype(jnp.float32)
    y = xf * lax.rsqrt(jnp.mean(xf * xf, axis=-1, keepdims=True) + EPS)
    return (y * w.astype(jnp.float32)).astype(x.dtype)


def l2norm(x):
    xf = x.astype(jnp.float32)
    return (xf * lax.rsqrt(jnp.sum(xf * xf, axis=-1, keepdims=True) + EPS)).astype(x.dtype)


def split_heads(x, n):
    b, t, _ = x.shape
    return x.reshape(b, t, n, -1).transpose(0, 2, 1, 3)


def short_conv(x, w, grid):
    b, t, ch = x.shape
    if grid:
        x = x.reshape(b, t // GRID_W, GRID_W, ch)
    length = x.shape[-2]
    pad = CONV_K // 2
    xp = jnp.pad(x, [(0, 0)] * (x.ndim - 2) + [(pad, pad), (0, 0)])
    y = sum(xp[..., s:s + length, :] * w[s] for s in range(CONV_K))
    return y.reshape(b, t, ch)


def zero_states(s0, b, h, dk, dv, dtype):
    if s0 is not None:
        return s0
    z = jnp.zeros((b, h, dk, dv), dtype)
    return (z, z)


def chunk_delta(q, k, v, beta, g, s0):
    out_dtype = v.dtype
    q, k, v, beta, g, s = [a.astype(jnp.float32) for a in (q, k, v, beta, g, s0)]
    b, h, t, dk = q.shape
    dv = v.shape[-1]
    c = DELTA_CHUNK
    n = t // c
    q, k, v = [a.reshape(b, h, n, c, -1) for a in (q, k, v)]
    beta = beta.reshape(b, h, n, c)
    g = jnp.cumsum(g.reshape(b, h, n, c), axis=-1)
    incl = jnp.tril(jnp.ones((c, c), bool))
    strict = jnp.tril(jnp.ones((c, c), bool), -1)
    decay = jnp.where(incl, jnp.exp(jnp.where(incl, g[..., :, None] - g[..., None, :], 0.0)), 0.0)
    lmat = jnp.where(strict, beta[..., :, None] * jnp.einsum('bhnid,bhnjd->bhnij', k, k) * decay, 0.0)
    rhs = jnp.concatenate([beta[..., None] * v, (beta * jnp.exp(g))[..., None] * k], axis=-1)
    sol = lax.linalg.triangular_solve(jnp.eye(c, dtype=jnp.float32) + lmat, rhs, left_side=True, lower=True)
    u0, w = sol[..., :dv], sol[..., dv:]
    attn = jnp.einsum('bhnid,bhnjd->bhnij', q, k) * decay
    qg = q * jnp.exp(g)[..., None]
    kd = k * jnp.exp(g[..., -1:] - g)[..., None]
    g_end = jnp.exp(g[..., -1])

    def step(state, xs):
        u0c, wc, ac, qc, kc, gc = xs
        u = u0c - jnp.einsum('bhik,bhkv->bhiv', wc, state)
        o = jnp.einsum('bhij,bhjv->bhiv', ac, u) + jnp.einsum('bhik,bhkv->bhiv', qc, state)
        state = gc[..., None, None] * state + jnp.einsum('bhjk,bhjv->bhkv', kc, u)
        return state, o

    xs = [jnp.moveaxis(a, 2, 0) for a in (u0, w, attn, qg, kd, g_end)]
    s, o = lax.scan(step, s, xs)
    o = jnp.moveaxis(o, 0, 2).reshape(b, h, t, dv)
    return o.astype(out_dtype), s.astype(out_dtype)


def chunk_gla(q, k, v, log_a, s0):
    out_dtype = v.dtype
    q, k, v, log_a, s = [a.astype(jnp.float32) for a in (q, k, v, log_a, s0)]
    b, h, t, dk = q.shape
    c = GATED_CHUNK
    n = t // c
    chunks = lambda a: jnp.moveaxis(a.reshape(b, h, n, c, a.shape[-1]), 2, 0)
    incl = jnp.tril(jnp.ones((c, c), bool))[..., None]

    def step(state, xs):
        qc, kc, vc, lc = xs
        cb = jnp.cumsum(lc, axis=-2)
        diff = cb[..., :, None, :] - cb[..., None, :, :]
        decay = jnp.where(incl, jnp.exp(jnp.where(incl, diff, 0.0)), 0.0)
        attn = jnp.einsum('bhik,bhjk,bhijk->bhij', qc, kc, decay)
        o = jnp.einsum('bhij,bhjv->bhiv', attn, vc) + jnp.einsum('bhik,bhkv->bhiv', qc * jnp.exp(cb), state)
        cb_end = cb[..., -1:, :]
        state = jnp.exp(cb_end[..., 0, :])[..., None] * state + jnp.einsum(
            'bhjk,bhjv->bhkv', kc * jnp.exp(cb_end - cb), vc)
        return state, o

    s, o = lax.scan(step, s, [chunks(a) for a in (q, k, v, log_a)])
    o = jnp.moveaxis(o, 0, 2).reshape(b, h, t, -1)
    return o.astype(out_dtype), s.astype(out_dtype)


def bidirectional(core, fwd, bwd, s0):
    o_f, s_f = core(*fwd, s0[0])
    o_b, s_b = core(*(jnp.flip(a, axis=2) for a in bwd), s0[1])
    return o_f + jnp.flip(o_b, axis=2), (s_f, s_b)


def gated_out(o, norm_w, gate, w_out):
    b, h, t, d = o.shape
    y = rms_norm(o.transpose(0, 2, 1, 3), norm_w) * jax.nn.silu(gate).reshape(b, t, h, d)
    return y.reshape(b, t, h * d) @ w_out


def deltanet_mixer(h, p, j, i, s0, grid):
    b, t, _ = h.shape
    proj = h @ p['dn_w_in'][j]
    n_conv = 2 * DN_KD + DN_VD
    qkv = jax.nn.silu(short_conv(proj[..., :n_conv], p['dn_conv'][j], grid))
    q, k, v = jnp.split(qkv, [DN_KD, 2 * DN_KD], axis=-1)
    z = proj[..., n_conv:n_conv + DN_VD]
    beta_f, beta_b, a_f, a_b = jnp.split(proj[..., n_conv + DN_VD:], 4, axis=-1)
    rep = DN_HV // DN_HK
    q = jnp.repeat(l2norm(split_heads(q, DN_HK)), rep, axis=1) * DN_DK ** -0.5
    k = jnp.repeat(l2norm(split_heads(k, DN_HK)), rep, axis=1)
    v = split_heads(v, DN_HV)

    def gates(bl, al, d):
        beta = jax.nn.sigmoid(bl).transpose(0, 2, 1)
        g = -jnp.exp(p['dn_A_log'][j, d])[:, None] * jax.nn.softplus(
            al + p['dn_dt_bias'][j, d]).transpose(0, 2, 1)
        return beta, g

    bf, gf = gates(beta_f, a_f, 0)
    bb, gb = gates(beta_b, a_b, 1)
    s0 = zero_states(s0, b, DN_HV, DN_DK, DN_DV, h.dtype)
    o, states = bidirectional(chunk_delta, (q, k, v, bf, gf), (q, k, v, bb, gb), s0)
    return gated_out(o, p['dn_norm'][j], z, p['dn_w_out'][j]), states


def gla_mixer(h, p, j, i, s0, grid):
    b, t, _ = h.shape
    q, k, v, r, a1 = jnp.split(h @ p['gla_w_in'][j],
                               [GLA_KD, 2 * GLA_KD, 2 * GLA_KD + GLA_VD, 2 * GLA_KD + 2 * GLA_VD], axis=-1)
    q = split_heads(q, GLA_H) * GLA_DK ** -0.5
    k = split_heads(k, GLA_H)
    v = split_heads(v, GLA_H)

    def log_alpha(d):
        a = a1[..., d * GLA_RANK:(d + 1) * GLA_RANK] @ p['gla_w_a2'][j, d] + p['gla_b_a'][j, d]
        return split_heads(jax.nn.log_sigmoid(a.astype(jnp.float32)) / GLA_TAU, GLA_H)

    s0 = zero_states(s0, b, GLA_H, GLA_DK, GLA_DV, h.dtype)
    o, states = bidirectional(chunk_gla, (q, k, v, log_alpha(0)), (q, k, v, log_alpha(1)), s0)
    return gated_out(o, p['gla_norm'][j], r, p['gla_w_out'][j]), states


def hgrn2_mixer(h, p, j, i, s0, grid):
    b, t, _ = h.shape
    q, inp, gate, f_f, f_b = jnp.split(h @ p['hgrn_w_in'][j], 5, axis=-1)
    probs = jax.nn.softmax(p['hgrn_lb_logits'].astype(jnp.float32), axis=0)
    lb = (jnp.cumsum(probs, axis=0) - probs[0])[i]

    def forget(fl):
        fl = fl.astype(jnp.float32)
        log_f = jnp.logaddexp(jnp.log(lb), jnp.log1p(-lb) + jax.nn.log_sigmoid(fl))
        k = (1.0 - lb) * jax.nn.sigmoid(-fl)
        return split_heads(k, HGRN_H), split_heads(log_f, HGRN_H)

    q = split_heads(jax.nn.silu(q), HGRN_H) * HGRN_DK ** -0.5
    v = split_heads(inp, HGRN_H)
    k_f, lf_f = forget(f_f)
    k_b, lf_b = forget(f_b)
    s0 = zero_states(s0, b, HGRN_H, HGRN_DK, HGRN_DV, h.dtype)
    o, states = bidirectional(chunk_gla, (q, k_f, v, lf_f), (q, k_b, v, lf_b), s0)
    return gated_out(o, p['hgrn_norm'][j], gate, p['hgrn_w_out'][j]), states


def sq_relu_mlp(h, w_up, w_down):
    return jnp.square(jax.nn.relu(h @ w_up)) @ w_down


def trunk(x, cond, cache, p):
    grid = cache is not None
    silu_cond = jax.nn.silu(cond)
    collected = ([], [], [])
    for i in range(DEPTH):
        kind, j = i % N_MIXERS, i // N_MIXERS
        mod = silu_cond @ p['ada_w'][i] + p['ada_b'][i]
        sh1, sc1, g1, sh2, sc2, g2 = jnp.split(mod[:, None, :], 6, axis=-1)
        h = rms_norm(x, p['norm1'][i]) * (1 + sc1) + sh1
        s0 = None if cache is None else (cache[kind][:, j, 0], cache[kind][:, j, 1])
        mixer = (deltanet_mixer, gla_mixer, hgrn2_mixer)[kind]
        out, states = mixer(h, p, j, i, s0, grid)
        x = x + g1 * out
        h = rms_norm(x, p['norm2'][i]) * (1 + sc2) + sh2
        x = x + g2 * sq_relu_mlp(h, p['w_up'][i], p['w_down'][i])
        if cache is None:
            collected[kind].append(jnp.stack(states, axis=1))
    y = rms_norm(x, p['final_norm'])
    if cache is not None:
        return y, None
    return y, [jnp.stack(s, axis=1) for s in collected]


def setup_inputs(seed: int = 0) -> dict:
    key = jax.random.key(seed)
    ks = iter(jax.random.split(key, 32))
    nrm = lambda shape, scale: jax.random.normal(next(ks), shape, jnp.float32) * scale
    d = D_MODEL
    dn_cols = 2 * DN_KD + 2 * DN_VD + 4 * DN_HV
    gla_cols = 2 * GLA_KD + 2 * GLA_VD + 2 * GLA_RANK
    inputs = {}
    inputs['x_prompt'] = nrm((BATCH, SEQ, d), 1.0)
    inputs['x_sample'] = nrm((DEC_BATCH, DEC_SEQ, d), 1.0)
    inputs['c'] = nrm((DEC_BATCH, d), 1.0)
    inputs['state_deltanet'] = nrm((DEC_BATCH, N_DN, 2, DN_HV, DN_DK, DN_DV), DN_DK ** -0.5)
    inputs['state_gla'] = nrm((DEC_BATCH, N_GLA, 2, GLA_H, GLA_DK, GLA_DV), GLA_DK ** -0.5)
    inputs['state_hgrn'] = nrm((DEC_BATCH, N_HGRN, 2, HGRN_H, HGRN_DK, HGRN_DV), HGRN_DK ** -0.5)
    inputs['c_ctx'] = nrm((d,), 1.0)
    inputs['ada_w'] = nrm((DEPTH, d, 6 * d), 0.5 * d ** -0.5)
    inputs['ada_b'] = nrm((DEPTH, 6 * d), 0.02)
    inputs['norm1'] = 1.0 + nrm((DEPTH, d), 0.02)
    inputs['norm2'] = 1.0 + nrm((DEPTH, d), 0.02)
    inputs['final_norm'] = 1.0 + nrm((d,), 0.02)
    inputs['w_up'] = nrm((DEPTH, d, D_FF), d ** -0.5)
    inputs['w_down'] = nrm((DEPTH, D_FF, d), D_FF ** -0.5)
    inputs['dn_w_in'] = nrm((N_DN, d, dn_cols), d ** -0.5)
    inputs['dn_conv'] = nrm((N_DN, CONV_K, 2 * DN_KD + DN_VD), CONV_K ** -0.5)
    inputs['dn_A_log'] = jnp.log(jax.random.uniform(next(ks), (N_DN, 2, DN_HV), jnp.float32, 1.0, 16.0))
    dt = jnp.exp(jax.random.uniform(next(ks), (N_DN, 2, DN_HV), jnp.float32, math.log(1e-3), math.log(1e-1)))
    inputs['dn_dt_bias'] = dt + jnp.log(-jnp.expm1(-dt))
    inputs['dn_norm'] = 1.0 + nrm((N_DN, DN_DV), 0.02)
    inputs['dn_w_out'] = nrm((N_DN, DN_VD, d), DN_VD ** -0.5)
    inputs['gla_w_in'] = nrm((N_GLA, d, gla_cols), d ** -0.5)
    inputs['gla_w_a2'] = nrm((N_GLA, 2, GLA_RANK, GLA_KD), GLA_RANK ** -0.5)
    inputs['gla_b_a'] = nrm((N_GLA, 2, GLA_KD), 0.1)
    inputs['gla_norm'] = 1.0 + nrm((N_GLA, GLA_DV), 0.02)
    inputs['gla_w_out'] = nrm((N_GLA, GLA_VD, d), GLA_VD ** -0.5)
    inputs['hgrn_w_in'] = nrm((N_HGRN, d, 5 * d), d ** -0.5)
    inputs['hgrn_lb_logits'] = nrm((DEPTH, d), 0.1)
    inputs['hgrn_norm'] = 1.0 + nrm((N_HGRN, HGRN_DV), 0.02)
    inputs['hgrn_w_out'] = nrm((N_HGRN, d, d), d ** -0.5)
    return inputs


def reference(x_prompt, x_sample, c, state_deltanet, state_gla, state_hgrn, c_ctx, ada_w, ada_b, norm1,
              norm2, final_norm, w_up, w_down, dn_w_in, dn_conv, dn_A_log, dn_dt_bias, dn_norm, dn_w_out,
              gla_w_in, gla_w_a2, gla_b_a, gla_norm, gla_w_out, hgrn_w_in, hgrn_lb_logits, hgrn_norm,
              hgrn_w_out):
    p = dict(ada_w=ada_w, ada_b=ada_b, norm1=norm1, norm2=norm2, final_norm=final_norm, w_up=w_up,
             w_down=w_down, dn_w_in=dn_w_in, dn_conv=dn_conv, dn_A_log=dn_A_log, dn_dt_bias=dn_dt_bias,
             dn_norm=dn_norm, dn_w_out=dn_w_out, gla_w_in=gla_w_in, gla_w_a2=gla_w_a2, gla_b_a=gla_b_a,
             gla_norm=gla_norm, gla_w_out=gla_w_out, hgrn_w_in=hgrn_w_in, hgrn_lb_logits=hgrn_lb_logits,
             hgrn_norm=hgrn_norm, hgrn_w_out=hgrn_w_out)
    y_prompt, ctx_states = trunk(x_prompt, c_ctx[None, :], None, p)
    new_state_deltanet, new_state_gla, new_state_hgrn = ctx_states
    y_sample, _ = trunk(x_sample, c, (state_deltanet, state_gla, state_hgrn), p)
    return (y_prompt, y_sample, new_state_deltanet, new_state_gla, new_state_hgrn)
```

```cpp
#include <hip/hip_runtime.h>
#include <cstdio>
#include <cstdint>

__device__ __forceinline__ int opaque_v(int x) { asm volatile("" : "+v"(x)); return x; }
#define PHASE_IDS() const int tid = opaque_v((int)threadIdx.x), lane = tid & 63, wave = __builtin_amdgcn_readfirstlane(tid >> 6), gw = (int)blockIdx.x * 8 + wave, NGW = (int)gridDim.x * 8; (void)lane; (void)wave; (void)gw; (void)NGW
namespace pg8 {
#define PG8_LAS __attribute__((address_space(3)))
typedef unsigned short bf16_t;
typedef short bf16x8 __attribute__((ext_vector_type(8)));
typedef float f32x4 __attribute__((ext_vector_type(4)));
typedef unsigned u32x4 __attribute__((ext_vector_type(4)));
constexpr int BM = 256, BK = 64, HALF = 128, HTB = HALF * BK * 2, STAGE_BYTES = 8 * HTB, NXCD = 8, WGM = 8;

__host__ __device__ __forceinline__ int lds_byte(int r, int c) { const int st = (r >> 4) * 2 + (c >> 5), rr = r & 15, cc = c & 31, ob = rr * 64 + cc * 2; return st * 1024 + (ob ^ (((ob >> 9) & 1) << 5)); }
__host__ __device__ __forceinline__ void stage_rc(int b, int& R, int& C) { const int st = b / 1024, sb = b % 1024, swz = sb ^ (((sb >> 9) & 1) << 5); R = (st >> 1) * 16 + swz / 64; C = (st & 1) * 32 + (swz % 64) / 2; }
__host__ __device__ __forceinline__ int perm32(int rho) { const int n = rho >> 4, i = rho & 15; return 8 * (i >> 2) + 4 * n + (i & 3); }

struct Unit { int pm, pn; };
struct Gemm { const bf16_t* A; const bf16_t* Bt; int M, N, K; size_t a_pn_step, b_pn_step; int nt; };
__host__ __device__ __forceinline__ Gemm mk_gemm(const bf16_t* A, const bf16_t* Bt, int M, int N, int K) { return Gemm{A, Bt, M, N, K, 0, (size_t)256 * K * 2, K / 64}; }

struct StaticOrder {
    int nM, nN, nwg, G, c, pm0;
    __host__ __device__ void init(int M, int N, int G_, int c_, int pm0_ = 0) { nM = M / BM; nN = N / BM; nwg = nM * nN; G = G_; c = c_; pm0 = pm0_; }
    __host__ __device__ bool next(int i, Unit& u) const {
        const long L = (long)i * G + c; if (L >= nwg) return false;
        int wgid = (int)L; { const int q = nwg / NXCD, r = nwg % NXCD, xcd = wgid % NXCD, off = wgid / NXCD; wgid = (xcd < r ? xcd * (q + 1) : r * (q + 1) + (xcd - r) * q) + off; }
        const int nig = WGM * nN, gid = wgid / nig, fm = gid * WGM, gsz = (nM - fm) < WGM ? (nM - fm) : WGM;
        u.pm = pm0 + fm + ((wgid % nig) % gsz); u.pn = (wgid % nig) / gsz; return true;
    }
    __device__ __forceinline__ void a_ready(const Unit&) const {}
    __device__ __forceinline__ void done(const Unit&) const {}
};

__device__ __forceinline__ unsigned cvt_pk_bf16(float lo, float hi) { unsigned r; asm volatile("v_cvt_pk_bf16_f32 %0, %1, %2" : "=v"(r) : "v"(lo), "v"(hi)); return r; }

template <int ACT> struct EpiBf16 {
    static constexpr bool PERM = true, AFTER_DRAIN = false;
    bf16_t* O; int ldc; int n_main; float* G;
    __device__ __forceinline__ void operator()(const f32x4 (&acc)[2][2][4][2], const Unit& u, int wr, int wc, int fr, int fq) const {
        const int row0 = u.pm * BM + wr * 64 + fr; const int colt = u.pn * BM;
        const int col0 = colt + wc * 32 + 8 * fq;
#pragma unroll
        for (int ai = 0; ai < 2; ++ai)
#pragma unroll
            for (int m = 0; m < 4; ++m) { bf16_t* rowp = O + (size_t)(row0 + ai * HALF + m * 16) * ldc + col0;
#pragma unroll
                for (int bj = 0; bj < 2; ++bj) { f32x4 v0 = acc[ai][bj][m][0], v1 = acc[ai][bj][m][1];
                    if (ACT == 1) {
#pragma unroll
                        for (int j = 0; j < 4; ++j) { const float a = fmaxf(v0[j], 0.f), b = fmaxf(v1[j], 0.f); v0[j] = a * a; v1[j] = b * b; } }
                    u32x4 w; w.x = cvt_pk_bf16(v0[0], v0[1]); w.y = cvt_pk_bf16(v0[2], v0[3]); w.z = cvt_pk_bf16(v1[0], v1[1]); w.w = cvt_pk_bf16(v1[2], v1[3]);
                    *(u32x4*)(rowp + bj * HALF) = w;
#ifdef PROBE_DOUBLE_STORE
                    asm volatile("" ::: "memory"); *(u32x4*)(rowp + bj * HALF) = w; asm volatile("" ::: "memory");
#endif
                    } }
    }
};
struct EpiGateP {
    static constexpr bool PERM = true, AFTER_DRAIN = false;
    float* GP;
    __device__ __forceinline__ void operator()(const f32x4 (&acc)[2][2][4][2], const Unit& u, int wr, int wc, int fr, int fq) const {
        const int row0 = u.pm * BM + wr * 64 + fr; const int col0 = wc * 32 + 8 * fq; float* base = GP + (size_t)u.pn * 16384 * 128;
#pragma unroll
        for (int ai = 0; ai < 2; ++ai)
#pragma unroll
            for (int m = 0; m < 4; ++m) { float* rowp = base + (size_t)(row0 + ai * HALF + m * 16) * 128 + col0;
                *(f32x4*)(rowp) = acc[ai][0][m][0]; *(f32x4*)(rowp + 4) = acc[ai][0][m][1]; }
    }
};
template <bool BASE_F32> struct EpiRes {
    static constexpr bool PERM = true, AFTER_DRAIN = false;
    const void* base_ctx; const void* base_lat; bf16_t* out; const float* gate;
    __device__ __forceinline__ void operator()(const f32x4 (&acc)[2][2][4][2], const Unit& u, int wr, int wc, int fr, int fq) const {
        const int row0 = u.pm * BM + wr * 64 + fr, col0 = u.pn * BM + wc * 32 + 8 * fq;
        const bool ctx = u.pm < 32; const int grp = ctx ? 0 : 1 + ((u.pm - 32) >> 3);
        const float* gp = gate + (size_t)grp * 12288 + col0;
        const void* base = ctx ? base_ctx : base_lat; const int rsub = (BASE_F32 && !ctx) ? 8192 : 0;
        f32x4 gv[2][2];
#pragma unroll
        for (int bj = 0; bj < 2; ++bj)
#pragma unroll
            for (int n = 0; n < 2; ++n) gv[bj][n] = *(const f32x4*)(gp + bj * HALF + 4 * n);
#pragma unroll
        for (int ai = 0; ai < 2; ++ai) {
            f32x4 bs[4][2][2];
#pragma unroll
            for (int m = 0; m < 4; ++m) { const size_t offb = (size_t)(row0 + ai * HALF + m * 16 - rsub) * 2048 + col0;
#pragma unroll
                for (int bj = 0; bj < 2; ++bj) {
                    if (BASE_F32) { bs[m][bj][0] = *(const f32x4*)((const float*)base + offb + bj * HALF); bs[m][bj][1] = *(const f32x4*)((const float*)base + offb + bj * HALF + 4); }
                    else { const u32x4 w = *(const u32x4*)((const bf16_t*)base + offb + bj * HALF);
                        bs[m][bj][0] = (f32x4){__uint_as_float(w.x << 16), __uint_as_float(w.x & 0xffff0000u), __uint_as_float(w.y << 16), __uint_as_float(w.y & 0xffff0000u)};
                        bs[m][bj][1] = (f32x4){__uint_as_float(w.z << 16), __uint_as_float(w.z & 0xffff0000u), __uint_as_float(w.w << 16), __uint_as_float(w.w & 0xffff0000u)}; } } }
#pragma unroll
            for (int m = 0; m < 4; ++m) { const size_t offo = (size_t)(row0 + ai * HALF + m * 16) * 2048 + col0;
#pragma unroll
                for (int bj = 0; bj < 2; ++bj) { const f32x4 v0 = bs[m][bj][0] + gv[bj][0] * acc[ai][bj][m][0], v1 = bs[m][bj][1] + gv[bj][1] * acc[ai][bj][m][1];
                    u32x4 w; w.x = cvt_pk_bf16(v0[0], v0[1]); w.y = cvt_pk_bf16(v0[2], v0[3]); w.z = cvt_pk_bf16(v1[0], v1[1]); w.w = cvt_pk_bf16(v1[2], v1[3]);
                    *(u32x4*)(out + offo + bj * HALF) = w; } }
            asm volatile("" ::: "memory");
        }
    }
};

template <class Epi, class Sched, bool ALIGN_EPI = false, bool SP2 = false>
__device__ __forceinline__ void gemm_phase(PG8_LAS unsigned char* lds, const Gemm g, const Sched& S, const Epi& E) {
    const int tid = opaque_v((int)threadIdx.x), wid = __builtin_amdgcn_readfirstlane(tid >> 6), lane = tid & 63, wr = wid >> 2, wc = wid & 3, fr = lane & 15, fq = lane >> 4;
    const int K = g.K, nt = g.nt;
    unsigned voffA[2], voffB[2];
#pragma unroll
    for (int i = 0; i < 2; ++i) { int R, C; stage_rc(tid * 16 + i * 8192, R, C); const int Rb = Epi::PERM ? ((R & ~31) + perm32(R & 31)) : R;
        voffA[i] = (unsigned)(R * K + C) * 2u; voffB[i] = (unsigned)(Rb * K + C) * 2u; }
    const size_t kstep = (size_t)(BK * 2);
    const size_t hstep = (size_t)HALF * K * 2;
    const size_t tstep = 2 * hstep;
    const unsigned ldsw = (unsigned)wid * 1024u;
    const int aoff = lds_byte(wr * 64 + fr, fq * 8), boff = lds_byte(wc * 32 + fr, fq * 8);
#define PG8_SA(b, h) (((b) * 2 + (h)) * HTB)
#define PG8_SB(b, h) ((4 + (b) * 2 + (h)) * HTB)
#define PG8_STAGE(bufoff, gbase, voff) do { _Pragma("unroll") for (int _i = 0; _i < 2; ++_i) \
        __builtin_amdgcn_global_load_lds((const unsigned*)((const char*)(gbase) + (voff)[_i]), (PG8_LAS unsigned*)(lds + (bufoff) + ldsw + _i * 8192), 16, 0, 0); } while (0)
#define PG8_LDA(dst, b, h) do { _Pragma("unroll") for (int m = 0; m < 4; ++m) _Pragma("unroll") for (int k = 0; k < 2; ++k) dst[m][k] = *(const PG8_LAS bf16x8*)(lds + PG8_SA(b, h) + aoff + m * 2048 + k * 1024); } while (0)
#define PG8_LDB(dst, b, h) do { _Pragma("unroll") for (int n = 0; n < 2; ++n) _Pragma("unroll") for (int k = 0; k < 2; ++k) dst[n][k] = *(const PG8_LAS bf16x8*)(lds + PG8_SB(b, h) + boff + n * 2048 + k * 1024); } while (0)
#define PG8_MMA(ai, bj, At, Bt) do { __builtin_amdgcn_s_setprio(1); _Pragma("unroll") for (int m = 0; m < 4; ++m) _Pragma("unroll") for (int n = 0; n < 2; ++n) _Pragma("unroll") for (int k = 0; k < 2; ++k) \
        acc[ai][bj][m][n] = __builtin_amdgcn_mfma_f32_16x16x32_bf16(Bt[n][k], At[m][k], acc[ai][bj][m][n], 0, 0, 0); __builtin_amdgcn_s_setprio(0); } while (0)
#define PG8_WAIT_V(n) asm volatile("s_waitcnt vmcnt(" #n ")" ::: "memory")
#define PG8_WAIT_L(n) asm volatile("s_waitcnt lgkmcnt(" #n ")" ::: "memory")
#define PG8_BAR __builtin_amdgcn_s_barrier()
#define PG8_SCHED __builtin_amdgcn_sched_barrier(0)
    Unit cur, nxt; int ui = 0;
    if (!S.next(0, cur)) return;
    f32x4 acc[2][2][4][2];
#pragma unroll
    for (int a = 0; a < 2; ++a)
#pragma unroll
        for (int b = 0; b < 2; ++b)
#pragma unroll
            for (int m = 0; m < 4; ++m)
#pragma unroll
                for (int n = 0; n < 2; ++n) acc[a][b][m][n] = (f32x4){0.f, 0.f, 0.f, 0.f};
    bf16x8 At[4][2], B0[2][2], B1[2][2];
    const char* cA = (const char*)g.A + (size_t)cur.pm * tstep + (size_t)cur.pn * g.a_pn_step; const char* cB = (const char*)g.Bt + (size_t)cur.pn * g.b_pn_step;
    S.a_ready(cur);
    if constexpr (SP2) {
        PG8_STAGE(PG8_SB(0, 0), cB, voffB); PG8_STAGE(PG8_SB(0, 1), cB + hstep, voffB); PG8_STAGE(PG8_SA(0, 0), cA, voffA); PG8_STAGE(PG8_SA(0, 1), cA + hstep, voffA);
        if (wr == 1) PG8_BAR;
        PG8_WAIT_V(2); PG8_BAR;
        PG8_STAGE(PG8_SB(1, 0), cB + kstep, voffB); PG8_STAGE(PG8_SA(1, 0), cA + kstep, voffA); PG8_STAGE(PG8_SB(1, 1), cB + hstep + kstep, voffB);
        PG8_WAIT_V(6); PG8_BAR;
    } else {
        PG8_STAGE(PG8_SB(0, 0), cB, voffB); PG8_STAGE(PG8_SA(0, 0), cA, voffA); PG8_STAGE(PG8_SB(0, 1), cB + hstep, voffB); PG8_STAGE(PG8_SA(0, 1), cA + hstep, voffA);
        if (wr == 1) PG8_BAR;
        PG8_WAIT_V(4); PG8_BAR;
        PG8_STAGE(PG8_SB(1, 0), cB + kstep, voffB); PG8_STAGE(PG8_SA(1, 0), cA + kstep, voffA); PG8_STAGE(PG8_SB(1, 1), cB + hstep + kstep, voffB);
        PG8_WAIT_V(6); PG8_BAR;
    }
    for (;;) {
        const bool has_next = S.next(ui + 1, nxt);
        const char* nA = has_next ? (const char*)g.A + (size_t)nxt.pm * tstep + (size_t)nxt.pn * g.a_pn_step : cA; const char* nB = has_next ? (const char*)g.Bt + (size_t)nxt.pn * g.b_pn_step : cB;
        for (int t = 0; t < nt; t += 2) {
            const bool last = (t == nt - 2);
            const char* a1 = cA + (size_t)(t + 1) * kstep;
            const char* a2 = last ? nA : cA + (size_t)(t + 2) * kstep; const char* b2 = last ? nB : cB + (size_t)(t + 2) * kstep;
            const char* a3 = a2 + kstep; const char* b3 = b2 + kstep;
            if (last && has_next) S.a_ready(nxt);
            if constexpr (SP2) {
            PG8_LDB(B0, 0, 0); PG8_LDB(B1, 0, 1); PG8_SCHED; PG8_LDA(At, 0, 0); PG8_STAGE(PG8_SA(1, 1), a1 + hstep, voffA);
            PG8_WAIT_V(8); PG8_WAIT_L(0); PG8_BAR; PG8_MMA(0, 0, At, B0); PG8_MMA(0, 1, At, B1); PG8_BAR; PG8_SCHED;
            PG8_LDA(At, 0, 1); PG8_STAGE(PG8_SB(0, 0), b2, voffB); PG8_STAGE(PG8_SB(0, 1), b2 + hstep, voffB); PG8_STAGE(PG8_SA(0, 0), a2, voffA);
            PG8_WAIT_V(8); PG8_WAIT_L(0); PG8_BAR; PG8_MMA(1, 0, At, B0); PG8_MMA(1, 1, At, B1); PG8_BAR; PG8_SCHED;
            PG8_LDB(B0, 1, 0); PG8_LDB(B1, 1, 1); PG8_SCHED; PG8_LDA(At, 1, 0); PG8_STAGE(PG8_SA(0, 1), a2 + hstep, voffA);
            PG8_WAIT_V(8); PG8_WAIT_L(0); PG8_BAR; PG8_MMA(0, 0, At, B0); PG8_MMA(0, 1, At, B1); PG8_BAR; PG8_SCHED;
            PG8_LDA(At, 1, 1); PG8_STAGE(PG8_SB(1, 0), b3, voffB); PG8_STAGE(PG8_SB(1, 1), b3 + hstep, voffB); PG8_STAGE(PG8_SA(1, 0), a3, voffA);
            PG8_WAIT_V(8); PG8_WAIT_L(0); PG8_BAR; PG8_MMA(1, 0, At, B0); PG8_MMA(1, 1, At, B1); PG8_BAR; PG8_SCHED;
            } else {
            PG8_LDB(B0, 0, 0); PG8_SCHED; PG8_LDA(At, 0, 0); PG8_STAGE(PG8_SA(1, 1), a1 + hstep, voffA);
            PG8_WAIT_L(8); PG8_BAR; PG8_WAIT_L(0); PG8_MMA(0, 0, At, B0); PG8_BAR; PG8_SCHED;
            PG8_LDB(B1, 0, 1); PG8_STAGE(PG8_SB(0, 0), b2, voffB);
            PG8_BAR; PG8_WAIT_L(0); PG8_MMA(0, 1, At, B1); PG8_BAR;
            PG8_LDA(At, 0, 1); PG8_STAGE(PG8_SA(0, 0), a2, voffA);
            PG8_BAR; PG8_WAIT_L(0); PG8_MMA(1, 0, At, B0); PG8_BAR; PG8_SCHED;
            PG8_STAGE(PG8_SB(0, 1), b2 + hstep, voffB);
            PG8_WAIT_V(6); PG8_BAR; PG8_MMA(1, 1, At, B1); PG8_BAR;
            PG8_LDB(B0, 1, 0); PG8_SCHED; PG8_LDA(At, 1, 0); PG8_STAGE(PG8_SA(0, 1), a2 + hstep, voffA);
            PG8_WAIT_L(8); PG8_BAR; PG8_WAIT_L(0); PG8_MMA(0, 0, At, B0); PG8_BAR; PG8_SCHED;
            PG8_LDB(B1, 1, 1); PG8_STAGE(PG8_SB(1, 0), b3, voffB);
            PG8_BAR; PG8_WAIT_L(0); PG8_MMA(0, 1, At, B1); PG8_BAR;
            PG8_LDA(At, 1, 1); PG8_STAGE(PG8_SA(1, 0), a3, voffA);
            PG8_BAR; PG8_WAIT_L(0); PG8_MMA(1, 0, At, B0); PG8_BAR; PG8_SCHED;
            PG8_STAGE(PG8_SB(1, 1), b3 + hstep, voffB);
            PG8_WAIT_V(6); PG8_BAR; PG8_MMA(1, 1, At, B1); PG8_BAR;
            }
        }
        if constexpr (ALIGN_EPI) { if (wr == 0) PG8_BAR; }
        if constexpr (!Epi::AFTER_DRAIN) { E(acc, cur, wr, wc, fr, fq); S.done(cur); }
        if (!has_next) break;
#pragma unroll
        for (int a = 0; a < 2; ++a)
#pragma unroll
            for (int b = 0; b < 2; ++b)
#pragma unroll
                for (int m = 0; m < 4; ++m)
#pragma unroll
                    for (int n = 0; n < 2; ++n) acc[a][b][m][n] = (f32x4){0.f, 0.f, 0.f, 0.f};
        cur = nxt; cA = nA; cB = nB; ++ui;
        if constexpr (ALIGN_EPI) { if (wr == 1) PG8_BAR; }
    }
    PG8_WAIT_V(0);
    if constexpr (!ALIGN_EPI) { if (wr == 0) PG8_BAR; }
    PG8_BAR;
#undef PG8_SA
#undef PG8_SB
#undef PG8_STAGE
#undef PG8_LDA
#undef PG8_LDB
#undef PG8_MMA
#undef PG8_WAIT_V
#undef PG8_WAIT_L
#undef PG8_BAR
#undef PG8_SCHED
}
}

#define XB_TMO      128
#define XB_XCNT(j)  (256  + 64 * (j))
#define XB_XSUB(j)  (1280 + 64 * (j))
#define XB_XGEN(j)  (2304 + 64 * (j))
#define XB_TOP      3328
#define XB_TOPGEN   3392
#define XCD_BAR_WORDS 3456
#define XB_SPIN_CAP (1u << 21)
#define LAS __attribute__((address_space(3)))

__device__ __forceinline__ unsigned xb_ld(unsigned* p)              { return __hip_atomic_load(p, __ATOMIC_RELAXED, __HIP_MEMORY_SCOPE_AGENT); }
__device__ __forceinline__ unsigned xb_add(unsigned* p, unsigned v) { return __hip_atomic_fetch_add(p, v, __ATOMIC_RELAXED, __HIP_MEMORY_SCOPE_AGENT); }
__device__ __forceinline__ unsigned xb_xcc_id() { return (unsigned)__builtin_amdgcn_s_getreg((3 << 11) | 20) & 0xFu; }
#define XB_SPIN(cond, bar) do { unsigned _sp = 0; while (cond) { __builtin_amdgcn_s_sleep(1); \
    if ((++_sp & 255u) == 0u) { if (xb_ld(&(bar)[XB_TMO])) break; if (_sp > XB_SPIN_CAP) { atomicAdd(&(bar)[XB_TMO], 1u); break; } } } } while (0)

struct XcdBarrier { unsigned* bar; unsigned x; volatile LAS unsigned* st; };

__device__ __forceinline__ XcdBarrier xcd_barrier_post(unsigned* bar, volatile LAS unsigned* st) {
    XcdBarrier b; b.bar = bar; b.x = xb_xcc_id(); b.st = st;
    if (threadIdx.x == 0) (void)xb_add(&bar[XB_XCNT(b.x)], 1u);
    return b;
}
__device__ __forceinline__ void xcd_barrier_complete(unsigned* bar, unsigned x, unsigned& nloc, unsigned& nx) {
    const unsigned G = gridDim.x * gridDim.y * gridDim.z;
    unsigned sum, cnt, mine, sp = 0u;
    for (;;) {
        sum = 0u; cnt = 0u; mine = 0u;
#pragma unroll
        for (unsigned j = 0; j < 16; ++j) { const unsigned c = xb_ld(&bar[XB_XCNT(j)]); sum += c; cnt += (c > 0u) ? 1u : 0u; mine = (j == x) ? c : mine; }
        if (sum == G) break;
        __builtin_amdgcn_s_sleep(1);
        if ((++sp & 255u) == 0u) { if (xb_ld(&bar[XB_TMO])) break; if (sp > XB_SPIN_CAP) { atomicAdd(&bar[XB_TMO], 1u); break; } }
    }
    nloc = mine > 0u ? mine : 1u; nx = cnt > 0u ? cnt : 1u;
}
__device__ __forceinline__ void xcd_barrier(const XcdBarrier& b) {
    asm volatile("s_waitcnt vmcnt(0)" ::: "memory");
    __syncthreads();
    if (threadIdx.x == 0) {
        unsigned* bar = b.bar;
        __builtin_amdgcn_s_waitcnt(0);
        unsigned nloc = b.st[0], nx = b.st[1];
        if (nloc == 0u) { xcd_barrier_complete(bar, b.x, nloc, nx); b.st[0] = nloc; b.st[1] = nx; }
        const unsigned old = xb_add(&bar[XB_XSUB(b.x)], 1u);
        const unsigned gen = old / nloc;
        if (old + 1u == (gen + 1u) * nloc) {
            __builtin_amdgcn_fence(__ATOMIC_RELEASE, "agent");
            asm volatile("s_waitcnt vmcnt(0)" ::: "memory");
            const unsigned og = xb_add(&bar[XB_TOP], 1u);
            const unsigned tg = og / nx;
            if (og + 1u == (tg + 1u) * nx) xb_add(&bar[XB_TOPGEN], 1u);
            else XB_SPIN(xb_ld(&bar[XB_TOPGEN]) == tg, bar);
            __builtin_amdgcn_fence(__ATOMIC_ACQUIRE, "agent");
            xb_add(&bar[XB_XGEN(b.x)], 1u);
            asm volatile("s_waitcnt vmcnt(0)" ::: "memory");
        } else {
            XB_SPIN(xb_ld(&bar[XB_XGEN(b.x)]) == gen, bar);
            __builtin_amdgcn_fence(__ATOMIC_ACQUIRE, "agent");
            asm volatile("s_waitcnt vmcnt(0)" ::: "memory");
        }
    }
    __syncthreads();
}

typedef unsigned short bf16;
typedef float f32x4 __attribute__((ext_vector_type(4)));
typedef unsigned u32x4 __attribute__((ext_vector_type(4)));
typedef unsigned u32x2 __attribute__((ext_vector_type(2)));

constexpr int D = 2048, DFF = 8192, MROWS = 16384, MCTX = 8192;
constexpr int NT = 512;
constexpr float EPS = 1e-6f;
constexpr int DN_NIN = 12416, DN_NMAIN = 12288, DN_NPAD = 12544;
constexpr int GLA_NIN = 6176, GLA_NMAIN = 6144, GLA_NPAD = 6400;
constexpr int HG_NIN = 10240;
constexpr int MODW = 12288;

constexpr size_t MiB = 1u << 20;
constexpr size_t WS_CTL = 0, CTL_BYTES = 1 * MiB;
constexpr size_t WS_MOD = 1 * MiB;
constexpr size_t WS_X = 2 * MiB;
constexpr size_t WS_H = WS_X + 128 * MiB;
constexpr size_t WS_BIG = WS_H + 64 * MiB;
constexpr size_t WS_GATE = WS_BIG + 384 * MiB;
constexpr size_t WS_QKV = WS_GATE + 8 * MiB;
constexpr size_t WS_OF = WS_QKV + 256 * MiB;
constexpr size_t WS_OB = WS_OF + 128 * MiB;
constexpr size_t WS_W = WS_OB + 128 * MiB;
constexpr size_t WOFF_IN = 0, WOFF_OUT = (size_t)DN_NPAD * D * 2, WOFF_UP = WOFF_OUT + (size_t)D * 4096 * 2, WOFF_DOWN = WOFF_UP + (size_t)DFF * D * 2;
constexpr size_t WS_TA = ((WS_W + WOFF_DOWN + (size_t)D * DFF * 2 + MiB - 1) / MiB) * MiB;
constexpr size_t WS_GS = WS_TA + 256 * MiB;
constexpr size_t WS_GP = WS_GS + 12 * MiB;
constexpr size_t WS_END = WS_GP + 32 * MiB;

constexpr size_t OUT_Y = 0;
constexpr size_t OUT_SDN = (size_t)MROWS * D;
constexpr size_t OUT_SGLA = OUT_SDN + (size_t)32 * 2 * 2 * 32 * 128 * 128;
constexpr size_t OUT_SHG = OUT_SGLA + (size_t)32 * 2 * 4 * 256 * 512;
constexpr size_t OUT_END = OUT_SHG + (size_t)32 * 2 * 16 * 128 * 128;

constexpr int LDS_BYTES = 147456;
constexpr int LDS_MISC = 143360;

struct Params {
    const float* in[29];
    float* out;
    unsigned char* ws;
};

__device__ __forceinline__ float bf2f(unsigned short b) { return __uint_as_float(((unsigned)b) << 16); }
typedef __bf16 bfv2_ __attribute__((ext_vector_type(2)));
typedef float f32x2_ __attribute__((ext_vector_type(2)));
__device__ __forceinline__ unsigned f2bf(float f) { return (unsigned)__builtin_bit_cast(unsigned short, (__bf16)f); }
__device__ __forceinline__ unsigned pk2(float lo, float hi) { const f32x2_ v = {lo, hi}; return __builtin_bit_cast(unsigned, __builtin_convertvector(v, bfv2_)); }
__device__ __forceinline__ float bflo(unsigned w) { return __uint_as_float(w << 16); }
__device__ __forceinline__ float bfhi(unsigned w) { return __uint_as_float(w & 0xffff0000u); }
__device__ __forceinline__ float wave_sum(float v) {
#pragma unroll
    for (int o = 1; o < 64; o <<= 1) v += __shfl_xor(v, o);
    return v;
}
__device__ __forceinline__ float rdlane(float v, int l) { return __builtin_bit_cast(float, __builtin_amdgcn_readlane(__builtin_bit_cast(int, v), l)); }
__device__ __forceinline__ float sigmoidf_(float x) { return 1.f / (1.f + __expf(-x)); }
__device__ __forceinline__ float siluf_(float x) { return x / (1.f + __expf(-x)); }
__device__ __forceinline__ float softplusf_(float x) { return fmaxf(x, 0.f) + log1pf(__expf(-fabsf(x))); }

__device__ __forceinline__ void transpose_item(const float* W, int K, int N, bf16* WT, LAS float* scr, int item, int lane) {
    const int nblk = N / 32, kb = item / nblk, nb = item % nblk, k0 = 64 * kb, n0 = 32 * nb;
    { f32x4 v[8]; const int kr = lane >> 3, c4 = (lane & 7) * 4;
#pragma unroll
      for (int i = 0; i < 8; ++i) v[i] = __builtin_nontemporal_load((const f32x4*)(W + (size_t)(k0 + kr + 8 * i) * N + n0 + c4));
#pragma unroll
      for (int i = 0; i < 8; ++i) { LAS float* d = scr + (kr + 8 * i) * 33 + c4; d[0] = v[i].x; d[1] = v[i].y; d[2] = v[i].z; d[3] = v[i].w; } }
    asm volatile("s_waitcnt lgkmcnt(0)" ::: "memory");
    const int c = lane & 7;
#pragma unroll
    for (int j = 0; j < 4; ++j) { const int n = (lane >> 3) + 8 * j; const LAS float* s = scr + (8 * c) * 33 + n;
        u32x4 o; o.x = pk2(s[0 * 33], s[1 * 33]); o.y = pk2(s[2 * 33], s[3 * 33]); o.z = pk2(s[4 * 33], s[5 * 33]); o.w = pk2(s[6 * 33], s[7 * 33]);
        *(u32x4*)(WT + (size_t)(n0 + n) * K + k0 + 8 * c) = o; }
    asm volatile("s_waitcnt lgkmcnt(0)" ::: "memory");
}

__device__ __forceinline__ void convert_layer_weights(const Params& P, int layer, LAS unsigned char* lds) {
    PHASE_IDS();
    LAS float* scr = (LAS float*)(lds + wave * 16384);
    const int kind = layer % 3, j = layer / 3;
    const float* Win; int Nin, Npad; const float* Wout; int Kout;
    if (kind == 0) { Win = P.in[14] + (size_t)j * D * DN_NIN; Nin = DN_NIN; Npad = DN_NPAD; Wout = P.in[19] + (size_t)j * 4096 * D; Kout = 4096; }
    else if (kind == 1) { Win = P.in[20] + (size_t)j * D * GLA_NIN; Nin = GLA_NIN; Npad = GLA_NPAD; Wout = P.in[24] + (size_t)j * D * D; Kout = 2048; }
    else { Win = P.in[25] + (size_t)j * D * HG_NIN; Nin = HG_NIN; Npad = HG_NIN; Wout = P.in[28] + (size_t)j * D * D; Kout = 2048; }
    const float* Wup = P.in[12] + (size_t)layer * D * DFF; const float* Wdn = P.in[13] + (size_t)layer * DFF * D;
    bf16* Tin = (bf16*)(P.ws + WS_W + WOFF_IN); bf16* Tout = (bf16*)(P.ws + WS_W + WOFF_OUT); bf16* Tup = (bf16*)(P.ws + WS_W + WOFF_UP); bf16* Tdn = (bf16*)(P.ws + WS_W + WOFF_DOWN);
    const int I_in = (D / 64) * (Nin / 32), I_out = (Kout / 64) * (D / 32), I_up = (D / 64) * (DFF / 32), I_dn = (DFF / 64) * (D / 32);
    const int NI = I_in + I_out + I_up + I_dn;
    for (int it = gw; it < NI; it += NGW) {
        int r = it;
        if (r < I_in) { transpose_item(Win, D, Nin, Tin, scr, r, lane); continue; } r -= I_in;
        if (r < I_out) { transpose_item(Wout, Kout, D, Tout, scr, r, lane); continue; } r -= I_out;
        if (r < I_up) { transpose_item(Wup, D, DFF, Tup, scr, r, lane); continue; } r -= I_up;
        transpose_item(Wdn, DFF, D, Tdn, scr, r, lane);
    }
    const int npadrows = Npad - Nin;
    if (npadrows > 0) {
        u32x4* z = (u32x4*)(Tin + (size_t)Nin * D); const int n16 = npadrows * D / 8;
        for (int i = gw * 64 + lane; i < n16; i += NGW * 64) z[i] = (u32x4){0u, 0u, 0u, 0u};
    }
}

__device__ __forceinline__ void mod_phase(const Params& P, LAS unsigned char* lds) {
    PHASE_IDS();
    LAS float* scond = (LAS float*)lds;
    LAS float* red = (LAS float*)(lds + 40960 + 1024);
    for (int i = tid; i < 5 * 2048; i += NT) { const int g = i / 2048, k = i % 2048; const float v = g == 0 ? P.in[6][k] : P.in[2][(g - 1) * 2048 + k]; scond[k * 5 + g] = siluf_(v); }
    __syncthreads();
    float* mod = (float*)(P.ws + WS_MOD);
    const int c4 = tid & 15, kg = tid >> 4;
    for (int cg = blockIdx.x; cg < 4 * MODW / 64; cg += gridDim.x) {
        const int layer = cg / (MODW / 64), colbase = (cg % (MODW / 64)) * 64;
        const float* W = P.in[7] + (size_t)layer * D * MODW + colbase + c4 * 4;
        f32x4 acc[5];
#pragma unroll
        for (int g = 0; g < 5; ++g) acc[g] = (f32x4){0.f, 0.f, 0.f, 0.f};
#pragma unroll 8
        for (int kk = 0; kk < 64; ++kk) {
            const int k = kg * 64 + kk;
            const f32x4 w = __builtin_nontemporal_load((const f32x4*)(W + (size_t)k * MODW));
#pragma unroll
            for (int g = 0; g < 5; ++g) acc[g] += w * scond[k * 5 + g];
        }
#pragma unroll
        for (int g = 0; g < 5; ++g)
#pragma unroll
            for (int e = 0; e < 4; ++e) red[(kg * 64 + c4 * 4 + e) * 5 + g] = acc[g][e];
        __syncthreads();
        if (tid < 64 * 5) { const int c = tid / 5, g = tid % 5; float sum = 0.f;
#pragma unroll 8
            for (int q = 0; q < 32; ++q) sum += red[(q * 64 + c) * 5 + g];
            mod[((size_t)layer * 5 + g) * MODW + colbase + c] = sum + P.in[8][(size_t)layer * MODW + colbase + c]; }
        __syncthreads();
    }
}

template <bool XF32> __device__ __forceinline__ void norm_mod_phase(const void* xc, const void* xl, const float* w, const float* mod, int sh_off, int sc_off, bf16* H) {
    PHASE_IDS();
    for (int m = gw; m < MROWS; m += NGW) {
        const bool ctx = m < MCTX; const int grp = ctx ? 0 : 1 + ((m - MCTX) >> 11);
        f32x4 v[8]; float ss = 0.f;
        if (XF32) { const float* xr = ctx ? (const float*)xc + (size_t)m * D : (const float*)xl + (size_t)(m - MCTX) * D;
#pragma unroll
            for (int jx = 0; jx < 4; ++jx) { v[2 * jx] = *(const f32x4*)(xr + 8 * (lane + 64 * jx)); v[2 * jx + 1] = *(const f32x4*)(xr + 8 * (lane + 64 * jx) + 4); } }
        else { const bf16* xr = (const bf16*)xc + (size_t)m * D;
#pragma unroll
            for (int jx = 0; jx < 4; ++jx) { const u32x4 q = *(const u32x4*)(xr + 8 * (lane + 64 * jx));
                v[2 * jx] = (f32x4){bflo(q.x), bfhi(q.x), bflo(q.y), bfhi(q.y)}; v[2 * jx + 1] = (f32x4){bflo(q.z), bfhi(q.z), bflo(q.w), bfhi(q.w)}; } }
#pragma unroll
        for (int i = 0; i < 8; ++i) ss += (v[i].x * v[i].x + v[i].y * v[i].y) + (v[i].z * v[i].z + v[i].w * v[i].w);
        const float rstd = rsqrtf(wave_sum(ss) * (1.f / D) + EPS);
        const float* mg = mod + (size_t)grp * MODW;
#pragma unroll
        for (int jx = 0; jx < 4; ++jx) { const int c = 8 * (lane + 64 * jx);
            const f32x4 y0 = v[2 * jx] * rstd * *(const f32x4*)(w + c) * (*(const f32x4*)(mg + sc_off + c) + 1.f) + *(const f32x4*)(mg + sh_off + c);
            const f32x4 y1 = v[2 * jx + 1] * rstd * *(const f32x4*)(w + c + 4) * (*(const f32x4*)(mg + sc_off + c + 4) + 1.f) + *(const f32x4*)(mg + sh_off + c + 4);
            u32x4 o; o.x = pk2(y0.x, y0.y); o.y = pk2(y0.z, y0.w); o.z = pk2(y1.x, y1.y); o.w = pk2(y1.z, y1.w);
            *(u32x4*)(H + (size_t)m * D + c) = o; }
    }
}
__device__ __forceinline__ void final_norm_phase(const bf16* X, const float* w, float* out) {
    PHASE_IDS();
    for (int m = gw; m < MROWS; m += NGW) {
        f32x4 v[8]; float ss = 0.f;
#pragma unroll
        for (int jx = 0; jx < 4; ++jx) { const u32x4 q = *(const u32x4*)(X + (size_t)m * D + 8 * (lane + 64 * jx));
            v[2 * jx] = (f32x4){bflo(q.x), bfhi(q.x), bflo(q.y), bfhi(q.y)}; v[2 * jx + 1] = (f32x4){bflo(q.z), bfhi(q.z), bflo(q.w), bfhi(q.w)}; }
#pragma unroll
        for (int i = 0; i < 8; ++i) ss += (v[i].x * v[i].x + v[i].y * v[i].y) + (v[i].z * v[i].z + v[i].w * v[i].w);
        const float rstd = rsqrtf(wave_sum(ss) * (1.f / D) + EPS);
#pragma unroll
        for (int jx = 0; jx < 4; ++jx) { const int c = 8 * (lane + 64 * jx);
            __builtin_nontemporal_store(v[2 * jx] * rstd * *(const f32x4*)(w + c), (f32x4*)(out + (size_t)m * D + c)); __builtin_nontemporal_store(v[2 * jx + 1] * rstd * *(const f32x4*)(w + c + 4), (f32x4*)(out + (size_t)m * D + c + 4)); }
    }
}

template <int DV> __device__ __forceinline__ void gate_phase(const bf16* OF, const bf16* OB, const bf16* proj, int ldp, int gcol0, const float* nw, bf16* Y, int W) {
    PHASE_IDS();
    const int ncg = W / 512;
    const int nitems = MROWS * ncg;
    for (int it0 = gw; it0 < nitems; it0 += 2 * NGW) {
        u32x4 a[2], b[2], gz[2]; int mm[2], cc[2]; bool ok[2];
#pragma unroll
        for (int u = 0; u < 2; ++u) { const int it = it0 + u * NGW; ok[u] = it < nitems; const int itc = ok[u] ? it : it0; mm[u] = itc / ncg; cc[u] = (itc % ncg) * 512 + lane * 8;
            a[u] = *(const u32x4*)(OF + (size_t)mm[u] * W + cc[u]); b[u] = *(const u32x4*)(OB + (size_t)mm[u] * W + cc[u]); gz[u] = *(const u32x4*)(proj + (size_t)mm[u] * ldp + gcol0 + cc[u]); }
#pragma unroll
        for (int u = 0; u < 2; ++u) {
            float o[8], z[8];
            o[0] = bflo(a[u].x) + bflo(b[u].x); o[1] = bfhi(a[u].x) + bfhi(b[u].x); o[2] = bflo(a[u].y) + bflo(b[u].y); o[3] = bfhi(a[u].y) + bfhi(b[u].y);
            o[4] = bflo(a[u].z) + bflo(b[u].z); o[5] = bfhi(a[u].z) + bfhi(b[u].z); o[6] = bflo(a[u].w) + bflo(b[u].w); o[7] = bfhi(a[u].w) + bfhi(b[u].w);
            z[0] = bflo(gz[u].x); z[1] = bfhi(gz[u].x); z[2] = bflo(gz[u].y); z[3] = bfhi(gz[u].y); z[4] = bflo(gz[u].z); z[5] = bfhi(gz[u].z); z[6] = bflo(gz[u].w); z[7] = bfhi(gz[u].w);
            float ss = 0.f;
#pragma unroll
            for (int i = 0; i < 8; ++i) ss += o[i] * o[i];
#pragma unroll
            for (int sft = 1; sft < DV / 8; sft <<= 1) ss += __shfl_xor(ss, sft);
            const float rstd = rsqrtf(ss * (1.f / DV) + EPS);
            const int cw = cc[u] % DV;
            const f32x4 w0 = *(const f32x4*)(nw + cw), w1 = *(const f32x4*)(nw + cw + 4);
            const float wv[8] = {w0.x, w0.y, w0.z, w0.w, w1.x, w1.y, w1.z, w1.w};
            float y[8];
#pragma unroll
            for (int i = 0; i < 8; ++i) y[i] = o[i] * rstd * wv[i] * siluf_(z[i]);
            u32x4 rr; rr.x = pk2(y[0], y[1]); rr.y = pk2(y[2], y[3]); rr.z = pk2(y[4], y[5]); rr.w = pk2(y[6], y[7]);
            if (ok[u]) *(u32x4*)(Y + (size_t)mm[u] * W + cc[u]) = rr;
        }
    }
}

__device__ __forceinline__ void dn_prep_phase(const Params& P, int j, bool do_gates = true) {
    PHASE_IDS();
    const bf16* proj = (const bf16*)(P.ws + WS_BIG); bf16* QKV = (bf16*)(P.ws + WS_QKV);
    const float* cw = P.in[15] + (size_t)j * 5 * 8192;
    for (int it = gw; it < 16 * 128; it += NGW) {
        const int cg = it & 15, chunk = it >> 4, c = cg * 512 + lane * 8;
        float w[5][8];
#pragma unroll
        for (int s = 0; s < 5; ++s) { const f32x4 a = *(const f32x4*)(cw + s * 8192 + c), b = *(const f32x4*)(cw + s * 8192 + c + 4);
            w[s][0] = a.x; w[s][1] = a.y; w[s][2] = a.z; w[s][3] = a.w; w[s][4] = b.x; w[s][5] = b.y; w[s][6] = b.z; w[s][7] = b.w; }
        const float qsc = cg < 4 ? 0.08838834764831845f : 1.f;
        for (int bt = 0; bt < 16; ++bt) {
            const int r0 = chunk * 128 + bt * 8;
            const int L = r0 < MCTX ? 256 : 64, pos0 = r0 < MCTX ? (r0 & 255) : ((r0 - MCTX) & 63);
            u32x4 xw[12];
#pragma unroll
            for (int i = 0; i < 12; ++i) { const int pp = pos0 + i - 2;
                xw[i] = (pp >= 0 && pp < L) ? *(const u32x4*)(proj + (size_t)(r0 + i - 2) * DN_NMAIN + c) : (u32x4){0u, 0u, 0u, 0u}; }
#pragma unroll
            for (int o = 0; o < 8; ++o) {
                float acc[8];
#pragma unroll
                for (int i = 0; i < 8; ++i) acc[i] = 0.f;
#pragma unroll
                for (int s = 0; s < 5; ++s) { const u32x4 x = xw[o + s];
                    acc[0] += bflo(x.x) * w[s][0]; acc[1] += bfhi(x.x) * w[s][1]; acc[2] += bflo(x.y) * w[s][2]; acc[3] += bfhi(x.y) * w[s][3];
                    acc[4] += bflo(x.z) * w[s][4]; acc[5] += bfhi(x.z) * w[s][5]; acc[6] += bflo(x.w) * w[s][6]; acc[7] += bfhi(x.w) * w[s][7]; }
                float ss = 0.f;
#pragma unroll
                for (int i = 0; i < 8; ++i) { acc[i] = siluf_(acc[i]); ss += acc[i] * acc[i]; }
                if (cg < 8) {
                    ss += __shfl_xor(ss, 1); ss += __shfl_xor(ss, 2); ss += __shfl_xor(ss, 4); ss += __shfl_xor(ss, 8);
                    const float sc = rsqrtf(ss + EPS) * qsc;
#pragma unroll
                    for (int i = 0; i < 8; ++i) acc[i] *= sc;
                }
                u32x4 ov; ov.x = pk2(acc[0], acc[1]); ov.y = pk2(acc[2], acc[3]); ov.z = pk2(acc[4], acc[5]); ov.w = pk2(acc[6], acc[7]);
                *(u32x4*)(QKV + (size_t)(r0 + o) * 8192 + c) = ov;
            }
        }
    }
    if (!do_gates) return;
    float* G = (float*)(P.ws + WS_GATE);
    const float* Alog = P.in[16] + j * 64; const float* dtb = P.in[17] + j * 64;
    const float* GPp = (const float*)(P.ws + WS_GP);
    for (int i = gw * 64 + lane; i < MROWS * 128; i += NGW * 64) {
        const int col = i & 127; const float x = (GPp[i] + GPp[i + (size_t)MROWS * 128]) + (GPp[i + (size_t)2 * MROWS * 128] + GPp[i + (size_t)3 * MROWS * 128]); float y;
        if (col < 64) y = sigmoidf_(x);
        else { const int dh = col - 64; y = -__expf(Alog[dh]) * softplusf_(x + dtb[dh]); }
        G[i] = y;
    }
}

typedef short bf16x8 __attribute__((ext_vector_type(8)));
typedef short s16x4 __attribute__((ext_vector_type(4)));
typedef __bf16 bfv8 __attribute__((ext_vector_type(8)));
typedef float f32x8 __attribute__((ext_vector_type(8)));
__device__ __forceinline__ bf16x8 pack8(f32x4 a, f32x4 b) { const f32x8 v = {a[0], a[1], a[2], a[3], b[0], b[1], b[2], b[3]}; return __builtin_bit_cast(bf16x8, __builtin_convertvector(v, bfv8)); }
__device__ __forceinline__ bf16x8 cat4(s16x4 a, s16x4 b) { return (bf16x8){a[0], a[1], a[2], a[3], b[0], b[1], b[2], b[3]}; }
__device__ __forceinline__ s16x4 ld_tr(const LAS unsigned char* p) { return __builtin_amdgcn_ds_read_tr16_b64_v4i16((LAS s16x4*)p); }
__device__ __forceinline__ s16x4 ld_b64(const LAS unsigned char* p) { return *(const LAS s16x4*)p; }
__device__ __forceinline__ bf16x8 ld_b128(const LAS unsigned char* p) { return *(const LAS bf16x8*)p; }
#define MFMA16(a, b, c) __builtin_amdgcn_mfma_f32_16x16x32_bf16((a), (b), (c), 0, 0, 0)

template <int KIND> __device__ __forceinline__ void gla_prep_phase(const Params& P, LAS unsigned char* lds) {
    PHASE_IDS();
    constexpr int NCH = KIND == 1 ? 1024 : 2048, LDP = KIND == 1 ? GLA_NMAIN : HG_NIN, NCB = NCH / 1024;
    const bf16* proj = (const bf16*)(P.ws + WS_BIG); const float* G = (const float*)(P.ws + WS_GATE);
    bf16* QT = (bf16*)(P.ws + WS_QKV); bf16* KT = QT + (size_t)2 * MROWS * NCH; float* E = (float*)(P.ws + WS_OF + 64 * MiB);
    constexpr int DKH = KIND == 1 ? 256 : 128, NHB = 1024 / DKH  , NHT = NCH / DKH  , PL = 2064  ;
    LAS unsigned char* QL = lds; LAS unsigned char* KL = lds + 32 * PL;
    LAS float* sa1 = (LAS float*)(lds + 2 * 32 * PL);
    unsigned* PG = (unsigned*)(P.ws + WS_OF + 72 * MiB);
    for (int it = blockIdx.x; it < 2 * 512 * NCB; it += gridDim.x) {
        const int cb_ = it % NCB, cidx = (it / NCB) % 512, d = it / (NCB * 512);
        const int c0 = cb_ * 1024 + 2 * tid, rbase = cidx * 32;
        float w0[16], w1[16], b0 = 0.f, b1 = 0.f, lb0 = 0.f, lb1 = 0.f;
        if (KIND == 1) {
            __syncthreads();
            { const int p = tid >> 4, r = tid & 15; const int row = rbase + (d ? 31 - p : p); const size_t gi = (size_t)row * 128 + d * 16 + r; const float* GPp = (const float*)(P.ws + WS_GP); sa1[tid] = (GPp[gi] + GPp[gi + (size_t)MROWS * 128]) + (GPp[gi + (size_t)2 * MROWS * 128] + GPp[gi + (size_t)3 * MROWS * 128]); }
            __syncthreads();
            const float* w2 = P.in[21] + (size_t)d * 16 * 1024 + c0;
#pragma unroll
            for (int r = 0; r < 16; ++r) { w0[r] = w2[(size_t)r * 1024]; w1[r] = w2[(size_t)r * 1024 + 1]; }
            b0 = P.in[22][d * 1024 + c0]; b1 = P.in[22][d * 1024 + c0 + 1];
        } else {
            const float* lg = P.in[26];
            { const float l0 = lg[c0], l1 = lg[2048 + c0], l2 = lg[4096 + c0], l3 = lg[6144 + c0]; const float mx = fmaxf(fmaxf(l0, l1), fmaxf(l2, l3));
              const float e0 = __expf(l0 - mx), e1 = __expf(l1 - mx), e2 = __expf(l2 - mx), e3 = __expf(l3 - mx); lb0 = (e1 + e2) / ((e0 + e1) + (e2 + e3)); }
            { const float l0 = lg[c0 + 1], l1 = lg[2048 + c0 + 1], l2 = lg[4096 + c0 + 1], l3 = lg[6144 + c0 + 1]; const float mx = fmaxf(fmaxf(l0, l1), fmaxf(l2, l3));
              const float e0 = __expf(l0 - mx), e1 = __expf(l1 - mx), e2 = __expf(l2 - mx), e3 = __expf(l3 - mx); lb1 = (e1 + e2) / ((e0 + e1) + (e2 + e3)); }
        }
        float cs0 = KIND == 1 ? 0.f : 1.f, cs1 = cs0;
#pragma unroll 8
        for (int p = 0; p < 32; ++p) {
            const int row = rbase + (d ? 31 - p : p); const bf16* pr = proj + (size_t)row * LDP;
            float q0, q1, k0, k1, la0, la1;
            if (KIND == 1) {
                const unsigned qw = *(const unsigned*)(pr + c0), kw = *(const unsigned*)(pr + 1024 + c0);
                q0 = bflo(qw) * 0.0625f; q1 = bfhi(qw) * 0.0625f; k0 = bflo(kw); k1 = bfhi(kw);
                float x0 = b0, x1 = b1;
#pragma unroll
                for (int r = 0; r < 16; ++r) { const float a = sa1[p * 16 + r]; x0 += a * w0[r]; x1 += a * w1[r]; }
                la0 = (fminf(x0, 0.f) - __logf(1.f + __expf(-fabsf(x0)))) * 0.0625f; la1 = (fminf(x1, 0.f) - __logf(1.f + __expf(-fabsf(x1)))) * 0.0625f;
            } else {
                const unsigned qw = *(const unsigned*)(pr + c0), fw = *(const unsigned*)(pr + (d ? 8192 : 6144) + c0);
                q0 = siluf_(bflo(qw)) * 0.08838834764831845f; q1 = siluf_(bfhi(qw)) * 0.08838834764831845f;
                const float a0 = lb0 + (1.f - lb0) * sigmoidf_(bflo(fw)), a1 = lb1 + (1.f - lb1) * sigmoidf_(bfhi(fw));
                k0 = 1.f - a0; k1 = 1.f - a1; la0 = a0; la1 = a1;
            }
            float e0, e1, i0, i1;
            if (KIND == 1) { cs0 += la0; cs1 += la1; e0 = __expf(cs0); e1 = __expf(cs1); i0 = __expf(-cs0); i1 = __expf(-cs1); }
            else { cs0 *= la0; cs1 *= la1; e0 = cs0; e1 = cs1; i0 = __builtin_amdgcn_rcpf(cs0); i1 = __builtin_amdgcn_rcpf(cs1); }
            const size_t o = ((size_t)d * MROWS + row) * NCH + c0;
            const unsigned qb = pk2(q0 * e0, q1 * e1), kb = pk2(k0 * i0, k1 * i1);
            *(unsigned*)(QT + o) = qb; *(unsigned*)(KT + o) = kb;
            *(LAS unsigned*)(QL + p * PL + 4 * tid) = qb; *(LAS unsigned*)(KL + p * PL + 4 * tid) = kb;
        }
        { float* e = E + ((size_t)d * 512 + cidx) * NCH + c0; e[0] = KIND == 1 ? __expf(cs0) : cs0; e[1] = KIND == 1 ? __expf(cs1) : cs1; }
        __syncthreads();
        {
            const int r = lane & 15, g = lane >> 4;
            const int hl = KIND == 1 ? (wave >> 1) : wave; const int cbase = hl * DKH;
            f32x4 t0 = {0.f, 0.f, 0.f, 0.f}, t1 = t0, t2 = t0;
            const bool do02 = KIND == 1 ? ((wave & 1) == 0) : true, do1 = KIND == 1 ? ((wave & 1) == 1) : true;
#pragma unroll
            for (int sx = 0; sx < DKH / 32; ++sx) {
                const int cb2 = (cbase + 32 * sx + 8 * g) * 2;
                const bf16x8 k0 = ld_b128(KL + r * PL + cb2), q1 = ld_b128(QL + (16 + r) * PL + cb2);
                if (do02) { const bf16x8 q0 = ld_b128(QL + r * PL + cb2), k1 = ld_b128(KL + (16 + r) * PL + cb2); t0 = MFMA16(k0, q0, t0); t2 = MFMA16(k1, q1, t2); }
                if (do1) t1 = MFMA16(k0, q1, t1);
            }
#pragma unroll
            for (int e = 0; e < 4; ++e) { if (r < 4 * g + e) { t0[e] = 0.f; t2[e] = 0.f; } }
            unsigned* pg = PG + (((size_t)d * 512 + cidx) * NHT + cb_ * NHB + hl) * 384 + lane * 2;
            if (do02) { pg[0] = pk2(t0[0], t0[1]); pg[1] = pk2(t0[2], t0[3]); pg[256] = pk2(t2[0], t2[1]); pg[257] = pk2(t2[2], t2[3]); }
            if (do1) { pg[128] = pk2(t1[0], t1[1]); pg[129] = pk2(t1[2], t1[3]); }
        }
        __syncthreads();
    }
}

template <int KIND> __device__ __forceinline__ void gla_chunk_phase(const Params& P, LAS unsigned char* lds) {
    PHASE_IDS();
    constexpr int DK = KIND == 1 ? 256 : 128, DV = KIND == 1 ? 512 : 128, NH = KIND == 1 ? 4 : 16, NSL = DV / 128, NKT = DK / 16, NCH = NH * DK;
    constexpr int LDP = KIND == 1 ? GLA_NMAIN : HG_NIN, W = 2048;
    constexpr int PQ = DK * 2 + 16, PV = 256 + 16;
    constexpr int OFF_Q = 0, OFF_K = 32 * PQ, OFF_V = 2 * 32 * PQ, OFF_E = OFF_V + 32 * PV;
    constexpr int NPQ = 32 * DK / 8 / NT;
    const bf16* proj = (const bf16*)(P.ws + WS_BIG);
    const bf16* QT = (const bf16*)(P.ws + WS_QKV); const bf16* KT = QT + (size_t)2 * MROWS * NCH; const float* Eg = (const float*)(P.ws + WS_OF + 64 * MiB);
    bf16* OF = (bf16*)(P.ws + WS_OF); bf16* OB = (bf16*)(P.ws + WS_OB);
    const u32x2* PG = (const u32x2*)(P.ws + WS_OF + 72 * MiB);
    const int r = lane & 15, g = lane >> 4, q4 = (lane & 15) >> 2, p4 = lane & 3;
    constexpr int UL = 4 * NH * 2 * NSL  , UC = 32 * NH * 2 * NSL  ;
    const int G = gridDim.x, bx = blockIdx.x;
    const bool bal = (G == 2 * UL);
    const int nun = bal ? (bx < UL ? 1 : UC / UL) : (UL + UC - bx + G - 1) / G;
    for (int ui = 0; ui < nun; ++ui) {
        const int bxl = bx < UL ? bx : bx - UL;
        const int bxq = (bal && NSL == 4) ? (((bxl & 7) + 8 * (bxl >> 5)) * 4 + ((bxl >> 3) & 3)) : bxl;
        const int unit = bal ? (bx < UL ? bxq : UL + bxq + UL * ui) : bx + ui * G;
        const bool lat = unit < UL; int u2 = lat ? unit : unit - UL;
        const int sl = u2 % NSL; u2 /= NSL; const int d = u2 & 1; u2 >>= 1; const int h = u2 % NH; const int b = u2 / NH;
        const int T = lat ? 2048 : 256, row0 = lat ? MCTX + b * 2048 : b * 256, nchunk = T / 32;
        bf16* O = d ? OB : OF;
        f32x4 S[NKT];
        { const float* s0 = (KIND == 1 ? P.in[4] : P.in[5]) + ((((size_t)b * 2 + d) * NH + h) * DK) * DV + sl * 128 + 16 * wave + r;
#pragma unroll
          for (int kt = 0; kt < NKT; ++kt)
#pragma unroll
              for (int e = 0; e < 4; ++e) S[kt][e] = lat ? s0[(size_t)(16 * kt + 4 * g + e) * DV] : 0.f; }
        u32x4 rq[NPQ], rk[NPQ], rv; f32x4 re = {0.f, 0.f, 0.f, 0.f}; u32x2 rp0 = {0u, 0u}, rp1 = rp0, rp2 = rp0;
#define GLC_PREFETCH(c_) do { \
            _Pragma("unroll") for (int x = 0; x < NPQ; ++x) { const int pi = tid + x * NT, pr = pi / (DK / 8), pc = pi % (DK / 8); const int pp = (c_) * 32 + pr; const int t = d ? T - 1 - pp : pp; \
                const size_t o = ((size_t)d * MROWS + row0 + t) * NCH + h * DK + pc * 8; rq[x] = *(const u32x4*)(QT + o); rk[x] = *(const u32x4*)(KT + o); } \
            { const int pr = tid >> 4, pc = tid & 15; const int pp = (c_) * 32 + pr; const int t = d ? T - 1 - pp : pp; rv = *(const u32x4*)(proj + (size_t)(row0 + t) * LDP + 2048 + h * DV + sl * 128 + pc * 8); } \
            { const int cg = d ? (row0 + T) / 32 - 1 - (c_) : row0 / 32 + (c_); if (tid < DK / 4) re = *(const f32x4*)(Eg + ((size_t)d * 512 + cg) * NCH + h * DK + tid * 4); \
              const u32x2* pg = PG + (((size_t)d * 512 + cg) * NH + h) * 192 + lane; rp0 = pg[0]; rp1 = pg[64]; rp2 = pg[128]; } } while (0)
        GLC_PREFETCH(0);
        for (int c = 0; c < nchunk; ++c) {
            __syncthreads();
#pragma unroll
            for (int x = 0; x < NPQ; ++x) { const int pi = tid + x * NT, pr = pi / (DK / 8), pc = pi % (DK / 8);
                *(LAS u32x4*)(lds + OFF_Q + pr * PQ + pc * 16) = rq[x]; *(LAS u32x4*)(lds + OFF_K + pr * PQ + pc * 16) = rk[x]; }
            { const int pr = tid >> 4, pc = tid & 15; *(LAS u32x4*)(lds + OFF_V + pr * PV + pc * 16) = rv; }
            if (tid < DK / 4) *(LAS f32x4*)(lds + OFF_E + tid * 16) = re;
            __syncthreads();
            const u32x2 cp0 = rp0, cp1 = rp1, cp2 = rp2;
            if (c + 1 < nchunk) GLC_PREFETCH(c + 1);
            const f32x4 zero4 = {0.f, 0.f, 0.f, 0.f};
            const bf16x8 vpa = cat4(ld_tr(lds + OFF_V + (4 * g + q4) * PV + (16 * wave + 4 * p4) * 2), ld_tr(lds + OFF_V + (16 + 4 * g + q4) * PV + (16 * wave + 4 * p4) * 2));
            const bf16x8 pb0 = __builtin_bit_cast(bf16x8, (u32x4){cp0.x, cp0.y, 0u, 0u}), pb1 = __builtin_bit_cast(bf16x8, (u32x4){cp1.x, cp1.y, cp2.x, cp2.y});
            f32x4 o0 = MFMA16(vpa, pb0, zero4), o1 = MFMA16(vpa, pb1, zero4);
#pragma unroll
            for (int s = 0; s < DK / 32; ++s) {
                const bf16x8 sb = pack8(S[2 * s], S[2 * s + 1]);
                const bf16x8 a0 = cat4(ld_b64(lds + OFF_Q + r * PQ + (32 * s + 4 * g) * 2), ld_b64(lds + OFF_Q + r * PQ + (32 * s + 16 + 4 * g) * 2));
                const bf16x8 a1 = cat4(ld_b64(lds + OFF_Q + (16 + r) * PQ + (32 * s + 4 * g) * 2), ld_b64(lds + OFF_Q + (16 + r) * PQ + (32 * s + 16 + 4 * g) * 2));
                o0 = MFMA16(sb, a0, o0); o1 = MFMA16(sb, a1, o1);
                if (KIND == 1 && (s & 3) == 3) asm volatile("" ::: "memory");
            }
            { const int colo = h * DV + sl * 128 + 16 * wave + 4 * g; const int pp0 = c * 32 + r, pp1 = c * 32 + 16 + r; const int t0 = d ? T - 1 - pp0 : pp0, t1 = d ? T - 1 - pp1 : pp1;
              u32x2 w0, w1; w0.x = pk2(o0[0], o0[1]); w0.y = pk2(o0[2], o0[3]); w1.x = pk2(o1[0], o1[1]); w1.y = pk2(o1[2], o1[3]);
              *(u32x2*)(O + (size_t)(row0 + t0) * W + colo) = w0; *(u32x2*)(O + (size_t)(row0 + t1) * W + colo) = w1; }
            const bf16x8 vb = cat4(ld_tr(lds + OFF_V + (8 * g + q4) * PV + (16 * wave + 4 * p4) * 2), ld_tr(lds + OFF_V + (8 * g + 4 + q4) * PV + (16 * wave + 4 * p4) * 2));
#pragma unroll
            for (int kt = 0; kt < NKT; ++kt) {
                const bf16x8 ka = cat4(ld_tr(lds + OFF_K + (8 * g + q4) * PQ + (16 * kt + 4 * p4) * 2), ld_tr(lds + OFF_K + (8 * g + 4 + q4) * PQ + (16 * kt + 4 * p4) * 2));
                const f32x4 ev = *(const LAS f32x4*)(lds + OFF_E + (16 * kt + 4 * g) * 4);
                S[kt] = MFMA16(ka, vb, S[kt]) * ev;
                if (KIND == 1 && (kt & 7) == 7) asm volatile("" ::: "memory");
            }
        }
#undef GLC_PREFETCH
        if (!lat) { float* sd = P.out + (KIND == 1 ? OUT_SGLA : OUT_SHG) + ((((size_t)b * 2 + d) * NH + h) * DK) * DV + sl * 128 + 16 * wave + r;
#pragma unroll
            for (int kt = 0; kt < NKT; ++kt)
#pragma unroll
                for (int e = 0; e < 4; ++e) __builtin_nontemporal_store(S[kt][e], sd + (size_t)(16 * kt + 4 * g + e) * DV); }
    }
}

#define MFMA4F(a, b, c) __builtin_amdgcn_mfma_f32_16x16x4f32((a), (b), (c), 0, 0, 0)
template <int I> __device__ __forceinline__ float row_share(float v) { return __builtin_bit_cast(float, __builtin_amdgcn_update_dpp(0, __builtin_bit_cast(int, v), 0x150 + I, 0xf, 0xf, false)); }
template <int I> struct DiagStep {
    static __device__ __forceinline__ void run(const float (&Ld)[16], float (&x)[16], int cc) {
        DiagStep<I - 1>::run(Ld, x, cc);
        float a0 = (I == cc) ? 1.f : 0.f, a1 = 0.f;
#pragma unroll
        for (int m = 0; m < I; ++m) { const float lv = row_share<I>(Ld[m]); if (m & 1) a1 -= lv * x[m]; else a0 -= lv * x[m]; }
        x[I] = a0 + a1;
    }
};
template <> struct DiagStep<-1> { static __device__ __forceinline__ void run(const float (&)[16], float (&)[16], int) {} };
__device__ __forceinline__ void dn_wu_prep_phase(const Params& P, LAS unsigned char* lds) {
    PHASE_IDS();
    constexpr int PKQ = 272;
    constexpr int LP = 68;
    constexpr int OFF_K = 0, OFF_Q = 64 * PKQ, OFF_L = 0  , OFF_KK = 4 * 64 * LP * 4, OFF_QK = OFF_KK + 64 * LP * 4, OFF_G = OFF_QK + 64 * LP * 4;
    const bf16* QKV = (const bf16*)(P.ws + WS_QKV); const float* G = (const float*)(P.ws + WS_GATE);
    bf16* TA = (bf16*)(P.ws + WS_TA); float* GS = (float*)(P.ws + WS_GS);
    const int r = lane & 15, g = lane >> 4;
    LAS float* KKs = (LAS float*)(lds + OFF_KK); LAS float* QKs = (LAS float*)(lds + OFF_QK); LAS float* Gs = (LAS float*)(lds + OFF_G);
    u32x4 pq[2], pk[2]; float pgv = 0.f;
#define WU_PREFETCH(grp_) do { const int cidx_ = (grp_) >> 4, kh_ = (grp_) & 15, rb_ = cidx_ * 64; \
        _Pragma("unroll") for (int x = 0; x < 2; ++x) { const int pi = tid + x * NT, pr = pi >> 4, pc = pi & 15; const size_t o = (size_t)(rb_ + pr) * 8192 + kh_ * 128 + pc * 8; pq[x] = *(const u32x4*)(QKV + o); pk[x] = *(const u32x4*)(QKV + o + 2048); } \
        { const int c4 = tid >> 7, which = (tid >> 6) & 1, i = tid & 63, hv = c4 >> 1, d = c4 & 1, h = 2 * kh_ + hv; pgv = G[(size_t)(rb_ + i) * 128 + (which ? 0 : 64) + d * 32 + h]; } } while (0)
    if ((int)blockIdx.x < 256 * 16) WU_PREFETCH(blockIdx.x);
    for (int grp = blockIdx.x; grp < 256 * 16; grp += gridDim.x) {
        const int cidx = grp >> 4, kh = grp & 15;
        __syncthreads();
#pragma unroll
        for (int x = 0; x < 2; ++x) { const int pi = tid + x * NT, pr = pi >> 4, pc = pi & 15;
            *(LAS u32x4*)(lds + OFF_Q + pr * PKQ + pc * 16) = pq[x]; *(LAS u32x4*)(lds + OFF_K + pr * PKQ + pc * 16) = pk[x]; }
        Gs[tid] = pgv;
        __syncthreads();
        if (grp + (int)gridDim.x < 256 * 16) WU_PREFETCH(grp + (int)gridDim.x);
        {
            const int it = wave & 3; const int offx = (wave >> 2) ? OFF_Q : OFF_K; LAS float* dst = (wave >> 2) ? QKs : KKs;
            f32x4 acc[4];
#pragma unroll
            for (int jt = 0; jt < 4; ++jt) acc[jt] = (f32x4){0.f, 0.f, 0.f, 0.f};
#pragma unroll
            for (int sx = 0; sx < 4; ++sx) { const bf16x8 a = ld_b128(lds + offx + (16 * it + r) * PKQ + (32 * sx + 8 * g) * 2);
#pragma unroll
                for (int jt = 0; jt < 4; ++jt) acc[jt] = MFMA16(a, ld_b128(lds + OFF_K + (16 * jt + r) * PKQ + (32 * sx + 8 * g) * 2), acc[jt]); }
#pragma unroll
            for (int jt = 0; jt < 4; ++jt)
#pragma unroll
                for (int e = 0; e < 4; ++e) dst[(16 * it + 4 * g + e) * LP + 16 * jt + r] = acc[jt][e];
        }
        __syncthreads();
        {
            const int c4 = wave & 3, hv = c4 >> 1, d = c4 & 1, h = 2 * kh + hv;
            const int nl = d ? 63 - lane : lane;
            float gcv = Gs[(c4 * 2 + 0) * 64 + nl];
#pragma unroll
            for (int o = 1; o < 64; o <<= 1) { const float t = __shfl_up(gcv, o); if (lane >= o) gcv += t; }
            const float betav = Gs[(c4 * 2 + 1) * 64 + nl];
            const size_t item = ((size_t)(cidx * 32 + h) * 2 + d);
            if (wave >= 4) {
                bf16* Ag = TA + item * 8192 + 4096;
                for (int p = 0; p < 64; ++p) { const float gp = rdlane(gcv, p); const int np_ = d ? 63 - p : p;
                    const float qk = QKs[np_ * LP + nl]; if ((lane & ~7) <= p) Ag[p * 64 + lane] = (bf16)f2bf(lane <= p ? qk * __expf(gp - gcv) : 0.f); }
                float* gs = GS + item * 192; const float gend = rdlane(gcv, 63);
                gs[lane] = __expf(gcv); gs[64 + lane] = betav; gs[128 + lane] = __expf(gend - gcv);
            } else {
                LAS float* W = (LAS float*)(lds + OFF_L) + c4 * 64 * LP;
                for (int p = 0; p < 64; ++p) { const float gp = rdlane(gcv, p), bp = rdlane(betav, p); const int np_ = d ? 63 - p : p;
                    const float kk = KKs[np_ * LP + nl]; W[p * LP + lane] = lane < p ? bp * kk * __expf(gp - gcv) : 0.f; }
                {
                    const int lane2 = opaque_v(lane); const int bb = lane2 >> 4, cc = lane2 & 15;
                    float Ld[16];
#pragma unroll
                    for (int m4 = 0; m4 < 4; ++m4) { const f32x4 v = *(const LAS f32x4*)(W + (16 * bb + cc) * LP + 16 * bb + 4 * m4); Ld[4 * m4] = v[0]; Ld[4 * m4 + 1] = v[1]; Ld[4 * m4 + 2] = v[2]; Ld[4 * m4 + 3] = v[3]; }
                    float x[16];
                    DiagStep<15>::run(Ld, x, cc);
#pragma unroll
                    for (int i = 0; i < 16; ++i) W[(16 * bb + i) * LP + 16 * bb + cc] = x[i];
                }
#define WU_PN(ar, ac, br, bc, acc_) do { _Pragma("unroll") for (int sx = 0; sx < 4; ++sx) acc_ = MFMA4F(W[((ar) + r) * LP + (ac) + 4 * sx + g], W[((br) + 4 * sx + g) * LP + (bc) + r], acc_); } while (0)
#define WU_PA(ar, ac, M_, acc_) do { _Pragma("unroll") for (int e = 0; e < 4; ++e) acc_ = MFMA4F(W[((ar) + r) * LP + (ac) + 4 * g + e], M_[e], acc_); } while (0)
#define WU_ST(r0, c0, acc_) do { _Pragma("unroll") for (int e = 0; e < 4; ++e) W[((r0) + 4 * g + e) * LP + (c0) + r] = -acc_[e]; } while (0)
                const f32x4 z4 = {0.f, 0.f, 0.f, 0.f};
                { f32x4 m1a = z4, m1b = z4; WU_PN(16, 0, 0, 0, m1a); WU_PN(48, 32, 32, 32, m1b);
                  f32x4 t10 = z4, t32 = z4; WU_PA(16, 16, m1a, t10); WU_PA(48, 48, m1b, t32);
                  WU_ST(16, 0, t10); WU_ST(48, 32, t32); }
                { f32x4 m00 = z4, m01 = z4, m10 = z4, m11 = z4;
                  WU_PN(32, 0, 0, 0, m00); WU_PN(32, 16, 16, 0, m00); WU_PN(32, 16, 16, 16, m01);
                  WU_PN(48, 0, 0, 0, m10); WU_PN(48, 16, 16, 0, m10); WU_PN(48, 16, 16, 16, m11);
                  f32x4 t00 = z4, t01 = z4, t10 = z4, t11 = z4;
                  WU_PA(32, 32, m00, t00); WU_PA(32, 32, m01, t01);
                  WU_PA(48, 32, m00, t10); WU_PA(48, 48, m10, t10); WU_PA(48, 32, m01, t11); WU_PA(48, 48, m11, t11);
                  WU_ST(32, 0, t00); WU_ST(32, 16, t01); WU_ST(48, 0, t10); WU_ST(48, 16, t11); }
#undef WU_PN
#undef WU_PA
#undef WU_ST
                bf16* Tg = TA + item * 8192;
#pragma unroll
                for (int x8 = 0; x8 < 8; ++x8) { const int piece = lane + 64 * x8, row = piece >> 3, pc = piece & 7;
                    const f32x4 v0 = *(const LAS f32x4*)(W + row * LP + pc * 8), v1 = *(const LAS f32x4*)(W + row * LP + pc * 8 + 4);
                    u32x4 o; o.x = pk2(v0[0], v0[1]); o.y = pk2(v0[2], v0[3]); o.z = pk2(v1[0], v1[1]); o.w = pk2(v1[2], v1[3]);
                    if (pc * 8 <= row) *(u32x4*)(Tg + row * 64 + pc * 8) = o; }
            }
        }
    }
#undef WU_PREFETCH
}

constexpr int DN_PQ = 272, DN_PT = 144;
constexpr int DN_OFF_Q = 0, DN_OFF_K = 64 * DN_PQ, DN_OFF_V = 2 * 64 * DN_PQ, DN_OFF_T = 3 * 64 * DN_PQ, DN_OFF_A = DN_OFF_T + 64 * DN_PT, DN_OFF_S = DN_OFF_A + 64 * DN_PT;
struct DnStage { u32x4 rq[2], rk[2], rv[2], rt, ra; f32x4 rs; };
__device__ __forceinline__ void dn_stage_load(DnStage& st, const bf16* QKV, const bf16* TA, const float* GS, int tid, int c, int d, int T, int row0, int kh, int h, int nchunk) {
#pragma unroll
    for (int x = 0; x < 2; ++x) { const int pi = tid + x * NT, pr = pi >> 4, pc = pi & 15; const int pp = c * 64 + pr; const int t = d ? T - 1 - pp : pp;
        const size_t o = (size_t)(row0 + t) * 8192 + pc * 8; st.rq[x] = *(const u32x4*)(QKV + o + kh * 128); st.rk[x] = *(const u32x4*)(QKV + o + 2048 + kh * 128); st.rv[x] = *(const u32x4*)(QKV + o + 4096 + h * 128); }
    const int nc = d ? nchunk - 1 - c : c; const size_t item = ((size_t)((row0 >> 6) + nc) * 32 + h) * 2 + d;
    const bool nz = ((tid & 7) * 8) <= (tid >> 3);
    st.rt = nz ? *(const u32x4*)(TA + item * 8192 + tid * 8) : (u32x4){0u, 0u, 0u, 0u}; st.ra = nz ? *(const u32x4*)(TA + item * 8192 + 4096 + tid * 8) : (u32x4){0u, 0u, 0u, 0u};
    st.rs = (f32x4){0.f, 0.f, 0.f, 0.f}; if (tid < 48) st.rs = *(const f32x4*)(GS + item * 192 + tid * 4);
}
__device__ __forceinline__ void dn_stage_store(const DnStage& st, LAS unsigned char* lds, int tid) {
#pragma unroll
    for (int x = 0; x < 2; ++x) { const int pi = tid + x * NT, pr = pi >> 4, pc = pi & 15;
        *(LAS u32x4*)(lds + DN_OFF_Q + pr * DN_PQ + pc * 16) = st.rq[x]; *(LAS u32x4*)(lds + DN_OFF_K + pr * DN_PQ + pc * 16) = st.rk[x]; *(LAS u32x4*)(lds + DN_OFF_V + pr * DN_PQ + pc * 16) = st.rv[x]; }
    { const int pr = tid >> 3, pc = tid & 7; *(LAS u32x4*)(lds + DN_OFF_T + pr * DN_PT + pc * 16) = st.rt; *(LAS u32x4*)(lds + DN_OFF_A + pr * DN_PT + pc * 16) = st.ra; }
    if (tid < 48) *(LAS f32x4*)(lds + DN_OFF_S + tid * 16) = st.rs;
}
__device__ __forceinline__ void dn_step_compute(f32x4 (&S)[8], LAS unsigned char* lds, bf16* O, int c, int d, int T, int row0, int h, int wave, int lane) {
    constexpr int PQ = DN_PQ, PT = DN_PT, OFF_Q = DN_OFF_Q, OFF_K = DN_OFF_K, OFF_V = DN_OFF_V, OFF_T = DN_OFF_T, OFF_A = DN_OFF_A, OFF_S = DN_OFF_S;
    const int r = lane & 15, g = lane >> 4, q4 = (lane & 15) >> 2, p4 = lane & 3;
#define DN_PERMROW(off_, pitch_, row_, col_) cat4(ld_b64(lds + (off_) + (row_) * (pitch_) + ((col_) + 4 * g) * 2), ld_b64(lds + (off_) + (row_) * (pitch_) + ((col_) + 16 + 4 * g) * 2))
    const f32x4 zero4 = {0.f, 0.f, 0.f, 0.f};
    bf16x8 sb[4];
    f32x4 R[4];
    {
        bf16x8 kf[4][4];
#pragma unroll
        for (int jt = 0; jt < 4; ++jt)
#pragma unroll
            for (int sx = 0; sx < 4; ++sx) kf[jt][sx] = DN_PERMROW(OFF_K, PQ, 16 * jt + r, 32 * sx);
#pragma unroll
        for (int sx = 0; sx < 4; ++sx) sb[sx] = pack8(S[2 * sx], S[2 * sx + 1]);
#pragma unroll
        for (int jt = 0; jt < 4; ++jt) R[jt] = zero4;
#pragma unroll
        for (int sx = 0; sx < 4; ++sx)
#pragma unroll
            for (int jt = 0; jt < 4; ++jt) R[jt] = MFMA16(kf[jt][sx], sb[sx], R[jt]);
    }
    __builtin_amdgcn_sched_barrier(0);
    f32x4 U[4];
    {
        bf16x8 tf[4][2]; s16x4 vt[4]; f32x4 eg[4], bt[4];
#pragma unroll
        for (int jt = 0; jt < 4; ++jt) { vt[jt] = ld_tr(lds + OFF_V + (16 * jt + 4 * g + q4) * PQ + (16 * wave + 4 * p4) * 2);
            eg[jt] = *(const LAS f32x4*)(lds + OFF_S + (16 * jt + 4 * g) * 4); bt[jt] = *(const LAS f32x4*)(lds + OFF_S + 256 + (16 * jt + 4 * g) * 4); }
#pragma unroll
        for (int it = 0; it < 4; ++it) { tf[it][0] = DN_PERMROW(OFF_T, PT, 16 * it + r, 0); tf[it][1] = DN_PERMROW(OFF_T, PT, 16 * it + r, 32); }
#pragma unroll
        for (int jt = 0; jt < 4; ++jt)
#pragma unroll
            for (int e = 0; e < 4; ++e) R[jt][e] = bt[jt][e] * (bf2f((unsigned short)vt[jt][e]) - eg[jt][e] * R[jt][e]);
        const bf16x8 rb0 = pack8(R[0], R[1]), rb1 = pack8(R[2], R[3]);
#pragma unroll
        for (int it = 0; it < 4; ++it) U[it] = MFMA16(tf[it][0], rb0, zero4);
#pragma unroll
        for (int it = 0; it < 4; ++it) U[it] = MFMA16(tf[it][1], rb1, U[it]);
    }
    __builtin_amdgcn_sched_barrier(0);
    {
        f32x4 Ot[4];
#pragma unroll
        for (int it = 0; it < 4; ++it) Ot[it] = zero4;
#pragma unroll
        for (int hq = 0; hq < 2; ++hq) {
            bf16x8 qf[2][4];
#pragma unroll
            for (int i2 = 0; i2 < 2; ++i2)
#pragma unroll
                for (int sx = 0; sx < 4; ++sx) qf[i2][sx] = DN_PERMROW(OFF_Q, PQ, 16 * (2 * hq + i2) + r, 32 * sx);
#pragma unroll
            for (int sx = 0; sx < 4; ++sx)
#pragma unroll
                for (int i2 = 0; i2 < 2; ++i2) Ot[2 * hq + i2] = MFMA16(sb[sx], qf[i2][sx], Ot[2 * hq + i2]);
        }
        bf16x8 af[4][2]; float egi[4];
#pragma unroll
        for (int it = 0; it < 4; ++it) { af[it][0] = DN_PERMROW(OFF_A, PT, 16 * it + r, 0); af[it][1] = DN_PERMROW(OFF_A, PT, 16 * it + r, 32); egi[it] = *(const LAS float*)(lds + OFF_S + (16 * it + r) * 4); }
        const bf16x8 ub0 = pack8(U[0], U[1]), ub1 = pack8(U[2], U[3]);
#pragma unroll
        for (int it = 0; it < 4; ++it) Ot[it] = Ot[it] * egi[it];
#pragma unroll
        for (int it = 0; it < 4; ++it) Ot[it] = MFMA16(ub0, af[it][0], Ot[it]);
#pragma unroll
        for (int it = 0; it < 4; ++it) Ot[it] = MFMA16(ub1, af[it][1], Ot[it]);
#pragma unroll
        for (int it = 0; it < 4; ++it) { const int pp = c * 64 + 16 * it + r; const int t = d ? T - 1 - pp : pp; u32x2 w; w.x = pk2(Ot[it][0], Ot[it][1]); w.y = pk2(Ot[it][2], Ot[it][3]);
            *(u32x2*)(O + (size_t)(row0 + t) * 4096 + h * 128 + 16 * wave + 4 * g) = w; }
    }
    __builtin_amdgcn_sched_barrier(0);
    {
#pragma unroll
        for (int jt = 0; jt < 4; ++jt) { const f32x4 dc = *(const LAS f32x4*)(lds + OFF_S + 512 + (16 * jt + 4 * g) * 4); U[jt] = U[jt] * dc; }
        const bf16x8 us0 = pack8(U[0], U[1]), us1 = pack8(U[2], U[3]);
        const float gend = *(const LAS float*)(lds + OFF_S + 63 * 4);
#pragma unroll
        for (int hk = 0; hk < 2; ++hk) {
            bf16x8 ktf[4][2];
#pragma unroll
            for (int k2 = 0; k2 < 4; ++k2) { const int kt = 4 * hk + k2;
                ktf[k2][0] = cat4(ld_tr(lds + OFF_K + (4 * g + q4) * PQ + (16 * kt + 4 * p4) * 2), ld_tr(lds + OFF_K + (16 + 4 * g + q4) * PQ + (16 * kt + 4 * p4) * 2));
                ktf[k2][1] = cat4(ld_tr(lds + OFF_K + (32 + 4 * g + q4) * PQ + (16 * kt + 4 * p4) * 2), ld_tr(lds + OFF_K + (48 + 4 * g + q4) * PQ + (16 * kt + 4 * p4) * 2)); }
#pragma unroll
            for (int k2 = 0; k2 < 4; ++k2) S[4 * hk + k2] = MFMA16(ktf[k2][0], us0, S[4 * hk + k2] * gend);
#pragma unroll
            for (int k2 = 0; k2 < 4; ++k2) S[4 * hk + k2] = MFMA16(ktf[k2][1], us1, S[4 * hk + k2]);
        }
    }
#undef DN_PERMROW
}
__device__ __forceinline__ void dn_chunk_phase(const Params& P, int j, LAS unsigned char* lds) {
    PHASE_IDS();
    const bf16* QKV = (const bf16*)(P.ws + WS_QKV); const bf16* TA = (const bf16*)(P.ws + WS_TA); const float* GS = (const float*)(P.ws + WS_GS);
    bf16* OF = (bf16*)(P.ws + WS_OF); bf16* OB = (bf16*)(P.ws + WS_OB);
    const int r = lane & 15, g = lane >> 4;
    const int bxp = (gridDim.x == 256) ? ({ const int x = blockIdx.x & 7, y = blockIdx.x >> 3, grp = x + 8 * (y >> 1), mem = y & 1; (grp >> 5) * 64 + (2 * ((grp >> 1) & 15) + mem) * 2 + (grp & 1); }) : (int)blockIdx.x;
    for (int unit0 = blockIdx.x; unit0 < 256 + 2048; unit0 += gridDim.x) {
        const int unit = (gridDim.x == 256) ? (unit0 - (int)blockIdx.x + bxp) : unit0;
        const bool lat = unit < 256; const int u2 = lat ? unit : unit - 256;
        const int b = u2 >> 6, h = (u2 >> 1) & 31, d = u2 & 1, T = lat ? 2048 : 256, row0 = lat ? MCTX + b * 2048 : b * 256, kh = h >> 1, nchunk = T / 64;
        bf16* O = d ? OB : OF;
        f32x4 S[8];
        { const float* s0 = P.in[3] + ((((size_t)b * 2 + j) * 2 + d) * 32 + h) * 128 * 128 + 16 * wave + r;
          if (lat) {
#pragma unroll
              for (int kt = 0; kt < 8; ++kt)
#pragma unroll
                  for (int e = 0; e < 4; ++e) S[kt][e] = s0[(size_t)(16 * kt + 4 * g + e) * 128];
          } else {
#pragma unroll
              for (int kt = 0; kt < 8; ++kt) S[kt] = (f32x4){0.f, 0.f, 0.f, 0.f};
          } }
        constexpr int DN_HSZ = DN_OFF_S + 768;
        DnStage sa;
        __syncthreads();
        dn_stage_load(sa, QKV, TA, GS, tid, 0, d, T, row0, kh, h, nchunk);
        dn_stage_store(sa, lds, tid);
        dn_stage_load(sa, QKV, TA, GS, tid, 1, d, T, row0, kh, h, nchunk);
        __syncthreads();
        for (int c = 0; c < nchunk; ++c) {
            LAS unsigned char* cur = lds + (c & 1) * DN_HSZ; LAS unsigned char* nxt = lds + ((c + 1) & 1) * DN_HSZ;
            if (c + 1 < nchunk) dn_stage_store(sa, nxt, tid);
            if (c + 2 < nchunk) dn_stage_load(sa, QKV, TA, GS, tid, c + 2, d, T, row0, kh, h, nchunk);
            dn_step_compute(S, cur, O, c, d, T, row0, h, wave, lane);
            __syncthreads();
        }
        if (!lat) { float* sd = P.out + OUT_SDN + ((((size_t)b * 2 + j) * 2 + d) * 32 + h) * 128 * 128 + 16 * wave + r;
#pragma unroll
            for (int kt = 0; kt < 8; ++kt)
#pragma unroll
                for (int e = 0; e < 4; ++e) __builtin_nontemporal_store(S[kt][e], sd + (size_t)(16 * kt + 4 * g + e) * 128); }
    }
}


#ifndef R_CONV
#define R_CONV 1
#endif
#ifndef R_MOD
#define R_MOD 1
#endif
#ifndef R_NORM
#define R_NORM 1
#endif
#ifndef R_GATE
#define R_GATE 1
#endif
#ifndef R_DNPREP
#define R_DNPREP 1
#endif
#ifndef R_WU
#define R_WU 1
#endif
#ifndef R_GLAPREP
#define R_GLAPREP 1
#endif
#ifndef R_DNSCAN
#define R_DNSCAN 1
#endif
#ifndef R_GSCAN
#define R_GSCAN 1
#endif
#ifndef R_FINAL
#define R_FINAL 1
#endif
#ifndef R_BAR
#define R_BAR 1
#endif
#ifndef R_GEMM
#define R_GEMM 1
#endif
#define REPN(n_) for (int rep_ = 0; rep_ < (n_); ++rep_)
#ifndef REP_THIN
#define REP_THIN 1
#endif
#ifndef REP_SCAN
#define REP_SCAN 1
#endif
#ifndef REP_A
#define REP_A 1
#endif
#ifndef REP_B
#define REP_B 1
#endif
#ifndef REP_C
#define REP_C 1
#endif
#define RT for (int rep_ = 0; rep_ < REP_THIN; ++rep_)
#define RA for (int rep_ = 0; rep_ < REP_A; ++rep_)
#define RB for (int rep_ = 0; rep_ < REP_B; ++rep_)
#define RC for (int rep_ = 0; rep_ < REP_C; ++rep_)
#define RS for (int rep_ = 0; rep_ < REP_SCAN; ++rep_)
template <int LAYER> __device__ __forceinline__ void layer_body(const Params& P, LAS unsigned char* lds, const XcdBarrier& bar) {
    bf16* X = (bf16*)(P.ws + WS_X); bf16* H = (bf16*)(P.ws + WS_H); bf16* BIG = (bf16*)(P.ws + WS_BIG); float* GATE = (float*)(P.ws + WS_GATE);
    bf16* Y = (bf16*)(P.ws + WS_QKV); bf16* OF = (bf16*)(P.ws + WS_OF); bf16* OB = (bf16*)(P.ws + WS_OB);
    const float* MOD = (const float*)(P.ws + WS_MOD);
    const bf16* Tin = (const bf16*)(P.ws + WS_W + WOFF_IN); const bf16* Tout = (const bf16*)(P.ws + WS_W + WOFF_OUT); const bf16* Tup = (const bf16*)(P.ws + WS_W + WOFF_UP); const bf16* Tdn = (const bf16*)(P.ws + WS_W + WOFF_DOWN);

        constexpr int layer = LAYER, kind = LAYER % 3, j = LAYER / 3;
        const float* modl = MOD + (size_t)layer * 5 * MODW;
        const void* xc = layer == 0 ? (const void*)P.in[0] : (const void*)X; const void* xl = layer == 0 ? (const void*)P.in[1] : (const void*)X;
#ifndef NO_CONV
        REPN(R_CONV) convert_layer_weights(P, layer, lds);
#endif
        if (layer == 0) REPN(R_BAR) xcd_barrier(bar);
        REPN(R_NORM) norm_mod_phase<layer == 0>(xc, xl, P.in[9] + layer * D, modl, 0, 2048, H);
        REPN(R_BAR) xcd_barrier(bar);
        {
            constexpr int Npad = kind == 0 ? DN_NPAD : (kind == 1 ? GLA_NPAD : HG_NIN), nmain = kind == 0 ? DN_NMAIN : (kind == 1 ? GLA_NMAIN : HG_NIN);
            { pg8::Gemm g = pg8::mk_gemm(H, Tin, MROWS, nmain, D); pg8::StaticOrder S; S.init(MROWS, nmain, (int)gridDim.x, (int)blockIdx.x);
              pg8::EpiBf16<0> E{BIG, nmain, nmain, GATE};
              REPN(R_GEMM) pg8::gemm_phase<pg8::EpiBf16<0>, pg8::StaticOrder, true, true>(lds, g, S, E); }
            if constexpr (Npad > nmain) {
              pg8::Gemm g{H, Tin + (size_t)nmain * D, MROWS, 4 * 256, D, (size_t)512 * 2, (size_t)512 * 2, 8}; pg8::StaticOrder S; S.init(MROWS, 4 * 256, (int)gridDim.x, (int)blockIdx.x);
              pg8::EpiGateP E{(float*)(P.ws + WS_GP)};
              pg8::gemm_phase<pg8::EpiGateP, pg8::StaticOrder, true, true>(lds, g, S, E); }
        }
        REPN(R_BAR) xcd_barrier(bar);
        if constexpr (kind == 0) {
#ifndef NO_DNPREP
            REPN(R_DNPREP) dn_prep_phase(P, j, rep_ == 0);
#endif
            REPN(R_BAR) xcd_barrier(bar);
            REPN(R_WU) dn_wu_prep_phase(P, lds);
            REPN(R_BAR) xcd_barrier(bar);
            REPN(R_DNSCAN) dn_chunk_phase(P, j, lds);
            REPN(R_BAR) xcd_barrier(bar);
            REPN(R_GATE) gate_phase<128>(OF, OB, BIG, DN_NMAIN, 8192, P.in[18] + j * 128, Y, 4096);
        } else if constexpr (kind == 1) {
            REPN(R_GLAPREP) gla_prep_phase<1>(P, lds);
            REPN(R_BAR) xcd_barrier(bar);
            REPN(R_GSCAN) gla_chunk_phase<1>(P, lds);
            REPN(R_BAR) xcd_barrier(bar);
            REPN(R_GATE) gate_phase<512>(OF, OB, BIG, GLA_NMAIN, 4096, P.in[23] + j * 512, Y, 2048);
        } else {
            REPN(R_GLAPREP) gla_prep_phase<2>(P, lds);
            REPN(R_BAR) xcd_barrier(bar);
            REPN(R_GSCAN) gla_chunk_phase<2>(P, lds);
            REPN(R_BAR) xcd_barrier(bar);
            REPN(R_GATE) gate_phase<128>(OF, OB, BIG, HG_NIN, 4096, P.in[27] + j * 128, Y, 2048);
        }
        REPN(R_BAR) xcd_barrier(bar);
        {
            const int Kout = kind == 0 ? 4096 : 2048;
            pg8::Gemm g = pg8::mk_gemm(Y, Tout, MROWS, D, Kout); pg8::StaticOrder S; S.init(MROWS, D, (int)gridDim.x, (int)blockIdx.x);
            pg8::EpiRes<layer == 0> E{xc, xl, X, modl + 4096};
            pg8::gemm_phase<pg8::EpiRes<layer == 0>, pg8::StaticOrder, true, true>(lds, g, S, E);
        }
        REPN(R_BAR) xcd_barrier(bar);
        REPN(R_NORM) norm_mod_phase<false>(X, X, P.in[10] + layer * D, modl, 6144, 8192, H);
        REPN(R_BAR) xcd_barrier(bar);
#pragma unroll
        for (int hf = 0; hf < 2; ++hf) {
            {
                pg8::Gemm g = pg8::mk_gemm(H, Tup, MROWS / 2, DFF, D); pg8::StaticOrder S; S.init(MROWS / 2, DFF, (int)gridDim.x, (int)blockIdx.x, hf * 32);
                pg8::EpiBf16<1> E{BIG, DFF, DFF, nullptr};
                REPN(R_GEMM) pg8::gemm_phase<pg8::EpiBf16<1>, pg8::StaticOrder, true, true>(lds, g, S, E);
            }
            REPN(R_BAR) xcd_barrier(bar);
            {
                pg8::Gemm g = pg8::mk_gemm(BIG, Tdn, MROWS / 2, D, DFF); pg8::StaticOrder S; S.init(MROWS / 2, D, (int)gridDim.x, (int)blockIdx.x, hf * 32);
                pg8::EpiRes<false> E{X, X, X, modl + 10240};
                pg8::gemm_phase<pg8::EpiRes<false>, pg8::StaticOrder, true, true>(lds, g, S, E);
            }
            REPN(R_BAR) xcd_barrier(bar);
        }
    }

__global__ void __launch_bounds__(NT, 2) fwd_kernel(Params P) {
    extern __shared__ __attribute__((aligned(16))) unsigned char lds_raw[];
    LAS unsigned char* lds = (LAS unsigned char*)lds_raw;
    const int tid = threadIdx.x;
    volatile LAS unsigned* misc = (volatile LAS unsigned*)(lds + LDS_MISC);
    if (tid < 64) misc[tid] = 0u;
    __syncthreads();
    XcdBarrier bar = xcd_barrier_post((unsigned*)(P.ws + WS_CTL) + 1024, misc + 8);

#ifndef NO_MOD
    REPN(R_MOD) mod_phase(P, lds);
#endif
    __syncthreads();

    layer_body<0>(P, lds, bar);
    layer_body<1>(P, lds, bar);
    layer_body<2>(P, lds, bar);
    layer_body<3>(P, lds, bar);
    REPN(R_FINAL) final_norm_phase((const bf16*)(P.ws + WS_X), P.in[11], P.out + OUT_Y);
}

extern "C" void kernel_launch(void* const* d_in, const int* in_sizes, int n_in, void* d_out, int out_size, void* d_ws, size_t ws_size, hipStream_t stream) {
    static int grid = 0;
    if (grid == 0) {
        if (n_in != 29 || (size_t)out_size != OUT_END || ws_size < WS_END) {
            fprintf(stderr, "kernel_launch: unexpected shapes: n_in %d out %d (want %zu) ws %zu (want %zu)\n", n_in, out_size, (size_t)OUT_END, ws_size, (size_t)WS_END); grid = -1; return; }
        int dev = 0, cus = 0, per_cu = 0;
        if (hipGetDevice(&dev) != hipSuccess || hipDeviceGetAttribute(&cus, hipDeviceAttributeMultiprocessorCount, dev) != hipSuccess) { grid = -1; return; }
        if (hipFuncSetAttribute((const void*)fwd_kernel, hipFuncAttributeMaxDynamicSharedMemorySize, LDS_BYTES) != hipSuccess) { fprintf(stderr, "kernel_launch: hipFuncSetAttribute failed\n"); grid = -1; return; }
        if (hipOccupancyMaxActiveBlocksPerMultiprocessor(&per_cu, (const void*)fwd_kernel, NT, LDS_BYTES) != hipSuccess || per_cu < 1) { fprintf(stderr, "kernel_launch: occupancy query says %d\n", per_cu); }
        (void)hipGetLastError();
        grid = cus;
    }
    if (grid < 0) return;
    hipMemsetAsync((char*)d_ws + WS_CTL, 0, CTL_BYTES, stream);
    Params p{};
    for (int i = 0; i < 29; ++i) p.in[i] = (const float*)d_in[i];
    p.out = (float*)d_out; p.ws = (unsigned char*)d_ws;
    hipLaunchKernelGGL(fwd_kernel, dim3(grid), dim3(NT), LDS_BYTES, stream, p);
}
```

```cpp
#include <hip/hip_runtime.h>
#include <cstdio>
#include <cstdint>

__device__ __forceinline__ int opaque_v(int x) { asm volatile("" : "+v"(x)); return x; }
#define PHASE_IDS() const int tid = opaque_v((int)threadIdx.x), lane = tid & 63, wave = __builtin_amdgcn_readfirstlane(tid >> 6), gw = (int)blockIdx.x * 8 + wave, NGW = (int)gridDim.x * 8; (void)lane; (void)wave; (void)gw; (void)NGW
namespace pg8 {
#define PG8_LAS __attribute__((address_space(3)))
typedef unsigned short bf16_t;
typedef short bf16x8 __attribute__((ext_vector_type(8)));
typedef float f32x4 __attribute__((ext_vector_type(4)));
typedef unsigned u32x4 __attribute__((ext_vector_type(4)));
constexpr int BM = 256, BK = 64, HALF = 128, HTB = HALF * BK * 2, STAGE_BYTES = 8 * HTB, NXCD = 8, WGM = 8;

__host__ __device__ __forceinline__ int lds_byte(int r, int c) { const int st = (r >> 4) * 2 + (c >> 5), rr = r & 15, cc = c & 31, ob = rr * 64 + cc * 2; return st * 1024 + (ob ^ (((ob >> 9) & 1) << 5)); }
__host__ __device__ __forceinline__ void stage_rc(int b, int& R, int& C) { const int st = b / 1024, sb = b % 1024, swz = sb ^ (((sb >> 9) & 1) << 5); R = (st >> 1) * 16 + swz / 64; C = (st & 1) * 32 + (swz % 64) / 2; }
__host__ __device__ __forceinline__ int perm32(int rho) { const int n = rho >> 4, i = rho & 15; return 8 * (i >> 2) + 4 * n + (i & 3); }

struct Unit { int pm, pn; };
struct Gemm { const bf16_t* A; const bf16_t* Bt; int M, N, K; size_t a_pn_step, b_pn_step; int nt; };
__host__ __device__ __forceinline__ Gemm mk_gemm(const bf16_t* A, const bf16_t* Bt, int M, int N, int K) { return Gemm{A, Bt, M, N, K, 0, (size_t)256 * K * 2, K / 64}; }

struct StaticOrder {
    int nM, nN, nwg, G, c, pm0;
    __host__ __device__ void init(int M, int N, int G_, int c_, int pm0_ = 0) { nM = M / BM; nN = N / BM; nwg = nM * nN; G = G_; c = c_; pm0 = pm0_; }
    __host__ __device__ bool next(int i, Unit& u) const {
        const long L = (long)i * G + c; if (L >= nwg) return false;
        int wgid = (int)L; { const int q = nwg / NXCD, r = nwg % NXCD, xcd = wgid % NXCD, off = wgid / NXCD; wgid = (xcd < r ? xcd * (q + 1) : r * (q + 1) + (xcd - r) * q) + off; }
        const int nig = WGM * nN, gid = wgid / nig, fm = gid * WGM, gsz = (nM - fm) < WGM ? (nM - fm) : WGM;
        u.pm = pm0 + fm + ((wgid % nig) % gsz); u.pn = (wgid % nig) / gsz; return true;
    }
    __device__ __forceinline__ void a_ready(const Unit&) const {}
    __device__ __forceinline__ void done(const Unit&) const {}
};

__device__ __forceinline__ unsigned cvt_pk_bf16(float lo, float hi) { unsigned r; asm volatile("v_cvt_pk_bf16_f32 %0, %1, %2" : "=v"(r) : "v"(lo), "v"(hi)); return r; }

template <int ACT> struct EpiBf16 {
    static constexpr bool PERM = true, AFTER_DRAIN = false;
    bf16_t* O; int ldc; int n_main; float* G;
    __device__ __forceinline__ void operator()(const f32x4 (&acc)[2][2][4][2], const Unit& u, int wr, int wc, int fr, int fq) const {
        const int row0 = u.pm * BM + wr * 64 + fr; const int colt = u.pn * BM;
        const int col0 = colt + wc * 32 + 8 * fq;
#pragma unroll
        for (int ai = 0; ai < 2; ++ai)
#pragma unroll
            for (int m = 0; m < 4; ++m) { bf16_t* rowp = O + (size_t)(row0 + ai * HALF + m * 16) * ldc + col0;
#pragma unroll
                for (int bj = 0; bj < 2; ++bj) { f32x4 v0 = acc[ai][bj][m][0], v1 = acc[ai][bj][m][1];
                    if (ACT == 1) {
#pragma unroll
                        for (int j = 0; j < 4; ++j) { const float a = fmaxf(v0[j], 0.f), b = fmaxf(v1[j], 0.f); v0[j] = a * a; v1[j] = b * b; } }
                    u32x4 w; w.x = cvt_pk_bf16(v0[0], v0[1]); w.y = cvt_pk_bf16(v0[2], v0[3]); w.z = cvt_pk_bf16(v1[0], v1[1]); w.w = cvt_pk_bf16(v1[2], v1[3]);
                    *(u32x4*)(rowp + bj * HALF) = w;
#ifdef PROBE_DOUBLE_STORE
                    asm volatile("" ::: "memory"); *(u32x4*)(rowp + bj * HALF) = w; asm volatile("" ::: "memory");
#endif
                    } }
    }
};
struct EpiGateP {
    static constexpr bool PERM = true, AFTER_DRAIN = false;
    float* GP;
    __device__ __forceinline__ void operator()(const f32x4 (&acc)[2][2][4][2], const Unit& u, int wr, int wc, int fr, int fq) const {
        const int row0 = u.pm * BM + wr * 64 + fr; const int col0 = wc * 32 + 8 * fq; float* base = GP + (size_t)u.pn * 16384 * 128;
#pragma unroll
        for (int ai = 0; ai < 2; ++ai)
#pragma unroll
            for (int m = 0; m < 4; ++m) { float* rowp = base + (size_t)(row0 + ai * HALF + m * 16) * 128 + col0;
                *(f32x4*)(rowp) = acc[ai][0][m][0]; *(f32x4*)(rowp + 4) = acc[ai][0][m][1]; }
    }
};
template <bool BASE_F32> struct EpiRes {
    static constexpr bool PERM = true, AFTER_DRAIN = false;
    const void* base_ctx; const void* base_lat; bf16_t* out; const float* gate;
    __device__ __forceinline__ void operator()(const f32x4 (&acc)[2][2][4][2], const Unit& u, int wr, int wc, int fr, int fq) const {
        const int row0 = u.pm * BM + wr * 64 + fr, col0 = u.pn * BM + wc * 32 + 8 * fq;
        const bool ctx = u.pm < 32; const int grp = ctx ? 0 : 1 + ((u.pm - 32) >> 3);
        const float* gp = gate + (size_t)grp * 12288 + col0;
        const void* base = ctx ? base_ctx : base_lat; const int rsub = (BASE_F32 && !ctx) ? 8192 : 0;
        f32x4 gv[2][2];
#pragma unroll
        for (int bj = 0; bj < 2; ++bj)
#pragma unroll
            for (int n = 0; n < 2; ++n) gv[bj][n] = *(const f32x4*)(gp + bj * HALF + 4 * n);
#pragma unroll
        for (int ai = 0; ai < 2; ++ai) {
            f32x4 bs[4][2][2];
#pragma unroll
            for (int m = 0; m < 4; ++m) { const size_t offb = (size_t)(row0 + ai * HALF + m * 16 - rsub) * 2048 + col0;
#pragma unroll
                for (int bj = 0; bj < 2; ++bj) {
                    if (BASE_F32) { bs[m][bj][0] = *(const f32x4*)((const float*)base + offb + bj * HALF); bs[m][bj][1] = *(const f32x4*)((const float*)base + offb + bj * HALF + 4); }
                    else { const u32x4 w = *(const u32x4*)((const bf16_t*)base + offb + bj * HALF);
                        bs[m][bj][0] = (f32x4){__uint_as_float(w.x << 16), __uint_as_float(w.x & 0xffff0000u), __uint_as_float(w.y << 16), __uint_as_float(w.y & 0xffff0000u)};
                        bs[m][bj][1] = (f32x4){__uint_as_float(w.z << 16), __uint_as_float(w.z & 0xffff0000u), __uint_as_float(w.w << 16), __uint_as_float(w.w & 0xffff0000u)}; } } }
#pragma unroll
            for (int m = 0; m < 4; ++m) { const size_t offo = (size_t)(row0 + ai * HALF + m * 16) * 2048 + col0;
#pragma unroll
                for (int bj = 0; bj < 2; ++bj) { const f32x4 v0 = bs[m][bj][0] + gv[bj][0] * acc[ai][bj][m][0], v1 = bs[m][bj][1] + gv[bj][1] * acc[ai][bj][m][1];
                    u32x4 w; w.x = cvt_pk_bf16(v0[0], v0[1]); w.y = cvt_pk_bf16(v0[2], v0[3]); w.z = cvt_pk_bf16(v1[0], v1[1]); w.w = cvt_pk_bf16(v1[2], v1[3]);
                    *(u32x4*)(out + offo + bj * HALF) = w; } }
            asm volatile("" ::: "memory");
        }
    }
};

template <class Epi, class Sched, bool ALIGN_EPI = false, bool SP2 = false>
__device__ __forceinline__ void gemm_phase(PG8_LAS unsigned char* lds, const Gemm g, const Sched& S, const Epi& E) {
    const int tid = opaque_v((int)threadIdx.x), wid = __builtin_amdgcn_readfirstlane(tid >> 6), lane = tid & 63, wr = wid >> 2, wc = wid & 3, fr = lane & 15, fq = lane >> 4;
    const int K = g.K, nt = g.nt;
    unsigned voffA[2], voffB[2];
#pragma unroll
    for (int i = 0; i < 2; ++i) { int R, C; stage_rc(tid * 16 + i * 8192, R, C); const int Rb = Epi::PERM ? ((R & ~31) + perm32(R & 31)) : R;
        voffA[i] = (unsigned)(R * K + C) * 2u; voffB[i] = (unsigned)(Rb * K + C) * 2u; }
    const size_t kstep = (size_t)(BK * 2);
    const size_t hstep = (size_t)HALF * K * 2;
    const size_t tstep = 2 * hstep;
    const unsigned ldsw = (unsigned)wid * 1024u;
    const int aoff = lds_byte(wr * 64 + fr, fq * 8), boff = lds_byte(wc * 32 + fr, fq * 8);
#define PG8_SA(b, h) (((b) * 2 + (h)) * HTB)
#define PG8_SB(b, h) ((4 + (b) * 2 + (h)) * HTB)
#define PG8_STAGE(bufoff, gbase, voff) do { _Pragma("unroll") for (int _i = 0; _i < 2; ++_i) \
        __builtin_amdgcn_global_load_lds((const unsigned*)((const char*)(gbase) + (voff)[_i]), (PG8_LAS unsigned*)(lds + (bufoff) + ldsw + _i * 8192), 16, 0, 0); } while (0)
#define PG8_LDA(dst, b, h) do { _Pragma("unroll") for (int m = 0; m < 4; ++m) _Pragma("unroll") for (int k = 0; k < 2; ++k) dst[m][k] = *(const PG8_LAS bf16x8*)(lds + PG8_SA(b, h) + aoff + m * 2048 + k * 1024); } while (0)
#define PG8_LDB(dst, b, h) do { _Pragma("unroll") for (int n = 0; n < 2; ++n) _Pragma("unroll") for (int k = 0; k < 2; ++k) dst[n][k] = *(const PG8_LAS bf16x8*)(lds + PG8_SB(b, h) + boff + n * 2048 + k * 1024); } while (0)
#define PG8_MMA(ai, bj, At, Bt) do { __builtin_amdgcn_s_setprio(1); _Pragma("unroll") for (int m = 0; m < 4; ++m) _Pragma("unroll") for (int n = 0; n < 2; ++n) _Pragma("unroll") for (int k = 0; k < 2; ++k) \
        acc[ai][bj][m][n] = __builtin_amdgcn_mfma_f32_16x16x32_bf16(Bt[n][k], At[m][k], acc[ai][bj][m][n], 0, 0, 0); __builtin_amdgcn_s_setprio(0); } while (0)
#define PG8_WAIT_V(n) asm volatile("s_waitcnt vmcnt(" #n ")" ::: "memory")
#define PG8_WAIT_L(n) asm volatile("s_waitcnt lgkmcnt(" #n ")" ::: "memory")
#define PG8_BAR __builtin_amdgcn_s_barrier()
#define PG8_SCHED __builtin_amdgcn_sched_barrier(0)
    Unit cur, nxt; int ui = 0;
    if (!S.next(0, cur)) return;
    f32x4 acc[2][2][4][2];
#pragma unroll
    for (int a = 0; a < 2; ++a)
#pragma unroll
        for (int b = 0; b < 2; ++b)
#pragma unroll
            for (int m = 0; m < 4; ++m)
#pragma unroll
                for (int n = 0; n < 2; ++n) acc[a][b][m][n] = (f32x4){0.f, 0.f, 0.f, 0.f};
    bf16x8 At[4][2], B0[2][2], B1[2][2];
    const char* cA = (const char*)g.A + (size_t)cur.pm * tstep + (size_t)cur.pn * g.a_pn_step; const char* cB = (const char*)g.Bt + (size_t)cur.pn * g.b_pn_step;
    S.a_ready(cur);
    if constexpr (SP2) {
        PG8_STAGE(PG8_SB(0, 0), cB, voffB); PG8_STAGE(PG8_SB(0, 1), cB + hstep, voffB); PG8_STAGE(PG8_SA(0, 0), cA, voffA); PG8_STAGE(PG8_SA(0, 1), cA + hstep, voffA);
        if (wr == 1) PG8_BAR;
        PG8_WAIT_V(2); PG8_BAR;
        PG8_STAGE(PG8_SB(1, 0), cB + kstep, voffB); PG8_STAGE(PG8_SA(1, 0), cA + kstep, voffA); PG8_STAGE(PG8_SB(1, 1), cB + hstep + kstep, voffB);
        PG8_WAIT_V(6); PG8_BAR;
    } else {
        PG8_STAGE(PG8_SB(0, 0), cB, voffB); PG8_STAGE(PG8_SA(0, 0), cA, voffA); PG8_STAGE(PG8_SB(0, 1), cB + hstep, voffB); PG8_STAGE(PG8_SA(0, 1), cA + hstep, voffA);
        if (wr == 1) PG8_BAR;
        PG8_WAIT_V(4); PG8_BAR;
        PG8_STAGE(PG8_SB(1, 0), cB + kstep, voffB); PG8_STAGE(PG8_SA(1, 0), cA + kstep, voffA); PG8_STAGE(PG8_SB(1, 1), cB + hstep + kstep, voffB);
        PG8_WAIT_V(6); PG8_BAR;
    }
    for (;;) {
        const bool has_next = S.next(ui + 1, nxt);
        const char* nA = has_next ? (const char*)g.A + (size_t)nxt.pm * tstep + (size_t)nxt.pn * g.a_pn_step : cA; const char* nB = has_next ? (const char*)g.Bt + (size_t)nxt.pn * g.b_pn_step : cB;
        for (int t = 0; t < nt; t += 2) {
            const bool last = (t == nt - 2);
            const char* a1 = cA + (size_t)(t + 1) * kstep;
            const char* a2 = last ? nA : cA + (size_t)(t + 2) * kstep; const char* b2 = last ? nB : cB + (size_t)(t + 2) * kstep;
            const char* a3 = a2 + kstep; const char* b3 = b2 + kstep;
            if (last && has_next) S.a_ready(nxt);
            if constexpr (SP2) {
            PG8_LDB(B0, 0, 0); PG8_LDB(B1, 0, 1); PG8_SCHED; PG8_LDA(At, 0, 0); PG8_STAGE(PG8_SA(1, 1), a1 + hstep, voffA);
            PG8_WAIT_V(8); PG8_WAIT_L(0); PG8_BAR; PG8_MMA(0, 0, At, B0); PG8_MMA(0, 1, At, B1); PG8_BAR; PG8_SCHED;
            PG8_LDA(At, 0, 1); PG8_STAGE(PG8_SB(0, 0), b2, voffB); PG8_STAGE(PG8_SB(0, 1), b2 + hstep, voffB); PG8_STAGE(PG8_SA(0, 0), a2, voffA);
            PG8_WAIT_V(8); PG8_WAIT_L(0); PG8_BAR; PG8_MMA(1, 0, At, B0); PG8_MMA(1, 1, At, B1); PG8_BAR; PG8_SCHED;
            PG8_LDB(B0, 1, 0); PG8_LDB(B1, 1, 1); PG8_SCHED; PG8_LDA(At, 1, 0); PG8_STAGE(PG8_SA(0, 1), a2 + hstep, voffA);
            PG8_WAIT_V(8); PG8_WAIT_L(0); PG8_BAR; PG8_MMA(0, 0, At, B0); PG8_MMA(0, 1, At, B1); PG8_BAR; PG8_SCHED;
            PG8_LDA(At, 1, 1); PG8_STAGE(PG8_SB(1, 0), b3, voffB); PG8_STAGE(PG8_SB(1, 1), b3 + hstep, voffB); PG8_STAGE(PG8_SA(1, 0), a3, voffA);
            PG8_WAIT_V(8); PG8_WAIT_L(0); PG8_BAR; PG8_MMA(1, 0, At, B0); PG8_MMA(1, 1, At, B1); PG8_BAR; PG8_SCHED;
            } else {
            PG8_LDB(B0, 0, 0); PG8_SCHED; PG8_LDA(At, 0, 0); PG8_STAGE(PG8_SA(1, 1), a1 + hstep, voffA);
            PG8_WAIT_L(8); PG8_BAR; PG8_WAIT_L(0); PG8_MMA(0, 0, At, B0); PG8_BAR; PG8_SCHED;
            PG8_LDB(B1, 0, 1); PG8_STAGE(PG8_SB(0, 0), b2, voffB);
            PG8_BAR; PG8_WAIT_L(0); PG8_MMA(0, 1, At, B1); PG8_BAR;
            PG8_LDA(At, 0, 1); PG8_STAGE(PG8_SA(0, 0), a2, voffA);
            PG8_BAR; PG8_WAIT_L(0); PG8_MMA(1, 0, At, B0); PG8_BAR; PG8_SCHED;
            PG8_STAGE(PG8_SB(0, 1), b2 + hstep, voffB);
            PG8_WAIT_V(6); PG8_BAR; PG8_MMA(1, 1, At, B1); PG8_BAR;
            PG8_LDB(B0, 1, 0); PG8_SCHED; PG8_LDA(At, 1, 0); PG8_STAGE(PG8_SA(0, 1), a2 + hstep, voffA);
            PG8_WAIT_L(8); PG8_BAR; PG8_WAIT_L(0); PG8_MMA(0, 0, At, B0); PG8_BAR; PG8_SCHED;
            PG8_LDB(B1, 1, 1); PG8_STAGE(PG8_SB(1, 0), b3, voffB);
            PG8_BAR; PG8_WAIT_L(0); PG8_MMA(0, 1, At, B1); PG8_BAR;
            PG8_LDA(At, 1, 1); PG8_STAGE(PG8_SA(1, 0), a3, voffA);
            PG8_BAR; PG8_WAIT_L(0); PG8_MMA(1, 0, At, B0); PG8_BAR; PG8_SCHED;
            PG8_STAGE(PG8_SB(1, 1), b3 + hstep, voffB);
            PG8_WAIT_V(6); PG8_BAR; PG8_MMA(1, 1, At, B1); PG8_BAR;
            }
        }
        if constexpr (ALIGN_EPI) { if (wr == 0) PG8_BAR; }
        if constexpr (!Epi::AFTER_DRAIN) { E(acc, cur, wr, wc, fr, fq); S.done(cur); }
        if (!has_next) break;
#pragma unroll
        for (int a = 0; a < 2; ++a)
#pragma unroll
            for (int b = 0; b < 2; ++b)
#pragma unroll
                for (int m = 0; m < 4; ++m)
#pragma unroll
                    for (int n = 0; n < 2; ++n) acc[a][b][m][n] = (f32x4){0.f, 0.f, 0.f, 0.f};
        cur = nxt; cA = nA; cB = nB; ++ui;
        if constexpr (ALIGN_EPI) { if (wr == 1) PG8_BAR; }
    }
    PG8_WAIT_V(0);
    if constexpr (!ALIGN_EPI) { if (wr == 0) PG8_BAR; }
    PG8_BAR;
#undef PG8_SA
#undef PG8_SB
#undef PG8_STAGE
#undef PG8_LDA
#undef PG8_LDB
#undef PG8_MMA
#undef PG8_WAIT_V
#undef PG8_WAIT_L
#undef PG8_BAR
#undef PG8_SCHED
}
}

#define XB_TMO      128
#define XB_XCNT(j)  (256  + 64 * (j))
#define XB_XSUB(j)  (1280 + 64 * (j))
#define XB_XGEN(j)  (2304 + 64 * (j))
#define XB_TOP      3328
#define XB_TOPGEN   3392
#define XCD_BAR_WORDS 3456
#define XB_SPIN_CAP (1u << 21)
#define LAS __attribute__((address_space(3)))

__device__ __forceinline__ unsigned xb_ld(unsigned* p)              { return __hip_atomic_load(p, __ATOMIC_RELAXED, __HIP_MEMORY_SCOPE_AGENT); }
__device__ __forceinline__ unsigned xb_add(unsigned* p, unsigned v) { return __hip_atomic_fetch_add(p, v, __ATOMIC_RELAXED, __HIP_MEMORY_SCOPE_AGENT); }
__device__ __forceinline__ unsigned xb_xcc_id() { return (unsigned)__builtin_amdgcn_s_getreg((3 << 11) | 20) & 0xFu; }
#define XB_SPIN(cond, bar) do { unsigned _sp = 0; while (cond) { __builtin_amdgcn_s_sleep(1); \
    if ((++_sp & 255u) == 0u) { if (xb_ld(&(bar)[XB_TMO])) break; if (_sp > XB_SPIN_CAP) { atomicAdd(&(bar)[XB_TMO], 1u); break; } } } } while (0)

struct XcdBarrier { unsigned* bar; unsigned x; volatile LAS unsigned* st; };

__device__ __forceinline__ XcdBarrier xcd_barrier_post(unsigned* bar, volatile LAS unsigned* st) {
    XcdBarrier b; b.bar = bar; b.x = xb_xcc_id(); b.st = st;
    if (threadIdx.x == 0) (void)xb_add(&bar[XB_XCNT(b.x)], 1u);
    return b;
}
__device__ __forceinline__ void xcd_barrier_complete(unsigned* bar, unsigned x, unsigned& nloc, unsigned& nx) {
    const unsigned G = gridDim.x * gridDim.y * gridDim.z;
    unsigned sum, cnt, mine, sp = 0u;
    for (;;) {
        sum = 0u; cnt = 0u; mine = 0u;
#pragma unroll
        for (unsigned j = 0; j < 16; ++j) { const unsigned c = xb_ld(&bar[XB_XCNT(j)]); sum += c; cnt += (c > 0u) ? 1u : 0u; mine = (j == x) ? c : mine; }
        if (sum == G) break;
        __builtin_amdgcn_s_sleep(1);
        if ((++sp & 255u) == 0u) { if (xb_ld(&bar[XB_TMO])) break; if (sp > XB_SPIN_CAP) { atomicAdd(&bar[XB_TMO], 1u); break; } }
    }
    nloc = mine > 0u ? mine : 1u; nx = cnt > 0u ? cnt : 1u;
}
__device__ __forceinline__ void xcd_barrier(const XcdBarrier& b) {
    asm volatile("s_waitcnt vmcnt(0)" ::: "memory");
    __syncthreads();
    if (threadIdx.x == 0) {
        unsigned* bar = b.bar;
        __builtin_amdgcn_s_waitcnt(0);
        unsigned nloc = b.st[0], nx = b.st[1];
        if (nloc == 0u) { xcd_barrier_complete(bar, b.x, nloc, nx); b.st[0] = nloc; b.st[1] = nx; }
        const unsigned old = xb_add(&bar[XB_XSUB(b.x)], 1u);
        const unsigned gen = old / nloc;
        if (old + 1u == (gen + 1u) * nloc) {
            __builtin_amdgcn_fence(__ATOMIC_RELEASE, "agent");
            asm volatile("s_waitcnt vmcnt(0)" ::: "memory");
            const unsigned og = xb_add(&bar[XB_TOP], 1u);
            const unsigned tg = og / nx;
            if (og + 1u == (tg + 1u) * nx) xb_add(&bar[XB_TOPGEN], 1u);
            else XB_SPIN(xb_ld(&bar[XB_TOPGEN]) == tg, bar);
            __builtin_amdgcn_fence(__ATOMIC_ACQUIRE, "agent");
            xb_add(&bar[XB_XGEN(b.x)], 1u);
            asm volatile("s_waitcnt vmcnt(0)" ::: "memory");
        } else {
            XB_SPIN(xb_ld(&bar[XB_XGEN(b.x)]) == gen, bar);
            __builtin_amdgcn_fence(__ATOMIC_ACQUIRE, "agent");
            asm volatile("s_waitcnt vmcnt(0)" ::: "memory");
        }
    }
    __syncthreads();
}

typedef unsigned short bf16;
typedef float f32x4 __attribute__((ext_vector_type(4)));
typedef unsigned u32x4 __attribute__((ext_vector_type(4)));
typedef unsigned u32x2 __attribute__((ext_vector_type(2)));

constexpr int D = 2048, DFF = 8192, MROWS = 16384, MCTX = 8192;
constexpr int NT = 512;
constexpr float EPS = 1e-6f;
constexpr int DN_NIN = 12416, DN_NMAIN = 12288, DN_NPAD = 12544;
constexpr int GLA_NIN = 6176, GLA_NMAIN = 6144, GLA_NPAD = 6400;
constexpr int HG_NIN = 10240;
constexpr int MODW = 12288;

constexpr size_t MiB = 1u << 20;
constexpr size_t WS_CTL = 0, CTL_BYTES = 1 * MiB;
constexpr size_t WS_MOD = 1 * MiB;
constexpr size_t WS_X = 2 * MiB;
constexpr size_t WS_H = WS_X + 128 * MiB;
constexpr size_t WS_BIG = WS_H + 64 * MiB;
constexpr size_t WS_GATE = WS_BIG + 384 * MiB;
constexpr size_t WS_QKV = WS_GATE + 8 * MiB;
constexpr size_t WS_OF = WS_QKV + 256 * MiB;
constexpr size_t WS_OB = WS_OF + 128 * MiB;
constexpr size_t WS_W = WS_OB + 128 * MiB;
constexpr size_t WOFF_IN = 0, WOFF_OUT = (size_t)DN_NPAD * D * 2, WOFF_UP = WOFF_OUT + (size_t)D * 4096 * 2, WOFF_DOWN = WOFF_UP + (size_t)DFF * D * 2;
constexpr size_t WS_TA = ((WS_W + WOFF_DOWN + (size_t)D * DFF * 2 + MiB - 1) / MiB) * MiB;
constexpr size_t WS_GS = WS_TA + 256 * MiB;
constexpr size_t WS_GP = WS_GS + 12 * MiB;
constexpr size_t WS_END = WS_GP + 32 * MiB;

constexpr size_t OUT_Y = 0;
constexpr size_t OUT_SDN = (size_t)MROWS * D;
constexpr size_t OUT_SGLA = OUT_SDN + (size_t)32 * 2 * 2 * 32 * 128 * 128;
constexpr size_t OUT_SHG = OUT_SGLA + (size_t)32 * 2 * 4 * 256 * 512;
constexpr size_t OUT_END = OUT_SHG + (size_t)32 * 2 * 16 * 128 * 128;

constexpr int LDS_BYTES = 147456;
constexpr int LDS_MISC = 143360;

struct Params {
    const float* in[29];
    float* out;
    unsigned char* ws;
};

__device__ __forceinline__ float bf2f(unsigned short b) { return __uint_as_float(((unsigned)b) << 16); }
typedef __bf16 bfv2_ __attribute__((ext_vector_type(2)));
typedef float f32x2_ __attribute__((ext_vector_type(2)));
__device__ __forceinline__ unsigned f2bf(float f) { return (unsigned)__builtin_bit_cast(unsigned short, (__bf16)f); }
__device__ __forceinline__ unsigned pk2(float lo, float hi) { const f32x2_ v = {lo, hi}; return __builtin_bit_cast(unsigned, __builtin_convertvector(v, bfv2_)); }
__device__ __forceinline__ float bflo(unsigned w) { return __uint_as_float(w << 16); }
__device__ __forceinline__ float bfhi(unsigned w) { return __uint_as_float(w & 0xffff0000u); }
__device__ __forceinline__ float wave_sum(float v) {
#pragma unroll
    for (int o = 1; o < 64; o <<= 1) v += __shfl_xor(v, o);
    return v;
}
__device__ __forceinline__ float rdlane(float v, int l) { return __builtin_bit_cast(float, __builtin_amdgcn_readlane(__builtin_bit_cast(int, v), l)); }
__device__ __forceinline__ float sigmoidf_(float x) { return 1.f / (1.f + __expf(-x)); }
__device__ __forceinline__ float siluf_(float x) { return x / (1.f + __expf(-x)); }
__device__ __forceinline__ float softplusf_(float x) { return fmaxf(x, 0.f) + log1pf(__expf(-fabsf(x))); }

__device__ __forceinline__ void transpose_item(const float* W, int K, int N, bf16* WT, LAS float* scr, int item, int lane) {
    const int nblk = N / 32, kb = item / nblk, nb = item % nblk, k0 = 64 * kb, n0 = 32 * nb;
    { f32x4 v[8]; const int kr = lane >> 3, c4 = (lane & 7) * 4;
#pragma unroll
      for (int i = 0; i < 8; ++i) v[i] = *(const f32x4*)(W + (size_t)(k0 + kr + 8 * i) * N + n0 + c4);
#pragma unroll
      for (int i = 0; i < 8; ++i) { LAS float* d = scr + (kr + 8 * i) * 33 + c4; d[0] = v[i].x; d[1] = v[i].y; d[2] = v[i].z; d[3] = v[i].w; } }
    asm volatile("s_waitcnt lgkmcnt(0)" ::: "memory");
    const int c = lane & 7;
#pragma unroll
    for (int j = 0; j < 4; ++j) { const int n = (lane >> 3) + 8 * j; const LAS float* s = scr + (8 * c) * 33 + n;
        u32x4 o; o.x = pk2(s[0 * 33], s[1 * 33]); o.y = pk2(s[2 * 33], s[3 * 33]); o.z = pk2(s[4 * 33], s[5 * 33]); o.w = pk2(s[6 * 33], s[7 * 33]);
        *(u32x4*)(WT + (size_t)(n0 + n) * K + k0 + 8 * c) = o; }
    asm volatile("s_waitcnt lgkmcnt(0)" ::: "memory");
}

__device__ __forceinline__ void convert_layer_weights(const Params& P, int layer, LAS unsigned char* lds) {
    PHASE_IDS();
    LAS float* scr = (LAS float*)(lds + wave * 16384);
    const int kind = layer % 3, j = layer / 3;
    const float* Win; int Nin, Npad; const float* Wout; int Kout;
    if (kind == 0) { Win = P.in[14] + (size_t)j * D * DN_NIN; Nin = DN_NIN; Npad = DN_NPAD; Wout = P.in[19] + (size_t)j * 4096 * D; Kout = 4096; }
    else if (kind == 1) { Win = P.in[20] + (size_t)j * D * GLA_NIN; Nin = GLA_NIN; Npad = GLA_NPAD; Wout = P.in[24] + (size_t)j * D * D; Kout = 2048; }
    else { Win = P.in[25] + (size_t)j * D * HG_NIN; Nin = HG_NIN; Npad = HG_NIN; Wout = P.in[28] + (size_t)j * D * D; Kout = 2048; }
    const float* Wup = P.in[12] + (size_t)layer * D * DFF; const float* Wdn = P.in[13] + (size_t)layer * DFF * D;
    bf16* Tin = (bf16*)(P.ws + WS_W + WOFF_IN); bf16* Tout = (bf16*)(P.ws + WS_W + WOFF_OUT); bf16* Tup = (bf16*)(P.ws + WS_W + WOFF_UP); bf16* Tdn = (bf16*)(P.ws + WS_W + WOFF_DOWN);
    const int I_in = (D / 64) * (Nin / 32), I_out = (Kout / 64) * (D / 32), I_up = (D / 64) * (DFF / 32), I_dn = (DFF / 64) * (D / 32);
    const int NI = I_in + I_out + I_up + I_dn;
    for (int it = gw; it < NI; it += NGW) {
        int r = it;
        if (r < I_in) { transpose_item(Win, D, Nin, Tin, scr, r, lane); continue; } r -= I_in;
        if (r < I_out) { transpose_item(Wout, Kout, D, Tout, scr, r, lane); continue; } r -= I_out;
        if (r < I_up) { transpose_item(Wup, D, DFF, Tup, scr, r, lane); continue; } r -= I_up;
        transpose_item(Wdn, DFF, D, Tdn, scr, r, lane);
    }
    const int npadrows = Npad - Nin;
    if (npadrows > 0) {
        u32x4* z = (u32x4*)(Tin + (size_t)Nin * D); const int n16 = npadrows * D / 8;
        for (int i = gw * 64 + lane; i < n16; i += NGW * 64) z[i] = (u32x4){0u, 0u, 0u, 0u};
    }
}

__device__ __forceinline__ void mod_phase(const Params& P, LAS unsigned char* lds) {
    PHASE_IDS();
    LAS float* scond = (LAS float*)lds;
    LAS float* red = (LAS float*)(lds + 40960 + 1024);
    for (int i = tid; i < 5 * 2048; i += NT) { const int g = i / 2048, k = i % 2048; const float v = g == 0 ? P.in[6][k] : P.in[2][(g - 1) * 2048 + k]; scond[k * 5 + g] = siluf_(v); }
    __syncthreads();
    float* mod = (float*)(P.ws + WS_MOD);
    const int c4 = tid & 15, kg = tid >> 4;
    for (int cg = blockIdx.x; cg < 4 * MODW / 64; cg += gridDim.x) {
        const int layer = cg / (MODW / 64), colbase = (cg % (MODW / 64)) * 64;
        const float* W = P.in[7] + (size_t)layer * D * MODW + colbase + c4 * 4;
        f32x4 acc[5];
#pragma unroll
        for (int g = 0; g < 5; ++g) acc[g] = (f32x4){0.f, 0.f, 0.f, 0.f};
#pragma unroll 8
        for (int kk = 0; kk < 64; ++kk) {
            const int k = kg * 64 + kk;
            const f32x4 w = *(const f32x4*)(W + (size_t)k * MODW);
#pragma unroll
            for (int g = 0; g < 5; ++g) acc[g] += w * scond[k * 5 + g];
        }
#pragma unroll
        for (int g = 0; g < 5; ++g)
#pragma unroll
            for (int e = 0; e < 4; ++e) red[(kg * 64 + c4 * 4 + e) * 5 + g] = acc[g][e];
        __syncthreads();
        if (tid < 64 * 5) { const int c = tid / 5, g = tid % 5; float sum = 0.f;
#pragma unroll 8
            for (int q = 0; q < 32; ++q) sum += red[(q * 64 + c) * 5 + g];
            mod[((size_t)layer * 5 + g) * MODW + colbase + c] = sum + P.in[8][(size_t)layer * MODW + colbase + c]; }
        __syncthreads();
    }
}

template <bool XF32> __device__ __forceinline__ void norm_mod_phase(const void* xc, const void* xl, const float* w, const float* mod, int sh_off, int sc_off, bf16* H) {
    PHASE_IDS();
    for (int m = gw; m < MROWS; m += NGW) {
        const bool ctx = m < MCTX; const int grp = ctx ? 0 : 1 + ((m - MCTX) >> 11);
        f32x4 v[8]; float ss = 0.f;
        if (XF32) { const float* xr = ctx ? (const float*)xc + (size_t)m * D : (const float*)xl + (size_t)(m - MCTX) * D;
#pragma unroll
            for (int jx = 0; jx < 4; ++jx) { v[2 * jx] = *(const f32x4*)(xr + 8 * (lane + 64 * jx)); v[2 * jx + 1] = *(const f32x4*)(xr + 8 * (lane + 64 * jx) + 4); } }
        else { const bf16* xr = (const bf16*)xc + (size_t)m * D;
#pragma unroll
            for (int jx = 0; jx < 4; ++jx) { const u32x4 q = *(const u32x4*)(xr + 8 * (lane + 64 * jx));
                v[2 * jx] = (f32x4){bflo(q.x), bfhi(q.x), bflo(q.y), bfhi(q.y)}; v[2 * jx + 1] = (f32x4){bflo(q.z), bfhi(q.z), bflo(q.w), bfhi(q.w)}; } }
#pragma unroll
        for (int i = 0; i < 8; ++i) ss += (v[i].x * v[i].x + v[i].y * v[i].y) + (v[i].z * v[i].z + v[i].w * v[i].w);
        const float rstd = rsqrtf(wave_sum(ss) * (1.f / D) + EPS);
        const float* mg = mod + (size_t)grp * MODW;
#pragma unroll
        for (int jx = 0; jx < 4; ++jx) { const int c = 8 * (lane + 64 * jx);
            const f32x4 y0 = v[2 * jx] * rstd * *(const f32x4*)(w + c) * (*(const f32x4*)(mg + sc_off + c) + 1.f) + *(const f32x4*)(mg + sh_off + c);
            const f32x4 y1 = v[2 * jx + 1] * rstd * *(const f32x4*)(w + c + 4) * (*(const f32x4*)(mg + sc_off + c + 4) + 1.f) + *(const f32x4*)(mg + sh_off + c + 4);
            u32x4 o; o.x = pk2(y0.x, y0.y); o.y = pk2(y0.z, y0.w); o.z = pk2(y1.x, y1.y); o.w = pk2(y1.z, y1.w);
            *(u32x4*)(H + (size_t)m * D + c) = o; }
    }
}
__device__ __forceinline__ void final_norm_phase(const bf16* X, const float* w, float* out) {
    PHASE_IDS();
    for (int m = gw; m < MROWS; m += NGW) {
        f32x4 v[8]; float ss = 0.f;
#pragma unroll
        for (int jx = 0; jx < 4; ++jx) { const u32x4 q = *(const u32x4*)(X + (size_t)m * D + 8 * (lane + 64 * jx));
            v[2 * jx] = (f32x4){bflo(q.x), bfhi(q.x), bflo(q.y), bfhi(q.y)}; v[2 * jx + 1] = (f32x4){bflo(q.z), bfhi(q.z), bflo(q.w), bfhi(q.w)}; }
#pragma unroll
        for (int i = 0; i < 8; ++i) ss += (v[i].x * v[i].x + v[i].y * v[i].y) + (v[i].z * v[i].z + v[i].w * v[i].w);
        const float rstd = rsqrtf(wave_sum(ss) * (1.f / D) + EPS);
#pragma unroll
        for (int jx = 0; jx < 4; ++jx) { const int c = 8 * (lane + 64 * jx);
            *(f32x4*)(out + (size_t)m * D + c) = v[2 * jx] * rstd * *(const f32x4*)(w + c); *(f32x4*)(out + (size_t)m * D + c + 4) = v[2 * jx + 1] * rstd * *(const f32x4*)(w + c + 4); }
    }
}

template <int DV> __device__ __forceinline__ void gate_phase(const bf16* OF, const bf16* OB, const bf16* proj, int ldp, int gcol0, const float* nw, bf16* Y, int W) {
    PHASE_IDS();
    const int ncg = W / 512;
    const int nitems = MROWS * ncg;
    for (int it0 = gw; it0 < nitems; it0 += 2 * NGW) {
        u32x4 a[2], b[2], gz[2]; int mm[2], cc[2]; bool ok[2];
#pragma unroll
        for (int u = 0; u < 2; ++u) { const int it = it0 + u * NGW; ok[u] = it < nitems; const int itc = ok[u] ? it : it0; mm[u] = itc / ncg; cc[u] = (itc % ncg) * 512 + lane * 8;
            a[u] = *(const u32x4*)(OF + (size_t)mm[u] * W + cc[u]); b[u] = *(const u32x4*)(OB + (size_t)mm[u] * W + cc[u]); gz[u] = *(const u32x4*)(proj + (size_t)mm[u] * ldp + gcol0 + cc[u]); }
#pragma unroll
        for (int u = 0; u < 2; ++u) {
            float o[8], z[8];
            o[0] = bflo(a[u].x) + bflo(b[u].x); o[1] = bfhi(a[u].x) + bfhi(b[u].x); o[2] = bflo(a[u].y) + bflo(b[u].y); o[3] = bfhi(a[u].y) + bfhi(b[u].y);
            o[4] = bflo(a[u].z) + bflo(b[u].z); o[5] = bfhi(a[u].z) + bfhi(b[u].z); o[6] = bflo(a[u].w) + bflo(b[u].w); o[7] = bfhi(a[u].w) + bfhi(b[u].w);
            z[0] = bflo(gz[u].x); z[1] = bfhi(gz[u].x); z[2] = bflo(gz[u].y); z[3] = bfhi(gz[u].y); z[4] = bflo(gz[u].z); z[5] = bfhi(gz[u].z); z[6] = bflo(gz[u].w); z[7] = bfhi(gz[u].w);
            float ss = 0.f;
#pragma unroll
            for (int i = 0; i < 8; ++i) ss += o[i] * o[i];
#pragma unroll
            for (int sft = 1; sft < DV / 8; sft <<= 1) ss += __shfl_xor(ss, sft);
            const float rstd = rsqrtf(ss * (1.f / DV) + EPS);
            const int cw = cc[u] % DV;
            const f32x4 w0 = *(const f32x4*)(nw + cw), w1 = *(const f32x4*)(nw + cw + 4);
            const float wv[8] = {w0.x, w0.y, w0.z, w0.w, w1.x, w1.y, w1.z, w1.w};
            float y[8];
#pragma unroll
            for (int i = 0; i < 8; ++i) y[i] = o[i] * rstd * wv[i] * siluf_(z[i]);
            u32x4 rr; rr.x = pk2(y[0], y[1]); rr.y = pk2(y[2], y[3]); rr.z = pk2(y[4], y[5]); rr.w = pk2(y[6], y[7]);
            if (ok[u]) *(u32x4*)(Y + (size_t)mm[u] * W + cc[u]) = rr;
        }
    }
}

__device__ __forceinline__ void dn_prep_phase(const Params& P, int j, bool do_gates = true) {
    PHASE_IDS();
    const bf16* proj = (const bf16*)(P.ws + WS_BIG); bf16* QKV = (bf16*)(P.ws + WS_QKV);
    const float* cw = P.in[15] + (size_t)j * 5 * 8192;
    for (int it = gw; it < 16 * 128; it += NGW) {
        const int cg = it & 15, chunk = it >> 4, c = cg * 512 + lane * 8;
        float w[5][8];
#pragma unroll
        for (int s = 0; s < 5; ++s) { const f32x4 a = *(const f32x4*)(cw + s * 8192 + c), b = *(const f32x4*)(cw + s * 8192 + c + 4);
            w[s][0] = a.x; w[s][1] = a.y; w[s][2] = a.z; w[s][3] = a.w; w[s][4] = b.x; w[s][5] = b.y; w[s][6] = b.z; w[s][7] = b.w; }
        const float qsc = cg < 4 ? 0.08838834764831845f : 1.f;
        for (int bt = 0; bt < 16; ++bt) {
            const int r0 = chunk * 128 + bt * 8;
            const int L = r0 < MCTX ? 256 : 64, pos0 = r0 < MCTX ? (r0 & 255) : ((r0 - MCTX) & 63);
            u32x4 xw[12];
#pragma unroll
            for (int i = 0; i < 12; ++i) { const int pp = pos0 + i - 2;
                xw[i] = (pp >= 0 && pp < L) ? *(const u32x4*)(proj + (size_t)(r0 + i - 2) * DN_NMAIN + c) : (u32x4){0u, 0u, 0u, 0u}; }
#pragma unroll
            for (int o = 0; o < 8; ++o) {
                float acc[8];
#pragma unroll
                for (int i = 0; i < 8; ++i) acc[i] = 0.f;
#pragma unroll
                for (int s = 0; s < 5; ++s) { const u32x4 x = xw[o + s];
                    acc[0] += bflo(x.x) * w[s][0]; acc[1] += bfhi(x.x) * w[s][1]; acc[2] += bflo(x.y) * w[s][2]; acc[3] += bfhi(x.y) * w[s][3];
                    acc[4] += bflo(x.z) * w[s][4]; acc[5] += bfhi(x.z) * w[s][5]; acc[6] += bflo(x.w) * w[s][6]; acc[7] += bfhi(x.w) * w[s][7]; }
                float ss = 0.f;
#pragma unroll
                for (int i = 0; i < 8; ++i) { acc[i] = siluf_(acc[i]); ss += acc[i] * acc[i]; }
                if (cg < 8) {
                    ss += __shfl_xor(ss, 1); ss += __shfl_xor(ss, 2); ss += __shfl_xor(ss, 4); ss += __shfl_xor(ss, 8);
                    const float sc = rsqrtf(ss + EPS) * qsc;
#pragma unroll
                    for (int i = 0; i < 8; ++i) acc[i] *= sc;
                }
                u32x4 ov; ov.x = pk2(acc[0], acc[1]); ov.y = pk2(acc[2], acc[3]); ov.z = pk2(acc[4], acc[5]); ov.w = pk2(acc[6], acc[7]);
                *(u32x4*)(QKV + (size_t)(r0 + o) * 8192 + c) = ov;
            }
        }
    }
    if (!do_gates) return;
    float* G = (float*)(P.ws + WS_GATE);
    const float* Alog = P.in[16] + j * 64; const float* dtb = P.in[17] + j * 64;
    const float* GPp = (const float*)(P.ws + WS_GP);
    for (int i = gw * 64 + lane; i < MROWS * 128; i += NGW * 64) {
        const int col = i & 127; const float x = (GPp[i] + GPp[i + (size_t)MROWS * 128]) + (GPp[i + (size_t)2 * MROWS * 128] + GPp[i + (size_t)3 * MROWS * 128]); float y;
        if (col < 64) y = sigmoidf_(x);
        else { const int dh = col - 64; y = -__expf(Alog[dh]) * softplusf_(x + dtb[dh]); }
        G[i] = y;
    }
}

typedef short bf16x8 __attribute__((ext_vector_type(8)));
typedef short s16x4 __attribute__((ext_vector_type(4)));
typedef __bf16 bfv8 __attribute__((ext_vector_type(8)));
typedef float f32x8 __attribute__((ext_vector_type(8)));
__device__ __forceinline__ bf16x8 pack8(f32x4 a, f32x4 b) { const f32x8 v = {a[0], a[1], a[2], a[3], b[0], b[1], b[2], b[3]}; return __builtin_bit_cast(bf16x8, __builtin_convertvector(v, bfv8)); }
__device__ __forceinline__ bf16x8 cat4(s16x4 a, s16x4 b) { return (bf16x8){a[0], a[1], a[2], a[3], b[0], b[1], b[2], b[3]}; }
__device__ __forceinline__ s16x4 ld_tr(const LAS unsigned char* p) { return __builtin_amdgcn_ds_read_tr16_b64_v4i16((LAS s16x4*)p); }
__device__ __forceinline__ s16x4 ld_b64(const LAS unsigned char* p) { return *(const volatile LAS s16x4*)p; }
__device__ __forceinline__ bf16x8 ld_b128(const LAS unsigned char* p) { return *(const LAS bf16x8*)p; }
#define MFMA16(a, b, c) __builtin_amdgcn_mfma_f32_16x16x32_bf16((a), (b), (c), 0, 0, 0)

template <int KIND> __device__ __forceinline__ void gla_prep_phase(const Params& P, LAS unsigned char* lds) {
    PHASE_IDS();
    constexpr int NCH = KIND == 1 ? 1024 : 2048, LDP = KIND == 1 ? GLA_NMAIN : HG_NIN, NCB = NCH / 1024;
    const bf16* proj = (const bf16*)(P.ws + WS_BIG); const float* G = (const float*)(P.ws + WS_GATE);
    bf16* QT = (bf16*)(P.ws + WS_QKV); bf16* KT = QT + (size_t)2 * MROWS * NCH; float* E = (float*)(P.ws + WS_OF + 64 * MiB);
    constexpr int DKH = KIND == 1 ? 256 : 128, NHB = 1024 / DKH  , NHT = NCH / DKH  , PL = 2064  ;
    LAS unsigned char* QL = lds; LAS unsigned char* KL = lds + 32 * PL;
    LAS float* sa1 = (LAS float*)(lds + 2 * 32 * PL);
    unsigned* PG = (unsigned*)(P.ws + WS_OF + 72 * MiB);
    for (int it = blockIdx.x; it < 2 * 512 * NCB; it += gridDim.x) {
        const int cb_ = it % NCB, cidx = (it / NCB) % 512, d = it / (NCB * 512);
        const int c0 = cb_ * 1024 + 2 * tid, rbase = cidx * 32;
        float w0[16], w1[16], b0 = 0.f, b1 = 0.f, lb0 = 0.f, lb1 = 0.f;
        if (KIND == 1) {
            __syncthreads();
            { const int p = tid >> 4, r = tid & 15; const int row = rbase + (d ? 31 - p : p); const size_t gi = (size_t)row * 128 + d * 16 + r; const float* GPp = (const float*)(P.ws + WS_GP); sa1[tid] = (GPp[gi] + GPp[gi + (size_t)MROWS * 128]) + (GPp[gi + (size_t)2 * MROWS * 128] + GPp[gi + (size_t)3 * MROWS * 128]); }
            __syncthreads();
            const float* w2 = P.in[21] + (size_t)d * 16 * 1024 + c0;
#pragma unroll
            for (int r = 0; r < 16; ++r) { w0[r] = w2[(size_t)r * 1024]; w1[r] = w2[(size_t)r * 1024 + 1]; }
            b0 = P.in[22][d * 1024 + c0]; b1 = P.in[22][d * 1024 + c0 + 1];
        } else {
            const float* lg = P.in[26];
            { const float l0 = lg[c0], l1 = lg[2048 + c0], l2 = lg[4096 + c0], l3 = lg[6144 + c0]; const float mx = fmaxf(fmaxf(l0, l1), fmaxf(l2, l3));
              const float e0 = __expf(l0 - mx), e1 = __expf(l1 - mx), e2 = __expf(l2 - mx), e3 = __expf(l3 - mx); lb0 = (e1 + e2) / ((e0 + e1) + (e2 + e3)); }
            { const float l0 = lg[c0 + 1], l1 = lg[2048 + c0 + 1], l2 = lg[4096 + c0 + 1], l3 = lg[6144 + c0 + 1]; const float mx = fmaxf(fmaxf(l0, l1), fmaxf(l2, l3));
              const float e0 = __expf(l0 - mx), e1 = __expf(l1 - mx), e2 = __expf(l2 - mx), e3 = __expf(l3 - mx); lb1 = (e1 + e2) / ((e0 + e1) + (e2 + e3)); }
        }
        float cs0 = KIND == 1 ? 0.f : 1.f, cs1 = cs0;
#pragma unroll 8
        for (int p = 0; p < 32; ++p) {
            const int row = rbase + (d ? 31 - p : p); const bf16* pr = proj + (size_t)row * LDP;
            float q0, q1, k0, k1, la0, la1;
            if (KIND == 1) {
                const unsigned qw = *(const unsigned*)(pr + c0), kw = *(const unsigned*)(pr + 1024 + c0);
                q0 = bflo(qw) * 0.0625f; q1 = bfhi(qw) * 0.0625f; k0 = bflo(kw); k1 = bfhi(kw);
                float x0 = b0, x1 = b1;
#pragma unroll
                for (int r = 0; r < 16; ++r) { const float a = sa1[p * 16 + r]; x0 += a * w0[r]; x1 += a * w1[r]; }
                la0 = (fminf(x0, 0.f) - __logf(1.f + __expf(-fabsf(x0)))) * 0.0625f; la1 = (fminf(x1, 0.f) - __logf(1.f + __expf(-fabsf(x1)))) * 0.0625f;
            } else {
                const unsigned qw = *(const unsigned*)(pr + c0), fw = *(const unsigned*)(pr + (d ? 8192 : 6144) + c0);
                q0 = siluf_(bflo(qw)) * 0.08838834764831845f; q1 = siluf_(bfhi(qw)) * 0.08838834764831845f;
                const float a0 = lb0 + (1.f - lb0) * sigmoidf_(bflo(fw)), a1 = lb1 + (1.f - lb1) * sigmoidf_(bfhi(fw));
                k0 = 1.f - a0; k1 = 1.f - a1; la0 = a0; la1 = a1;
            }
            float e0, e1, i0, i1;
            if (KIND == 1) { cs0 += la0; cs1 += la1; e0 = __expf(cs0); e1 = __expf(cs1); i0 = __expf(-cs0); i1 = __expf(-cs1); }
            else { cs0 *= la0; cs1 *= la1; e0 = cs0; e1 = cs1; i0 = __builtin_amdgcn_rcpf(cs0); i1 = __builtin_amdgcn_rcpf(cs1); }
            const size_t o = ((size_t)d * MROWS + row) * NCH + c0;
            const unsigned qb = pk2(q0 * e0, q1 * e1), kb = pk2(k0 * i0, k1 * i1);
            *(unsigned*)(QT + o) = qb; *(unsigned*)(KT + o) = kb;
            *(LAS unsigned*)(QL + p * PL + 4 * tid) = qb; *(LAS unsigned*)(KL + p * PL + 4 * tid) = kb;
        }
        { float* e = E + ((size_t)d * 512 + cidx) * NCH + c0; e[0] = KIND == 1 ? __expf(cs0) : cs0; e[1] = KIND == 1 ? __expf(cs1) : cs1; }
        __syncthreads();
        {
            const int r = lane & 15, g = lane >> 4;
            const int hl = KIND == 1 ? (wave >> 1) : wave; const int cbase = hl * DKH;
            f32x4 t0 = {0.f, 0.f, 0.f, 0.f}, t1 = t0, t2 = t0;
            const bool do02 = KIND == 1 ? ((wave & 1) == 0) : true, do1 = KIND == 1 ? ((wave & 1) == 1) : true;
#pragma unroll
            for (int sx = 0; sx < DKH / 32; ++sx) {
                const int cb2 = (cbase + 32 * sx + 8 * g) * 2;
                const bf16x8 k0 = ld_b128(KL + r * PL + cb2), q1 = ld_b128(QL + (16 + r) * PL + cb2);
                if (do02) { const bf16x8 q0 = ld_b128(QL + r * PL + cb2), k1 = ld_b128(KL + (16 + r) * PL + cb2); t0 = MFMA16(k0, q0, t0); t2 = MFMA16(k1, q1, t2); }
                if (do1) t1 = MFMA16(k0, q1, t1);
            }
#pragma unroll
            for (int e = 0; e < 4; ++e) { if (r < 4 * g + e) { t0[e] = 0.f; t2[e] = 0.f; } }
            unsigned* pg = PG + (((size_t)d * 512 + cidx) * NHT + cb_ * NHB + hl) * 384 + lane * 2;
            if (do02) { pg[0] = pk2(t0[0], t0[1]); pg[1] = pk2(t0[2], t0[3]); pg[256] = pk2(t2[0], t2[1]); pg[257] = pk2(t2[2], t2[3]); }
            if (do1) { pg[128] = pk2(t1[0], t1[1]); pg[129] = pk2(t1[2], t1[3]); }
        }
        __syncthreads();
    }
}

template <int KIND> __device__ __forceinline__ void gla_chunk_phase(const Params& P, LAS unsigned char* lds) {
    PHASE_IDS();
    constexpr int DK = KIND == 1 ? 256 : 128, DV = KIND == 1 ? 512 : 128, NH = KIND == 1 ? 4 : 16, NSL = DV / 128, NKT = DK / 16, NCH = NH * DK;
    constexpr int LDP = KIND == 1 ? GLA_NMAIN : HG_NIN, W = 2048;
    constexpr int PQ = DK * 2 + 16, PV = 256 + 16;
    constexpr int OFF_Q = 0, OFF_K = 32 * PQ, OFF_V = 2 * 32 * PQ, OFF_E = OFF_V + 32 * PV;
    constexpr int NPQ = 32 * DK / 8 / NT;
    const bf16* proj = (const bf16*)(P.ws + WS_BIG);
    const bf16* QT = (const bf16*)(P.ws + WS_QKV); const bf16* KT = QT + (size_t)2 * MROWS * NCH; const float* Eg = (const float*)(P.ws + WS_OF + 64 * MiB);
    bf16* OF = (bf16*)(P.ws + WS_OF); bf16* OB = (bf16*)(P.ws + WS_OB);
    const u32x2* PG = (const u32x2*)(P.ws + WS_OF + 72 * MiB);
    const int r = lane & 15, g = lane >> 4, q4 = (lane & 15) >> 2, p4 = lane & 3;
    constexpr int UL = 4 * NH * 2 * NSL  , UC = 32 * NH * 2 * NSL  ;
    const int G = gridDim.x, bx = blockIdx.x;
    const bool bal = (G == 2 * UL);
    const int nun = bal ? (bx < UL ? 1 : UC / UL) : (UL + UC - bx + G - 1) / G;
    for (int ui = 0; ui < nun; ++ui) {
        const int bxl = bx < UL ? bx : bx - UL;
        const int bxq = (bal && NSL == 4) ? (((bxl & 7) + 8 * (bxl >> 5)) * 4 + ((bxl >> 3) & 3)) : bxl;
        const int unit = bal ? (bx < UL ? bxq : UL + bxq + UL * ui) : bx + ui * G;
        const bool lat = unit < UL; int u2 = lat ? unit : unit - UL;
        const int sl = u2 % NSL; u2 /= NSL; const int d = u2 & 1; u2 >>= 1; const int h = u2 % NH; const int b = u2 / NH;
        const int T = lat ? 2048 : 256, row0 = lat ? MCTX + b * 2048 : b * 256, nchunk = T / 32;
        bf16* O = d ? OB : OF;
        f32x4 S[NKT];
        { const float* s0 = (KIND == 1 ? P.in[4] : P.in[5]) + ((((size_t)b * 2 + d) * NH + h) * DK) * DV + sl * 128 + 16 * wave + r;
#pragma unroll
          for (int kt = 0; kt < NKT; ++kt)
#pragma unroll
              for (int e = 0; e < 4; ++e) S[kt][e] = lat ? s0[(size_t)(16 * kt + 4 * g + e) * DV] : 0.f; }
        u32x4 rq[NPQ], rk[NPQ], rv; f32x4 re = {0.f, 0.f, 0.f, 0.f}; u32x2 rp0 = {0u, 0u}, rp1 = rp0, rp2 = rp0;
#define GLC_PREFETCH(c_) do { \
            _Pragma("unroll") for (int x = 0; x < NPQ; ++x) { const int pi = tid + x * NT, pr = pi / (DK / 8), pc = pi % (DK / 8); const int pp = (c_) * 32 + pr; const int t = d ? T - 1 - pp : pp; \
                const size_t o = ((size_t)d * MROWS + row0 + t) * NCH + h * DK + pc * 8; rq[x] = *(const u32x4*)(QT + o); rk[x] = *(const u32x4*)(KT + o); } \
            { const int pr = tid >> 4, pc = tid & 15; const int pp = (c_) * 32 + pr; const int t = d ? T - 1 - pp : pp; rv = *(const u32x4*)(proj + (size_t)(row0 + t) * LDP + 2048 + h * DV + sl * 128 + pc * 8); } \
            { const int cg = d ? (row0 + T) / 32 - 1 - (c_) : row0 / 32 + (c_); if (tid < DK / 4) re = *(const f32x4*)(Eg + ((size_t)d * 512 + cg) * NCH + h * DK + tid * 4); \
              const u32x2* pg = PG + (((size_t)d * 512 + cg) * NH + h) * 192 + lane; rp0 = pg[0]; rp1 = pg[64]; rp2 = pg[128]; } } while (0)
        GLC_PREFETCH(0);
        for (int c = 0; c < nchunk; ++c) {
            __syncthreads();
#pragma unroll
            for (int x = 0; x < NPQ; ++x) { const int pi = tid + x * NT, pr = pi / (DK / 8), pc = pi % (DK / 8);
                *(LAS u32x4*)(lds + OFF_Q + pr * PQ + pc * 16) = rq[x]; *(LAS u32x4*)(lds + OFF_K + pr * PQ + pc * 16) = rk[x]; }
            { const int pr = tid >> 4, pc = tid & 15; *(LAS u32x4*)(lds + OFF_V + pr * PV + pc * 16) = rv; }
            if (tid < DK / 4) *(LAS f32x4*)(lds + OFF_E + tid * 16) = re;
            __syncthreads();
            const u32x2 cp0 = rp0, cp1 = rp1, cp2 = rp2;
            if (c + 1 < nchunk) GLC_PREFETCH(c + 1);
            const f32x4 zero4 = {0.f, 0.f, 0.f, 0.f};
            const bf16x8 vpa = cat4(ld_tr(lds + OFF_V + (4 * g + q4) * PV + (16 * wave + 4 * p4) * 2), ld_tr(lds + OFF_V + (16 + 4 * g + q4) * PV + (16 * wave + 4 * p4) * 2));
            const bf16x8 pb0 = __builtin_bit_cast(bf16x8, (u32x4){cp0.x, cp0.y, 0u, 0u}), pb1 = __builtin_bit_cast(bf16x8, (u32x4){cp1.x, cp1.y, cp2.x, cp2.y});
            f32x4 o0 = MFMA16(vpa, pb0, zero4), o1 = MFMA16(vpa, pb1, zero4);
#pragma unroll
            for (int s = 0; s < DK / 32; ++s) {
                const bf16x8 sb = pack8(S[2 * s], S[2 * s + 1]);
                const bf16x8 a0 = cat4(ld_b64(lds + OFF_Q + r * PQ + (32 * s + 4 * g) * 2), ld_b64(lds + OFF_Q + r * PQ + (32 * s + 16 + 4 * g) * 2));
                const bf16x8 a1 = cat4(ld_b64(lds + OFF_Q + (16 + r) * PQ + (32 * s + 4 * g) * 2), ld_b64(lds + OFF_Q + (16 + r) * PQ + (32 * s + 16 + 4 * g) * 2));
                o0 = MFMA16(sb, a0, o0); o1 = MFMA16(sb, a1, o1);
                if (KIND == 1 && (s & 3) == 3) asm volatile("" ::: "memory");
            }
            { const int colo = h * DV + sl * 128 + 16 * wave + 4 * g; const int pp0 = c * 32 + r, pp1 = c * 32 + 16 + r; const int t0 = d ? T - 1 - pp0 : pp0, t1 = d ? T - 1 - pp1 : pp1;
              u32x2 w0, w1; w0.x = pk2(o0[0], o0[1]); w0.y = pk2(o0[2], o0[3]); w1.x = pk2(o1[0], o1[1]); w1.y = pk2(o1[2], o1[3]);
              *(u32x2*)(O + (size_t)(row0 + t0) * W + colo) = w0; *(u32x2*)(O + (size_t)(row0 + t1) * W + colo) = w1; }
            const bf16x8 vb = cat4(ld_tr(lds + OFF_V + (8 * g + q4) * PV + (16 * wave + 4 * p4) * 2), ld_tr(lds + OFF_V + (8 * g + 4 + q4) * PV + (16 * wave + 4 * p4) * 2));
#pragma unroll
            for (int kt = 0; kt < NKT; ++kt) {
                const bf16x8 ka = cat4(ld_tr(lds + OFF_K + (8 * g + q4) * PQ + (16 * kt + 4 * p4) * 2), ld_tr(lds + OFF_K + (8 * g + 4 + q4) * PQ + (16 * kt + 4 * p4) * 2));
                const f32x4 ev = *(const LAS f32x4*)(lds + OFF_E + (16 * kt + 4 * g) * 4);
                S[kt] = MFMA16(ka, vb, S[kt]) * ev;
                if (KIND == 1 && (kt & 7) == 7) asm volatile("" ::: "memory");
            }
        }
#undef GLC_PREFETCH
        if (!lat) { float* sd = P.out + (KIND == 1 ? OUT_SGLA : OUT_SHG) + ((((size_t)b * 2 + d) * NH + h) * DK) * DV + sl * 128 + 16 * wave + r;
#pragma unroll
            for (int kt = 0; kt < NKT; ++kt)
#pragma unroll
                for (int e = 0; e < 4; ++e) sd[(size_t)(16 * kt + 4 * g + e) * DV] = S[kt][e]; }
    }
}

#define MFMA4F(a, b, c) __builtin_amdgcn_mfma_f32_16x16x4f32((a), (b), (c), 0, 0, 0)
template <int I> __device__ __forceinline__ float row_share(float v) { return __builtin_bit_cast(float, __builtin_amdgcn_update_dpp(0, __builtin_bit_cast(int, v), 0x150 + I, 0xf, 0xf, false)); }
template <int I> struct DiagStep {
    static __device__ __forceinline__ void run(const float (&Ld)[16], float (&x)[16], int cc) {
        DiagStep<I - 1>::run(Ld, x, cc);
        float a0 = (I == cc) ? 1.f : 0.f, a1 = 0.f;
#pragma unroll
        for (int m = 0; m < I; ++m) { const float lv = row_share<I>(Ld[m]); if (m & 1) a1 -= lv * x[m]; else a0 -= lv * x[m]; }
        x[I] = a0 + a1;
    }
};
template <> struct DiagStep<-1> { static __device__ __forceinline__ void run(const float (&)[16], float (&)[16], int) {} };
__device__ __forceinline__ void dn_wu_prep_phase(const Params& P, LAS unsigned char* lds) {
    PHASE_IDS();
    constexpr int PKQ = 272;
    constexpr int LP = 68;
    constexpr int OFF_K = 0, OFF_Q = 64 * PKQ, OFF_L = 0  , OFF_KK = 4 * 64 * LP * 4, OFF_QK = OFF_KK + 64 * LP * 4, OFF_G = OFF_QK + 64 * LP * 4;
    const bf16* QKV = (const bf16*)(P.ws + WS_QKV); const float* G = (const float*)(P.ws + WS_GATE);
    bf16* TA = (bf16*)(P.ws + WS_TA); float* GS = (float*)(P.ws + WS_GS);
    const int r = lane & 15, g = lane >> 4;
    LAS float* KKs = (LAS float*)(lds + OFF_KK); LAS float* QKs = (LAS float*)(lds + OFF_QK); LAS float* Gs = (LAS float*)(lds + OFF_G);
    u32x4 pq[2], pk[2]; float pgv = 0.f;
#define WU_PREFETCH(grp_) do { const int cidx_ = (grp_) >> 4, kh_ = (grp_) & 15, rb_ = cidx_ * 64; \
        _Pragma("unroll") for (int x = 0; x < 2; ++x) { const int pi = tid + x * NT, pr = pi >> 4, pc = pi & 15; const size_t o = (size_t)(rb_ + pr) * 8192 + kh_ * 128 + pc * 8; pq[x] = *(const u32x4*)(QKV + o); pk[x] = *(const u32x4*)(QKV + o + 2048); } \
        { const int c4 = tid >> 7, which = (tid >> 6) & 1, i = tid & 63, hv = c4 >> 1, d = c4 & 1, h = 2 * kh_ + hv; pgv = G[(size_t)(rb_ + i) * 128 + (which ? 0 : 64) + d * 32 + h]; } } while (0)
    if ((int)blockIdx.x < 256 * 16) WU_PREFETCH(blockIdx.x);
    for (int grp = blockIdx.x; grp < 256 * 16; grp += gridDim.x) {
        const int cidx = grp >> 4, kh = grp & 15;
        __syncthreads();
#pragma unroll
        for (int x = 0; x < 2; ++x) { const int pi = tid + x * NT, pr = pi >> 4, pc = pi & 15;
            *(LAS u32x4*)(lds + OFF_Q + pr * PKQ + pc * 16) = pq[x]; *(LAS u32x4*)(lds + OFF_K + pr * PKQ + pc * 16) = pk[x]; }
        Gs[tid] = pgv;
        __syncthreads();
        if (grp + (int)gridDim.x < 256 * 16) WU_PREFETCH(grp + (int)gridDim.x);
        {
            const int it = wave & 3; const int offx = (wave >> 2) ? OFF_Q : OFF_K; LAS float* dst = (wave >> 2) ? QKs : KKs;
            f32x4 acc[4];
#pragma unroll
            for (int jt = 0; jt < 4; ++jt) acc[jt] = (f32x4){0.f, 0.f, 0.f, 0.f};
#pragma unroll
            for (int sx = 0; sx < 4; ++sx) { const bf16x8 a = ld_b128(lds + offx + (16 * it + r) * PKQ + (32 * sx + 8 * g) * 2);
#pragma unroll
                for (int jt = 0; jt < 4; ++jt) acc[jt] = MFMA16(a, ld_b128(lds + OFF_K + (16 * jt + r) * PKQ + (32 * sx + 8 * g) * 2), acc[jt]); }
#pragma unroll
            for (int jt = 0; jt < 4; ++jt)
#pragma unroll
                for (int e = 0; e < 4; ++e) dst[(16 * it + 4 * g + e) * LP + 16 * jt + r] = acc[jt][e];
        }
        __syncthreads();
        {
            const int c4 = wave & 3, hv = c4 >> 1, d = c4 & 1, h = 2 * kh + hv;
            const int nl = d ? 63 - lane : lane;
            float gcv = Gs[(c4 * 2 + 0) * 64 + nl];
#pragma unroll
            for (int o = 1; o < 64; o <<= 1) { const float t = __shfl_up(gcv, o); if (lane >= o) gcv += t; }
            const float betav = Gs[(c4 * 2 + 1) * 64 + nl];
            const size_t item = ((size_t)(cidx * 32 + h) * 2 + d);
            if (wave >= 4) {
                bf16* Ag = TA + item * 8192 + 4096;
                for (int p = 0; p < 64; ++p) { const float gp = rdlane(gcv, p); const int np_ = d ? 63 - p : p;
                    const float qk = QKs[np_ * LP + nl]; if ((lane & ~7) <= p) Ag[p * 64 + lane] = (bf16)f2bf(lane <= p ? qk * __expf(gp - gcv) : 0.f); }
                float* gs = GS + item * 192; const float gend = rdlane(gcv, 63);
                gs[lane] = __expf(gcv); gs[64 + lane] = betav; gs[128 + lane] = __expf(gend - gcv);
            } else {
                LAS float* W = (LAS float*)(lds + OFF_L) + c4 * 64 * LP;
                for (int p = 0; p < 64; ++p) { const float gp = rdlane(gcv, p), bp = rdlane(betav, p); const int np_ = d ? 63 - p : p;
                    const float kk = KKs[np_ * LP + nl]; W[p * LP + lane] = lane < p ? bp * kk * __expf(gp - gcv) : 0.f; }
                {
                    const int lane2 = opaque_v(lane); const int bb = lane2 >> 4, cc = lane2 & 15;
                    float Ld[16];
#pragma unroll
                    for (int m4 = 0; m4 < 4; ++m4) { const f32x4 v = *(const LAS f32x4*)(W + (16 * bb + cc) * LP + 16 * bb + 4 * m4); Ld[4 * m4] = v[0]; Ld[4 * m4 + 1] = v[1]; Ld[4 * m4 + 2] = v[2]; Ld[4 * m4 + 3] = v[3]; }
                    float x[16];
                    DiagStep<15>::run(Ld, x, cc);
#pragma unroll
                    for (int i = 0; i < 16; ++i) W[(16 * bb + i) * LP + 16 * bb + cc] = x[i];
                }
#define WU_PN(ar, ac, br, bc, acc_) do { _Pragma("unroll") for (int sx = 0; sx < 4; ++sx) acc_ = MFMA4F(W[((ar) + r) * LP + (ac) + 4 * sx + g], W[((br) + 4 * sx + g) * LP + (bc) + r], acc_); } while (0)
#define WU_PA(ar, ac, M_, acc_) do { _Pragma("unroll") for (int e = 0; e < 4; ++e) acc_ = MFMA4F(W[((ar) + r) * LP + (ac) + 4 * g + e], M_[e], acc_); } while (0)
#define WU_ST(r0, c0, acc_) do { _Pragma("unroll") for (int e = 0; e < 4; ++e) W[((r0) + 4 * g + e) * LP + (c0) + r] = -acc_[e]; } while (0)
                const f32x4 z4 = {0.f, 0.f, 0.f, 0.f};
                { f32x4 m1a = z4, m1b = z4; WU_PN(16, 0, 0, 0, m1a); WU_PN(48, 32, 32, 32, m1b);
                  f32x4 t10 = z4, t32 = z4; WU_PA(16, 16, m1a, t10); WU_PA(48, 48, m1b, t32);
                  WU_ST(16, 0, t10); WU_ST(48, 32, t32); }
                { f32x4 m00 = z4, m01 = z4, m10 = z4, m11 = z4;
                  WU_PN(32, 0, 0, 0, m00); WU_PN(32, 16, 16, 0, m00); WU_PN(32, 16, 16, 16, m01);
                  WU_PN(48, 0, 0, 0, m10); WU_PN(48, 16, 16, 0, m10); WU_PN(48, 16, 16, 16, m11);
                  f32x4 t00 = z4, t01 = z4, t10 = z4, t11 = z4;
                  WU_PA(32, 32, m00, t00); WU_PA(32, 32, m01, t01);
                  WU_PA(48, 32, m00, t10); WU_PA(48, 48, m10, t10); WU_PA(48, 32, m01, t11); WU_PA(48, 48, m11, t11);
                  WU_ST(32, 0, t00); WU_ST(32, 16, t01); WU_ST(48, 0, t10); WU_ST(48, 16, t11); }
#undef WU_PN
#undef WU_PA
#undef WU_ST
                bf16* Tg = TA + item * 8192;
#pragma unroll
                for (int x8 = 0; x8 < 8; ++x8) { const int piece = lane + 64 * x8, row = piece >> 3, pc = piece & 7;
                    const f32x4 v0 = *(const LAS f32x4*)(W + row * LP + pc * 8), v1 = *(const LAS f32x4*)(W + row * LP + pc * 8 + 4);
                    u32x4 o; o.x = pk2(v0[0], v0[1]); o.y = pk2(v0[2], v0[3]); o.z = pk2(v1[0], v1[1]); o.w = pk2(v1[2], v1[3]);
                    if (pc * 8 <= row) *(u32x4*)(Tg + row * 64 + pc * 8) = o; }
            }
        }
    }
#undef WU_PREFETCH
}

constexpr int DN_PQ = 272, DN_PT = 144;
constexpr int DN_OFF_Q = 0, DN_OFF_K = 64 * DN_PQ, DN_OFF_V = 2 * 64 * DN_PQ, DN_OFF_T = 3 * 64 * DN_PQ, DN_OFF_A = DN_OFF_T + 64 * DN_PT, DN_OFF_S = DN_OFF_A + 64 * DN_PT;
struct DnStage { u32x4 rq[2], rk[2], rv[2], rt, ra; f32x4 rs; };
__device__ __forceinline__ void dn_stage_load(DnStage& st, const bf16* QKV, const bf16* TA, const float* GS, int tid, int c, int d, int T, int row0, int kh, int h, int nchunk) {
#pragma unroll
    for (int x = 0; x < 2; ++x) { const int pi = tid + x * NT, pr = pi >> 4, pc = pi & 15; const int pp = c * 64 + pr; const int t = d ? T - 1 - pp : pp;
        const size_t o = (size_t)(row0 + t) * 8192 + pc * 8; st.rq[x] = *(const u32x4*)(QKV + o + kh * 128); st.rk[x] = *(const u32x4*)(QKV + o + 2048 + kh * 128); st.rv[x] = *(const u32x4*)(QKV + o + 4096 + h * 128); }
    const int nc = d ? nchunk - 1 - c : c; const size_t item = ((size_t)((row0 >> 6) + nc) * 32 + h) * 2 + d;
    const bool nz = ((tid & 7) * 8) <= (tid >> 3);
    st.rt = nz ? *(const u32x4*)(TA + item * 8192 + tid * 8) : (u32x4){0u, 0u, 0u, 0u}; st.ra = nz ? *(const u32x4*)(TA + item * 8192 + 4096 + tid * 8) : (u32x4){0u, 0u, 0u, 0u};
    st.rs = (f32x4){0.f, 0.f, 0.f, 0.f}; if (tid < 48) st.rs = *(const f32x4*)(GS + item * 192 + tid * 4);
}
__device__ __forceinline__ void dn_stage_store(const DnStage& st, LAS unsigned char* lds, int tid) {
#pragma unroll
    for (int x = 0; x < 2; ++x) { const int pi = tid + x * NT, pr = pi >> 4, pc = pi & 15;
        *(LAS u32x4*)(lds + DN_OFF_Q + pr * DN_PQ + pc * 16) = st.rq[x]; *(LAS u32x4*)(lds + DN_OFF_K + pr * DN_PQ + pc * 16) = st.rk[x]; *(LAS u32x4*)(lds + DN_OFF_V + pr * DN_PQ + pc * 16) = st.rv[x]; }
    { const int pr = tid >> 3, pc = tid & 7; *(LAS u32x4*)(lds + DN_OFF_T + pr * DN_PT + pc * 16) = st.rt; *(LAS u32x4*)(lds + DN_OFF_A + pr * DN_PT + pc * 16) = st.ra; }
    if (tid < 48) *(LAS f32x4*)(lds + DN_OFF_S + tid * 16) = st.rs;
}
__device__ __forceinline__ void dn_step_compute(f32x4 (&S)[8], LAS unsigned char* lds, bf16* O, int c, int d, int T, int row0, int h, int wave, int lane) {
    constexpr int PQ = DN_PQ, PT = DN_PT, OFF_Q = DN_OFF_Q, OFF_K = DN_OFF_K, OFF_V = DN_OFF_V, OFF_T = DN_OFF_T, OFF_A = DN_OFF_A, OFF_S = DN_OFF_S;
    const int r = lane & 15, g = lane >> 4, q4 = (lane & 15) >> 2, p4 = lane & 3;
#define DN_PERMROW(off_, pitch_, row_, col_) cat4(ld_b64(lds + (off_) + (row_) * (pitch_) + ((col_) + 4 * g) * 2), ld_b64(lds + (off_) + (row_) * (pitch_) + ((col_) + 16 + 4 * g) * 2))
    const f32x4 zero4 = {0.f, 0.f, 0.f, 0.f};
    bf16x8 sb[4];
    f32x4 R[4];
    {
        bf16x8 kf[4][4];
#pragma unroll
        for (int jt = 0; jt < 4; ++jt)
#pragma unroll
            for (int sx = 0; sx < 4; ++sx) kf[jt][sx] = DN_PERMROW(OFF_K, PQ, 16 * jt + r, 32 * sx);
#pragma unroll
        for (int sx = 0; sx < 4; ++sx) sb[sx] = pack8(S[2 * sx], S[2 * sx + 1]);
#pragma unroll
        for (int jt = 0; jt < 4; ++jt) R[jt] = zero4;
#pragma unroll
        for (int sx = 0; sx < 4; ++sx)
#pragma unroll
            for (int jt = 0; jt < 4; ++jt) R[jt] = MFMA16(kf[jt][sx], sb[sx], R[jt]);
    }
    __builtin_amdgcn_sched_barrier(0);
    f32x4 U[4];
    {
        bf16x8 tf[4][2]; s16x4 vt[4]; f32x4 eg[4], bt[4];
#pragma unroll
        for (int jt = 0; jt < 4; ++jt) { vt[jt] = ld_tr(lds + OFF_V + (16 * jt + 4 * g + q4) * PQ + (16 * wave + 4 * p4) * 2);
            eg[jt] = *(const LAS f32x4*)(lds + OFF_S + (16 * jt + 4 * g) * 4); bt[jt] = *(const LAS f32x4*)(lds + OFF_S + 256 + (16 * jt + 4 * g) * 4); }
#pragma unroll
        for (int it = 0; it < 4; ++it) { tf[it][0] = DN_PERMROW(OFF_T, PT, 16 * it + r, 0); tf[it][1] = DN_PERMROW(OFF_T, PT, 16 * it + r, 32); }
#pragma unroll
        for (int jt = 0; jt < 4; ++jt)
#pragma unroll
            for (int e = 0; e < 4; ++e) R[jt][e] = bt[jt][e] * (bf2f((unsigned short)vt[jt][e]) - eg[jt][e] * R[jt][e]);
        const bf16x8 rb0 = pack8(R[0], R[1]), rb1 = pack8(R[2], R[3]);
#pragma unroll
        for (int it = 0; it < 4; ++it) U[it] = MFMA16(tf[it][0], rb0, zero4);
#pragma unroll
        for (int it = 0; it < 4; ++it) U[it] = MFMA16(tf[it][1], rb1, U[it]);
    }
    __builtin_amdgcn_sched_barrier(0);
    {
        f32x4 Ot[4];
#pragma unroll
        for (int it = 0; it < 4; ++it) Ot[it] = zero4;
#pragma unroll
        for (int hq = 0; hq < 2; ++hq) {
            bf16x8 qf[2][4];
#pragma unroll
            for (int i2 = 0; i2 < 2; ++i2)
#pragma unroll
                for (int sx = 0; sx < 4; ++sx) qf[i2][sx] = DN_PERMROW(OFF_Q, PQ, 16 * (2 * hq + i2) + r, 32 * sx);
#pragma unroll
            for (int sx = 0; sx < 4; ++sx)
#pragma unroll
                for (int i2 = 0; i2 < 2; ++i2) Ot[2 * hq + i2] = MFMA16(sb[sx], qf[i2][sx], Ot[2 * hq + i2]);
        }
        bf16x8 af[4][2]; float egi[4];
#pragma unroll
        for (int it = 0; it < 4; ++it) { af[it][0] = DN_PERMROW(OFF_A, PT, 16 * it + r, 0); af[it][1] = DN_PERMROW(OFF_A, PT, 16 * it + r, 32); egi[it] = *(const LAS float*)(lds + OFF_S + (16 * it + r) * 4); }
        const bf16x8 ub0 = pack8(U[0], U[1]), ub1 = pack8(U[2], U[3]);
#pragma unroll
        for (int it = 0; it < 4; ++it) Ot[it] = Ot[it] * egi[it];
#pragma unroll
        for (int it = 0; it < 4; ++it) Ot[it] = MFMA16(ub0, af[it][0], Ot[it]);
#pragma unroll
        for (int it = 0; it < 4; ++it) Ot[it] = MFMA16(ub1, af[it][1], Ot[it]);
#pragma unroll
        for (int it = 0; it < 4; ++it) { const int pp = c * 64 + 16 * it + r; const int t = d ? T - 1 - pp : pp; u32x2 w; w.x = pk2(Ot[it][0], Ot[it][1]); w.y = pk2(Ot[it][2], Ot[it][3]);
            *(u32x2*)(O + (size_t)(row0 + t) * 4096 + h * 128 + 16 * wave + 4 * g) = w; }
    }
    __builtin_amdgcn_sched_barrier(0);
    {
#pragma unroll
        for (int jt = 0; jt < 4; ++jt) { const f32x4 dc = *(const LAS f32x4*)(lds + OFF_S + 512 + (16 * jt + 4 * g) * 4); U[jt] = U[jt] * dc; }
        const bf16x8 us0 = pack8(U[0], U[1]), us1 = pack8(U[2], U[3]);
        const float gend = *(const LAS float*)(lds + OFF_S + 63 * 4);
#pragma unroll
        for (int hk = 0; hk < 2; ++hk) {
            bf16x8 ktf[4][2];
#pragma unroll
            for (int k2 = 0; k2 < 4; ++k2) { const int kt = 4 * hk + k2;
                ktf[k2][0] = cat4(ld_tr(lds + OFF_K + (4 * g + q4) * PQ + (16 * kt + 4 * p4) * 2), ld_tr(lds + OFF_K + (16 + 4 * g + q4) * PQ + (16 * kt + 4 * p4) * 2));
                ktf[k2][1] = cat4(ld_tr(lds + OFF_K + (32 + 4 * g + q4) * PQ + (16 * kt + 4 * p4) * 2), ld_tr(lds + OFF_K + (48 + 4 * g + q4) * PQ + (16 * kt + 4 * p4) * 2)); }
#pragma unroll
            for (int k2 = 0; k2 < 4; ++k2) S[4 * hk + k2] = MFMA16(ktf[k2][0], us0, S[4 * hk + k2] * gend);
#pragma unroll
            for (int k2 = 0; k2 < 4; ++k2) S[4 * hk + k2] = MFMA16(ktf[k2][1], us1, S[4 * hk + k2]);
        }
    }
#undef DN_PERMROW
}
__device__ __forceinline__ void dn_chunk_phase(const Params& P, int j, LAS unsigned char* lds) {
    PHASE_IDS();
    const bf16* QKV = (const bf16*)(P.ws + WS_QKV); const bf16* TA = (const bf16*)(P.ws + WS_TA); const float* GS = (const float*)(P.ws + WS_GS);
    bf16* OF = (bf16*)(P.ws + WS_OF); bf16* OB = (bf16*)(P.ws + WS_OB);
    const int r = lane & 15, g = lane >> 4;
    const int bxp = (gridDim.x == 256) ? ({ const int x = blockIdx.x & 7, y = blockIdx.x >> 3, grp = x + 8 * (y >> 1), mem = y & 1; (grp >> 5) * 64 + (2 * ((grp >> 1) & 15) + mem) * 2 + (grp & 1); }) : (int)blockIdx.x;
    for (int unit0 = blockIdx.x; unit0 < 256 + 2048; unit0 += gridDim.x) {
        const int unit = (gridDim.x == 256) ? (unit0 - (int)blockIdx.x + bxp) : unit0;
        const bool lat = unit < 256; const int u2 = lat ? unit : unit - 256;
        const int b = u2 >> 6, h = (u2 >> 1) & 31, d = u2 & 1, T = lat ? 2048 : 256, row0 = lat ? MCTX + b * 2048 : b * 256, kh = h >> 1, nchunk = T / 64;
        bf16* O = d ? OB : OF;
        f32x4 S[8];
        { const float* s0 = P.in[3] + ((((size_t)b * 2 + j) * 2 + d) * 32 + h) * 128 * 128 + 16 * wave + r;
          if (lat) {
#pragma unroll
              for (int kt = 0; kt < 8; ++kt)
#pragma unroll
                  for (int e = 0; e < 4; ++e) S[kt][e] = s0[(size_t)(16 * kt + 4 * g + e) * 128];
          } else {
#pragma unroll
              for (int kt = 0; kt < 8; ++kt) S[kt] = (f32x4){0.f, 0.f, 0.f, 0.f};
          } }
        constexpr int DN_HSZ = DN_OFF_S + 768;
        DnStage sa;
        __syncthreads();
        dn_stage_load(sa, QKV, TA, GS, tid, 0, d, T, row0, kh, h, nchunk);
        dn_stage_store(sa, lds, tid);
        dn_stage_load(sa, QKV, TA, GS, tid, 1, d, T, row0, kh, h, nchunk);
        __syncthreads();
        for (int c = 0; c < nchunk; ++c) {
            LAS unsigned char* cur = lds + (c & 1) * DN_HSZ; LAS unsigned char* nxt = lds + ((c + 1) & 1) * DN_HSZ;
            if (c + 1 < nchunk) dn_stage_store(sa, nxt, tid);
            if (c + 2 < nchunk) dn_stage_load(sa, QKV, TA, GS, tid, c + 2, d, T, row0, kh, h, nchunk);
            dn_step_compute(S, cur, O, c, d, T, row0, h, wave, lane);
            __syncthreads();
        }
        if (!lat) { float* sd = P.out + OUT_SDN + ((((size_t)b * 2 + j) * 2 + d) * 32 + h) * 128 * 128 + 16 * wave + r;
#pragma unroll
            for (int kt = 0; kt < 8; ++kt)
#pragma unroll
                for (int e = 0; e < 4; ++e) sd[(size_t)(16 * kt + 4 * g + e) * 128] = S[kt][e]; }
    }
}


#ifndef R_CONV
#define R_CONV 1
#endif
#ifndef R_MOD
#define R_MOD 1
#endif
#ifndef R_NORM
#define R_NORM 1
#endif
#ifndef R_GATE
#define R_GATE 1
#endif
#ifndef R_DNPREP
#define R_DNPREP 1
#endif
#ifndef R_WU
#define R_WU 1
#endif
#ifndef R_GLAPREP
#define R_GLAPREP 1
#endif
#ifndef R_DNSCAN
#define R_DNSCAN 1
#endif
#ifndef R_GSCAN
#define R_GSCAN 1
#endif
#ifndef R_FINAL
#define R_FINAL 1
#endif
#ifndef R_BAR
#define R_BAR 1
#endif
#ifndef R_GEMM
#define R_GEMM 1
#endif
#define REPN(n_) for (int rep_ = 0; rep_ < (n_); ++rep_)
#ifndef REP_THIN
#define REP_THIN 1
#endif
#ifndef REP_SCAN
#define REP_SCAN 1
#endif
#ifndef REP_A
#define REP_A 1
#endif
#ifndef REP_B
#define REP_B 1
#endif
#ifndef REP_C
#define REP_C 1
#endif
#define RT for (int rep_ = 0; rep_ < REP_THIN; ++rep_)
#define RA for (int rep_ = 0; rep_ < REP_A; ++rep_)
#define RB for (int rep_ = 0; rep_ < REP_B; ++rep_)
#define RC for (int rep_ = 0; rep_ < REP_C; ++rep_)
#define RS for (int rep_ = 0; rep_ < REP_SCAN; ++rep_)
template <int LAYER> __device__ __forceinline__ void layer_body(const Params& P, LAS unsigned char* lds, const XcdBarrier& bar) {
    bf16* X = (bf16*)(P.ws + WS_X); bf16* H = (bf16*)(P.ws + WS_H); bf16* BIG = (bf16*)(P.ws + WS_BIG); float* GATE = (float*)(P.ws + WS_GATE);
    bf16* Y = (bf16*)(P.ws + WS_QKV); bf16* OF = (bf16*)(P.ws + WS_OF); bf16* OB = (bf16*)(P.ws + WS_OB);
    const float* MOD = (const float*)(P.ws + WS_MOD);
    const bf16* Tin = (const bf16*)(P.ws + WS_W + WOFF_IN); const bf16* Tout = (const bf16*)(P.ws + WS_W + WOFF_OUT); const bf16* Tup = (const bf16*)(P.ws + WS_W + WOFF_UP); const bf16* Tdn = (const bf16*)(P.ws + WS_W + WOFF_DOWN);

        constexpr int layer = LAYER, kind = LAYER % 3, j = LAYER / 3;
        const float* modl = MOD + (size_t)layer * 5 * MODW;
        const void* xc = layer == 0 ? (const void*)P.in[0] : (const void*)X; const void* xl = layer == 0 ? (const void*)P.in[1] : (const void*)X;
#ifndef NO_CONV
        REPN(R_CONV) convert_layer_weights(P, layer, lds);
#endif
        if (layer == 0) REPN(R_BAR) xcd_barrier(bar);
        REPN(R_NORM) norm_mod_phase<layer == 0>(xc, xl, P.in[9] + layer * D, modl, 0, 2048, H);
        REPN(R_BAR) xcd_barrier(bar);
        {
            constexpr int Npad = kind == 0 ? DN_NPAD : (kind == 1 ? GLA_NPAD : HG_NIN), nmain = kind == 0 ? DN_NMAIN : (kind == 1 ? GLA_NMAIN : HG_NIN);
            { pg8::Gemm g = pg8::mk_gemm(H, Tin, MROWS, nmain, D); pg8::StaticOrder S; S.init(MROWS, nmain, (int)gridDim.x, (int)blockIdx.x);
              pg8::EpiBf16<0> E{BIG, nmain, nmain, GATE};
              REPN(R_GEMM) pg8::gemm_phase<pg8::EpiBf16<0>, pg8::StaticOrder, true, true>(lds, g, S, E); }
            if constexpr (Npad > nmain) {
              pg8::Gemm g{H, Tin + (size_t)nmain * D, MROWS, 4 * 256, D, (size_t)512 * 2, (size_t)512 * 2, 8}; pg8::StaticOrder S; S.init(MROWS, 4 * 256, (int)gridDim.x, (int)blockIdx.x);
              pg8::EpiGateP E{(float*)(P.ws + WS_GP)};
              pg8::gemm_phase<pg8::EpiGateP, pg8::StaticOrder, true, true>(lds, g, S, E); }
        }
        REPN(R_BAR) xcd_barrier(bar);
        if constexpr (kind == 0) {
#ifndef NO_DNPREP
            REPN(R_DNPREP) dn_prep_phase(P, j, rep_ == 0);
#endif
            REPN(R_BAR) xcd_barrier(bar);
            REPN(R_WU) dn_wu_prep_phase(P, lds);
            REPN(R_BAR) xcd_barrier(bar);
            REPN(R_DNSCAN) dn_chunk_phase(P, j, lds);
            REPN(R_BAR) xcd_barrier(bar);
            REPN(R_GATE) gate_phase<128>(OF, OB, BIG, DN_NMAIN, 8192, P.in[18] + j * 128, Y, 4096);
        } else if constexpr (kind == 1) {
            REPN(R_GLAPREP) gla_prep_phase<1>(P, lds);
            REPN(R_BAR) xcd_barrier(bar);
            REPN(R_GSCAN) gla_chunk_phase<1>(P, lds);
            REPN(R_BAR) xcd_barrier(bar);
            REPN(R_GATE) gate_phase<512>(OF, OB, BIG, GLA_NMAIN, 4096, P.in[23] + j * 512, Y, 2048);
        } else {
            REPN(R_GLAPREP) gla_prep_phase<2>(P, lds);
            REPN(R_BAR) xcd_barrier(bar);
            REPN(R_GSCAN) gla_chunk_phase<2>(P, lds);
            REPN(R_BAR) xcd_barrier(bar);
            REPN(R_GATE) gate_phase<128>(OF, OB, BIG, HG_NIN, 4096, P.in[27] + j * 128, Y, 2048);
        }
        REPN(R_BAR) xcd_barrier(bar);
        {
            const int Kout = kind == 0 ? 4096 : 2048;
            pg8::Gemm g = pg8::mk_gemm(Y, Tout, MROWS, D, Kout); pg8::StaticOrder S; S.init(MROWS, D, (int)gridDim.x, (int)blockIdx.x);
            pg8::EpiRes<layer == 0> E{xc, xl, X, modl + 4096};
            pg8::gemm_phase<pg8::EpiRes<layer == 0>, pg8::StaticOrder, true, true>(lds, g, S, E);
        }
        REPN(R_BAR) xcd_barrier(bar);
        REPN(R_NORM) norm_mod_phase<false>(X, X, P.in[10] + layer * D, modl, 6144, 8192, H);
        REPN(R_BAR) xcd_barrier(bar);
#pragma unroll
        for (int hf = 0; hf < 2; ++hf) {
            {
                pg8::Gemm g = pg8::mk_gemm(H, Tup, MROWS / 2, DFF, D); pg8::StaticOrder S; S.init(MROWS / 2, DFF, (int)gridDim.x, (int)blockIdx.x, hf * 32);
                pg8::EpiBf16<1> E{BIG, DFF, DFF, nullptr};
                REPN(R_GEMM) pg8::gemm_phase<pg8::EpiBf16<1>, pg8::StaticOrder, true, true>(lds, g, S, E);
            }
            REPN(R_BAR) xcd_barrier(bar);
            {
                pg8::Gemm g = pg8::mk_gemm(BIG, Tdn, MROWS / 2, D, DFF); pg8::StaticOrder S; S.init(MROWS / 2, D, (int)gridDim.x, (int)blockIdx.x, hf * 32);
                pg8::EpiRes<false> E{X, X, X, modl + 10240};
                pg8::gemm_phase<pg8::EpiRes<false>, pg8::StaticOrder, true, true>(lds, g, S, E);
            }
            REPN(R_BAR) xcd_barrier(bar);
        }
    }

__global__ void __launch_bounds__(NT, 2) fwd_kernel(Params P) {
    extern __shared__ __attribute__((aligned(16))) unsigned char lds_raw[];
    LAS unsigned char* lds = (LAS unsigned char*)lds_raw;
    const int tid = threadIdx.x;
    volatile LAS unsigned* misc = (volatile LAS unsigned*)(lds + LDS_MISC);
    if (tid < 64) misc[tid] = 0u;
    __syncthreads();
    XcdBarrier bar = xcd_barrier_post((unsigned*)(P.ws + WS_CTL) + 1024, misc + 8);

#ifndef NO_MOD
    REPN(R_MOD) mod_phase(P, lds);
#endif
    __syncthreads();

    layer_body<0>(P, lds, bar);
    layer_body<1>(P, lds, bar);
    layer_body<2>(P, lds, bar);
    layer_body<3>(P, lds, bar);
    REPN(R_FINAL) final_norm_phase((const bf16*)(P.ws + WS_X), P.in[11], P.out + OUT_Y);
}

extern "C" void kernel_launch(void* const* d_in, const int* in_sizes, int n_in, void* d_out, int out_size, void* d_ws, size_t ws_size, hipStream_t stream) {
    static int grid = 0;
    if (grid == 0) {
        if (n_in != 29 || (size_t)out_size != OUT_END || ws_size < WS_END) {
            fprintf(stderr, "kernel_launch: unexpected shapes: n_in %d out %d (want %zu) ws %zu (want %zu)\n", n_in, out_size, (size_t)OUT_END, ws_size, (size_t)WS_END); grid = -1; return; }
        int dev = 0, cus = 0, per_cu = 0;
        if (hipGetDevice(&dev) != hipSuccess || hipDeviceGetAttribute(&cus, hipDeviceAttributeMultiprocessorCount, dev) != hipSuccess) { grid = -1; return; }
        if (hipFuncSetAttribute((const void*)fwd_kernel, hipFuncAttributeMaxDynamicSharedMemorySize, LDS_BYTES) != hipSuccess) { fprintf(stderr, "kernel_launch: hipFuncSetAttribute failed\n"); grid = -1; return; }
        if (hipOccupancyMaxActiveBlocksPerMultiprocessor(&per_cu, (const void*)fwd_kernel, NT, LDS_BYTES) != hipSuccess || per_cu < 1) { fprintf(stderr, "kernel_launch: occupancy query says %d\n", per_cu); }
        (void)hipGetLastError();
        grid = cus;
    }
    if (grid < 0) return;
    hipMemsetAsync((char*)d_ws + WS_CTL, 0, CTL_BYTES, stream);
    Params p{};
    for (int i = 0; i < 29; ++i) p.in[i] = (const float*)d_in[i];
    p.out = (float*)d_out; p.ws = (unsigned char*)d_ws;
    hipLaunchKernelGGL(fwd_kernel, dim3(grid), dim3(NT), LDS_BYTES, stream, p);
}
```

```cpp
#include <hip/hip_runtime.h>
#include <cstdio>
#include <cstdint>

__device__ __forceinline__ int opaque_v(int x) { asm volatile("" : "+v"(x)); return x; }
#define PHASE_IDS() const int tid = opaque_v((int)threadIdx.x), lane = tid & 63, wave = __builtin_amdgcn_readfirstlane(tid >> 6), gw = (int)blockIdx.x * 8 + wave, NGW = (int)gridDim.x * 8; (void)lane; (void)wave; (void)gw; (void)NGW
namespace pg8 {
#define PG8_LAS __attribute__((address_space(3)))
typedef unsigned short bf16_t;
typedef short bf16x8 __attribute__((ext_vector_type(8)));
typedef float f32x4 __attribute__((ext_vector_type(4)));
typedef unsigned u32x4 __attribute__((ext_vector_type(4)));
constexpr int BM = 256, BK = 64, HALF = 128, HTB = HALF * BK * 2, STAGE_BYTES = 8 * HTB, NXCD = 8, WGM = 8;

__host__ __device__ __forceinline__ int lds_byte(int r, int c) { const int st = (r >> 4) * 2 + (c >> 5), rr = r & 15, cc = c & 31, ob = rr * 64 + cc * 2; return st * 1024 + (ob ^ (((ob >> 9) & 1) << 5)); }
__host__ __device__ __forceinline__ void stage_rc(int b, int& R, int& C) { const int st = b / 1024, sb = b % 1024, swz = sb ^ (((sb >> 9) & 1) << 5); R = (st >> 1) * 16 + swz / 64; C = (st & 1) * 32 + (swz % 64) / 2; }
__host__ __device__ __forceinline__ int perm32(int rho) { const int n = rho >> 4, i = rho & 15; return 8 * (i >> 2) + 4 * n + (i & 3); }

struct Unit { int pm, pn; };
struct Gemm { const bf16_t* A; const bf16_t* Bt; int M, N, K; size_t a_pn_step, b_pn_step; int nt; };
__host__ __device__ __forceinline__ Gemm mk_gemm(const bf16_t* A, const bf16_t* Bt, int M, int N, int K) { return Gemm{A, Bt, M, N, K, 0, (size_t)256 * K * 2, K / 64}; }

struct StaticOrder {
    int nM, nN, nwg, G, c, pm0;
    __host__ __device__ void init(int M, int N, int G_, int c_, int pm0_ = 0) { nM = M / BM; nN = N / BM; nwg = nM * nN; G = G_; c = c_; pm0 = pm0_; }
    __host__ __device__ bool next(int i, Unit& u) const {
        const long L = (long)i * G + c; if (L >= nwg) return false;
        int wgid = (int)L; { const int q = nwg / NXCD, r = nwg % NXCD, xcd = wgid % NXCD, off = wgid / NXCD; wgid = (xcd < r ? xcd * (q + 1) : r * (q + 1) + (xcd - r) * q) + off; }
        const int nig = WGM * nN, gid = wgid / nig, fm = gid * WGM, gsz = (nM - fm) < WGM ? (nM - fm) : WGM;
        u.pm = pm0 + fm + ((wgid % nig) % gsz); u.pn = (wgid % nig) / gsz; return true;
    }
    __device__ __forceinline__ void a_ready(const Unit&) const {}
    __device__ __forceinline__ void done(const Unit&) const {}
};

__device__ __forceinline__ unsigned cvt_pk_bf16(float lo, float hi) { unsigned r; asm volatile("v_cvt_pk_bf16_f32 %0, %1, %2" : "=v"(r) : "v"(lo), "v"(hi)); return r; }

template <int ACT> struct EpiBf16 {
    static constexpr bool PERM = true, AFTER_DRAIN = false;
    bf16_t* O; int ldc; int n_main; float* G;
    __device__ __forceinline__ void operator()(const f32x4 (&acc)[2][2][4][2], const Unit& u, int wr, int wc, int fr, int fq) const {
        const int row0 = u.pm * BM + wr * 64 + fr; const int colt = u.pn * BM;
        const int col0 = colt + wc * 32 + 8 * fq;
#pragma unroll
        for (int ai = 0; ai < 2; ++ai)
#pragma unroll
            for (int m = 0; m < 4; ++m) { bf16_t* rowp = O + (size_t)(row0 + ai * HALF + m * 16) * ldc + col0;
#pragma unroll
                for (int bj = 0; bj < 2; ++bj) { f32x4 v0 = acc[ai][bj][m][0], v1 = acc[ai][bj][m][1];
                    if (ACT == 1) {
#pragma unroll
                        for (int j = 0; j < 4; ++j) { const float a = fmaxf(v0[j], 0.f), b = fmaxf(v1[j], 0.f); v0[j] = a * a; v1[j] = b * b; } }
                    u32x4 w; w.x = cvt_pk_bf16(v0[0], v0[1]); w.y = cvt_pk_bf16(v0[2], v0[3]); w.z = cvt_pk_bf16(v1[0], v1[1]); w.w = cvt_pk_bf16(v1[2], v1[3]);
                    *(u32x4*)(rowp + bj * HALF) = w;
#ifdef PROBE_DOUBLE_STORE
                    asm volatile("" ::: "memory"); *(u32x4*)(rowp + bj * HALF) = w; asm volatile("" ::: "memory");
#endif
                    } }
    }
};
struct EpiGateP {
    static constexpr bool PERM = true, AFTER_DRAIN = false;
    float* GP;
    __device__ __forceinline__ void operator()(const f32x4 (&acc)[2][2][4][2], const Unit& u, int wr, int wc, int fr, int fq) const {
        const int row0 = u.pm * BM + wr * 64 + fr; const int col0 = wc * 32 + 8 * fq; float* base = GP + (size_t)u.pn * 16384 * 128;
#pragma unroll
        for (int ai = 0; ai < 2; ++ai)
#pragma unroll
            for (int m = 0; m < 4; ++m) { float* rowp = base + (size_t)(row0 + ai * HALF + m * 16) * 128 + col0;
                *(f32x4*)(rowp) = acc[ai][0][m][0]; *(f32x4*)(rowp + 4) = acc[ai][0][m][1]; }
    }
};
template <bool BASE_F32> struct EpiRes {
    static constexpr bool PERM = true, AFTER_DRAIN = false;
    const void* base_ctx; const void* base_lat; bf16_t* out; const float* gate;
    __device__ __forceinline__ void operator()(const f32x4 (&acc)[2][2][4][2], const Unit& u, int wr, int wc, int fr, int fq) const {
        const int row0 = u.pm * BM + wr * 64 + fr, col0 = u.pn * BM + wc * 32 + 8 * fq;
        const bool ctx = u.pm < 32; const int grp = ctx ? 0 : 1 + ((u.pm - 32) >> 3);
        const float* gp = gate + (size_t)grp * 12288 + col0;
        const void* base = ctx ? base_ctx : base_lat; const int rsub = (BASE_F32 && !ctx) ? 8192 : 0;
        f32x4 gv[2][2];
#pragma unroll
        for (int bj = 0; bj < 2; ++bj)
#pragma unroll
            for (int n = 0; n < 2; ++n) gv[bj][n] = *(const f32x4*)(gp + bj * HALF + 4 * n);
#pragma unroll
        for (int ai = 0; ai < 2; ++ai) {
            f32x4 bs[4][2][2];
#pragma unroll
            for (int m = 0; m < 4; ++m) { const size_t offb = (size_t)(row0 + ai * HALF + m * 16 - rsub) * 2048 + col0;
#pragma unroll
                for (int bj = 0; bj < 2; ++bj) {
                    if (BASE_F32) { bs[m][bj][0] = *(const f32x4*)((const float*)base + offb + bj * HALF); bs[m][bj][1] = *(const f32x4*)((const float*)base + offb + bj * HALF + 4); }
                    else { const u32x4 w = *(const u32x4*)((const bf16_t*)base + offb + bj * HALF);
                        bs[m][bj][0] = (f32x4){__uint_as_float(w.x << 16), __uint_as_float(w.x & 0xffff0000u), __uint_as_float(w.y << 16), __uint_as_float(w.y & 0xffff0000u)};
                        bs[m][bj][1] = (f32x4){__uint_as_float(w.z << 16), __uint_as_float(w.z & 0xffff0000u), __uint_as_float(w.w << 16), __uint_as_float(w.w & 0xffff0000u)}; } } }
#pragma unroll
            for (int m = 0; m < 4; ++m) { const size_t offo = (size_t)(row0 + ai * HALF + m * 16) * 2048 + col0;
#pragma unroll
                for (int bj = 0; bj < 2; ++bj) { const f32x4 v0 = bs[m][bj][0] + gv[bj][0] * acc[ai][bj][m][0], v1 = bs[m][bj][1] + gv[bj][1] * acc[ai][bj][m][1];
                    u32x4 w; w.x = cvt_pk_bf16(v0[0], v0[1]); w.y = cvt_pk_bf16(v0[2], v0[3]); w.z = cvt_pk_bf16(v1[0], v1[1]); w.w = cvt_pk_bf16(v1[2], v1[3]);
                    *(u32x4*)(out + offo + bj * HALF) = w; } }
            asm volatile("" ::: "memory");
        }
    }
};

template <class Epi, class Sched, bool ALIGN_EPI = false, bool SP2 = false>
__device__ __forceinline__ void gemm_phase(PG8_LAS unsigned char* lds, const Gemm g, const Sched& S, const Epi& E) {
    const int tid = opaque_v((int)threadIdx.x), wid = __builtin_amdgcn_readfirstlane(tid >> 6), lane = tid & 63, wr = wid >> 2, wc = wid & 3, fr = lane & 15, fq = lane >> 4;
    const int K = g.K, nt = g.nt;
    unsigned voffA[2], voffB[2];
#pragma unroll
    for (int i = 0; i < 2; ++i) { int R, C; stage_rc(tid * 16 + i * 8192, R, C); const int Rb = Epi::PERM ? ((R & ~31) + perm32(R & 31)) : R;
        voffA[i] = (unsigned)(R * K + C) * 2u; voffB[i] = (unsigned)(Rb * K + C) * 2u; }
    const size_t kstep = (size_t)(BK * 2);
    const size_t hstep = (size_t)HALF * K * 2;
    const size_t tstep = 2 * hstep;
    const unsigned ldsw = (unsigned)wid * 1024u;
    const int aoff = lds_byte(wr * 64 + fr, fq * 8), boff = lds_byte(wc * 32 + fr, fq * 8);
#define PG8_SA(b, h) (((b) * 2 + (h)) * HTB)
#define PG8_SB(b, h) ((4 + (b) * 2 + (h)) * HTB)
#define PG8_STAGE(bufoff, gbase, voff) do { _Pragma("unroll") for (int _i = 0; _i < 2; ++_i) \
        __builtin_amdgcn_global_load_lds((const unsigned*)((const char*)(gbase) + (voff)[_i]), (PG8_LAS unsigned*)(lds + (bufoff) + ldsw + _i * 8192), 16, 0, 0); } while (0)
#define PG8_LDA(dst, b, h) do { _Pragma("unroll") for (int m = 0; m < 4; ++m) _Pragma("unroll") for (int k = 0; k < 2; ++k) dst[m][k] = *(const PG8_LAS bf16x8*)(lds + PG8_SA(b, h) + aoff + m * 2048 + k * 1024); } while (0)
#define PG8_LDB(dst, b, h) do { _Pragma("unroll") for (int n = 0; n < 2; ++n) _Pragma("unroll") for (int k = 0; k < 2; ++k) dst[n][k] = *(const PG8_LAS bf16x8*)(lds + PG8_SB(b, h) + boff + n * 2048 + k * 1024); } while (0)
#define PG8_MMA(ai, bj, At, Bt) do { __builtin_amdgcn_s_setprio(1); _Pragma("unroll") for (int m = 0; m < 4; ++m) _Pragma("unroll") for (int n = 0; n < 2; ++n) _Pragma("unroll") for (int k = 0; k < 2; ++k) \
        acc[ai][bj][m][n] = __builtin_amdgcn_mfma_f32_16x16x32_bf16(Bt[n][k], At[m][k], acc[ai][bj][m][n], 0, 0, 0); __builtin_amdgcn_s_setprio(0); } while (0)
#define PG8_WAIT_V(n) asm volatile("s_waitcnt vmcnt(" #n ")" ::: "memory")
#define PG8_WAIT_L(n) asm volatile("s_waitcnt lgkmcnt(" #n ")" ::: "memory")
#define PG8_BAR __builtin_amdgcn_s_barrier()
#define PG8_SCHED __builtin_amdgcn_sched_barrier(0)
    Unit cur, nxt; int ui = 0;
    if (!S.next(0, cur)) return;
    f32x4 acc[2][2][4][2];
#pragma unroll
    for (int a = 0; a < 2; ++a)
#pragma unroll
        for (int b = 0; b < 2; ++b)
#pragma unroll
            for (int m = 0; m < 4; ++m)
#pragma unroll
                for (int n = 0; n < 2; ++n) acc[a][b][m][n] = (f32x4){0.f, 0.f, 0.f, 0.f};
    bf16x8 At[4][2], B0[2][2], B1[2][2];
    const char* cA = (const char*)g.A + (size_t)cur.pm * tstep + (size_t)cur.pn * g.a_pn_step; const char* cB = (const char*)g.Bt + (size_t)cur.pn * g.b_pn_step;
    S.a_ready(cur);
    if constexpr (SP2) {
        PG8_STAGE(PG8_SB(0, 0), cB, voffB); PG8_STAGE(PG8_SB(0, 1), cB + hstep, voffB); PG8_STAGE(PG8_SA(0, 0), cA, voffA); PG8_STAGE(PG8_SA(0, 1), cA + hstep, voffA);
        if (wr == 1) PG8_BAR;
        PG8_WAIT_V(2); PG8_BAR;
        PG8_STAGE(PG8_SB(1, 0), cB + kstep, voffB); PG8_STAGE(PG8_SA(1, 0), cA + kstep, voffA); PG8_STAGE(PG8_SB(1, 1), cB + hstep + kstep, voffB);
        PG8_WAIT_V(6); PG8_BAR;
    } else {
        PG8_STAGE(PG8_SB(0, 0), cB, voffB); PG8_STAGE(PG8_SA(0, 0), cA, voffA); PG8_STAGE(PG8_SB(0, 1), cB + hstep, voffB); PG8_STAGE(PG8_SA(0, 1), cA + hstep, voffA);
        if (wr == 1) PG8_BAR;
        PG8_WAIT_V(4); PG8_BAR;
        PG8_STAGE(PG8_SB(1, 0), cB + kstep, voffB); PG8_STAGE(PG8_SA(1, 0), cA + kstep, voffA); PG8_STAGE(PG8_SB(1, 1), cB + hstep + kstep, voffB);
        PG8_WAIT_V(6); PG8_BAR;
    }
    for (;;) {
        const bool has_next = S.next(ui + 1, nxt);
        const char* nA = has_next ? (const char*)g.A + (size_t)nxt.pm * tstep + (size_t)nxt.pn * g.a_pn_step : cA; const char* nB = has_next ? (const char*)g.Bt + (size_t)nxt.pn * g.b_pn_step : cB;
        for (int t = 0; t < nt; t += 2) {
            const bool last = (t == nt - 2);
            const char* a1 = cA + (size_t)(t + 1) * kstep;
            const char* a2 = last ? nA : cA + (size_t)(t + 2) * kstep; const char* b2 = last ? nB : cB + (size_t)(t + 2) * kstep;
            const char* a3 = a2 + kstep; const char* b3 = b2 + kstep;
            if (last && has_next) S.a_ready(nxt);
            if constexpr (SP2) {
            PG8_LDB(B0, 0, 0); PG8_LDB(B1, 0, 1); PG8_SCHED; PG8_LDA(At, 0, 0); PG8_STAGE(PG8_SA(1, 1), a1 + hstep, voffA);
            PG8_WAIT_V(8); PG8_WAIT_L(0); PG8_BAR; PG8_MMA(0, 0, At, B0); PG8_MMA(0, 1, At, B1); PG8_BAR; PG8_SCHED;
            PG8_LDA(At, 0, 1); PG8_STAGE(PG8_SB(0, 0), b2, voffB); PG8_STAGE(PG8_SB(0, 1), b2 + hstep, voffB); PG8_STAGE(PG8_SA(0, 0), a2, voffA);
            PG8_WAIT_V(8); PG8_WAIT_L(0); PG8_BAR; PG8_MMA(1, 0, At, B0); PG8_MMA(1, 1, At, B1); PG8_BAR; PG8_SCHED;
            PG8_LDB(B0, 1, 0); PG8_LDB(B1, 1, 1); PG8_SCHED; PG8_LDA(At, 1, 0); PG8_STAGE(PG8_SA(0, 1), a2 + hstep, voffA);
            PG8_WAIT_V(8); PG8_WAIT_L(0); PG8_BAR; PG8_MMA(0, 0, At, B0); PG8_MMA(0, 1, At, B1); PG8_BAR; PG8_SCHED;
            PG8_LDA(At, 1, 1); PG8_STAGE(PG8_SB(1, 0), b3, voffB); PG8_STAGE(PG8_SB(1, 1), b3 + hstep, voffB); PG8_STAGE(PG8_SA(1, 0), a3, voffA);
            PG8_WAIT_V(8); PG8_WAIT_L(0); PG8_BAR; PG8_MMA(1, 0, At, B0); PG8_MMA(1, 1, At, B1); PG8_BAR; PG8_SCHED;
            } else {
            PG8_LDB(B0, 0, 0); PG8_SCHED; PG8_LDA(At, 0, 0); PG8_STAGE(PG8_SA(1, 1), a1 + hstep, voffA);
            PG8_WAIT_L(8); PG8_BAR; PG8_WAIT_L(0); PG8_MMA(0, 0, At, B0); PG8_BAR; PG8_SCHED;
            PG8_LDB(B1, 0, 1); PG8_STAGE(PG8_SB(0, 0), b2, voffB);
            PG8_BAR; PG8_WAIT_L(0); PG8_MMA(0, 1, At, B1); PG8_BAR;
            PG8_LDA(At, 0, 1); PG8_STAGE(PG8_SA(0, 0), a2, voffA);
            PG8_BAR; PG8_WAIT_L(0); PG8_MMA(1, 0, At, B0); PG8_BAR; PG8_SCHED;
            PG8_STAGE(PG8_SB(0, 1), b2 + hstep, voffB);
            PG8_WAIT_V(6); PG8_BAR; PG8_MMA(1, 1, At, B1); PG8_BAR;
            PG8_LDB(B0, 1, 0); PG8_SCHED; PG8_LDA(At, 1, 0); PG8_STAGE(PG8_SA(0, 1), a2 + hstep, voffA);
            PG8_WAIT_L(8); PG8_BAR; PG8_WAIT_L(0); PG8_MMA(0, 0, At, B0); PG8_BAR; PG8_SCHED;
            PG8_LDB(B1, 1, 1); PG8_STAGE(PG8_SB(1, 0), b3, voffB);
            PG8_BAR; PG8_WAIT_L(0); PG8_MMA(0, 1, At, B1); PG8_BAR;
            PG8_LDA(At, 1, 1); PG8_STAGE(PG8_SA(1, 0), a3, voffA);
            PG8_BAR; PG8_WAIT_L(0); PG8_MMA(1, 0, At, B0); PG8_BAR; PG8_SCHED;
            PG8_STAGE(PG8_SB(1, 1), b3 + hstep, voffB);
            PG8_WAIT_V(6); PG8_BAR; PG8_MMA(1, 1, At, B1); PG8_BAR;
            }
        }
        if constexpr (ALIGN_EPI) { if (wr == 0) PG8_BAR; }
        if constexpr (!Epi::AFTER_DRAIN) { E(acc, cur, wr, wc, fr, fq); S.done(cur); }
        if (!has_next) break;
#pragma unroll
        for (int a = 0; a < 2; ++a)
#pragma unroll
            for (int b = 0; b < 2; ++b)
#pragma unroll
                for (int m = 0; m < 4; ++m)
#pragma unroll
                    for (int n = 0; n < 2; ++n) acc[a][b][m][n] = (f32x4){0.f, 0.f, 0.f, 0.f};
        cur = nxt; cA = nA; cB = nB; ++ui;
        if constexpr (ALIGN_EPI) { if (wr == 1) PG8_BAR; }
    }
    PG8_WAIT_V(0);
    if constexpr (!ALIGN_EPI) { if (wr == 0) PG8_BAR; }
    PG8_BAR;
#undef PG8_SA
#undef PG8_SB
#undef PG8_STAGE
#undef PG8_LDA
#undef PG8_LDB
#undef PG8_MMA
#undef PG8_WAIT_V
#undef PG8_WAIT_L
#undef PG8_BAR
#undef PG8_SCHED
}
}

#define XB_TMO      128
#define XB_XCNT(j)  (256  + 64 * (j))
#define XB_XSUB(j)  (1280 + 64 * (j))
#define XB_XGEN(j)  (2304 + 64 * (j))
#define XB_TOP      3328
#define XB_TOPGEN   3392
#define XCD_BAR_WORDS 3456
#define XB_SPIN_CAP (1u << 21)
#define LAS __attribute__((address_space(3)))

__device__ __forceinline__ unsigned xb_ld(unsigned* p)              { return __hip_atomic_load(p, __ATOMIC_RELAXED, __HIP_MEMORY_SCOPE_AGENT); }
__device__ __forceinline__ unsigned xb_add(unsigned* p, unsigned v) { return __hip_atomic_fetch_add(p, v, __ATOMIC_RELAXED, __HIP_MEMORY_SCOPE_AGENT); }
__device__ __forceinline__ unsigned xb_xcc_id() { return (unsigned)__builtin_amdgcn_s_getreg((3 << 11) | 20) & 0xFu; }
#define XB_SPIN(cond, bar) do { unsigned _sp = 0; while (cond) { __builtin_amdgcn_s_sleep(1); \
    if ((++_sp & 255u) == 0u) { if (xb_ld(&(bar)[XB_TMO])) break; if (_sp > XB_SPIN_CAP) { atomicAdd(&(bar)[XB_TMO], 1u); break; } } } } while (0)

struct XcdBarrier { unsigned* bar; unsigned x; volatile LAS unsigned* st; };

__device__ __forceinline__ XcdBarrier xcd_barrier_post(unsigned* bar, volatile LAS unsigned* st) {
    XcdBarrier b; b.bar = bar; b.x = xb_xcc_id(); b.st = st;
    if (threadIdx.x == 0) (void)xb_add(&bar[XB_XCNT(b.x)], 1u);
    return b;
}
__device__ __forceinline__ void xcd_barrier_complete(unsigned* bar, unsigned x, unsigned& nloc, unsigned& nx) {
    const unsigned G = gridDim.x * gridDim.y * gridDim.z;
    unsigned sum, cnt, mine, sp = 0u;
    for (;;) {
        sum = 0u; cnt = 0u; mine = 0u;
#pragma unroll
        for (unsigned j = 0; j < 16; ++j) { const unsigned c = xb_ld(&bar[XB_XCNT(j)]); sum += c; cnt += (c > 0u) ? 1u : 0u; mine = (j == x) ? c : mine; }
        if (sum == G) break;
        __builtin_amdgcn_s_sleep(1);
        if ((++sp & 255u) == 0u) { if (xb_ld(&bar[XB_TMO])) break; if (sp > XB_SPIN_CAP) { atomicAdd(&bar[XB_TMO], 1u); break; } }
    }
    nloc = mine > 0u ? mine : 1u; nx = cnt > 0u ? cnt : 1u;
}
__device__ __forceinline__ void xcd_barrier(const XcdBarrier& b) {
    asm volatile("s_waitcnt vmcnt(0)" ::: "memory");
    __syncthreads();
    if (threadIdx.x == 0) {
        unsigned* bar = b.bar;
        __builtin_amdgcn_s_waitcnt(0);
        unsigned nloc = b.st[0], nx = b.st[1];
        if (nloc == 0u) { xcd_barrier_complete(bar, b.x, nloc, nx); b.st[0] = nloc; b.st[1] = nx; }
        const unsigned old = xb_add(&bar[XB_XSUB(b.x)], 1u);
        const unsigned gen = old / nloc;
        if (old + 1u == (gen + 1u) * nloc) {
            __builtin_amdgcn_fence(__ATOMIC_RELEASE, "agent");
            asm volatile("s_waitcnt vmcnt(0)" ::: "memory");
            const unsigned og = xb_add(&bar[XB_TOP], 1u);
            const unsigned tg = og / nx;
            if (og + 1u == (tg + 1u) * nx) xb_add(&bar[XB_TOPGEN], 1u);
            else XB_SPIN(xb_ld(&bar[XB_TOPGEN]) == tg, bar);
            __builtin_amdgcn_fence(__ATOMIC_ACQUIRE, "agent");
            xb_add(&bar[XB_XGEN(b.x)], 1u);
            asm volatile("s_waitcnt vmcnt(0)" ::: "memory");
        } else {
            XB_SPIN(xb_ld(&bar[XB_XGEN(b.x)]) == gen, bar);
            __builtin_amdgcn_fence(__ATOMIC_ACQUIRE, "agent");
            asm volatile("s_waitcnt vmcnt(0)" ::: "memory");
        }
    }
    __syncthreads();
}

typedef unsigned short bf16;
typedef float f32x4 __attribute__((ext_vector_type(4)));
typedef unsigned u32x4 __attribute__((ext_vector_type(4)));
typedef unsigned u32x2 __attribute__((ext_vector_type(2)));

constexpr int D = 2048, DFF = 8192, MROWS = 16384, MCTX = 8192;
constexpr int NT = 512;
constexpr float EPS = 1e-6f;
constexpr int DN_NIN = 12416, DN_NMAIN = 12288, DN_NPAD = 12544;
constexpr int GLA_NIN = 6176, GLA_NMAIN = 6144, GLA_NPAD = 6400;
constexpr int HG_NIN = 10240;
constexpr int MODW = 12288;

constexpr size_t MiB = 1u << 20;
constexpr size_t WS_CTL = 0, CTL_BYTES = 1 * MiB;
constexpr size_t WS_MOD = 1 * MiB;
constexpr size_t WS_X = 2 * MiB;
constexpr size_t WS_H = WS_X + 128 * MiB;
constexpr size_t WS_BIG = WS_H + 64 * MiB;
constexpr size_t WS_GATE = WS_BIG + 384 * MiB;
constexpr size_t WS_QKV = WS_GATE + 8 * MiB;
constexpr size_t WS_OF = WS_QKV + 256 * MiB;
constexpr size_t WS_OB = WS_OF + 128 * MiB;
constexpr size_t WS_W = WS_OB + 128 * MiB;
constexpr size_t WOFF_IN = 0, WOFF_OUT = (size_t)DN_NPAD * D * 2, WOFF_UP = WOFF_OUT + (size_t)D * 4096 * 2, WOFF_DOWN = WOFF_UP + (size_t)DFF * D * 2;
constexpr size_t WS_TA = ((WS_W + WOFF_DOWN + (size_t)D * DFF * 2 + MiB - 1) / MiB) * MiB;
constexpr size_t WS_GS = WS_TA + 256 * MiB;
constexpr size_t WS_GP = WS_GS + 12 * MiB;
constexpr size_t WS_END = WS_GP + 32 * MiB;

constexpr size_t OUT_Y = 0;
constexpr size_t OUT_SDN = (size_t)MROWS * D;
constexpr size_t OUT_SGLA = OUT_SDN + (size_t)32 * 2 * 2 * 32 * 128 * 128;
constexpr size_t OUT_SHG = OUT_SGLA + (size_t)32 * 2 * 4 * 256 * 512;
constexpr size_t OUT_END = OUT_SHG + (size_t)32 * 2 * 16 * 128 * 128;

constexpr int LDS_BYTES = 151552;
constexpr int LDS_MISC = 150528;

struct Params {
    const float* in[29];
    float* out;
    unsigned char* ws;
};

__device__ __forceinline__ float bf2f(unsigned short b) { return __uint_as_float(((unsigned)b) << 16); }
typedef __bf16 bfv2_ __attribute__((ext_vector_type(2)));
typedef float f32x2_ __attribute__((ext_vector_type(2)));
__device__ __forceinline__ unsigned f2bf(float f) { return (unsigned)__builtin_bit_cast(unsigned short, (__bf16)f); }
__device__ __forceinline__ unsigned pk2(float lo, float hi) { const f32x2_ v = {lo, hi}; return __builtin_bit_cast(unsigned, __builtin_convertvector(v, bfv2_)); }
__device__ __forceinline__ float bflo(unsigned w) { return __uint_as_float(w << 16); }
__device__ __forceinline__ float bfhi(unsigned w) { return __uint_as_float(w & 0xffff0000u); }
__device__ __forceinline__ float wave_sum(float v) {
#pragma unroll
    for (int o = 1; o < 64; o <<= 1) v += __shfl_xor(v, o);
    return v;
}
__device__ __forceinline__ float rdlane(float v, int l) { return __builtin_bit_cast(float, __builtin_amdgcn_readlane(__builtin_bit_cast(int, v), l)); }
__device__ __forceinline__ float sigmoidf_(float x) { return 1.f / (1.f + __expf(-x)); }
__device__ __forceinline__ float siluf_(float x) { return x / (1.f + __expf(-x)); }
__device__ __forceinline__ float softplusf_(float x) { return fmaxf(x, 0.f) + log1pf(__expf(-fabsf(x))); }

__device__ __forceinline__ void transpose_item(const float* W, int K, int N, bf16* WT, LAS float* scr, int item, int lane) {
    const int nblk = N / 32, kb = item / nblk, nb = item % nblk, k0 = 64 * kb, n0 = 32 * nb;
    { f32x4 v[8]; const int kr = lane >> 3, c4 = (lane & 7) * 4;
#pragma unroll
      for (int i = 0; i < 8; ++i) v[i] = *(const f32x4*)(W + (size_t)(k0 + kr + 8 * i) * N + n0 + c4);
#pragma unroll
      for (int i = 0; i < 8; ++i) { LAS float* d = scr + (kr + 8 * i) * 33 + c4; d[0] = v[i].x; d[1] = v[i].y; d[2] = v[i].z; d[3] = v[i].w; } }
    asm volatile("s_waitcnt lgkmcnt(0)" ::: "memory");
    const int c = lane & 7;
#pragma unroll
    for (int j = 0; j < 4; ++j) { const int n = (lane >> 3) + 8 * j; const LAS float* s = scr + (8 * c) * 33 + n;
        u32x4 o; o.x = pk2(s[0 * 33], s[1 * 33]); o.y = pk2(s[2 * 33], s[3 * 33]); o.z = pk2(s[4 * 33], s[5 * 33]); o.w = pk2(s[6 * 33], s[7 * 33]);
        *(u32x4*)(WT + (size_t)(n0 + n) * K + k0 + 8 * c) = o; }
    asm volatile("s_waitcnt lgkmcnt(0)" ::: "memory");
}

__device__ __forceinline__ void convert_layer_weights(const Params& P, int layer, LAS unsigned char* lds) {
    PHASE_IDS();
    LAS float* scr = (LAS float*)(lds + wave * 16384);
    const int kind = layer % 3, j = layer / 3;
    const float* Win; int Nin, Npad; const float* Wout; int Kout;
    if (kind == 0) { Win = P.in[14] + (size_t)j * D * DN_NIN; Nin = DN_NIN; Npad = DN_NPAD; Wout = P.in[19] + (size_t)j * 4096 * D; Kout = 4096; }
    else if (kind == 1) { Win = P.in[20] + (size_t)j * D * GLA_NIN; Nin = GLA_NIN; Npad = GLA_NPAD; Wout = P.in[24] + (size_t)j * D * D; Kout = 2048; }
    else { Win = P.in[25] + (size_t)j * D * HG_NIN; Nin = HG_NIN; Npad = HG_NIN; Wout = P.in[28] + (size_t)j * D * D; Kout = 2048; }
    const float* Wup = P.in[12] + (size_t)layer * D * DFF; const float* Wdn = P.in[13] + (size_t)layer * DFF * D;
    bf16* Tin = (bf16*)(P.ws + WS_W + WOFF_IN); bf16* Tout = (bf16*)(P.ws + WS_W + WOFF_OUT); bf16* Tup = (bf16*)(P.ws + WS_W + WOFF_UP); bf16* Tdn = (bf16*)(P.ws + WS_W + WOFF_DOWN);
    const int I_in = (D / 64) * (Nin / 32), I_out = (Kout / 64) * (D / 32), I_up = (D / 64) * (DFF / 32), I_dn = (DFF / 64) * (D / 32);
    const int NI = I_in + I_out + I_up + I_dn;
    for (int it = gw; it < NI; it += NGW) {
        int r = it;
        if (r < I_in) { transpose_item(Win, D, Nin, Tin, scr, r, lane); continue; } r -= I_in;
        if (r < I_out) { transpose_item(Wout, Kout, D, Tout, scr, r, lane); continue; } r -= I_out;
        if (r < I_up) { transpose_item(Wup, D, DFF, Tup, scr, r, lane); continue; } r -= I_up;
        transpose_item(Wdn, DFF, D, Tdn, scr, r, lane);
    }
    const int npadrows = Npad - Nin;
    if (npadrows > 0) {
        u32x4* z = (u32x4*)(Tin + (size_t)Nin * D); const int n16 = npadrows * D / 8;
        for (int i = gw * 64 + lane; i < n16; i += NGW * 64) z[i] = (u32x4){0u, 0u, 0u, 0u};
    }
}

__device__ __forceinline__ void mod_phase(const Params& P, LAS unsigned char* lds) {
    PHASE_IDS();
    LAS float* scond = (LAS float*)lds;
    LAS float* red = (LAS float*)(lds + 40960 + 1024);
    for (int i = tid; i < 5 * 2048; i += NT) { const int g = i / 2048, k = i % 2048; const float v = g == 0 ? P.in[6][k] : P.in[2][(g - 1) * 2048 + k]; scond[k * 5 + g] = siluf_(v); }
    __syncthreads();
    float* mod = (float*)(P.ws + WS_MOD);
    const int c4 = tid & 15, kg = tid >> 4;
    for (int cg = blockIdx.x; cg < 4 * MODW / 64; cg += gridDim.x) {
        const int layer = cg / (MODW / 64), colbase = (cg % (MODW / 64)) * 64;
        const float* W = P.in[7] + (size_t)layer * D * MODW + colbase + c4 * 4;
        f32x4 acc[5];
#pragma unroll
        for (int g = 0; g < 5; ++g) acc[g] = (f32x4){0.f, 0.f, 0.f, 0.f};
#pragma unroll 8
        for (int kk = 0; kk < 64; ++kk) {
            const int k = kg * 64 + kk;
            const f32x4 w = *(const f32x4*)(W + (size_t)k * MODW);
#pragma unroll
            for (int g = 0; g < 5; ++g) acc[g] += w * scond[k * 5 + g];
        }
#pragma unroll
        for (int g = 0; g < 5; ++g)
#pragma unroll
            for (int e = 0; e < 4; ++e) red[(kg * 64 + c4 * 4 + e) * 5 + g] = acc[g][e];
        __syncthreads();
        if (tid < 64 * 5) { const int c = tid / 5, g = tid % 5; float sum = 0.f;
#pragma unroll 8
            for (int q = 0; q < 32; ++q) sum += red[(q * 64 + c) * 5 + g];
            mod[((size_t)layer * 5 + g) * MODW + colbase + c] = sum + P.in[8][(size_t)layer * MODW + colbase + c]; }
        __syncthreads();
    }
}

template <bool XF32> __device__ __forceinline__ void norm_mod_phase(const void* xc, const void* xl, const float* w, const float* mod, int sh_off, int sc_off, bf16* H) {
    PHASE_IDS();
    for (int m = gw; m < MROWS; m += NGW) {
        const bool ctx = m < MCTX; const int grp = ctx ? 0 : 1 + ((m - MCTX) >> 11);
        f32x4 v[8]; float ss = 0.f;
        if (XF32) { const float* xr = ctx ? (const float*)xc + (size_t)m * D : (const float*)xl + (size_t)(m - MCTX) * D;
#pragma unroll
            for (int jx = 0; jx < 4; ++jx) { v[2 * jx] = *(const f32x4*)(xr + 8 * (lane + 64 * jx)); v[2 * jx + 1] = *(const f32x4*)(xr + 8 * (lane + 64 * jx) + 4); } }
        else { const bf16* xr = (const bf16*)xc + (size_t)m * D;
#pragma unroll
            for (int jx = 0; jx < 4; ++jx) { const u32x4 q = *(const u32x4*)(xr + 8 * (lane + 64 * jx));
                v[2 * jx] = (f32x4){bflo(q.x), bfhi(q.x), bflo(q.y), bfhi(q.y)}; v[2 * jx + 1] = (f32x4){bflo(q.z), bfhi(q.z), bflo(q.w), bfhi(q.w)}; } }
#pragma unroll
        for (int i = 0; i < 8; ++i) ss += (v[i].x * v[i].x + v[i].y * v[i].y) + (v[i].z * v[i].z + v[i].w * v[i].w);
        const float rstd = rsqrtf(wave_sum(ss) * (1.f / D) + EPS);
        const float* mg = mod + (size_t)grp * MODW;
#pragma unroll
        for (int jx = 0; jx < 4; ++jx) { const int c = 8 * (lane + 64 * jx);
            const f32x4 y0 = v[2 * jx] * rstd * *(const f32x4*)(w + c) * (*(const f32x4*)(mg + sc_off + c) + 1.f) + *(const f32x4*)(mg + sh_off + c);
            const f32x4 y1 = v[2 * jx + 1] * rstd * *(const f32x4*)(w + c + 4) * (*(const f32x4*)(mg + sc_off + c + 4) + 1.f) + *(const f32x4*)(mg + sh_off + c + 4);
            u32x4 o; o.x = pk2(y0.x, y0.y); o.y = pk2(y0.z, y0.w); o.z = pk2(y1.x, y1.y); o.w = pk2(y1.z, y1.w);
            *(u32x4*)(H + (size_t)m * D + c) = o; }
    }
}
__device__ __forceinline__ void final_norm_phase(const bf16* X, const float* w, float* out) {
    PHASE_IDS();
    for (int m = gw; m < MROWS; m += NGW) {
        f32x4 v[8]; float ss = 0.f;
#pragma unroll
        for (int jx = 0; jx < 4; ++jx) { const u32x4 q = *(const u32x4*)(X + (size_t)m * D + 8 * (lane + 64 * jx));
            v[2 * jx] = (f32x4){bflo(q.x), bfhi(q.x), bflo(q.y), bfhi(q.y)}; v[2 * jx + 1] = (f32x4){bflo(q.z), bfhi(q.z), bflo(q.w), bfhi(q.w)}; }
#pragma unroll
        for (int i = 0; i < 8; ++i) ss += (v[i].x * v[i].x + v[i].y * v[i].y) + (v[i].z * v[i].z + v[i].w * v[i].w);
        const float rstd = rsqrtf(wave_sum(ss) * (1.f / D) + EPS);
#pragma unroll
        for (int jx = 0; jx < 4; ++jx) { const int c = 8 * (lane + 64 * jx);
            *(f32x4*)(out + (size_t)m * D + c) = v[2 * jx] * rstd * *(const f32x4*)(w + c); *(f32x4*)(out + (size_t)m * D + c + 4) = v[2 * jx + 1] * rstd * *(const f32x4*)(w + c + 4); }
    }
}

template <int DV> __device__ __forceinline__ void gate_phase(const bf16* OF, const bf16* OB, const bf16* proj, int ldp, int gcol0, const float* nw, bf16* Y, int W) {
    PHASE_IDS();
    const int ncg = W / 512;
    const int nitems = MROWS * ncg;
    for (int it0 = gw; it0 < nitems; it0 += 2 * NGW) {
        u32x4 a[2], b[2], gz[2]; int mm[2], cc[2]; bool ok[2];
#pragma unroll
        for (int u = 0; u < 2; ++u) { const int it = it0 + u * NGW; ok[u] = it < nitems; const int itc = ok[u] ? it : it0; mm[u] = itc / ncg; cc[u] = (itc % ncg) * 512 + lane * 8;
            a[u] = *(const u32x4*)(OF + (size_t)mm[u] * W + cc[u]); b[u] = *(const u32x4*)(OB + (size_t)mm[u] * W + cc[u]); gz[u] = *(const u32x4*)(proj + (size_t)mm[u] * ldp + gcol0 + cc[u]); }
#pragma unroll
        for (int u = 0; u < 2; ++u) {
            float o[8], z[8];
            o[0] = bflo(a[u].x) + bflo(b[u].x); o[1] = bfhi(a[u].x) + bfhi(b[u].x); o[2] = bflo(a[u].y) + bflo(b[u].y); o[3] = bfhi(a[u].y) + bfhi(b[u].y);
            o[4] = bflo(a[u].z) + bflo(b[u].z); o[5] = bfhi(a[u].z) + bfhi(b[u].z); o[6] = bflo(a[u].w) + bflo(b[u].w); o[7] = bfhi(a[u].w) + bfhi(b[u].w);
            z[0] = bflo(gz[u].x); z[1] = bfhi(gz[u].x); z[2] = bflo(gz[u].y); z[3] = bfhi(gz[u].y); z[4] = bflo(gz[u].z); z[5] = bfhi(gz[u].z); z[6] = bflo(gz[u].w); z[7] = bfhi(gz[u].w);
            float ss = 0.f;
#pragma unroll
            for (int i = 0; i < 8; ++i) ss += o[i] * o[i];
#pragma unroll
            for (int sft = 1; sft < DV / 8; sft <<= 1) ss += __shfl_xor(ss, sft);
            const float rstd = rsqrtf(ss * (1.f / DV) + EPS);
            const int cw = cc[u] % DV;
            const f32x4 w0 = *(const f32x4*)(nw + cw), w1 = *(const f32x4*)(nw + cw + 4);
            const float wv[8] = {w0.x, w0.y, w0.z, w0.w, w1.x, w1.y, w1.z, w1.w};
            float y[8];
#pragma unroll
            for (int i = 0; i < 8; ++i) y[i] = o[i] * rstd * wv[i] * siluf_(z[i]);
            u32x4 rr; rr.x = pk2(y[0], y[1]); rr.y = pk2(y[2], y[3]); rr.z = pk2(y[4], y[5]); rr.w = pk2(y[6], y[7]);
            if (ok[u]) *(u32x4*)(Y + (size_t)mm[u] * W + cc[u]) = rr;
        }
    }
}

__device__ __forceinline__ void dn_prep_phase(const Params& P, int j, bool do_gates = true) {
    PHASE_IDS();
    const bf16* proj = (const bf16*)(P.ws + WS_BIG); bf16* QKV = (bf16*)(P.ws + WS_QKV);
    const float* cw = P.in[15] + (size_t)j * 5 * 8192;
    for (int it = gw; it < 16 * 128; it += NGW) {
        const int cg = it & 15, chunk = it >> 4, c = cg * 512 + lane * 8;
        float w[5][8];
#pragma unroll
        for (int s = 0; s < 5; ++s) { const f32x4 a = *(const f32x4*)(cw + s * 8192 + c), b = *(const f32x4*)(cw + s * 8192 + c + 4);
            w[s][0] = a.x; w[s][1] = a.y; w[s][2] = a.z; w[s][3] = a.w; w[s][4] = b.x; w[s][5] = b.y; w[s][6] = b.z; w[s][7] = b.w; }
        const float qsc = cg < 4 ? 0.08838834764831845f : 1.f;
        for (int bt = 0; bt < 16; ++bt) {
            const int r0 = chunk * 128 + bt * 8;
            const int L = r0 < MCTX ? 256 : 64, pos0 = r0 < MCTX ? (r0 & 255) : ((r0 - MCTX) & 63);
            u32x4 xw[12];
#pragma unroll
            for (int i = 0; i < 12; ++i) { const int pp = pos0 + i - 2;
                xw[i] = (pp >= 0 && pp < L) ? *(const u32x4*)(proj + (size_t)(r0 + i - 2) * DN_NMAIN + c) : (u32x4){0u, 0u, 0u, 0u}; }
#pragma unroll
            for (int o = 0; o < 8; ++o) {
                float acc[8];
#pragma unroll
                for (int i = 0; i < 8; ++i) acc[i] = 0.f;
#pragma unroll
                for (int s = 0; s < 5; ++s) { const u32x4 x = xw[o + s];
                    acc[0] += bflo(x.x) * w[s][0]; acc[1] += bfhi(x.x) * w[s][1]; acc[2] += bflo(x.y) * w[s][2]; acc[3] += bfhi(x.y) * w[s][3];
                    acc[4] += bflo(x.z) * w[s][4]; acc[5] += bfhi(x.z) * w[s][5]; acc[6] += bflo(x.w) * w[s][6]; acc[7] += bfhi(x.w) * w[s][7]; }
                float ss = 0.f;
#pragma unroll
                for (int i = 0; i < 8; ++i) { acc[i] = siluf_(acc[i]); ss += acc[i] * acc[i]; }
                if (cg < 8) {
                    ss += __shfl_xor(ss, 1); ss += __shfl_xor(ss, 2); ss += __shfl_xor(ss, 4); ss += __shfl_xor(ss, 8);
                    const float sc = rsqrtf(ss + EPS) * qsc;
#pragma unroll
                    for (int i = 0; i < 8; ++i) acc[i] *= sc;
                }
                u32x4 ov; ov.x = pk2(acc[0], acc[1]); ov.y = pk2(acc[2], acc[3]); ov.z = pk2(acc[4], acc[5]); ov.w = pk2(acc[6], acc[7]);
                *(u32x4*)(QKV + (size_t)(r0 + o) * 8192 + c) = ov;
            }
        }
    }
    if (!do_gates) return;
    float* G = (float*)(P.ws + WS_GATE);
    const float* Alog = P.in[16] + j * 64; const float* dtb = P.in[17] + j * 64;
    const float* GPp = (const float*)(P.ws + WS_GP);
    for (int i = gw * 64 + lane; i < MROWS * 128; i += NGW * 64) {
        const int col = i & 127; const float x = (GPp[i] + GPp[i + (size_t)MROWS * 128]) + (GPp[i + (size_t)2 * MROWS * 128] + GPp[i + (size_t)3 * MROWS * 128]); float y;
        if (col < 64) y = sigmoidf_(x);
        else { const int dh = col - 64; y = -__expf(Alog[dh]) * softplusf_(x + dtb[dh]); }
        G[i] = y;
    }
}

typedef short bf16x8 __attribute__((ext_vector_type(8)));
typedef short s16x4 __attribute__((ext_vector_type(4)));
typedef __bf16 bfv8 __attribute__((ext_vector_type(8)));
typedef float f32x8 __attribute__((ext_vector_type(8)));
__device__ __forceinline__ bf16x8 pack8(f32x4 a, f32x4 b) { const f32x8 v = {a[0], a[1], a[2], a[3], b[0], b[1], b[2], b[3]}; return __builtin_bit_cast(bf16x8, __builtin_convertvector(v, bfv8)); }
__device__ __forceinline__ bf16x8 cat4(s16x4 a, s16x4 b) { return (bf16x8){a[0], a[1], a[2], a[3], b[0], b[1], b[2], b[3]}; }
__device__ __forceinline__ s16x4 ld_tr(const LAS unsigned char* p) { return __builtin_amdgcn_ds_read_tr16_b64_v4i16((LAS s16x4*)p); }
__device__ __forceinline__ s16x4 ld_b64(const LAS unsigned char* p) { return *(const volatile LAS s16x4*)p; }
__device__ __forceinline__ bf16x8 ld_b128(const LAS unsigned char* p) { return *(const LAS bf16x8*)p; }
#define MFMA16(a, b, c) __builtin_amdgcn_mfma_f32_16x16x32_bf16((a), (b), (c), 0, 0, 0)

template <int KIND> __device__ __forceinline__ void gla_prep_phase(const Params& P, LAS unsigned char* lds) {
    PHASE_IDS();
    constexpr int NCH = KIND == 1 ? 1024 : 2048, LDP = KIND == 1 ? GLA_NMAIN : HG_NIN, NCB = NCH / 1024;
    const bf16* proj = (const bf16*)(P.ws + WS_BIG); const float* G = (const float*)(P.ws + WS_GATE);
    bf16* QT = (bf16*)(P.ws + WS_QKV); bf16* KT = QT + (size_t)2 * MROWS * NCH; float* E = (float*)(P.ws + WS_OF + 64 * MiB);
    constexpr int DKH = KIND == 1 ? 256 : 128, NHB = 1024 / DKH  , NHT = NCH / DKH  , PL = 2064  ;
    LAS unsigned char* QL = lds; LAS unsigned char* KL = lds + 32 * PL;
    LAS float* sa1 = (LAS float*)(lds + 2 * 32 * PL);
    unsigned* PG = (unsigned*)(P.ws + WS_OF + 72 * MiB);
    for (int it = blockIdx.x; it < 2 * 512 * NCB; it += gridDim.x) {
        const int cb_ = it % NCB, cidx = (it / NCB) % 512, d = it / (NCB * 512);
        const int c0 = cb_ * 1024 + 2 * tid, rbase = cidx * 32;
        float w0[16], w1[16], b0 = 0.f, b1 = 0.f, lb0 = 0.f, lb1 = 0.f;
        if (KIND == 1) {
            __syncthreads();
            { const int p = tid >> 4, r = tid & 15; const int row = rbase + (d ? 31 - p : p); const size_t gi = (size_t)row * 128 + d * 16 + r; const float* GPp = (const float*)(P.ws + WS_GP); sa1[tid] = (GPp[gi] + GPp[gi + (size_t)MROWS * 128]) + (GPp[gi + (size_t)2 * MROWS * 128] + GPp[gi + (size_t)3 * MROWS * 128]); }
            __syncthreads();
            const float* w2 = P.in[21] + (size_t)d * 16 * 1024 + c0;
#pragma unroll
            for (int r = 0; r < 16; ++r) { w0[r] = w2[(size_t)r * 1024]; w1[r] = w2[(size_t)r * 1024 + 1]; }
            b0 = P.in[22][d * 1024 + c0]; b1 = P.in[22][d * 1024 + c0 + 1];
        } else {
            const float* lg = P.in[26];
            { const float l0 = lg[c0], l1 = lg[2048 + c0], l2 = lg[4096 + c0], l3 = lg[6144 + c0]; const float mx = fmaxf(fmaxf(l0, l1), fmaxf(l2, l3));
              const float e0 = __expf(l0 - mx), e1 = __expf(l1 - mx), e2 = __expf(l2 - mx), e3 = __expf(l3 - mx); lb0 = (e1 + e2) / ((e0 + e1) + (e2 + e3)); }
            { const float l0 = lg[c0 + 1], l1 = lg[2048 + c0 + 1], l2 = lg[4096 + c0 + 1], l3 = lg[6144 + c0 + 1]; const float mx = fmaxf(fmaxf(l0, l1), fmaxf(l2, l3));
              const float e0 = __expf(l0 - mx), e1 = __expf(l1 - mx), e2 = __expf(l2 - mx), e3 = __expf(l3 - mx); lb1 = (e1 + e2) / ((e0 + e1) + (e2 + e3)); }
        }
        float cs0 = KIND == 1 ? 0.f : 1.f, cs1 = cs0;
#pragma unroll 8
        for (int p = 0; p < 32; ++p) {
            const int row = rbase + (d ? 31 - p : p); const bf16* pr = proj + (size_t)row * LDP;
            float q0, q1, k0, k1, la0, la1;
            if (KIND == 1) {
                const unsigned qw = *(const unsigned*)(pr + c0), kw = *(const unsigned*)(pr + 1024 + c0);
                q0 = bflo(qw) * 0.0625f; q1 = bfhi(qw) * 0.0625f; k0 = bflo(kw); k1 = bfhi(kw);
                float x0 = b0, x1 = b1;
#pragma unroll
                for (int r = 0; r < 16; ++r) { const float a = sa1[p * 16 + r]; x0 += a * w0[r]; x1 += a * w1[r]; }
                la0 = (fminf(x0, 0.f) - __logf(1.f + __expf(-fabsf(x0)))) * 0.0625f; la1 = (fminf(x1, 0.f) - __logf(1.f + __expf(-fabsf(x1)))) * 0.0625f;
            } else {
                const unsigned qw = *(const unsigned*)(pr + c0), fw = *(const unsigned*)(pr + (d ? 8192 : 6144) + c0);
                q0 = siluf_(bflo(qw)) * 0.08838834764831845f; q1 = siluf_(bfhi(qw)) * 0.08838834764831845f;
                const float a0 = lb0 + (1.f - lb0) * sigmoidf_(bflo(fw)), a1 = lb1 + (1.f - lb1) * sigmoidf_(bfhi(fw));
                k0 = 1.f - a0; k1 = 1.f - a1; la0 = a0; la1 = a1;
            }
            float e0, e1, i0, i1;
            if (KIND == 1) { cs0 += la0; cs1 += la1; e0 = __expf(cs0); e1 = __expf(cs1); i0 = __expf(-cs0); i1 = __expf(-cs1); }
            else { cs0 *= la0; cs1 *= la1; e0 = cs0; e1 = cs1; i0 = __builtin_amdgcn_rcpf(cs0); i1 = __builtin_amdgcn_rcpf(cs1); }
            const size_t o = ((size_t)d * MROWS + row) * NCH + c0;
            const unsigned qb = pk2(q0 * e0, q1 * e1), kb = pk2(k0 * i0, k1 * i1);
            *(unsigned*)(QT + o) = qb; *(unsigned*)(KT + o) = kb;
            *(LAS unsigned*)(QL + p * PL + 4 * tid) = qb; *(LAS unsigned*)(KL + p * PL + 4 * tid) = kb;
        }
        { float* e = E + ((size_t)d * 512 + cidx) * NCH + c0; e[0] = KIND == 1 ? __expf(cs0) : cs0; e[1] = KIND == 1 ? __expf(cs1) : cs1; }
        __syncthreads();
        {
            const int r = lane & 15, g = lane >> 4;
            const int hl = KIND == 1 ? (wave >> 1) : wave; const int cbase = hl * DKH;
            f32x4 t0 = {0.f, 0.f, 0.f, 0.f}, t1 = t0, t2 = t0;
            const bool do02 = KIND == 1 ? ((wave & 1) == 0) : true, do1 = KIND == 1 ? ((wave & 1) == 1) : true;
#pragma unroll
            for (int sx = 0; sx < DKH / 32; ++sx) {
                const int cb2 = (cbase + 32 * sx + 8 * g) * 2;
                const bf16x8 k0 = ld_b128(KL + r * PL + cb2), q1 = ld_b128(QL + (16 + r) * PL + cb2);
                if (do02) { const bf16x8 q0 = ld_b128(QL + r * PL + cb2), k1 = ld_b128(KL + (16 + r) * PL + cb2); t0 = MFMA16(k0, q0, t0); t2 = MFMA16(k1, q1, t2); }
                if (do1) t1 = MFMA16(k0, q1, t1);
            }
#pragma unroll
            for (int e = 0; e < 4; ++e) { if (r < 4 * g + e) { t0[e] = 0.f; t2[e] = 0.f; } }
            unsigned* pg = PG + (((size_t)d * 512 + cidx) * NHT + cb_ * NHB + hl) * 384 + lane * 2;
            if (do02) { pg[0] = pk2(t0[0], t0[1]); pg[1] = pk2(t0[2], t0[3]); pg[256] = pk2(t2[0], t2[1]); pg[257] = pk2(t2[2], t2[3]); }
            if (do1) { pg[128] = pk2(t1[0], t1[1]); pg[129] = pk2(t1[2], t1[3]); }
        }
        __syncthreads();
    }
}

template <int KIND> __device__ __forceinline__ void gla_chunk_phase(const Params& P, LAS unsigned char* lds) {
    PHASE_IDS();
    constexpr int DK = KIND == 1 ? 256 : 128, DV = KIND == 1 ? 512 : 128, NH = KIND == 1 ? 4 : 16, NSL = DV / 128, NKT = DK / 16, NCH = NH * DK;
    constexpr int LDP = KIND == 1 ? GLA_NMAIN : HG_NIN, W = 2048;
    constexpr int PQ = DK * 2 + 16, PV = 256 + 16;
    constexpr int OFF_Q = 0, OFF_K = 32 * PQ, OFF_V = 2 * 32 * PQ, OFF_E = OFF_V + 32 * PV;
    constexpr int NPQ = 32 * DK / 8 / NT;
    const bf16* proj = (const bf16*)(P.ws + WS_BIG);
    const bf16* QT = (const bf16*)(P.ws + WS_QKV); const bf16* KT = QT + (size_t)2 * MROWS * NCH; const float* Eg = (const float*)(P.ws + WS_OF + 64 * MiB);
    bf16* OF = (bf16*)(P.ws + WS_OF); bf16* OB = (bf16*)(P.ws + WS_OB);
    const u32x2* PG = (const u32x2*)(P.ws + WS_OF + 72 * MiB);
    const int r = lane & 15, g = lane >> 4, q4 = (lane & 15) >> 2, p4 = lane & 3;
    constexpr int UL = 4 * NH * 2 * NSL  , UC = 32 * NH * 2 * NSL  ;
    const int G = gridDim.x, bx = blockIdx.x;
    const bool bal = (G == 2 * UL);
    const int nun = bal ? (bx < UL ? 1 : UC / UL) : (UL + UC - bx + G - 1) / G;
    for (int ui = 0; ui < nun; ++ui) {
        const int bxl = bx < UL ? bx : bx - UL;
        const int bxq = (bal && NSL == 4) ? (((bxl & 7) + 8 * (bxl >> 5)) * 4 + ((bxl >> 3) & 3)) : bxl;
        const int unit = bal ? (bx < UL ? bxq : UL + bxq + UL * ui) : bx + ui * G;
        const bool lat = unit < UL; int u2 = lat ? unit : unit - UL;
        const int sl = u2 % NSL; u2 /= NSL; const int d = u2 & 1; u2 >>= 1; const int h = u2 % NH; const int b = u2 / NH;
        const int T = lat ? 2048 : 256, row0 = lat ? MCTX + b * 2048 : b * 256, nchunk = T / 32;
        bf16* O = d ? OB : OF;
        f32x4 S[NKT];
        { const float* s0 = (KIND == 1 ? P.in[4] : P.in[5]) + ((((size_t)b * 2 + d) * NH + h) * DK) * DV + sl * 128 + 16 * wave + r;
#pragma unroll
          for (int kt = 0; kt < NKT; ++kt)
#pragma unroll
              for (int e = 0; e < 4; ++e) S[kt][e] = lat ? s0[(size_t)(16 * kt + 4 * g + e) * DV] : 0.f; }
        u32x4 rq[NPQ], rk[NPQ], rv; f32x4 re = {0.f, 0.f, 0.f, 0.f}; u32x2 rp0 = {0u, 0u}, rp1 = rp0, rp2 = rp0;
#define GLC_PREFETCH(c_) do { \
            _Pragma("unroll") for (int x = 0; x < NPQ; ++x) { const int pi = tid + x * NT, pr = pi / (DK / 8), pc = pi % (DK / 8); const int pp = (c_) * 32 + pr; const int t = d ? T - 1 - pp : pp; \
                const size_t o = ((size_t)d * MROWS + row0 + t) * NCH + h * DK + pc * 8; rq[x] = *(const u32x4*)(QT + o); rk[x] = *(const u32x4*)(KT + o); } \
            { const int pr = tid >> 4, pc = tid & 15; const int pp = (c_) * 32 + pr; const int t = d ? T - 1 - pp : pp; rv = *(const u32x4*)(proj + (size_t)(row0 + t) * LDP + 2048 + h * DV + sl * 128 + pc * 8); } \
            { const int cg = d ? (row0 + T) / 32 - 1 - (c_) : row0 / 32 + (c_); if (tid < DK / 4) re = *(const f32x4*)(Eg + ((size_t)d * 512 + cg) * NCH + h * DK + tid * 4); \
              const u32x2* pg = PG + (((size_t)d * 512 + cg) * NH + h) * 192 + lane; rp0 = pg[0]; rp1 = pg[64]; rp2 = pg[128]; } } while (0)
        GLC_PREFETCH(0);
        for (int c = 0; c < nchunk; ++c) {
            __syncthreads();
#pragma unroll
            for (int x = 0; x < NPQ; ++x) { const int pi = tid + x * NT, pr = pi / (DK / 8), pc = pi % (DK / 8);
                *(LAS u32x4*)(lds + OFF_Q + pr * PQ + pc * 16) = rq[x]; *(LAS u32x4*)(lds + OFF_K + pr * PQ + pc * 16) = rk[x]; }
            { const int pr = tid >> 4, pc = tid & 15; *(LAS u32x4*)(lds + OFF_V + pr * PV + pc * 16) = rv; }
            if (tid < DK / 4) *(LAS f32x4*)(lds + OFF_E + tid * 16) = re;
            __syncthreads();
            const u32x2 cp0 = rp0, cp1 = rp1, cp2 = rp2;
            if (c + 1 < nchunk) GLC_PREFETCH(c + 1);
            const f32x4 zero4 = {0.f, 0.f, 0.f, 0.f};
            const bf16x8 vpa = cat4(ld_tr(lds + OFF_V + (4 * g + q4) * PV + (16 * wave + 4 * p4) * 2), ld_tr(lds + OFF_V + (16 + 4 * g + q4) * PV + (16 * wave + 4 * p4) * 2));
            const bf16x8 pb0 = __builtin_bit_cast(bf16x8, (u32x4){cp0.x, cp0.y, 0u, 0u}), pb1 = __builtin_bit_cast(bf16x8, (u32x4){cp1.x, cp1.y, cp2.x, cp2.y});
            f32x4 o0 = MFMA16(vpa, pb0, zero4), o1 = MFMA16(vpa, pb1, zero4);
#pragma unroll
            for (int s = 0; s < DK / 32; ++s) {
                const bf16x8 sb = pack8(S[2 * s], S[2 * s + 1]);
                const bf16x8 a0 = cat4(ld_b64(lds + OFF_Q + r * PQ + (32 * s + 4 * g) * 2), ld_b64(lds + OFF_Q + r * PQ + (32 * s + 16 + 4 * g) * 2));
                const bf16x8 a1 = cat4(ld_b64(lds + OFF_Q + (16 + r) * PQ + (32 * s + 4 * g) * 2), ld_b64(lds + OFF_Q + (16 + r) * PQ + (32 * s + 16 + 4 * g) * 2));
                o0 = MFMA16(sb, a0, o0); o1 = MFMA16(sb, a1, o1);
                if (KIND == 1 && (s & 3) == 3) asm volatile("" ::: "memory");
            }
            { const int colo = h * DV + sl * 128 + 16 * wave + 4 * g; const int pp0 = c * 32 + r, pp1 = c * 32 + 16 + r; const int t0 = d ? T - 1 - pp0 : pp0, t1 = d ? T - 1 - pp1 : pp1;
              u32x2 w0, w1; w0.x = pk2(o0[0], o0[1]); w0.y = pk2(o0[2], o0[3]); w1.x = pk2(o1[0], o1[1]); w1.y = pk2(o1[2], o1[3]);
              *(u32x2*)(O + (size_t)(row0 + t0) * W + colo) = w0; *(u32x2*)(O + (size_t)(row0 + t1) * W + colo) = w1; }
            const bf16x8 vb = cat4(ld_tr(lds + OFF_V + (8 * g + q4) * PV + (16 * wave + 4 * p4) * 2), ld_tr(lds + OFF_V + (8 * g + 4 + q4) * PV + (16 * wave + 4 * p4) * 2));
#pragma unroll
            for (int kt = 0; kt < NKT; ++kt) {
                const bf16x8 ka = cat4(ld_tr(lds + OFF_K + (8 * g + q4) * PQ + (16 * kt + 4 * p4) * 2), ld_tr(lds + OFF_K + (8 * g + 4 + q4) * PQ + (16 * kt + 4 * p4) * 2));
                const f32x4 ev = *(const LAS f32x4*)(lds + OFF_E + (16 * kt + 4 * g) * 4);
                S[kt] = MFMA16(ka, vb, S[kt]) * ev;
                if (KIND == 1 && (kt & 7) == 7) asm volatile("" ::: "memory");
            }
        }
#undef GLC_PREFETCH
        if (!lat) { float* sd = P.out + (KIND == 1 ? OUT_SGLA : OUT_SHG) + ((((size_t)b * 2 + d) * NH + h) * DK) * DV + sl * 128 + 16 * wave + r;
#pragma unroll
            for (int kt = 0; kt < NKT; ++kt)
#pragma unroll
                for (int e = 0; e < 4; ++e) sd[(size_t)(16 * kt + 4 * g + e) * DV] = S[kt][e]; }
    }
}

#define MFMA4F(a, b, c) __builtin_amdgcn_mfma_f32_16x16x4f32((a), (b), (c), 0, 0, 0)
template <int I> __device__ __forceinline__ float row_share(float v) { return __builtin_bit_cast(float, __builtin_amdgcn_update_dpp(0, __builtin_bit_cast(int, v), 0x150 + I, 0xf, 0xf, false)); }
template <int I> struct DiagStep {
    static __device__ __forceinline__ void run(const float (&Ld)[16], float (&x)[16], int cc) {
        DiagStep<I - 1>::run(Ld, x, cc);
        float a0 = (I == cc) ? 1.f : 0.f, a1 = 0.f;
#pragma unroll
        for (int m = 0; m < I; ++m) { const float lv = row_share<I>(Ld[m]); if (m & 1) a1 -= lv * x[m]; else a0 -= lv * x[m]; }
        x[I] = a0 + a1;
    }
};
template <> struct DiagStep<-1> { static __device__ __forceinline__ void run(const float (&)[16], float (&)[16], int) {} };
__device__ __forceinline__ void dn_wu_prep_phase(const Params& P, LAS unsigned char* lds) {
    PHASE_IDS();
    constexpr int PKQ = 272;
    constexpr int LP = 68;
    constexpr int OFF_K = 0, OFF_Q = 64 * PKQ, OFF_L = 0  , OFF_KK = 4 * 64 * LP * 4, OFF_QK = OFF_KK + 64 * LP * 4, OFF_G = OFF_QK + 64 * LP * 4;
    const bf16* QKV = (const bf16*)(P.ws + WS_QKV); const float* G = (const float*)(P.ws + WS_GATE);
    bf16* TA = (bf16*)(P.ws + WS_TA); float* GS = (float*)(P.ws + WS_GS);
    const int r = lane & 15, g = lane >> 4;
    LAS float* KKs = (LAS float*)(lds + OFF_KK); LAS float* QKs = (LAS float*)(lds + OFF_QK); LAS float* Gs = (LAS float*)(lds + OFF_G);
    u32x4 pq[2], pk[2]; float pgv = 0.f;
#define WU_PREFETCH(grp_) do { const int cidx_ = (grp_) >> 4, kh_ = (grp_) & 15, rb_ = cidx_ * 64; \
        _Pragma("unroll") for (int x = 0; x < 2; ++x) { const int pi = tid + x * NT, pr = pi >> 4, pc = pi & 15; const size_t o = (size_t)(rb_ + pr) * 8192 + kh_ * 128 + pc * 8; pq[x] = *(const u32x4*)(QKV + o); pk[x] = *(const u32x4*)(QKV + o + 2048); } \
        { const int c4 = tid >> 7, which = (tid >> 6) & 1, i = tid & 63, hv = c4 >> 1, d = c4 & 1, h = 2 * kh_ + hv; pgv = G[(size_t)(rb_ + i) * 128 + (which ? 0 : 64) + d * 32 + h]; } } while (0)
    if ((int)blockIdx.x < 256 * 16) WU_PREFETCH(blockIdx.x);
    for (int grp = blockIdx.x; grp < 256 * 16; grp += gridDim.x) {
        const int cidx = grp >> 4, kh = grp & 15;
        __syncthreads();
#pragma unroll
        for (int x = 0; x < 2; ++x) { const int pi = tid + x * NT, pr = pi >> 4, pc = pi & 15;
            *(LAS u32x4*)(lds + OFF_Q + pr * PKQ + pc * 16) = pq[x]; *(LAS u32x4*)(lds + OFF_K + pr * PKQ + pc * 16) = pk[x]; }
        Gs[tid] = pgv;
        __syncthreads();
        if (grp + (int)gridDim.x < 256 * 16) WU_PREFETCH(grp + (int)gridDim.x);
        {
            const int it = wave & 3; const int offx = (wave >> 2) ? OFF_Q : OFF_K; LAS float* dst = (wave >> 2) ? QKs : KKs;
            f32x4 acc[4];
#pragma unroll
            for (int jt = 0; jt < 4; ++jt) acc[jt] = (f32x4){0.f, 0.f, 0.f, 0.f};
#pragma unroll
            for (int sx = 0; sx < 4; ++sx) { const bf16x8 a = ld_b128(lds + offx + (16 * it + r) * PKQ + (32 * sx + 8 * g) * 2);
#pragma unroll
                for (int jt = 0; jt < 4; ++jt) acc[jt] = MFMA16(a, ld_b128(lds + OFF_K + (16 * jt + r) * PKQ + (32 * sx + 8 * g) * 2), acc[jt]); }
#pragma unroll
            for (int jt = 0; jt < 4; ++jt)
#pragma unroll
                for (int e = 0; e < 4; ++e) dst[(16 * it + 4 * g + e) * LP + 16 * jt + r] = acc[jt][e];
        }
        __syncthreads();
        {
            const int c4 = wave & 3, hv = c4 >> 1, d = c4 & 1, h = 2 * kh + hv;
            const int nl = d ? 63 - lane : lane;
            float gcv = Gs[(c4 * 2 + 0) * 64 + nl];
#pragma unroll
            for (int o = 1; o < 64; o <<= 1) { const float t = __shfl_up(gcv, o); if (lane >= o) gcv += t; }
            const float betav = Gs[(c4 * 2 + 1) * 64 + nl];
            const size_t item = ((size_t)(cidx * 32 + h) * 2 + d);
            if (wave >= 4) {
                bf16* Ag = TA + item * 8192 + 4096;
                for (int p = 0; p < 64; ++p) { const float gp = rdlane(gcv, p); const int np_ = d ? 63 - p : p;
                    const float qk = QKs[np_ * LP + nl]; if ((lane & ~7) <= p) Ag[p * 64 + lane] = (bf16)f2bf(lane <= p ? qk * __expf(gp - gcv) : 0.f); }
                float* gs = GS + item * 192; const float gend = rdlane(gcv, 63);
                gs[lane] = __expf(gcv); gs[64 + lane] = betav; gs[128 + lane] = __expf(gend - gcv);
            } else {
                LAS float* W = (LAS float*)(lds + OFF_L) + c4 * 64 * LP;
                for (int p = 0; p < 64; ++p) { const float gp = rdlane(gcv, p), bp = rdlane(betav, p); const int np_ = d ? 63 - p : p;
                    const float kk = KKs[np_ * LP + nl]; W[p * LP + lane] = lane < p ? bp * kk * __expf(gp - gcv) : 0.f; }
                {
                    const int lane2 = opaque_v(lane); const int bb = lane2 >> 4, cc = lane2 & 15;
                    float Ld[16];
#pragma unroll
                    for (int m4 = 0; m4 < 4; ++m4) { const f32x4 v = *(const LAS f32x4*)(W + (16 * bb + cc) * LP + 16 * bb + 4 * m4); Ld[4 * m4] = v[0]; Ld[4 * m4 + 1] = v[1]; Ld[4 * m4 + 2] = v[2]; Ld[4 * m4 + 3] = v[3]; }
                    float x[16];
                    DiagStep<15>::run(Ld, x, cc);
#pragma unroll
                    for (int i = 0; i < 16; ++i) W[(16 * bb + i) * LP + 16 * bb + cc] = x[i];
                }
#define WU_PN(ar, ac, br, bc, acc_) do { _Pragma("unroll") for (int sx = 0; sx < 4; ++sx) acc_ = MFMA4F(W[((ar) + r) * LP + (ac) + 4 * sx + g], W[((br) + 4 * sx + g) * LP + (bc) + r], acc_); } while (0)
#define WU_PA(ar, ac, M_, acc_) do { _Pragma("unroll") for (int e = 0; e < 4; ++e) acc_ = MFMA4F(W[((ar) + r) * LP + (ac) + 4 * g + e], M_[e], acc_); } while (0)
#define WU_ST(r0, c0, acc_) do { _Pragma("unroll") for (int e = 0; e < 4; ++e) W[((r0) + 4 * g + e) * LP + (c0) + r] = -acc_[e]; } while (0)
                const f32x4 z4 = {0.f, 0.f, 0.f, 0.f};
                { f32x4 m1a = z4, m1b = z4; WU_PN(16, 0, 0, 0, m1a); WU_PN(48, 32, 32, 32, m1b);
                  f32x4 t10 = z4, t32 = z4; WU_PA(16, 16, m1a, t10); WU_PA(48, 48, m1b, t32);
                  WU_ST(16, 0, t10); WU_ST(48, 32, t32); }
                { f32x4 m00 = z4, m01 = z4, m10 = z4, m11 = z4;
                  WU_PN(32, 0, 0, 0, m00); WU_PN(32, 16, 16, 0, m00); WU_PN(32, 16, 16, 16, m01);
                  WU_PN(48, 0, 0, 0, m10); WU_PN(48, 16, 16, 0, m10); WU_PN(48, 16, 16, 16, m11);
                  f32x4 t00 = z4, t01 = z4, t10 = z4, t11 = z4;
                  WU_PA(32, 32, m00, t00); WU_PA(32, 32, m01, t01);
                  WU_PA(48, 32, m00, t10); WU_PA(48, 48, m10, t10); WU_PA(48, 32, m01, t11); WU_PA(48, 48, m11, t11);
                  WU_ST(32, 0, t00); WU_ST(32, 16, t01); WU_ST(48, 0, t10); WU_ST(48, 16, t11); }
#undef WU_PN
#undef WU_PA
#undef WU_ST
                bf16* Tg = TA + item * 8192;
#pragma unroll
                for (int x8 = 0; x8 < 8; ++x8) { const int piece = lane + 64 * x8, row = piece >> 3, pc = piece & 7;
                    const f32x4 v0 = *(const LAS f32x4*)(W + row * LP + pc * 8), v1 = *(const LAS f32x4*)(W + row * LP + pc * 8 + 4);
                    u32x4 o; o.x = pk2(v0[0], v0[1]); o.y = pk2(v0[2], v0[3]); o.z = pk2(v1[0], v1[1]); o.w = pk2(v1[2], v1[3]);
                    if (pc * 8 <= row) *(u32x4*)(Tg + row * 64 + pc * 8) = o; }
            }
        }
    }
#undef WU_PREFETCH
}

constexpr int DN_PQ = 272;
constexpr int DN_PXQ = 144, DN_XQ = 64 * DN_PXQ, DN_PXT = 80, DN_XT = 64 * DN_PXT;
constexpr int DN_OFF_Q = 0, DN_OFF_K = 2 * DN_XQ, DN_OFF_V = DN_OFF_K + 64 * DN_PQ, DN_OFF_T = DN_OFF_V + 64 * DN_PQ, DN_OFF_A = DN_OFF_T + 2 * DN_XT, DN_OFF_S = DN_OFF_A + 2 * DN_XT;
struct DnStage { u32x4 rq[2], rk[2], rv[2], rt, ra; f32x4 rs; };
__device__ __forceinline__ void dn_stage_load(DnStage& st, const bf16* QKV, const bf16* TA, const float* GS, int tid, int c, int d, int T, int row0, int kh, int h, int nchunk) {
#pragma unroll
    for (int x = 0; x < 2; ++x) { const int pi = tid + x * NT, pr = pi >> 4, pc = pi & 15; const int pp = c * 64 + pr; const int t = d ? T - 1 - pp : pp;
        const size_t o = (size_t)(row0 + t) * 8192 + pc * 8; st.rq[x] = *(const u32x4*)(QKV + o + kh * 128); st.rk[x] = *(const u32x4*)(QKV + o + 2048 + kh * 128); st.rv[x] = *(const u32x4*)(QKV + o + 4096 + h * 128); }
    const int nc = d ? nchunk - 1 - c : c; const size_t item = ((size_t)((row0 >> 6) + nc) * 32 + h) * 2 + d;
    const bool nz = ((tid & 7) * 8) <= (tid >> 3);
    st.rt = nz ? *(const u32x4*)(TA + item * 8192 + tid * 8) : (u32x4){0u, 0u, 0u, 0u}; st.ra = nz ? *(const u32x4*)(TA + item * 8192 + 4096 + tid * 8) : (u32x4){0u, 0u, 0u, 0u};
    st.rs = (f32x4){0.f, 0.f, 0.f, 0.f}; if (tid < 48) st.rs = *(const f32x4*)(GS + item * 192 + tid * 4);
}
__device__ __forceinline__ void dn_stage_store(const DnStage& st, LAS unsigned char* lds, int tid) {
#pragma unroll
    for (int x = 0; x < 2; ++x) { const int pi = tid + x * NT, pr = pi >> 4, pc = pi & 15;
        { LAS unsigned char* qd = lds + DN_OFF_Q + pr * DN_PXQ + (2 * (pc >> 2) + (pc & 1)) * 16 + ((pc >> 1) & 1) * 8;
          *(LAS u32x2*)qd = (u32x2){st.rq[x].x, st.rq[x].y}; *(LAS u32x2*)(qd + DN_XQ) = (u32x2){st.rq[x].z, st.rq[x].w}; }
        *(LAS u32x4*)(lds + DN_OFF_K + pr * DN_PQ + pc * 16) = st.rk[x]; *(LAS u32x4*)(lds + DN_OFF_V + pr * DN_PQ + pc * 16) = st.rv[x]; }
    { const int pr = tid >> 3, pc = tid & 7; const int o = pr * DN_PXT + (2 * (pc >> 2) + (pc & 1)) * 16 + ((pc >> 1) & 1) * 8;
      *(LAS u32x2*)(lds + DN_OFF_T + o) = (u32x2){st.rt.x, st.rt.y}; *(LAS u32x2*)(lds + DN_OFF_T + o + DN_XT) = (u32x2){st.rt.z, st.rt.w};
      *(LAS u32x2*)(lds + DN_OFF_A + o) = (u32x2){st.ra.x, st.ra.y}; *(LAS u32x2*)(lds + DN_OFF_A + o + DN_XT) = (u32x2){st.ra.z, st.ra.w}; }
    if (tid < 48) *(LAS f32x4*)(lds + DN_OFF_S + tid * 16) = st.rs;
}
__device__ __forceinline__ void dn_step_compute(f32x4 (&S)[8], LAS unsigned char* lds, bf16* O, int c, int d, int T, int row0, int h, int wave, int lane) {
    constexpr int PQ = DN_PQ, OFF_Q = DN_OFF_Q, OFF_K = DN_OFF_K, OFF_V = DN_OFF_V, OFF_T = DN_OFF_T, OFF_A = DN_OFF_A, OFF_S = DN_OFF_S;
    const int r = lane & 15, g = lane >> 4, q4 = (lane & 15) >> 2, p4 = lane & 3;
#define DN_PERMROW(off_, pitch_, row_, col_) cat4(ld_b64(lds + (off_) + (row_) * (pitch_) + ((col_) + 4 * g) * 2), ld_b64(lds + (off_) + (row_) * (pitch_) + ((col_) + 16 + 4 * g) * 2))
#define DN_CHUNK(off_, xsz_, pitch_, row_, sx_) ld_b128(lds + (off_) + (g & 1) * (xsz_) + (row_) * (pitch_) + (2 * (sx_) + (g >> 1)) * 16)
    const f32x4 zero4 = {0.f, 0.f, 0.f, 0.f};
    bf16x8 sb[4];
    f32x4 R[4];
    {
        bf16x8 kf[4][4];
#pragma unroll
        for (int jt = 0; jt < 4; ++jt)
#pragma unroll
            for (int sx = 0; sx < 4; ++sx) kf[jt][sx] = DN_PERMROW(OFF_K, PQ, 16 * jt + r, 32 * sx);
#pragma unroll
        for (int sx = 0; sx < 4; ++sx) sb[sx] = pack8(S[2 * sx], S[2 * sx + 1]);
#pragma unroll
        for (int jt = 0; jt < 4; ++jt) R[jt] = zero4;
#pragma unroll
        for (int sx = 0; sx < 4; ++sx)
#pragma unroll
            for (int jt = 0; jt < 4; ++jt) R[jt] = MFMA16(kf[jt][sx], sb[sx], R[jt]);
    }
    __builtin_amdgcn_sched_barrier(0);
    f32x4 U[4];
    {
        bf16x8 tf[4][2]; s16x4 vt[4]; f32x4 eg[4], bt[4];
#pragma unroll
        for (int jt = 0; jt < 4; ++jt) { vt[jt] = ld_tr(lds + OFF_V + (16 * jt + 4 * g + q4) * PQ + (16 * wave + 4 * p4) * 2);
            eg[jt] = *(const LAS f32x4*)(lds + OFF_S + (16 * jt + 4 * g) * 4); bt[jt] = *(const LAS f32x4*)(lds + OFF_S + 256 + (16 * jt + 4 * g) * 4); }
#pragma unroll
        for (int it = 0; it < 4; ++it) { tf[it][0] = DN_CHUNK(OFF_T, DN_XT, DN_PXT, 16 * it + r, 0); tf[it][1] = DN_CHUNK(OFF_T, DN_XT, DN_PXT, 16 * it + r, 1); }
#pragma unroll
        for (int jt = 0; jt < 4; ++jt)
#pragma unroll
            for (int e = 0; e < 4; ++e) R[jt][e] = bt[jt][e] * (bf2f((unsigned short)vt[jt][e]) - eg[jt][e] * R[jt][e]);
        const bf16x8 rb0 = pack8(R[0], R[1]), rb1 = pack8(R[2], R[3]);
#pragma unroll
        for (int it = 0; it < 4; ++it) U[it] = MFMA16(tf[it][0], rb0, zero4);
#pragma unroll
        for (int it = 0; it < 4; ++it) U[it] = MFMA16(tf[it][1], rb1, U[it]);
    }
    __builtin_amdgcn_sched_barrier(0);
    {
        f32x4 Ot[4];
#pragma unroll
        for (int it = 0; it < 4; ++it) Ot[it] = zero4;
#pragma unroll
        for (int hq = 0; hq < 2; ++hq) {
            bf16x8 qf[2][4];
#pragma unroll
            for (int i2 = 0; i2 < 2; ++i2)
#pragma unroll
                for (int sx = 0; sx < 4; ++sx) qf[i2][sx] = DN_CHUNK(OFF_Q, DN_XQ, DN_PXQ, 16 * (2 * hq + i2) + r, sx);
#pragma unroll
            for (int sx = 0; sx < 4; ++sx)
#pragma unroll
                for (int i2 = 0; i2 < 2; ++i2) Ot[2 * hq + i2] = MFMA16(sb[sx], qf[i2][sx], Ot[2 * hq + i2]);
        }
        bf16x8 af[4][2]; float egi[4];
#pragma unroll
        for (int it = 0; it < 4; ++it) { af[it][0] = DN_CHUNK(OFF_A, DN_XT, DN_PXT, 16 * it + r, 0); af[it][1] = DN_CHUNK(OFF_A, DN_XT, DN_PXT, 16 * it + r, 1); egi[it] = *(const LAS float*)(lds + OFF_S + (16 * it + r) * 4); }
        const bf16x8 ub0 = pack8(U[0], U[1]), ub1 = pack8(U[2], U[3]);
#pragma unroll
        for (int it = 0; it < 4; ++it) Ot[it] = Ot[it] * egi[it];
#pragma unroll
        for (int it = 0; it < 4; ++it) Ot[it] = MFMA16(ub0, af[it][0], Ot[it]);
#pragma unroll
        for (int it = 0; it < 4; ++it) Ot[it] = MFMA16(ub1, af[it][1], Ot[it]);
#pragma unroll
        for (int it = 0; it < 4; ++it) { const int pp = c * 64 + 16 * it + r; const int t = d ? T - 1 - pp : pp; u32x2 w; w.x = pk2(Ot[it][0], Ot[it][1]); w.y = pk2(Ot[it][2], Ot[it][3]);
            *(u32x2*)(O + (size_t)(row0 + t) * 4096 + h * 128 + 16 * wave + 4 * g) = w; }
    }
    __builtin_amdgcn_sched_barrier(0);
    {
#pragma unroll
        for (int jt = 0; jt < 4; ++jt) { const f32x4 dc = *(const LAS f32x4*)(lds + OFF_S + 512 + (16 * jt + 4 * g) * 4); U[jt] = U[jt] * dc; }
        const bf16x8 us0 = pack8(U[0], U[1]), us1 = pack8(U[2], U[3]);
        const float gend = *(const LAS float*)(lds + OFF_S + 63 * 4);
#pragma unroll
        for (int hk = 0; hk < 2; ++hk) {
            bf16x8 ktf[4][2];
#pragma unroll
            for (int k2 = 0; k2 < 4; ++k2) { const int kt = 4 * hk + k2;
                ktf[k2][0] = cat4(ld_tr(lds + OFF_K + (4 * g + q4) * PQ + (16 * kt + 4 * p4) * 2), ld_tr(lds + OFF_K + (16 + 4 * g + q4) * PQ + (16 * kt + 4 * p4) * 2));
                ktf[k2][1] = cat4(ld_tr(lds + OFF_K + (32 + 4 * g + q4) * PQ + (16 * kt + 4 * p4) * 2), ld_tr(lds + OFF_K + (48 + 4 * g + q4) * PQ + (16 * kt + 4 * p4) * 2)); }
#pragma unroll
            for (int k2 = 0; k2 < 4; ++k2) S[4 * hk + k2] = MFMA16(ktf[k2][0], us0, S[4 * hk + k2] * gend);
#pragma unroll
            for (int k2 = 0; k2 < 4; ++k2) S[4 * hk + k2] = MFMA16(ktf[k2][1], us1, S[4 * hk + k2]);
        }
    }
#undef DN_PERMROW
#undef DN_CHUNK
}
__device__ __forceinline__ void dn_chunk_phase(const Params& P, int j, LAS unsigned char* lds) {
    PHASE_IDS();
    const bf16* QKV = (const bf16*)(P.ws + WS_QKV); const bf16* TA = (const bf16*)(P.ws + WS_TA); const float* GS = (const float*)(P.ws + WS_GS);
    bf16* OF = (bf16*)(P.ws + WS_OF); bf16* OB = (bf16*)(P.ws + WS_OB);
    const int r = lane & 15, g = lane >> 4;
    const int bxp = (gridDim.x == 256) ? ({ const int x = blockIdx.x & 7, y = blockIdx.x >> 3, grp = x + 8 * (y >> 1), mem = y & 1; (grp >> 5) * 64 + (2 * ((grp >> 1) & 15) + mem) * 2 + (grp & 1); }) : (int)blockIdx.x;
    for (int unit0 = blockIdx.x; unit0 < 256 + 2048; unit0 += gridDim.x) {
        const int unit = (gridDim.x == 256) ? (unit0 - (int)blockIdx.x + bxp) : unit0;
        const bool lat = unit < 256; const int u2 = lat ? unit : unit - 256;
        const int b = u2 >> 6, h = (u2 >> 1) & 31, d = u2 & 1, T = lat ? 2048 : 256, row0 = lat ? MCTX + b * 2048 : b * 256, kh = h >> 1, nchunk = T / 64;
        bf16* O = d ? OB : OF;
        f32x4 S[8];
        { const float* s0 = P.in[3] + ((((size_t)b * 2 + j) * 2 + d) * 32 + h) * 128 * 128 + 16 * wave + r;
          if (lat) {
#pragma unroll
              for (int kt = 0; kt < 8; ++kt)
#pragma unroll
                  for (int e = 0; e < 4; ++e) S[kt][e] = s0[(size_t)(16 * kt + 4 * g + e) * 128];
          } else {
#pragma unroll
              for (int kt = 0; kt < 8; ++kt) S[kt] = (f32x4){0.f, 0.f, 0.f, 0.f};
          } }
        constexpr int DN_HSZ = DN_OFF_S + 768;
        DnStage sa;
        __syncthreads();
        dn_stage_load(sa, QKV, TA, GS, tid, 0, d, T, row0, kh, h, nchunk);
        dn_stage_store(sa, lds, tid);
        dn_stage_load(sa, QKV, TA, GS, tid, 1, d, T, row0, kh, h, nchunk);
        __syncthreads();
        for (int c = 0; c < nchunk; ++c) {
            LAS unsigned char* cur = lds + (c & 1) * DN_HSZ; LAS unsigned char* nxt = lds + ((c + 1) & 1) * DN_HSZ;
            if (c + 1 < nchunk) dn_stage_store(sa, nxt, tid);
            if (c + 2 < nchunk) dn_stage_load(sa, QKV, TA, GS, tid, c + 2, d, T, row0, kh, h, nchunk);
            dn_step_compute(S, cur, O, c, d, T, row0, h, wave, lane);
            __syncthreads();
        }
        if (!lat) { float* sd = P.out + OUT_SDN + ((((size_t)b * 2 + j) * 2 + d) * 32 + h) * 128 * 128 + 16 * wave + r;
#pragma unroll
            for (int kt = 0; kt < 8; ++kt)
#pragma unroll
                for (int e = 0; e < 4; ++e) sd[(size_t)(16 * kt + 4 * g + e) * 128] = S[kt][e]; }
    }
}


#ifndef R_CONV
#define R_CONV 1
#endif
#ifndef R_MOD
#define R_MOD 1
#endif
#ifndef R_NORM
#define R_NORM 1
#endif
#ifndef R_GATE
#define R_GATE 1
#endif
#ifndef R_DNPREP
#define R_DNPREP 1
#endif
#ifndef R_WU
#define R_WU 1
#endif
#ifndef R_GLAPREP
#define R_GLAPREP 1
#endif
#ifndef R_DNSCAN
#define R_DNSCAN 1
#endif
#ifndef R_GSCAN
#define R_GSCAN 1
#endif
#ifndef R_FINAL
#define R_FINAL 1
#endif
#ifndef R_BAR
#define R_BAR 1
#endif
#ifndef R_GEMM
#define R_GEMM 1
#endif
#define REPN(n_) for (int rep_ = 0; rep_ < (n_); ++rep_)
#ifndef REP_THIN
#define REP_THIN 1
#endif
#ifndef REP_SCAN
#define REP_SCAN 1
#endif
#ifndef REP_A
#define REP_A 1
#endif
#ifndef REP_B
#define REP_B 1
#endif
#ifndef REP_C
#define REP_C 1
#endif
#define RT for (int rep_ = 0; rep_ < REP_THIN; ++rep_)
#define RA for (int rep_ = 0; rep_ < REP_A; ++rep_)
#define RB for (int rep_ = 0; rep_ < REP_B; ++rep_)
#define RC for (int rep_ = 0; rep_ < REP_C; ++rep_)
#define RS for (int rep_ = 0; rep_ < REP_SCAN; ++rep_)
template <int LAYER> __device__ __forceinline__ void layer_body(const Params& P, LAS unsigned char* lds, const XcdBarrier& bar) {
    bf16* X = (bf16*)(P.ws + WS_X); bf16* H = (bf16*)(P.ws + WS_H); bf16* BIG = (bf16*)(P.ws + WS_BIG); float* GATE = (float*)(P.ws + WS_GATE);
    bf16* Y = (bf16*)(P.ws + WS_QKV); bf16* OF = (bf16*)(P.ws + WS_OF); bf16* OB = (bf16*)(P.ws + WS_OB);
    const float* MOD = (const float*)(P.ws + WS_MOD);
    const bf16* Tin = (const bf16*)(P.ws + WS_W + WOFF_IN); const bf16* Tout = (const bf16*)(P.ws + WS_W + WOFF_OUT); const bf16* Tup = (const bf16*)(P.ws + WS_W + WOFF_UP); const bf16* Tdn = (const bf16*)(P.ws + WS_W + WOFF_DOWN);

        constexpr int layer = LAYER, kind = LAYER % 3, j = LAYER / 3;
        const float* modl = MOD + (size_t)layer * 5 * MODW;
        const void* xc = layer == 0 ? (const void*)P.in[0] : (const void*)X; const void* xl = layer == 0 ? (const void*)P.in[1] : (const void*)X;
#ifndef NO_CONV
        REPN(R_CONV) convert_layer_weights(P, layer, lds);
#endif
        if (layer == 0) REPN(R_BAR) xcd_barrier(bar);
        REPN(R_NORM) norm_mod_phase<layer == 0>(xc, xl, P.in[9] + layer * D, modl, 0, 2048, H);
        REPN(R_BAR) xcd_barrier(bar);
        {
            constexpr int Npad = kind == 0 ? DN_NPAD : (kind == 1 ? GLA_NPAD : HG_NIN), nmain = kind == 0 ? DN_NMAIN : (kind == 1 ? GLA_NMAIN : HG_NIN);
            { pg8::Gemm g = pg8::mk_gemm(H, Tin, MROWS, nmain, D); pg8::StaticOrder S; S.init(MROWS, nmain, (int)gridDim.x, (int)blockIdx.x);
              pg8::EpiBf16<0> E{BIG, nmain, nmain, GATE};
              REPN(R_GEMM) pg8::gemm_phase<pg8::EpiBf16<0>, pg8::StaticOrder, true, true>(lds, g, S, E); }
            if constexpr (Npad > nmain) {
              pg8::Gemm g{H, Tin + (size_t)nmain * D, MROWS, 4 * 256, D, (size_t)512 * 2, (size_t)512 * 2, 8}; pg8::StaticOrder S; S.init(MROWS, 4 * 256, (int)gridDim.x, (int)blockIdx.x);
              pg8::EpiGateP E{(float*)(P.ws + WS_GP)};
              pg8::gemm_phase<pg8::EpiGateP, pg8::StaticOrder, true, true>(lds, g, S, E); }
        }
        REPN(R_BAR) xcd_barrier(bar);
        if constexpr (kind == 0) {
#ifndef NO_DNPREP
            REPN(R_DNPREP) dn_prep_phase(P, j, rep_ == 0);
#endif
            REPN(R_BAR) xcd_barrier(bar);
            REPN(R_WU) dn_wu_prep_phase(P, lds);
            REPN(R_BAR) xcd_barrier(bar);
            REPN(R_DNSCAN) dn_chunk_phase(P, j, lds);
            REPN(R_BAR) xcd_barrier(bar);
            REPN(R_GATE) gate_phase<128>(OF, OB, BIG, DN_NMAIN, 8192, P.in[18] + j * 128, Y, 4096);
        } else if constexpr (kind == 1) {
            REPN(R_GLAPREP) gla_prep_phase<1>(P, lds);
            REPN(R_BAR) xcd_barrier(bar);
            REPN(R_GSCAN) gla_chunk_phase<1>(P, lds);
            REPN(R_BAR) xcd_barrier(bar);
            REPN(R_GATE) gate_phase<512>(OF, OB, BIG, GLA_NMAIN, 4096, P.in[23] + j * 512, Y, 2048);
        } else {
            REPN(R_GLAPREP) gla_prep_phase<2>(P, lds);
            REPN(R_BAR) xcd_barrier(bar);
            REPN(R_GSCAN) gla_chunk_phase<2>(P, lds);
            REPN(R_BAR) xcd_barrier(bar);
            REPN(R_GATE) gate_phase<128>(OF, OB, BIG, HG_NIN, 4096, P.in[27] + j * 128, Y, 2048);
        }
        REPN(R_BAR) xcd_barrier(bar);
        {
            const int Kout = kind == 0 ? 4096 : 2048;
            pg8::Gemm g = pg8::mk_gemm(Y, Tout, MROWS, D, Kout); pg8::StaticOrder S; S.init(MROWS, D, (int)gridDim.x, (int)blockIdx.x);
            pg8::EpiRes<layer == 0> E{xc, xl, X, modl + 4096};
            pg8::gemm_phase<pg8::EpiRes<layer == 0>, pg8::StaticOrder, true, true>(lds, g, S, E);
        }
        REPN(R_BAR) xcd_barrier(bar);
        REPN(R_NORM) norm_mod_phase<false>(X, X, P.in[10] + layer * D, modl, 6144, 8192, H);
        REPN(R_BAR) xcd_barrier(bar);
#pragma unroll
        for (int hf = 0; hf < 2; ++hf) {
            {
                pg8::Gemm g = pg8::mk_gemm(H, Tup, MROWS / 2, DFF, D); pg8::StaticOrder S; S.init(MROWS / 2, DFF, (int)gridDim.x, (int)blockIdx.x, hf * 32);
                pg8::EpiBf16<1> E{BIG, DFF, DFF, nullptr};
                REPN(R_GEMM) pg8::gemm_phase<pg8::EpiBf16<1>, pg8::StaticOrder, true, true>(lds, g, S, E);
            }
            REPN(R_BAR) xcd_barrier(bar);
            {
                pg8::Gemm g = pg8::mk_gemm(BIG, Tdn, MROWS / 2, D, DFF); pg8::StaticOrder S; S.init(MROWS / 2, D, (int)gridDim.x, (int)blockIdx.x, hf * 32);
                pg8::EpiRes<false> E{X, X, X, modl + 10240};
                pg8::gemm_phase<pg8::EpiRes<false>, pg8::StaticOrder, true, true>(lds, g, S, E);
            }
            REPN(R_BAR) xcd_barrier(bar);
        }
    }

__global__ void __launch_bounds__(NT, 2) fwd_kernel(Params P) {
    extern __shared__ __attribute__((aligned(16))) unsigned char lds_raw[];
    LAS unsigned char* lds = (LAS unsigned char*)lds_raw;
    const int tid = threadIdx.x;
    volatile LAS unsigned* misc = (volatile LAS unsigned*)(lds + LDS_MISC);
    if (tid < 64) misc[tid] = 0u;
    __syncthreads();
    XcdBarrier bar = xcd_barrier_post((unsigned*)(P.ws + WS_CTL) + 1024, misc + 8);

#ifndef NO_MOD
    REPN(R_MOD) mod_phase(P, lds);
#endif
    __syncthreads();

    layer_body<0>(P, lds, bar);
    layer_body<1>(P, lds, bar);
    layer_body<2>(P, lds, bar);
    layer_body<3>(P, lds, bar);
    REPN(R_FINAL) final_norm_phase((const bf16*)(P.ws + WS_X), P.in[11], P.out + OUT_Y);
}

extern "C" void kernel_launch(void* const* d_in, const int* in_sizes, int n_in, void* d_out, int out_size, void* d_ws, size_t ws_size, hipStream_t stream) {
    static int grid = 0;
    if (grid == 0) {
        if (n_in != 29 || (size_t)out_size != OUT_END || ws_size < WS_END) {
            fprintf(stderr, "kernel_launch: unexpected shapes: n_in %d out %d (want %zu) ws %zu (want %zu)\n", n_in, out_size, (size_t)OUT_END, ws_size, (size_t)WS_END); grid = -1; return; }
        int dev = 0, cus = 0, per_cu = 0;
        if (hipGetDevice(&dev) != hipSuccess || hipDeviceGetAttribute(&cus, hipDeviceAttributeMultiprocessorCount, dev) != hipSuccess) { grid = -1; return; }
        if (hipFuncSetAttribute((const void*)fwd_kernel, hipFuncAttributeMaxDynamicSharedMemorySize, LDS_BYTES) != hipSuccess) { fprintf(stderr, "kernel_launch: hipFuncSetAttribute failed\n"); grid = -1; return; }
        if (hipOccupancyMaxActiveBlocksPerMultiprocessor(&per_cu, (const void*)fwd_kernel, NT, LDS_BYTES) != hipSuccess || per_cu < 1) { fprintf(stderr, "kernel_launch: occupancy query says %d\n", per_cu); }
        (void)hipGetLastError();
        grid = cus;
    }
    if (grid < 0) return;
    hipMemsetAsync((char*)d_ws + WS_CTL, 0, CTL_BYTES, stream);
    Params p{};
    for (int i = 0; i < 29; ++i) p.in[i] = (const float*)d_in[i];
    p.out = (float*)d_out; p.ws = (unsigned char*)d_ws;
    hipLaunchKernelGGL(fwd_kernel, dim3(grid), dim3(NT), LDS_BYTES, stream, p);
}
```

```cpp
#include <hip/hip_runtime.h>
#include <cstdio>
#include <cstdint>

__device__ __forceinline__ int opaque_v(int x) { asm volatile("" : "+v"(x)); return x; }
#define PHASE_IDS() const int tid = opaque_v((int)threadIdx.x), lane = tid & 63, wave = __builtin_amdgcn_readfirstlane(tid >> 6), gw = (int)blockIdx.x * 8 + wave, NGW = (int)gridDim.x * 8; (void)lane; (void)wave; (void)gw; (void)NGW
namespace pg8 {
#define PG8_LAS __attribute__((address_space(3)))
typedef unsigned short bf16_t;
typedef short bf16x8 __attribute__((ext_vector_type(8)));
typedef float f32x4 __attribute__((ext_vector_type(4)));
typedef unsigned u32x4 __attribute__((ext_vector_type(4)));
constexpr int BM = 256, BK = 64, HALF = 128, HTB = HALF * BK * 2, STAGE_BYTES = 8 * HTB, NXCD = 8, WGM = 8;

__host__ __device__ __forceinline__ int lds_byte(int r, int c) { const int st = (r >> 4) * 2 + (c >> 5), rr = r & 15, cc = c & 31, ob = rr * 64 + cc * 2; return st * 1024 + (ob ^ (((ob >> 9) & 1) << 5)); }
__host__ __device__ __forceinline__ void stage_rc(int b, int& R, int& C) { const int st = b / 1024, sb = b % 1024, swz = sb ^ (((sb >> 9) & 1) << 5); R = (st >> 1) * 16 + swz / 64; C = (st & 1) * 32 + (swz % 64) / 2; }
__host__ __device__ __forceinline__ int perm32(int rho) { const int n = rho >> 4, i = rho & 15; return 8 * (i >> 2) + 4 * n + (i & 3); }

struct Unit { int pm, pn; };
struct Gemm { const bf16_t* A; const bf16_t* Bt; int M, N, K; size_t a_pn_step, b_pn_step; int nt; };
__host__ __device__ __forceinline__ Gemm mk_gemm(const bf16_t* A, const bf16_t* Bt, int M, int N, int K) { return Gemm{A, Bt, M, N, K, 0, (size_t)256 * K * 2, K / 64}; }

struct StaticOrder {
    int nM, nN, nwg, G, c, pm0;
    __host__ __device__ void init(int M, int N, int G_, int c_, int pm0_ = 0) { nM = M / BM; nN = N / BM; nwg = nM * nN; G = G_; c = c_; pm0 = pm0_; }
    __host__ __device__ bool next(int i, Unit& u) const {
        const long L = (long)i * G + c; if (L >= nwg) return false;
        int wgid = (int)L; { const int q = nwg / NXCD, r = nwg % NXCD, xcd = wgid % NXCD, off = wgid / NXCD; wgid = (xcd < r ? xcd * (q + 1) : r * (q + 1) + (xcd - r) * q) + off; }
        const int nig = WGM * nN, gid = wgid / nig, fm = gid * WGM, gsz = (nM - fm) < WGM ? (nM - fm) : WGM;
        u.pm = pm0 + fm + ((wgid % nig) % gsz); u.pn = (wgid % nig) / gsz; return true;
    }
    __device__ __forceinline__ void a_ready(const Unit&) const {}
    __device__ __forceinline__ void done(const Unit&) const {}
};

__device__ __forceinline__ unsigned cvt_pk_bf16(float lo, float hi) { unsigned r; asm volatile("v_cvt_pk_bf16_f32 %0, %1, %2" : "=v"(r) : "v"(lo), "v"(hi)); return r; }

template <int ACT> struct EpiBf16 {
    static constexpr bool PERM = true, AFTER_DRAIN = false;
    bf16_t* O; int ldc; int n_main; float* G;
    __device__ __forceinline__ void operator()(const f32x4 (&acc)[2][2][4][2], const Unit& u, int wr, int wc, int fr, int fq) const {
        const int row0 = u.pm * BM + wr * 64 + fr; const int colt = u.pn * BM;
        const int col0 = colt + wc * 32 + 8 * fq;
#pragma unroll
        for (int ai = 0; ai < 2; ++ai)
#pragma unroll
            for (int m = 0; m < 4; ++m) { bf16_t* rowp = O + (size_t)(row0 + ai * HALF + m * 16) * ldc + col0;
#pragma unroll
                for (int bj = 0; bj < 2; ++bj) { f32x4 v0 = acc[ai][bj][m][0], v1 = acc[ai][bj][m][1];
                    if (ACT == 1) {
#pragma unroll
                        for (int j = 0; j < 4; ++j) { const float a = fmaxf(v0[j], 0.f), b = fmaxf(v1[j], 0.f); v0[j] = a * a; v1[j] = b * b; } }
                    u32x4 w; w.x = cvt_pk_bf16(v0[0], v0[1]); w.y = cvt_pk_bf16(v0[2], v0[3]); w.z = cvt_pk_bf16(v1[0], v1[1]); w.w = cvt_pk_bf16(v1[2], v1[3]);
                    *(u32x4*)(rowp + bj * HALF) = w;
#ifdef PROBE_DOUBLE_STORE
                    asm volatile("" ::: "memory"); *(u32x4*)(rowp + bj * HALF) = w; asm volatile("" ::: "memory");
#endif
                    } }
    }
};
struct EpiGateP {
    static constexpr bool PERM = true, AFTER_DRAIN = false;
    float* GP;
    __device__ __forceinline__ void operator()(const f32x4 (&acc)[2][2][4][2], const Unit& u, int wr, int wc, int fr, int fq) const {
        const int row0 = u.pm * BM + wr * 64 + fr; const int col0 = wc * 32 + 8 * fq; float* base = GP + (size_t)u.pn * 16384 * 128;
#pragma unroll
        for (int ai = 0; ai < 2; ++ai)
#pragma unroll
            for (int m = 0; m < 4; ++m) { float* rowp = base + (size_t)(row0 + ai * HALF + m * 16) * 128 + col0;
                *(f32x4*)(rowp) = acc[ai][0][m][0]; *(f32x4*)(rowp + 4) = acc[ai][0][m][1]; }
    }
};
template <bool BASE_F32> struct EpiRes {
    static constexpr bool PERM = true, AFTER_DRAIN = false;
    const void* base_ctx; const void* base_lat; bf16_t* out; const float* gate;
    __device__ __forceinline__ void operator()(const f32x4 (&acc)[2][2][4][2], const Unit& u, int wr, int wc, int fr, int fq) const {
        const int row0 = u.pm * BM + wr * 64 + fr, col0 = u.pn * BM + wc * 32 + 8 * fq;
        const bool ctx = u.pm < 32; const int grp = ctx ? 0 : 1 + ((u.pm - 32) >> 3);
        const float* gp = gate + (size_t)grp * 12288 + col0;
        const void* base = ctx ? base_ctx : base_lat; const int rsub = (BASE_F32 && !ctx) ? 8192 : 0;
        f32x4 gv[2][2];
#pragma unroll
        for (int bj = 0; bj < 2; ++bj)
#pragma unroll
            for (int n = 0; n < 2; ++n) gv[bj][n] = *(const f32x4*)(gp + bj * HALF + 4 * n);
#pragma unroll
        for (int ai = 0; ai < 2; ++ai) {
            f32x4 bs[4][2][2];
#pragma unroll
            for (int m = 0; m < 4; ++m) { const size_t offb = (size_t)(row0 + ai * HALF + m * 16 - rsub) * 2048 + col0;
#pragma unroll
                for (int bj = 0; bj < 2; ++bj) {
                    if (BASE_F32) { bs[m][bj][0] = *(const f32x4*)((const float*)base + offb + bj * HALF); bs[m][bj][1] = *(const f32x4*)((const float*)base + offb + bj * HALF + 4); }
                    else { const u32x4 w = *(const u32x4*)((const bf16_t*)base + offb + bj * HALF);
                        bs[m][bj][0] = (f32x4){__uint_as_float(w.x << 16), __uint_as_float(w.x & 0xffff0000u), __uint_as_float(w.y << 16), __uint_as_float(w.y & 0xffff0000u)};
                        bs[m][bj][1] = (f32x4){__uint_as_float(w.z << 16), __uint_as_float(w.z & 0xffff0000u), __uint_as_float(w.w << 16), __uint_as_float(w.w & 0xffff0000u)}; } } }
#pragma unroll
            for (int m = 0; m < 4; ++m) { const size_t offo = (size_t)(row0 + ai * HALF + m * 16) * 2048 + col0;
#pragma unroll
                for (int bj = 0; bj < 2; ++bj) { const f32x4 v0 = bs[m][bj][0] + gv[bj][0] * acc[ai][bj][m][0], v1 = bs[m][bj][1] + gv[bj][1] * acc[ai][bj][m][1];
                    u32x4 w; w.x = cvt_pk_bf16(v0[0], v0[1]); w.y = cvt_pk_bf16(v0[2], v0[3]); w.z = cvt_pk_bf16(v1[0], v1[1]); w.w = cvt_pk_bf16(v1[2], v1[3]);
                    *(u32x4*)(out + offo + bj * HALF) = w; } }
            asm volatile("" ::: "memory");
        }
    }
};

template <class Epi, class Sched, bool ALIGN_EPI = false, bool SP2 = false>
__device__ __forceinline__ void gemm_phase(PG8_LAS unsigned char* lds, const Gemm g, const Sched& S, const Epi& E) {
    const int tid = opaque_v((int)threadIdx.x), wid = __builtin_amdgcn_readfirstlane(tid >> 6), lane = tid & 63, wr = wid >> 2, wc = wid & 3, fr = lane & 15, fq = lane >> 4;
    const int K = g.K, nt = g.nt;
    unsigned voffA[2], voffB[2];
#pragma unroll
    for (int i = 0; i < 2; ++i) { int R, C; stage_rc(tid * 16 + i * 8192, R, C); const int Rb = Epi::PERM ? ((R & ~31) + perm32(R & 31)) : R;
        voffA[i] = (unsigned)(R * K + C) * 2u; voffB[i] = (unsigned)(Rb * K + C) * 2u; }
    const size_t kstep = (size_t)(BK * 2);
    const size_t hstep = (size_t)HALF * K * 2;
    const size_t tstep = 2 * hstep;
    const unsigned ldsw = (unsigned)wid * 1024u;
    const int aoff = lds_byte(wr * 64 + fr, fq * 8), boff = lds_byte(wc * 32 + fr, fq * 8);
#define PG8_SA(b, h) (((b) * 2 + (h)) * HTB)
#define PG8_SB(b, h) ((4 + (b) * 2 + (h)) * HTB)
#define PG8_STAGE(bufoff, gbase, voff) do { _Pragma("unroll") for (int _i = 0; _i < 2; ++_i) \
        __builtin_amdgcn_global_load_lds((const unsigned*)((const char*)(gbase) + (voff)[_i]), (PG8_LAS unsigned*)(lds + (bufoff) + ldsw + _i * 8192), 16, 0, 0); } while (0)
#define PG8_LDA(dst, b, h) do { _Pragma("unroll") for (int m = 0; m < 4; ++m) _Pragma("unroll") for (int k = 0; k < 2; ++k) dst[m][k] = *(const PG8_LAS bf16x8*)(lds + PG8_SA(b, h) + aoff + m * 2048 + k * 1024); } while (0)
#define PG8_LDB(dst, b, h) do { _Pragma("unroll") for (int n = 0; n < 2; ++n) _Pragma("unroll") for (int k = 0; k < 2; ++k) dst[n][k] = *(const PG8_LAS bf16x8*)(lds + PG8_SB(b, h) + boff + n * 2048 + k * 1024); } while (0)
#define PG8_MMA(ai, bj, At, Bt) do { __builtin_amdgcn_s_setprio(1); _Pragma("unroll") for (int m = 0; m < 4; ++m) _Pragma("unroll") for (int n = 0; n < 2; ++n) _Pragma("unroll") for (int k = 0; k < 2; ++k) \
        acc[ai][bj][m][n] = __builtin_amdgcn_mfma_f32_16x16x32_bf16(Bt[n][k], At[m][k], acc[ai][bj][m][n], 0, 0, 0); __builtin_amdgcn_s_setprio(0); } while (0)
#define PG8_WAIT_V(n) asm volatile("s_waitcnt vmcnt(" #n ")" ::: "memory")
#define PG8_WAIT_L(n) asm volatile("s_waitcnt lgkmcnt(" #n ")" ::: "memory")
#define PG8_BAR __builtin_amdgcn_s_barrier()
#define PG8_SCHED __builtin_amdgcn_sched_barrier(0)
    Unit cur, nxt; int ui = 0;
    if (!S.next(0, cur)) return;
    f32x4 acc[2][2][4][2];
#pragma unroll
    for (int a = 0; a < 2; ++a)
#pragma unroll
        for (int b = 0; b < 2; ++b)
#pragma unroll
            for (int m = 0; m < 4; ++m)
#pragma unroll
                for (int n = 0; n < 2; ++n) acc[a][b][m][n] = (f32x4){0.f, 0.f, 0.f, 0.f};
    bf16x8 At[4][2], B0[2][2], B1[2][2];
    const char* cA = (const char*)g.A + (size_t)cur.pm * tstep + (size_t)cur.pn * g.a_pn_step; const char* cB = (const char*)g.Bt + (size_t)cur.pn * g.b_pn_step;
    S.a_ready(cur);
    if constexpr (SP2) {
        PG8_STAGE(PG8_SB(0, 0), cB, voffB); PG8_STAGE(PG8_SB(0, 1), cB + hstep, voffB); PG8_STAGE(PG8_SA(0, 0), cA, voffA); PG8_STAGE(PG8_SA(0, 1), cA + hstep, voffA);
        if (wr == 1) PG8_BAR;
        PG8_WAIT_V(2); PG8_BAR;
        PG8_STAGE(PG8_SB(1, 0), cB + kstep, voffB); PG8_STAGE(PG8_SA(1, 0), cA + kstep, voffA); PG8_STAGE(PG8_SB(1, 1), cB + hstep + kstep, voffB);
        PG8_WAIT_V(6); PG8_BAR;
    } else {
        PG8_STAGE(PG8_SB(0, 0), cB, voffB); PG8_STAGE(PG8_SA(0, 0), cA, voffA); PG8_STAGE(PG8_SB(0, 1), cB + hstep, voffB); PG8_STAGE(PG8_SA(0, 1), cA + hstep, voffA);
        if (wr == 1) PG8_BAR;
        PG8_WAIT_V(4); PG8_BAR;
        PG8_STAGE(PG8_SB(1, 0), cB + kstep, voffB); PG8_STAGE(PG8_SA(1, 0), cA + kstep, voffA); PG8_STAGE(PG8_SB(1, 1), cB + hstep + kstep, voffB);
        PG8_WAIT_V(6); PG8_BAR;
    }
    for (;;) {
        const bool has_next = S.next(ui + 1, nxt);
        const char* nA = has_next ? (const char*)g.A + (size_t)nxt.pm * tstep + (size_t)nxt.pn * g.a_pn_step : cA; const char* nB = has_next ? (const char*)g.Bt + (size_t)nxt.pn * g.b_pn_step : cB;
        for (int t = 0; t < nt; t += 2) {
            const bool last = (t == nt - 2);
            const char* a1 = cA + (size_t)(t + 1) * kstep;
            const char* a2 = last ? nA : cA + (size_t)(t + 2) * kstep; const char* b2 = last ? nB : cB + (size_t)(t + 2) * kstep;
            const char* a3 = a2 + kstep; const char* b3 = b2 + kstep;
            if (last && has_next) S.a_ready(nxt);
            if constexpr (SP2) {
            PG8_LDB(B0, 0, 0); PG8_LDB(B1, 0, 1); PG8_SCHED; PG8_LDA(At, 0, 0); PG8_STAGE(PG8_SA(1, 1), a1 + hstep, voffA);
            PG8_WAIT_V(8); PG8_WAIT_L(0); PG8_BAR; PG8_MMA(0, 0, At, B0); PG8_MMA(0, 1, At, B1); PG8_BAR; PG8_SCHED;
            PG8_LDA(At, 0, 1); PG8_STAGE(PG8_SB(0, 0), b2, voffB); PG8_STAGE(PG8_SB(0, 1), b2 + hstep, voffB); PG8_STAGE(PG8_SA(0, 0), a2, voffA);
            PG8_WAIT_V(8); PG8_WAIT_L(0); PG8_BAR; PG8_MMA(1, 0, At, B0); PG8_MMA(1, 1, At, B1); PG8_BAR; PG8_SCHED;
            PG8_LDB(B0, 1, 0); PG8_LDB(B1, 1, 1); PG8_SCHED; PG8_LDA(At, 1, 0); PG8_STAGE(PG8_SA(0, 1), a2 + hstep, voffA);
            PG8_WAIT_V(8); PG8_WAIT_L(0); PG8_BAR; PG8_MMA(0, 0, At, B0); PG8_MMA(0, 1, At, B1); PG8_BAR; PG8_SCHED;
            PG8_LDA(At, 1, 1); PG8_STAGE(PG8_SB(1, 0), b3, voffB); PG8_STAGE(PG8_SB(1, 1), b3 + hstep, voffB); PG8_STAGE(PG8_SA(1, 0), a3, voffA);
            PG8_WAIT_V(8); PG8_WAIT_L(0); PG8_BAR; PG8_MMA(1, 0, At, B0); PG8_MMA(1, 1, At, B1); PG8_BAR; PG8_SCHED;
            } else {
            PG8_LDB(B0, 0, 0); PG8_SCHED; PG8_LDA(At, 0, 0); PG8_STAGE(PG8_SA(1, 1), a1 + hstep, voffA);
            PG8_WAIT_L(8); PG8_BAR; PG8_WAIT_L(0); PG8_MMA(0, 0, At, B0); PG8_BAR; PG8_SCHED;
            PG8_LDB(B1, 0, 1); PG8_STAGE(PG8_SB(0, 0), b2, voffB);
            PG8_BAR; PG8_WAIT_L(0); PG8_MMA(0, 1, At, B1); PG8_BAR;
            PG8_LDA(At, 0, 1); PG8_STAGE(PG8_SA(0, 0), a2, voffA);
            PG8_BAR; PG8_WAIT_L(0); PG8_MMA(1, 0, At, B0); PG8_BAR; PG8_SCHED;
            PG8_STAGE(PG8_SB(0, 1), b2 + hstep, voffB);
            PG8_WAIT_V(6); PG8_BAR; PG8_MMA(1, 1, At, B1); PG8_BAR;
            PG8_LDB(B0, 1, 0); PG8_SCHED; PG8_LDA(At, 1, 0); PG8_STAGE(PG8_SA(0, 1), a2 + hstep, voffA);
            PG8_WAIT_L(8); PG8_BAR; PG8_WAIT_L(0); PG8_MMA(0, 0, At, B0); PG8_BAR; PG8_SCHED;
            PG8_LDB(B1, 1, 1); PG8_STAGE(PG8_SB(1, 0), b3, voffB);
            PG8_BAR; PG8_WAIT_L(0); PG8_MMA(0, 1, At, B1); PG8_BAR;
            PG8_LDA(At, 1, 1); PG8_STAGE(PG8_SA(1, 0), a3, voffA);
            PG8_BAR; PG8_WAIT_L(0); PG8_MMA(1, 0, At, B0); PG8_BAR; PG8_SCHED;
            PG8_STAGE(PG8_SB(1, 1), b3 + hstep, voffB);
            PG8_WAIT_V(6); PG8_BAR; PG8_MMA(1, 1, At, B1); PG8_BAR;
            }
        }
        if constexpr (ALIGN_EPI) { if (wr == 0) PG8_BAR; }
        if constexpr (!Epi::AFTER_DRAIN) { E(acc, cur, wr, wc, fr, fq); S.done(cur); }
        if (!has_next) break;
#pragma unroll
        for (int a = 0; a < 2; ++a)
#pragma unroll
            for (int b = 0; b < 2; ++b)
#pragma unroll
                for (int m = 0; m < 4; ++m)
#pragma unroll
                    for (int n = 0; n < 2; ++n) acc[a][b][m][n] = (f32x4){0.f, 0.f, 0.f, 0.f};
        cur = nxt; cA = nA; cB = nB; ++ui;
        if constexpr (ALIGN_EPI) { if (wr == 1) PG8_BAR; }
    }
    PG8_WAIT_V(0);
    if constexpr (!ALIGN_EPI) { if (wr == 0) PG8_BAR; }
    PG8_BAR;
#undef PG8_SA
#undef PG8_SB
#undef PG8_STAGE
#undef PG8_LDA
#undef PG8_LDB
#undef PG8_MMA
#undef PG8_WAIT_V
#undef PG8_WAIT_L
#undef PG8_BAR
#undef PG8_SCHED
}
}

#define XB_TMO      128
#define XB_XCNT(j)  (256  + 64 * (j))
#define XB_XSUB(j)  (1280 + 64 * (j))
#define XB_XGEN(j)  (2304 + 64 * (j))
#define XB_TOP      3328
#define XB_TOPGEN   3392
#define XCD_BAR_WORDS 3456
#define XB_SPIN_CAP (1u << 21)
#define LAS __attribute__((address_space(3)))

__device__ __forceinline__ unsigned xb_ld(unsigned* p)              { return __hip_atomic_load(p, __ATOMIC_RELAXED, __HIP_MEMORY_SCOPE_AGENT); }
__device__ __forceinline__ unsigned xb_add(unsigned* p, unsigned v) { return __hip_atomic_fetch_add(p, v, __ATOMIC_RELAXED, __HIP_MEMORY_SCOPE_AGENT); }
__device__ __forceinline__ unsigned xb_xcc_id() { return (unsigned)__builtin_amdgcn_s_getreg((3 << 11) | 20) & 0xFu; }
#define XB_SPIN(cond, bar) do { unsigned _sp = 0; while (cond) { __builtin_amdgcn_s_sleep(1); \
    if ((++_sp & 255u) == 0u) { if (xb_ld(&(bar)[XB_TMO])) break; if (_sp > XB_SPIN_CAP) { atomicAdd(&(bar)[XB_TMO], 1u); break; } } } } while (0)

struct XcdBarrier { unsigned* bar; unsigned x; volatile LAS unsigned* st; };

__device__ __forceinline__ XcdBarrier xcd_barrier_post(unsigned* bar, volatile LAS unsigned* st) {
    XcdBarrier b; b.bar = bar; b.x = xb_xcc_id(); b.st = st;
    if (threadIdx.x == 0) (void)xb_add(&bar[XB_XCNT(b.x)], 1u);
    return b;
}
__device__ __forceinline__ void xcd_barrier_complete(unsigned* bar, unsigned x, unsigned& nloc, unsigned& nx) {
    const unsigned G = gridDim.x * gridDim.y * gridDim.z;
    unsigned sum, cnt, mine, sp = 0u;
    for (;;) {
        sum = 0u; cnt = 0u; mine = 0u;
#pragma unroll
        for (unsigned j = 0; j < 16; ++j) { const unsigned c = xb_ld(&bar[XB_XCNT(j)]); sum += c; cnt += (c > 0u) ? 1u : 0u; mine = (j == x) ? c : mine; }
        if (sum == G) break;
        __builtin_amdgcn_s_sleep(1);
        if ((++sp & 255u) == 0u) { if (xb_ld(&bar[XB_TMO])) break; if (sp > XB_SPIN_CAP) { atomicAdd(&bar[XB_TMO], 1u); break; } }
    }
    nloc = mine > 0u ? mine : 1u; nx = cnt > 0u ? cnt : 1u;
}
__device__ __forceinline__ void xcd_barrier(const XcdBarrier& b) {
    asm volatile("s_waitcnt vmcnt(0)" ::: "memory");
    __syncthreads();
    if (threadIdx.x == 0) {
        unsigned* bar = b.bar;
        __builtin_amdgcn_s_waitcnt(0);
        unsigned nloc = b.st[0], nx = b.st[1];
        if (nloc == 0u) { xcd_barrier_complete(bar, b.x, nloc, nx); b.st[0] = nloc; b.st[1] = nx; }
        const unsigned old = xb_add(&bar[XB_XSUB(b.x)], 1u);
        const unsigned gen = old / nloc;
        if (old + 1u == (gen + 1u) * nloc) {
            __builtin_amdgcn_fence(__ATOMIC_RELEASE, "agent");
            asm volatile("s_waitcnt vmcnt(0)" ::: "memory");
            const unsigned og = xb_add(&bar[XB_TOP], 1u);
            const unsigned tg = og / nx;
            if (og + 1u == (tg + 1u) * nx) xb_add(&bar[XB_TOPGEN], 1u);
            else XB_SPIN(xb_ld(&bar[XB_TOPGEN]) == tg, bar);
            __builtin_amdgcn_fence(__ATOMIC_ACQUIRE, "agent");
            xb_add(&bar[XB_XGEN(b.x)], 1u);
            asm volatile("s_waitcnt vmcnt(0)" ::: "memory");
        } else {
            XB_SPIN(xb_ld(&bar[XB_XGEN(b.x)]) == gen, bar);
            __builtin_amdgcn_fence(__ATOMIC_ACQUIRE, "agent");
            asm volatile("s_waitcnt vmcnt(0)" ::: "memory");
        }
    }
    __syncthreads();
}

typedef unsigned short bf16;
typedef float f32x4 __attribute__((ext_vector_type(4)));
typedef unsigned u32x4 __attribute__((ext_vector_type(4)));
typedef unsigned u32x2 __attribute__((ext_vector_type(2)));

constexpr int D = 2048, DFF = 8192, MROWS = 16384, MCTX = 8192;
constexpr int NT = 512;
constexpr float EPS = 1e-6f;
constexpr int DN_NIN = 12416, DN_NMAIN = 12288, DN_NPAD = 12544;
constexpr int GLA_NIN = 6176, GLA_NMAIN = 6144, GLA_NPAD = 6400;
constexpr int HG_NIN = 10240;
constexpr int MODW = 12288;

constexpr size_t MiB = 1u << 20;
constexpr size_t WS_CTL = 0, CTL_BYTES = 1 * MiB;
constexpr size_t WS_MOD = 1 * MiB;
constexpr size_t WS_X = 2 * MiB;
constexpr size_t WS_H = WS_X + 128 * MiB;
constexpr size_t WS_BIG = WS_H + 64 * MiB;
constexpr size_t WS_GATE = WS_BIG + 384 * MiB;
constexpr size_t WS_QKV = WS_GATE + 8 * MiB;
constexpr size_t WS_OF = WS_QKV + 256 * MiB;
constexpr size_t WS_OB = WS_OF + 128 * MiB;
constexpr size_t WS_W = WS_OB + 128 * MiB;
constexpr size_t WOFF_IN = 0, WOFF_OUT = (size_t)DN_NPAD * D * 2, WOFF_UP = WOFF_OUT + (size_t)D * 4096 * 2, WOFF_DOWN = WOFF_UP + (size_t)DFF * D * 2;
constexpr size_t WS_TA = ((WS_W + WOFF_DOWN + (size_t)D * DFF * 2 + MiB - 1) / MiB) * MiB;
constexpr size_t WS_GS = WS_TA + 256 * MiB;
constexpr size_t WS_GP = WS_GS + 12 * MiB;
constexpr size_t WS_END = WS_GP + 32 * MiB;

constexpr size_t OUT_Y = 0;
constexpr size_t OUT_SDN = (size_t)MROWS * D;
constexpr size_t OUT_SGLA = OUT_SDN + (size_t)32 * 2 * 2 * 32 * 128 * 128;
constexpr size_t OUT_SHG = OUT_SGLA + (size_t)32 * 2 * 4 * 256 * 512;
constexpr size_t OUT_END = OUT_SHG + (size_t)32 * 2 * 16 * 128 * 128;

constexpr int LDS_BYTES = 151552;
constexpr int LDS_MISC = 150528;

struct Params {
    const float* in[29];
    float* out;
    unsigned char* ws;
};

__device__ __forceinline__ float bf2f(unsigned short b) { return __uint_as_float(((unsigned)b) << 16); }
typedef __bf16 bfv2_ __attribute__((ext_vector_type(2)));
typedef float f32x2_ __attribute__((ext_vector_type(2)));
__device__ __forceinline__ unsigned f2bf(float f) { return (unsigned)__builtin_bit_cast(unsigned short, (__bf16)f); }
__device__ __forceinline__ unsigned pk2(float lo, float hi) { const f32x2_ v = {lo, hi}; return __builtin_bit_cast(unsigned, __builtin_convertvector(v, bfv2_)); }
__device__ __forceinline__ float bflo(unsigned w) { return __uint_as_float(w << 16); }
__device__ __forceinline__ float bfhi(unsigned w) { return __uint_as_float(w & 0xffff0000u); }
__device__ __forceinline__ float wave_sum(float v) {
#pragma unroll
    for (int o = 1; o < 64; o <<= 1) v += __shfl_xor(v, o);
    return v;
}
__device__ __forceinline__ float rdlane(float v, int l) { return __builtin_bit_cast(float, __builtin_amdgcn_readlane(__builtin_bit_cast(int, v), l)); }
__device__ __forceinline__ float sigmoidf_(float x) { return 1.f / (1.f + __expf(-x)); }
__device__ __forceinline__ float siluf_(float x) { return x / (1.f + __expf(-x)); }
__device__ __forceinline__ float softplusf_(float x) { return fmaxf(x, 0.f) + log1pf(__expf(-fabsf(x))); }

__device__ __forceinline__ void transpose_item(const float* W, int K, int N, bf16* WT, LAS float* scr, int item, int lane) {
    const int nblk = N / 32, kb = item / nblk, nb = item % nblk, k0 = 64 * kb, n0 = 32 * nb;
    { f32x4 v[8]; const int kr = lane >> 3, c4 = (lane & 7) * 4;
#pragma unroll
      for (int i = 0; i < 8; ++i) v[i] = *(const f32x4*)(W + (size_t)(k0 + kr + 8 * i) * N + n0 + c4);
#pragma unroll
      for (int i = 0; i < 8; ++i) { LAS float* d = scr + (kr + 8 * i) * 33 + c4; d[0] = v[i].x; d[1] = v[i].y; d[2] = v[i].z; d[3] = v[i].w; } }
    asm volatile("s_waitcnt lgkmcnt(0)" ::: "memory");
    const int c = lane & 7;
#pragma unroll
    for (int j = 0; j < 4; ++j) { const int n = (lane >> 3) + 8 * j; const LAS float* s = scr + (8 * c) * 33 + n;
        u32x4 o; o.x = pk2(s[0 * 33], s[1 * 33]); o.y = pk2(s[2 * 33], s[3 * 33]); o.z = pk2(s[4 * 33], s[5 * 33]); o.w = pk2(s[6 * 33], s[7 * 33]);
        *(u32x4*)(WT + (size_t)(n0 + n) * K + k0 + 8 * c) = o; }
    asm volatile("s_waitcnt lgkmcnt(0)" ::: "memory");
}

__device__ __forceinline__ void convert_layer_weights(const Params& P, int layer, LAS unsigned char* lds) {
    PHASE_IDS();
    LAS float* scr = (LAS float*)(lds + wave * 16384);
    const int kind = layer % 3, j = layer / 3;
    const float* Win; int Nin, Npad; const float* Wout; int Kout;
    if (kind == 0) { Win = P.in[14] + (size_t)j * D * DN_NIN; Nin = DN_NIN; Npad = DN_NPAD; Wout = P.in[19] + (size_t)j * 4096 * D; Kout = 4096; }
    else if (kind == 1) { Win = P.in[20] + (size_t)j * D * GLA_NIN; Nin = GLA_NIN; Npad = GLA_NPAD; Wout = P.in[24] + (size_t)j * D * D; Kout = 2048; }
    else { Win = P.in[25] + (size_t)j * D * HG_NIN; Nin = HG_NIN; Npad = HG_NIN; Wout = P.in[28] + (size_t)j * D * D; Kout = 2048; }
    const float* Wup = P.in[12] + (size_t)layer * D * DFF; const float* Wdn = P.in[13] + (size_t)layer * DFF * D;
    bf16* Tin = (bf16*)(P.ws + WS_W + WOFF_IN); bf16* Tout = (bf16*)(P.ws + WS_W + WOFF_OUT); bf16* Tup = (bf16*)(P.ws + WS_W + WOFF_UP); bf16* Tdn = (bf16*)(P.ws + WS_W + WOFF_DOWN);
    const int I_in = (D / 64) * (Nin / 32), I_out = (Kout / 64) * (D / 32), I_up = (D / 64) * (DFF / 32), I_dn = (DFF / 64) * (D / 32);
    const int NI = I_in + I_out + I_up + I_dn;
    for (int it = gw; it < NI; it += NGW) {
        int r = it;
        if (r < I_in) { transpose_item(Win, D, Nin, Tin, scr, r, lane); continue; } r -= I_in;
        if (r < I_out) { transpose_item(Wout, Kout, D, Tout, scr, r, lane); continue; } r -= I_out;
        if (r < I_up) { transpose_item(Wup, D, DFF, Tup, scr, r, lane); continue; } r -= I_up;
        transpose_item(Wdn, DFF, D, Tdn, scr, r, lane);
    }
    const int npadrows = Npad - Nin;
    if (npadrows > 0) {
        u32x4* z = (u32x4*)(Tin + (size_t)Nin * D); const int n16 = npadrows * D / 8;
        for (int i = gw * 64 + lane; i < n16; i += NGW * 64) z[i] = (u32x4){0u, 0u, 0u, 0u};
    }
}

__device__ __forceinline__ void mod_phase(const Params& P, LAS unsigned char* lds) {
    PHASE_IDS();
    LAS float* scond = (LAS float*)lds;
    LAS float* red = (LAS float*)(lds + 40960 + 1024);
    for (int i = tid; i < 5 * 2048; i += NT) { const int g = i / 2048, k = i % 2048; const float v = g == 0 ? P.in[6][k] : P.in[2][(g - 1) * 2048 + k]; scond[k * 5 + g] = siluf_(v); }
    __syncthreads();
    float* mod = (float*)(P.ws + WS_MOD);
    const int c4 = tid & 15, kg = tid >> 4;
    for (int cg = blockIdx.x; cg < 4 * MODW / 64; cg += gridDim.x) {
        const int layer = cg / (MODW / 64), colbase = (cg % (MODW / 64)) * 64;
        const float* W = P.in[7] + (size_t)layer * D * MODW + colbase + c4 * 4;
        f32x4 acc[5];
#pragma unroll
        for (int g = 0; g < 5; ++g) acc[g] = (f32x4){0.f, 0.f, 0.f, 0.f};
#pragma unroll 8
        for (int kk = 0; kk < 64; ++kk) {
            const int k = kg * 64 + kk;
            const f32x4 w = *(const f32x4*)(W + (size_t)k * MODW);
#pragma unroll
            for (int g = 0; g < 5; ++g) acc[g] += w * scond[k * 5 + g];
        }
#pragma unroll
        for (int g = 0; g < 5; ++g)
#pragma unroll
            for (int e = 0; e < 4; ++e) red[(kg * 64 + c4 * 4 + e) * 5 + g] = acc[g][e];
        __syncthreads();
        if (tid < 64 * 5) { const int c = tid / 5, g = tid % 5; float sum = 0.f;
#pragma unroll 8
            for (int q = 0; q < 32; ++q) sum += red[(q * 64 + c) * 5 + g];
            mod[((size_t)layer * 5 + g) * MODW + colbase + c] = sum + P.in[8][(size_t)layer * MODW + colbase + c]; }
        __syncthreads();
    }
}

template <bool XF32> __device__ __forceinline__ void norm_mod_phase(const void* xc, const void* xl, const float* w, const float* mod, int sh_off, int sc_off, bf16* H) {
    PHASE_IDS();
    for (int m = gw; m < MROWS; m += NGW) {
        const bool ctx = m < MCTX; const int grp = ctx ? 0 : 1 + ((m - MCTX) >> 11);
        f32x4 v[8]; float ss = 0.f;
        if (XF32) { const float* xr = ctx ? (const float*)xc + (size_t)m * D : (const float*)xl + (size_t)(m - MCTX) * D;
#pragma unroll
            for (int jx = 0; jx < 4; ++jx) { v[2 * jx] = *(const f32x4*)(xr + 8 * (lane + 64 * jx)); v[2 * jx + 1] = *(const f32x4*)(xr + 8 * (lane + 64 * jx) + 4); } }
        else { const bf16* xr = (const bf16*)xc + (size_t)m * D;
#pragma unroll
            for (int jx = 0; jx < 4; ++jx) { const u32x4 q = *(const u32x4*)(xr + 8 * (lane + 64 * jx));
                v[2 * jx] = (f32x4){bflo(q.x), bfhi(q.x), bflo(q.y), bfhi(q.y)}; v[2 * jx + 1] = (f32x4){bflo(q.z), bfhi(q.z), bflo(q.w), bfhi(q.w)}; } }
#pragma unroll
        for (int i = 0; i < 8; ++i) ss += (v[i].x * v[i].x + v[i].y * v[i].y) + (v[i].z * v[i].z + v[i].w * v[i].w);
        const float rstd = rsqrtf(wave_sum(ss) * (1.f / D) + EPS);
        const float* mg = mod + (size_t)grp * MODW;
#pragma unroll
        for (int jx = 0; jx < 4; ++jx) { const int c = 8 * (lane + 64 * jx);
            const f32x4 y0 = v[2 * jx] * rstd * *(const f32x4*)(w + c) * (*(const f32x4*)(mg + sc_off + c) + 1.f) + *(const f32x4*)(mg + sh_off + c);
            const f32x4 y1 = v[2 * jx + 1] * rstd * *(const f32x4*)(w + c + 4) * (*(const f32x4*)(mg + sc_off + c + 4) + 1.f) + *(const f32x4*)(mg + sh_off + c + 4);
            u32x4 o; o.x = pk2(y0.x, y0.y); o.y = pk2(y0.z, y0.w); o.z = pk2(y1.x, y1.y); o.w = pk2(y1.z, y1.w);
            *(u32x4*)(H + (size_t)m * D + c) = o; }
    }
}
__device__ __forceinline__ void final_norm_phase(const bf16* X, const float* w, float* out) {
    PHASE_IDS();
    for (int m = gw; m < MROWS; m += NGW) {
        f32x4 v[8]; float ss = 0.f;
#pragma unroll
        for (int jx = 0; jx < 4; ++jx) { const u32x4 q = *(const u32x4*)(X + (size_t)m * D + 8 * (lane + 64 * jx));
            v[2 * jx] = (f32x4){bflo(q.x), bfhi(q.x), bflo(q.y), bfhi(q.y)}; v[2 * jx + 1] = (f32x4){bflo(q.z), bfhi(q.z), bflo(q.w), bfhi(q.w)}; }
#pragma unroll
        for (int i = 0; i < 8; ++i) ss += (v[i].x * v[i].x + v[i].y * v[i].y) + (v[i].z * v[i].z + v[i].w * v[i].w);
        const float rstd = rsqrtf(wave_sum(ss) * (1.f / D) + EPS);
#pragma unroll
        for (int jx = 0; jx < 4; ++jx) { const int c = 8 * (lane + 64 * jx);
            *(f32x4*)(out + (size_t)m * D + c) = v[2 * jx] * rstd * *(const f32x4*)(w + c); *(f32x4*)(out + (size_t)m * D + c + 4) = v[2 * jx + 1] * rstd * *(const f32x4*)(w + c + 4); }
    }
}

template <int DV> __device__ __forceinline__ void gate_phase(const bf16* OF, const bf16* OB, const bf16* proj, int ldp, int gcol0, const float* nw, bf16* Y, int W) {
    PHASE_IDS();
    const int ncg = W / 512;
    const int nitems = MROWS * ncg;
    for (int it0 = gw; it0 < nitems; it0 += 2 * NGW) {
        u32x4 a[2], b[2], gz[2]; int mm[2], cc[2]; bool ok[2];
#pragma unroll
        for (int u = 0; u < 2; ++u) { const int it = it0 + u * NGW; ok[u] = it < nitems; const int itc = ok[u] ? it : it0; mm[u] = itc / ncg; cc[u] = (itc % ncg) * 512 + lane * 8;
            a[u] = *(const u32x4*)(OF + (size_t)mm[u] * W + cc[u]); b[u] = *(const u32x4*)(OB + (size_t)mm[u] * W + cc[u]); gz[u] = *(const u32x4*)(proj + (size_t)mm[u] * ldp + gcol0 + cc[u]); }
#pragma unroll
        for (int u = 0; u < 2; ++u) {
            float o[8], z[8];
            o[0] = bflo(a[u].x) + bflo(b[u].x); o[1] = bfhi(a[u].x) + bfhi(b[u].x); o[2] = bflo(a[u].y) + bflo(b[u].y); o[3] = bfhi(a[u].y) + bfhi(b[u].y);
            o[4] = bflo(a[u].z) + bflo(b[u].z); o[5] = bfhi(a[u].z) + bfhi(b[u].z); o[6] = bflo(a[u].w) + bflo(b[u].w); o[7] = bfhi(a[u].w) + bfhi(b[u].w);
            z[0] = bflo(gz[u].x); z[1] = bfhi(gz[u].x); z[2] = bflo(gz[u].y); z[3] = bfhi(gz[u].y); z[4] = bflo(gz[u].z); z[5] = bfhi(gz[u].z); z[6] = bflo(gz[u].w); z[7] = bfhi(gz[u].w);
            float ss = 0.f;
#pragma unroll
            for (int i = 0; i < 8; ++i) ss += o[i] * o[i];
#pragma unroll
            for (int sft = 1; sft < DV / 8; sft <<= 1) ss += __shfl_xor(ss, sft);
            const float rstd = rsqrtf(ss * (1.f / DV) + EPS);
            const int cw = cc[u] % DV;
            const f32x4 w0 = *(const f32x4*)(nw + cw), w1 = *(const f32x4*)(nw + cw + 4);
            const float wv[8] = {w0.x, w0.y, w0.z, w0.w, w1.x, w1.y, w1.z, w1.w};
            float y[8];
#pragma unroll
            for (int i = 0; i < 8; ++i) y[i] = o[i] * rstd * wv[i] * siluf_(z[i]);
            u32x4 rr; rr.x = pk2(y[0], y[1]); rr.y = pk2(y[2], y[3]); rr.z = pk2(y[4], y[5]); rr.w = pk2(y[6], y[7]);
            if (ok[u]) *(u32x4*)(Y + (size_t)mm[u] * W + cc[u]) = rr;
        }
    }
}

__device__ __forceinline__ void dn_prep_phase(const Params& P, int j, bool do_gates = true) {
    PHASE_IDS();
    const bf16* proj = (const bf16*)(P.ws + WS_BIG); bf16* QKV = (bf16*)(P.ws + WS_QKV);
    const float* cw = P.in[15] + (size_t)j * 5 * 8192;
    for (int it = gw; it < 16 * 128; it += NGW) {
        const int cg = it & 15, chunk = it >> 4, c = cg * 512 + lane * 8;
        float w[5][8];
#pragma unroll
        for (int s = 0; s < 5; ++s) { const f32x4 a = *(const f32x4*)(cw + s * 8192 + c), b = *(const f32x4*)(cw + s * 8192 + c + 4);
            w[s][0] = a.x; w[s][1] = a.y; w[s][2] = a.z; w[s][3] = a.w; w[s][4] = b.x; w[s][5] = b.y; w[s][6] = b.z; w[s][7] = b.w; }
        const float qsc = cg < 4 ? 0.08838834764831845f : 1.f;
        for (int bt = 0; bt < 16; ++bt) {
            const int r0 = chunk * 128 + bt * 8;
            const int L = r0 < MCTX ? 256 : 64, pos0 = r0 < MCTX ? (r0 & 255) : ((r0 - MCTX) & 63);
            u32x4 xw[12];
#pragma unroll
            for (int i = 0; i < 12; ++i) { const int pp = pos0 + i - 2;
                xw[i] = (pp >= 0 && pp < L) ? *(const u32x4*)(proj + (size_t)(r0 + i - 2) * DN_NMAIN + c) : (u32x4){0u, 0u, 0u, 0u}; }
#pragma unroll
            for (int o = 0; o < 8; ++o) {
                float acc[8];
#pragma unroll
                for (int i = 0; i < 8; ++i) acc[i] = 0.f;
#pragma unroll
                for (int s = 0; s < 5; ++s) { const u32x4 x = xw[o + s];
                    acc[0] += bflo(x.x) * w[s][0]; acc[1] += bfhi(x.x) * w[s][1]; acc[2] += bflo(x.y) * w[s][2]; acc[3] += bfhi(x.y) * w[s][3];
                    acc[4] += bflo(x.z) * w[s][4]; acc[5] += bfhi(x.z) * w[s][5]; acc[6] += bflo(x.w) * w[s][6]; acc[7] += bfhi(x.w) * w[s][7]; }
                float ss = 0.f;
#pragma unroll
                for (int i = 0; i < 8; ++i) { acc[i] = siluf_(acc[i]); ss += acc[i] * acc[i]; }
                if (cg < 8) {
                    ss += __shfl_xor(ss, 1); ss += __shfl_xor(ss, 2); ss += __shfl_xor(ss, 4); ss += __shfl_xor(ss, 8);
                    const float sc = rsqrtf(ss + EPS) * qsc;
#pragma unroll
                    for (int i = 0; i < 8; ++i) acc[i] *= sc;
                }
                u32x4 ov; ov.x = pk2(acc[0], acc[1]); ov.y = pk2(acc[2], acc[3]); ov.z = pk2(acc[4], acc[5]); ov.w = pk2(acc[6], acc[7]);
                *(u32x4*)(QKV + (size_t)(r0 + o) * 8192 + c) = ov;
            }
        }
    }
    if (!do_gates) return;
    float* G = (float*)(P.ws + WS_GATE);
    const float* Alog = P.in[16] + j * 64; const float* dtb = P.in[17] + j * 64;
    const float* GPp = (const float*)(P.ws + WS_GP);
    for (int i = gw * 64 + lane; i < MROWS * 128; i += NGW * 64) {
        const int col = i & 127; const float x = (GPp[i] + GPp[i + (size_t)MROWS * 128]) + (GPp[i + (size_t)2 * MROWS * 128] + GPp[i + (size_t)3 * MROWS * 128]); float y;
        if (col < 64) y = sigmoidf_(x);
        else { const int dh = col - 64; y = -__expf(Alog[dh]) * softplusf_(x + dtb[dh]); }
        G[i] = y;
    }
}

typedef short bf16x8 __attribute__((ext_vector_type(8)));
typedef short s16x4 __attribute__((ext_vector_type(4)));
typedef __bf16 bfv8 __attribute__((ext_vector_type(8)));
typedef float f32x8 __attribute__((ext_vector_type(8)));
__device__ __forceinline__ bf16x8 pack8(f32x4 a, f32x4 b) { const f32x8 v = {a[0], a[1], a[2], a[3], b[0], b[1], b[2], b[3]}; return __builtin_bit_cast(bf16x8, __builtin_convertvector(v, bfv8)); }
__device__ __forceinline__ bf16x8 cat4(s16x4 a, s16x4 b) { return (bf16x8){a[0], a[1], a[2], a[3], b[0], b[1], b[2], b[3]}; }
__device__ __forceinline__ s16x4 ld_tr(const LAS unsigned char* p) { return __builtin_amdgcn_ds_read_tr16_b64_v4i16((LAS s16x4*)p); }
__device__ __forceinline__ s16x4 ld_b64(const LAS unsigned char* p) { return *(const volatile LAS s16x4*)p; }
__device__ __forceinline__ bf16x8 ld_b128(const LAS unsigned char* p) { return *(const LAS bf16x8*)p; }
#define MFMA16(a, b, c) __builtin_amdgcn_mfma_f32_16x16x32_bf16((a), (b), (c), 0, 0, 0)

template <int KIND> __device__ __forceinline__ void gla_prep_phase(const Params& P, LAS unsigned char* lds) {
    PHASE_IDS();
    constexpr int NCH = KIND == 1 ? 1024 : 2048, LDP = KIND == 1 ? GLA_NMAIN : HG_NIN, NCB = NCH / 1024;
    const bf16* proj = (const bf16*)(P.ws + WS_BIG); const float* G = (const float*)(P.ws + WS_GATE);
    bf16* QT = (bf16*)(P.ws + WS_QKV); bf16* KT = QT + (size_t)2 * MROWS * NCH; float* E = (float*)(P.ws + WS_OF + 64 * MiB);
    constexpr int DKH = KIND == 1 ? 256 : 128, NHB = 1024 / DKH  , NHT = NCH / DKH  , PL = 2064  ;
    LAS unsigned char* QL = lds; LAS unsigned char* KL = lds + 32 * PL;
    LAS float* sa1 = (LAS float*)(lds + 2 * 32 * PL);
    unsigned* PG = (unsigned*)(P.ws + WS_OF + 72 * MiB);
    for (int it = blockIdx.x; it < 2 * 512 * NCB; it += gridDim.x) {
        const int cb_ = it % NCB, cidx = (it / NCB) % 512, d = it / (NCB * 512);
        const int c0 = cb_ * 1024 + 2 * tid, rbase = cidx * 32;
        float w0[16], w1[16], b0 = 0.f, b1 = 0.f, lb0 = 0.f, lb1 = 0.f;
        if (KIND == 1) {
            __syncthreads();
            { const int p = tid >> 4, r = tid & 15; const int row = rbase + (d ? 31 - p : p); const size_t gi = (size_t)row * 128 + d * 16 + r; const float* GPp = (const float*)(P.ws + WS_GP); sa1[tid] = (GPp[gi] + GPp[gi + (size_t)MROWS * 128]) + (GPp[gi + (size_t)2 * MROWS * 128] + GPp[gi + (size_t)3 * MROWS * 128]); }
            __syncthreads();
            const float* w2 = P.in[21] + (size_t)d * 16 * 1024 + c0;
#pragma unroll
            for (int r = 0; r < 16; ++r) { w0[r] = w2[(size_t)r * 1024]; w1[r] = w2[(size_t)r * 1024 + 1]; }
            b0 = P.in[22][d * 1024 + c0]; b1 = P.in[22][d * 1024 + c0 + 1];
        } else {
            const float* lg = P.in[26];
            { const float l0 = lg[c0], l1 = lg[2048 + c0], l2 = lg[4096 + c0], l3 = lg[6144 + c0]; const float mx = fmaxf(fmaxf(l0, l1), fmaxf(l2, l3));
              const float e0 = __expf(l0 - mx), e1 = __expf(l1 - mx), e2 = __expf(l2 - mx), e3 = __expf(l3 - mx); lb0 = (e1 + e2) / ((e0 + e1) + (e2 + e3)); }
            { const float l0 = lg[c0 + 1], l1 = lg[2048 + c0 + 1], l2 = lg[4096 + c0 + 1], l3 = lg[6144 + c0 + 1]; const float mx = fmaxf(fmaxf(l0, l1), fmaxf(l2, l3));
              const float e0 = __expf(l0 - mx), e1 = __expf(l1 - mx), e2 = __expf(l2 - mx), e3 = __expf(l3 - mx); lb1 = (e1 + e2) / ((e0 + e1) + (e2 + e3)); }
        }
        float cs0 = KIND == 1 ? 0.f : 1.f, cs1 = cs0;
#pragma unroll 8
        for (int p = 0; p < 32; ++p) {
            const int row = rbase + (d ? 31 - p : p); const bf16* pr = proj + (size_t)row * LDP;
            float q0, q1, k0, k1, la0, la1;
            if (KIND == 1) {
                const unsigned qw = *(const unsigned*)(pr + c0), kw = *(const unsigned*)(pr + 1024 + c0);
                q0 = bflo(qw) * 0.0625f; q1 = bfhi(qw) * 0.0625f; k0 = bflo(kw); k1 = bfhi(kw);
                float x0 = b0, x1 = b1;
#pragma unroll
                for (int r = 0; r < 16; ++r) { const float a = sa1[p * 16 + r]; x0 += a * w0[r]; x1 += a * w1[r]; }
                la0 = (fminf(x0, 0.f) - __logf(1.f + __expf(-fabsf(x0)))) * 0.0625f; la1 = (fminf(x1, 0.f) - __logf(1.f + __expf(-fabsf(x1)))) * 0.0625f;
            } else {
                const unsigned qw = *(const unsigned*)(pr + c0), fw = *(const unsigned*)(pr + (d ? 8192 : 6144) + c0);
                q0 = siluf_(bflo(qw)) * 0.08838834764831845f; q1 = siluf_(bfhi(qw)) * 0.08838834764831845f;
                const float a0 = lb0 + (1.f - lb0) * sigmoidf_(bflo(fw)), a1 = lb1 + (1.f - lb1) * sigmoidf_(bfhi(fw));
                k0 = 1.f - a0; k1 = 1.f - a1; la0 = a0; la1 = a1;
            }
            float e0, e1, i0, i1;
            if (KIND == 1) { cs0 += la0; cs1 += la1; e0 = __expf(cs0); e1 = __expf(cs1); i0 = __expf(-cs0); i1 = __expf(-cs1); }
            else { cs0 *= la0; cs1 *= la1; e0 = cs0; e1 = cs1; i0 = __builtin_amdgcn_rcpf(cs0); i1 = __builtin_amdgcn_rcpf(cs1); }
            const size_t o = ((size_t)d * MROWS + row) * NCH + c0;
            const unsigned qb = pk2(q0 * e0, q1 * e1), kb = pk2(k0 * i0, k1 * i1);
            *(unsigned*)(QT + o) = qb; *(unsigned*)(KT + o) = kb;
            *(LAS unsigned*)(QL + p * PL + 4 * tid) = qb; *(LAS unsigned*)(KL + p * PL + 4 * tid) = kb;
        }
        { float* e = E + ((size_t)d * 512 + cidx) * NCH + c0; e[0] = KIND == 1 ? __expf(cs0) : cs0; e[1] = KIND == 1 ? __expf(cs1) : cs1; }
        __syncthreads();
        {
            const int r = lane & 15, g = lane >> 4;
            const int hl = KIND == 1 ? (wave >> 1) : wave; const int cbase = hl * DKH;
            f32x4 t0 = {0.f, 0.f, 0.f, 0.f}, t1 = t0, t2 = t0;
            const bool do02 = KIND == 1 ? ((wave & 1) == 0) : true, do1 = KIND == 1 ? ((wave & 1) == 1) : true;
#pragma unroll
            for (int sx = 0; sx < DKH / 32; ++sx) {
                const int cb2 = (cbase + 32 * sx + 8 * g) * 2;
                const bf16x8 k0 = ld_b128(KL + r * PL + cb2), q1 = ld_b128(QL + (16 + r) * PL + cb2);
                if (do02) { const bf16x8 q0 = ld_b128(QL + r * PL + cb2), k1 = ld_b128(KL + (16 + r) * PL + cb2); t0 = MFMA16(k0, q0, t0); t2 = MFMA16(k1, q1, t2); }
                if (do1) t1 = MFMA16(k0, q1, t1);
            }
#pragma unroll
            for (int e = 0; e < 4; ++e) { if (r < 4 * g + e) { t0[e] = 0.f; t2[e] = 0.f; } }
            unsigned* pg = PG + (((size_t)d * 512 + cidx) * NHT + cb_ * NHB + hl) * 384 + lane * 2;
            if (do02) { pg[0] = pk2(t0[0], t0[1]); pg[1] = pk2(t0[2], t0[3]); pg[256] = pk2(t2[0], t2[1]); pg[257] = pk2(t2[2], t2[3]); }
            if (do1) { pg[128] = pk2(t1[0], t1[1]); pg[129] = pk2(t1[2], t1[3]); }
        }
        __syncthreads();
    }
}

template <int KIND> __device__ __forceinline__ void gla_chunk_phase(const Params& P, LAS unsigned char* lds) {
    PHASE_IDS();
    constexpr int DK = KIND == 1 ? 256 : 128, DV = KIND == 1 ? 512 : 128, NH = KIND == 1 ? 4 : 16, NSL = DV / 128, NKT = DK / 16, NCH = NH * DK;
    constexpr int LDP = KIND == 1 ? GLA_NMAIN : HG_NIN, W = 2048;
    constexpr int PQ = DK * 2 + 16, PV = 256 + 16;
    constexpr int OFF_Q = 0, OFF_K = 32 * PQ, OFF_V = 2 * 32 * PQ, OFF_E = OFF_V + 32 * PV;
    constexpr int NPQ = 32 * DK / 8 / NT;
    const bf16* proj = (const bf16*)(P.ws + WS_BIG);
    const bf16* QT = (const bf16*)(P.ws + WS_QKV); const bf16* KT = QT + (size_t)2 * MROWS * NCH; const float* Eg = (const float*)(P.ws + WS_OF + 64 * MiB);
    bf16* OF = (bf16*)(P.ws + WS_OF); bf16* OB = (bf16*)(P.ws + WS_OB);
    const u32x2* PG = (const u32x2*)(P.ws + WS_OF + 72 * MiB);
    const int r = lane & 15, g = lane >> 4, q4 = (lane & 15) >> 2, p4 = lane & 3;
    constexpr int UL = 4 * NH * 2 * NSL  , UC = 32 * NH * 2 * NSL  ;
    const int G = gridDim.x, bx = blockIdx.x;
    const bool bal = (G == 2 * UL);
    const int nun = bal ? (bx < UL ? 1 : UC / UL) : (UL + UC - bx + G - 1) / G;
    for (int ui = 0; ui < nun; ++ui) {
        const int bxl = bx < UL ? bx : bx - UL;
        const int bxq = (bal && NSL == 4) ? (((bxl & 7) + 8 * (bxl >> 5)) * 4 + ((bxl >> 3) & 3)) : bxl;
        const int unit = bal ? (bx < UL ? bxq : UL + bxq + UL * ui) : bx + ui * G;
        const bool lat = unit < UL; int u2 = lat ? unit : unit - UL;
        const int sl = u2 % NSL; u2 /= NSL; const int d = u2 & 1; u2 >>= 1; const int h = u2 % NH; const int b = u2 / NH;
        const int T = lat ? 2048 : 256, row0 = lat ? MCTX + b * 2048 : b * 256, nchunk = T / 32;
        bf16* O = d ? OB : OF;
        f32x4 S[NKT];
        { const float* s0 = (KIND == 1 ? P.in[4] : P.in[5]) + ((((size_t)b * 2 + d) * NH + h) * DK) * DV + sl * 128 + 16 * wave + r;
#pragma unroll
          for (int kt = 0; kt < NKT; ++kt)
#pragma unroll
              for (int e = 0; e < 4; ++e) S[kt][e] = lat ? s0[(size_t)(16 * kt + 4 * g + e) * DV] : 0.f; }
        u32x4 rq[NPQ], rk[NPQ], rv; f32x4 re = {0.f, 0.f, 0.f, 0.f}; u32x2 rp0 = {0u, 0u}, rp1 = rp0, rp2 = rp0;
#define GLC_PREFETCH(c_) do { \
            _Pragma("unroll") for (int x = 0; x < NPQ; ++x) { const int pi = tid + x * NT, pr = pi / (DK / 8), pc = pi % (DK / 8); const int pp = (c_) * 32 + pr; const int t = d ? T - 1 - pp : pp; \
                const size_t o = ((size_t)d * MROWS + row0 + t) * NCH + h * DK + pc * 8; rq[x] = *(const u32x4*)(QT + o); rk[x] = *(const u32x4*)(KT + o); } \
            { const int pr = tid >> 4, pc = tid & 15; const int pp = (c_) * 32 + pr; const int t = d ? T - 1 - pp : pp; rv = *(const u32x4*)(proj + (size_t)(row0 + t) * LDP + 2048 + h * DV + sl * 128 + pc * 8); } \
            { const int cg = d ? (row0 + T) / 32 - 1 - (c_) : row0 / 32 + (c_); if (tid < DK / 4) re = *(const f32x4*)(Eg + ((size_t)d * 512 + cg) * NCH + h * DK + tid * 4); \
              const u32x2* pg = PG + (((size_t)d * 512 + cg) * NH + h) * 192 + lane; rp0 = pg[0]; rp1 = pg[64]; rp2 = pg[128]; } } while (0)
        GLC_PREFETCH(0);
        for (int c = 0; c < nchunk; ++c) {
            __syncthreads();
#pragma unroll
            for (int x = 0; x < NPQ; ++x) { const int pi = tid + x * NT, pr = pi / (DK / 8), pc = pi % (DK / 8);
                *(LAS u32x4*)(lds + OFF_Q + pr * PQ + pc * 16) = rq[x]; *(LAS u32x4*)(lds + OFF_K + pr * PQ + pc * 16) = rk[x]; }
            { const int pr = tid >> 4, pc = tid & 15; *(LAS u32x4*)(lds + OFF_V + pr * PV + pc * 16) = rv; }
            if (tid < DK / 4) *(LAS f32x4*)(lds + OFF_E + tid * 16) = re;
            __syncthreads();
            const u32x2 cp0 = rp0, cp1 = rp1, cp2 = rp2;
            if (c + 1 < nchunk) GLC_PREFETCH(c + 1);
            const f32x4 zero4 = {0.f, 0.f, 0.f, 0.f};
            const bf16x8 vpa = cat4(ld_tr(lds + OFF_V + (4 * g + q4) * PV + (16 * wave + 4 * p4) * 2), ld_tr(lds + OFF_V + (16 + 4 * g + q4) * PV + (16 * wave + 4 * p4) * 2));
            const bf16x8 pb0 = __builtin_bit_cast(bf16x8, (u32x4){cp0.x, cp0.y, 0u, 0u}), pb1 = __builtin_bit_cast(bf16x8, (u32x4){cp1.x, cp1.y, cp2.x, cp2.y});
            f32x4 o0 = MFMA16(vpa, pb0, zero4), o1 = MFMA16(vpa, pb1, zero4);
#pragma unroll
            for (int s = 0; s < DK / 32; ++s) {
                const bf16x8 sb = pack8(S[2 * s], S[2 * s + 1]);
                const bf16x8 a0 = cat4(ld_b64(lds + OFF_Q + r * PQ + (32 * s + 4 * g) * 2), ld_b64(lds + OFF_Q + r * PQ + (32 * s + 16 + 4 * g) * 2));
                const bf16x8 a1 = cat4(ld_b64(lds + OFF_Q + (16 + r) * PQ + (32 * s + 4 * g) * 2), ld_b64(lds + OFF_Q + (16 + r) * PQ + (32 * s + 16 + 4 * g) * 2));
                o0 = MFMA16(sb, a0, o0); o1 = MFMA16(sb, a1, o1);
                if (KIND == 1 && (s & 3) == 3) asm volatile("" ::: "memory");
            }
            { const int colo = h * DV + sl * 128 + 16 * wave + 4 * g; const int pp0 = c * 32 + r, pp1 = c * 32 + 16 + r; const int t0 = d ? T - 1 - pp0 : pp0, t1 = d ? T - 1 - pp1 : pp1;
              u32x2 w0, w1; w0.x = pk2(o0[0], o0[1]); w0.y = pk2(o0[2], o0[3]); w1.x = pk2(o1[0], o1[1]); w1.y = pk2(o1[2], o1[3]);
              *(u32x2*)(O + (size_t)(row0 + t0) * W + colo) = w0; *(u32x2*)(O + (size_t)(row0 + t1) * W + colo) = w1; }
            const bf16x8 vb = cat4(ld_tr(lds + OFF_V + (8 * g + q4) * PV + (16 * wave + 4 * p4) * 2), ld_tr(lds + OFF_V + (8 * g + 4 + q4) * PV + (16 * wave + 4 * p4) * 2));
#pragma unroll
            for (int kt = 0; kt < NKT; ++kt) {
                const bf16x8 ka = cat4(ld_tr(lds + OFF_K + (8 * g + q4) * PQ + (16 * kt + 4 * p4) * 2), ld_tr(lds + OFF_K + (8 * g + 4 + q4) * PQ + (16 * kt + 4 * p4) * 2));
                const f32x4 ev = *(const LAS f32x4*)(lds + OFF_E + (16 * kt + 4 * g) * 4);
                S[kt] = MFMA16(ka, vb, S[kt]) * ev;
                if (KIND == 1 && (kt & 7) == 7) asm volatile("" ::: "memory");
            }
        }
#undef GLC_PREFETCH
        if (!lat) { float* sd = P.out + (KIND == 1 ? OUT_SGLA : OUT_SHG) + ((((size_t)b * 2 + d) * NH + h) * DK) * DV + sl * 128 + 16 * wave + r;
#pragma unroll
            for (int kt = 0; kt < NKT; ++kt)
#pragma unroll
                for (int e = 0; e < 4; ++e) sd[(size_t)(16 * kt + 4 * g + e) * DV] = S[kt][e]; }
    }
}

#define MFMA4F(a, b, c) __builtin_amdgcn_mfma_f32_16x16x4f32((a), (b), (c), 0, 0, 0)
template <int I> __device__ __forceinline__ float row_share(float v) { return __builtin_bit_cast(float, __builtin_amdgcn_update_dpp(0, __builtin_bit_cast(int, v), 0x150 + I, 0xf, 0xf, false)); }
template <int I> struct DiagStep {
    static __device__ __forceinline__ void run(const float (&Ld)[16], float (&x)[16], int cc) {
        DiagStep<I - 1>::run(Ld, x, cc);
        float a0 = (I == cc) ? 1.f : 0.f, a1 = 0.f;
#pragma unroll
        for (int m = 0; m < I; ++m) { const float lv = row_share<I>(Ld[m]); if (m & 1) a1 -= lv * x[m]; else a0 -= lv * x[m]; }
        x[I] = a0 + a1;
    }
};
template <> struct DiagStep<-1> { static __device__ __forceinline__ void run(const float (&)[16], float (&)[16], int) {} };
__device__ __forceinline__ void dn_wu_prep_phase(const Params& P, LAS unsigned char* lds) {
    PHASE_IDS();
    constexpr int PKQ = 272;
    constexpr int LP = 68;
    constexpr int OFF_K = 0, OFF_Q = 64 * PKQ, OFF_L = 0  , OFF_KK = 4 * 64 * LP * 4, OFF_QK = OFF_KK + 64 * LP * 4, OFF_G = OFF_QK + 64 * LP * 4;
    const bf16* QKV = (const bf16*)(P.ws + WS_QKV); const float* G = (const float*)(P.ws + WS_GATE);
    bf16* TA = (bf16*)(P.ws + WS_TA); float* GS = (float*)(P.ws + WS_GS);
    const int r = lane & 15, g = lane >> 4;
    LAS float* KKs = (LAS float*)(lds + OFF_KK); LAS float* QKs = (LAS float*)(lds + OFF_QK); LAS float* Gs = (LAS float*)(lds + OFF_G);
    u32x4 pq[2], pk[2]; float pgv = 0.f;
#define WU_PREFETCH(grp_) do { const int cidx_ = (grp_) >> 4, kh_ = (grp_) & 15, rb_ = cidx_ * 64; \
        _Pragma("unroll") for (int x = 0; x < 2; ++x) { const int pi = tid + x * NT, pr = pi >> 4, pc = pi & 15; const size_t o = (size_t)(rb_ + pr) * 8192 + kh_ * 128 + pc * 8; pq[x] = *(const u32x4*)(QKV + o); pk[x] = *(const u32x4*)(QKV + o + 2048); } \
        { const int c4 = tid >> 7, which = (tid >> 6) & 1, i = tid & 63, hv = c4 >> 1, d = c4 & 1, h = 2 * kh_ + hv; pgv = G[(size_t)(rb_ + i) * 128 + (which ? 0 : 64) + d * 32 + h]; } } while (0)
    if ((int)blockIdx.x < 256 * 16) WU_PREFETCH(blockIdx.x);
    for (int grp = blockIdx.x; grp < 256 * 16; grp += gridDim.x) {
        const int cidx = grp >> 4, kh = grp & 15;
        __syncthreads();
#pragma unroll
        for (int x = 0; x < 2; ++x) { const int pi = tid + x * NT, pr = pi >> 4, pc = pi & 15;
            *(LAS u32x4*)(lds + OFF_Q + pr * PKQ + pc * 16) = pq[x]; *(LAS u32x4*)(lds + OFF_K + pr * PKQ + pc * 16) = pk[x]; }
        Gs[tid] = pgv;
        __syncthreads();
        if (grp + (int)gridDim.x < 256 * 16) WU_PREFETCH(grp + (int)gridDim.x);
        {
            const int it = wave & 3; const int offx = (wave >> 2) ? OFF_Q : OFF_K; LAS float* dst = (wave >> 2) ? QKs : KKs;
            f32x4 acc[4];
#pragma unroll
            for (int jt = 0; jt < 4; ++jt) acc[jt] = (f32x4){0.f, 0.f, 0.f, 0.f};
#pragma unroll
            for (int sx = 0; sx < 4; ++sx) { const bf16x8 a = ld_b128(lds + offx + (16 * it + r) * PKQ + (32 * sx + 8 * g) * 2);
#pragma unroll
                for (int jt = 0; jt < 4; ++jt) acc[jt] = MFMA16(a, ld_b128(lds + OFF_K + (16 * jt + r) * PKQ + (32 * sx + 8 * g) * 2), acc[jt]); }
#pragma unroll
            for (int jt = 0; jt < 4; ++jt)
#pragma unroll
                for (int e = 0; e < 4; ++e) dst[(16 * it + 4 * g + e) * LP + 16 * jt + r] = acc[jt][e];
        }
        __syncthreads();
        {
            const int c4 = wave & 3, hv = c4 >> 1, d = c4 & 1, h = 2 * kh + hv;
            const int nl = d ? 63 - lane : lane;
            float gcv = Gs[(c4 * 2 + 0) * 64 + nl];
#pragma unroll
            for (int o = 1; o < 64; o <<= 1) { const float t = __shfl_up(gcv, o); if (lane >= o) gcv += t; }
            const float betav = Gs[(c4 * 2 + 1) * 64 + nl];
            const size_t item = ((size_t)(cidx * 32 + h) * 2 + d);
            LAS float* W = (LAS float*)(lds + OFF_L) + c4 * 64 * LP;
            {
                bf16* Ag = TA + item * 8192 + 4096;
                const int pb = (wave >> 2) * 32;
#define WU_LA_TRIPS(REV_) \
                _Pragma("unroll 1") for (int p0 = pb; p0 < pb + 32; p0 += 8) { \
                    const LAS float* kb_ = KKs + ((REV_) ? 56 - p0 : p0) * LP + nl; const LAS float* qb_ = QKs + ((REV_) ? 56 - p0 : p0) * LP + nl; \
                    LAS float* wb_ = W + p0 * LP + lane; bf16* ab_ = Ag + p0 * 64 + lane; const int lrel_ = lane - p0; \
                    float kkv[8], qkv[8]; \
                    _Pragma("unroll") for (int u = 0; u < 8; ++u) { kkv[u] = kb_[((REV_) ? 7 - u : u) * LP]; qkv[u] = qb_[((REV_) ? 7 - u : u) * LP]; } \
                    _Pragma("unroll") for (int u = 0; u < 8; ++u) { const int p = p0 + u; const float gp = rdlane(gcv, p), bp = rdlane(betav, p); const float ex = __expf(gp - gcv); \
                        float lv = bp * kkv[u] * ex, av = qkv[u] * ex; \
                        asm volatile("" : "+v"(lv), "+v"(av)); \
                        wb_[u * LP] = lrel_ < u ? lv : 0.f; \
                        ab_[u * 64] = (bf16)f2bf(lrel_ <= u ? av : 0.f); } \
                }
                if (d) { WU_LA_TRIPS(1) } else { WU_LA_TRIPS(0) }
#undef WU_LA_TRIPS
            }
            if (wave >= 4) {
                float* gs = GS + item * 192; const float gend = rdlane(gcv, 63);
                gs[lane] = __expf(gcv); gs[64 + lane] = betav; gs[128 + lane] = __expf(gend - gcv);
            }
            __syncthreads();
            if (wave < 4) {
                {
                    const int lane2 = opaque_v(lane); const int bb = lane2 >> 4, cc = lane2 & 15;
                    float Ld[16];
#pragma unroll
                    for (int m4 = 0; m4 < 4; ++m4) { const f32x4 v = *(const LAS f32x4*)(W + (16 * bb + cc) * LP + 16 * bb + 4 * m4); Ld[4 * m4] = v[0]; Ld[4 * m4 + 1] = v[1]; Ld[4 * m4 + 2] = v[2]; Ld[4 * m4 + 3] = v[3]; }
                    float x[16];
                    DiagStep<15>::run(Ld, x, cc);
#pragma unroll
                    for (int i = 0; i < 16; ++i) W[(16 * bb + i) * LP + 16 * bb + cc] = x[i];
                }
#define WU_PN(ar, ac, br, bc, acc_) do { _Pragma("unroll") for (int sx = 0; sx < 4; ++sx) acc_ = MFMA4F(W[((ar) + r) * LP + (ac) + 4 * sx + g], W[((br) + 4 * sx + g) * LP + (bc) + r], acc_); } while (0)
#define WU_PA(ar, ac, M_, acc_) do { _Pragma("unroll") for (int e = 0; e < 4; ++e) acc_ = MFMA4F(W[((ar) + r) * LP + (ac) + 4 * g + e], M_[e], acc_); } while (0)
#define WU_ST(r0, c0, acc_) do { _Pragma("unroll") for (int e = 0; e < 4; ++e) W[((r0) + 4 * g + e) * LP + (c0) + r] = -acc_[e]; } while (0)
                const f32x4 z4 = {0.f, 0.f, 0.f, 0.f};
                { f32x4 m1a = z4, m1b = z4; WU_PN(16, 0, 0, 0, m1a); WU_PN(48, 32, 32, 32, m1b);
                  f32x4 t10 = z4, t32 = z4; WU_PA(16, 16, m1a, t10); WU_PA(48, 48, m1b, t32);
                  WU_ST(16, 0, t10); WU_ST(48, 32, t32); }
                { f32x4 m00 = z4, m01 = z4, m10 = z4, m11 = z4;
                  WU_PN(32, 0, 0, 0, m00); WU_PN(32, 16, 16, 0, m00); WU_PN(32, 16, 16, 16, m01);
                  WU_PN(48, 0, 0, 0, m10); WU_PN(48, 16, 16, 0, m10); WU_PN(48, 16, 16, 16, m11);
                  f32x4 t00 = z4, t01 = z4, t10 = z4, t11 = z4;
                  WU_PA(32, 32, m00, t00); WU_PA(32, 32, m01, t01);
                  WU_PA(48, 32, m00, t10); WU_PA(48, 48, m10, t10); WU_PA(48, 32, m01, t11); WU_PA(48, 48, m11, t11);
                  WU_ST(32, 0, t00); WU_ST(32, 16, t01); WU_ST(48, 0, t10); WU_ST(48, 16, t11); }
#undef WU_PN
#undef WU_PA
#undef WU_ST
                bf16* Tg = TA + item * 8192;
#pragma unroll
                for (int x8 = 0; x8 < 8; ++x8) { const int piece = lane + 64 * x8, row = piece >> 3, pc = piece & 7;
                    const f32x4 v0 = *(const LAS f32x4*)(W + row * LP + pc * 8), v1 = *(const LAS f32x4*)(W + row * LP + pc * 8 + 4);
                    u32x4 o; o.x = pk2(v0[0], v0[1]); o.y = pk2(v0[2], v0[3]); o.z = pk2(v1[0], v1[1]); o.w = pk2(v1[2], v1[3]);
                    if (pc * 8 <= row) *(u32x4*)(Tg + row * 64 + pc * 8) = o; }
            }
        }
    }
#undef WU_PREFETCH
}

constexpr int DN_PQ = 272;
constexpr int DN_PXQ = 144, DN_XQ = 64 * DN_PXQ, DN_PXT = 80, DN_XT = 64 * DN_PXT;
constexpr int DN_OFF_Q = 0, DN_OFF_K = 2 * DN_XQ, DN_OFF_V = DN_OFF_K + 64 * DN_PQ, DN_OFF_T = DN_OFF_V + 64 * DN_PQ, DN_OFF_A = DN_OFF_T + 2 * DN_XT, DN_OFF_S = DN_OFF_A + 2 * DN_XT;
struct DnStage { u32x4 rq[2], rk[2], rv[2], rt, ra; f32x4 rs; };
__device__ __forceinline__ void dn_stage_load(DnStage& st, const bf16* QKV, const bf16* TA, const float* GS, int tid, int c, int d, int T, int row0, int kh, int h, int nchunk) {
#pragma unroll
    for (int x = 0; x < 2; ++x) { const int pi = tid + x * NT, pr = pi >> 4, pc = pi & 15; const int pp = c * 64 + pr; const int t = d ? T - 1 - pp : pp;
        const size_t o = (size_t)(row0 + t) * 8192 + pc * 8; st.rq[x] = *(const u32x4*)(QKV + o + kh * 128); st.rk[x] = *(const u32x4*)(QKV + o + 2048 + kh * 128); st.rv[x] = *(const u32x4*)(QKV + o + 4096 + h * 128); }
    const int nc = d ? nchunk - 1 - c : c; const size_t item = ((size_t)((row0 >> 6) + nc) * 32 + h) * 2 + d;
    const bool nz = ((tid & 7) * 8) <= (tid >> 3);
    st.rt = nz ? *(const u32x4*)(TA + item * 8192 + tid * 8) : (u32x4){0u, 0u, 0u, 0u}; st.ra = nz ? *(const u32x4*)(TA + item * 8192 + 4096 + tid * 8) : (u32x4){0u, 0u, 0u, 0u};
    st.rs = (f32x4){0.f, 0.f, 0.f, 0.f}; if (tid < 48) st.rs = *(const f32x4*)(GS + item * 192 + tid * 4);
}
__device__ __forceinline__ void dn_stage_store(const DnStage& st, LAS unsigned char* lds, int tid) {
#pragma unroll
    for (int x = 0; x < 2; ++x) { const int pi = tid + x * NT, pr = pi >> 4, pc = pi & 15;
        { LAS unsigned char* qd = lds + DN_OFF_Q + pr * DN_PXQ + (2 * (pc >> 2) + (pc & 1)) * 16 + ((pc >> 1) & 1) * 8;
          *(LAS u32x2*)qd = (u32x2){st.rq[x].x, st.rq[x].y}; *(LAS u32x2*)(qd + DN_XQ) = (u32x2){st.rq[x].z, st.rq[x].w}; }
        *(LAS u32x4*)(lds + DN_OFF_K + pr * DN_PQ + pc * 16) = st.rk[x]; *(LAS u32x4*)(lds + DN_OFF_V + pr * DN_PQ + pc * 16) = st.rv[x]; }
    { const int pr = tid >> 3, pc = tid & 7; const int o = pr * DN_PXT + (2 * (pc >> 2) + (pc & 1)) * 16 + ((pc >> 1) & 1) * 8;
      *(LAS u32x2*)(lds + DN_OFF_T + o) = (u32x2){st.rt.x, st.rt.y}; *(LAS u32x2*)(lds + DN_OFF_T + o + DN_XT) = (u32x2){st.rt.z, st.rt.w};
      *(LAS u32x2*)(lds + DN_OFF_A + o) = (u32x2){st.ra.x, st.ra.y}; *(LAS u32x2*)(lds + DN_OFF_A + o + DN_XT) = (u32x2){st.ra.z, st.ra.w}; }
    if (tid < 48) *(LAS f32x4*)(lds + DN_OFF_S + tid * 16) = st.rs;
}
__device__ __forceinline__ void dn_step_compute(f32x4 (&S)[8], LAS unsigned char* lds, bf16* O, int c, int d, int T, int row0, int h, int wave, int lane) {
    constexpr int PQ = DN_PQ, OFF_Q = DN_OFF_Q, OFF_K = DN_OFF_K, OFF_V = DN_OFF_V, OFF_T = DN_OFF_T, OFF_A = DN_OFF_A, OFF_S = DN_OFF_S;
    const int r = lane & 15, g = lane >> 4, q4 = (lane & 15) >> 2, p4 = lane & 3;
#define DN_PERMROW(off_, pitch_, row_, col_) cat4(ld_b64(lds + (off_) + (row_) * (pitch_) + ((col_) + 4 * g) * 2), ld_b64(lds + (off_) + (row_) * (pitch_) + ((col_) + 16 + 4 * g) * 2))
#define DN_CHUNK(off_, xsz_, pitch_, row_, sx_) ld_b128(lds + (off_) + (g & 1) * (xsz_) + (row_) * (pitch_) + (2 * (sx_) + (g >> 1)) * 16)
    const f32x4 zero4 = {0.f, 0.f, 0.f, 0.f};
    bf16x8 sb[4];
    f32x4 R[4];
    {
        bf16x8 kf[4][4];
#pragma unroll
        for (int jt = 0; jt < 4; ++jt)
#pragma unroll
            for (int sx = 0; sx < 4; ++sx) kf[jt][sx] = DN_PERMROW(OFF_K, PQ, 16 * jt + r, 32 * sx);
#pragma unroll
        for (int sx = 0; sx < 4; ++sx) sb[sx] = pack8(S[2 * sx], S[2 * sx + 1]);
#pragma unroll
        for (int jt = 0; jt < 4; ++jt) R[jt] = zero4;
#pragma unroll
        for (int sx = 0; sx < 4; ++sx)
#pragma unroll
            for (int jt = 0; jt < 4; ++jt) R[jt] = MFMA16(kf[jt][sx], sb[sx], R[jt]);
    }
    __builtin_amdgcn_sched_barrier(0);
    f32x4 U[4];
    {
        bf16x8 tf[4][2]; s16x4 vt[4]; f32x4 eg[4], bt[4];
#pragma unroll
        for (int jt = 0; jt < 4; ++jt) { vt[jt] = ld_tr(lds + OFF_V + (16 * jt + 4 * g + q4) * PQ + (16 * wave + 4 * p4) * 2);
            eg[jt] = *(const LAS f32x4*)(lds + OFF_S + (16 * jt + 4 * g) * 4); bt[jt] = *(const LAS f32x4*)(lds + OFF_S + 256 + (16 * jt + 4 * g) * 4); }
#pragma unroll
        for (int it = 0; it < 4; ++it) { tf[it][0] = DN_CHUNK(OFF_T, DN_XT, DN_PXT, 16 * it + r, 0); tf[it][1] = DN_CHUNK(OFF_T, DN_XT, DN_PXT, 16 * it + r, 1); }
#pragma unroll
        for (int jt = 0; jt < 4; ++jt)
#pragma unroll
            for (int e = 0; e < 4; ++e) R[jt][e] = bt[jt][e] * (bf2f((unsigned short)vt[jt][e]) - eg[jt][e] * R[jt][e]);
        const bf16x8 rb0 = pack8(R[0], R[1]), rb1 = pack8(R[2], R[3]);
#pragma unroll
        for (int it = 0; it < 4; ++it) U[it] = MFMA16(tf[it][0], rb0, zero4);
#pragma unroll
        for (int it = 0; it < 4; ++it) U[it] = MFMA16(tf[it][1], rb1, U[it]);
    }
    __builtin_amdgcn_sched_barrier(0);
    {
        f32x4 Ot[4];
#pragma unroll
        for (int it = 0; it < 4; ++it) Ot[it] = zero4;
#pragma unroll
        for (int hq = 0; hq < 2; ++hq) {
            bf16x8 qf[2][4];
#pragma unroll
            for (int i2 = 0; i2 < 2; ++i2)
#pragma unroll
                for (int sx = 0; sx < 4; ++sx) qf[i2][sx] = DN_CHUNK(OFF_Q, DN_XQ, DN_PXQ, 16 * (2 * hq + i2) + r, sx);
#pragma unroll
            for (int sx = 0; sx < 4; ++sx)
#pragma unroll
                for (int i2 = 0; i2 < 2; ++i2) Ot[2 * hq + i2] = MFMA16(sb[sx], qf[i2][sx], Ot[2 * hq + i2]);
        }
        bf16x8 af[4][2]; float egi[4];
#pragma unroll
        for (int it = 0; it < 4; ++it) { af[it][0] = DN_CHUNK(OFF_A, DN_XT, DN_PXT, 16 * it + r, 0); af[it][1] = DN_CHUNK(OFF_A, DN_XT, DN_PXT, 16 * it + r, 1); egi[it] = *(const LAS float*)(lds + OFF_S + (16 * it + r) * 4); }
        const bf16x8 ub0 = pack8(U[0], U[1]), ub1 = pack8(U[2], U[3]);
#pragma unroll
        for (int it = 0; it < 4; ++it) Ot[it] = Ot[it] * egi[it];
#pragma unroll
        for (int it = 0; it < 4; ++it) Ot[it] = MFMA16(ub0, af[it][0], Ot[it]);
#pragma unroll
        for (int it = 0; it < 4; ++it) Ot[it] = MFMA16(ub1, af[it][1], Ot[it]);
#pragma unroll
        for (int it = 0; it < 4; ++it) { const int pp = c * 64 + 16 * it + r; const int t = d ? T - 1 - pp : pp; u32x2 w; w.x = pk2(Ot[it][0], Ot[it][1]); w.y = pk2(Ot[it][2], Ot[it][3]);
            *(u32x2*)(O + (size_t)(row0 + t) * 4096 + h * 128 + 16 * wave + 4 * g) = w; }
    }
    __builtin_amdgcn_sched_barrier(0);
    {
#pragma unroll
        for (int jt = 0; jt < 4; ++jt) { const f32x4 dc = *(const LAS f32x4*)(lds + OFF_S + 512 + (16 * jt + 4 * g) * 4); U[jt] = U[jt] * dc; }
        const bf16x8 us0 = pack8(U[0], U[1]), us1 = pack8(U[2], U[3]);
        const float gend = *(const LAS float*)(lds + OFF_S + 63 * 4);
#pragma unroll
        for (int hk = 0; hk < 2; ++hk) {
            bf16x8 ktf[4][2];
#pragma unroll
            for (int k2 = 0; k2 < 4; ++k2) { const int kt = 4 * hk + k2;
                ktf[k2][0] = cat4(ld_tr(lds + OFF_K + (4 * g + q4) * PQ + (16 * kt + 4 * p4) * 2), ld_tr(lds + OFF_K + (16 + 4 * g + q4) * PQ + (16 * kt + 4 * p4) * 2));
                ktf[k2][1] = cat4(ld_tr(lds + OFF_K + (32 + 4 * g + q4) * PQ + (16 * kt + 4 * p4) * 2), ld_tr(lds + OFF_K + (48 + 4 * g + q4) * PQ + (16 * kt + 4 * p4) * 2)); }
#pragma unroll
            for (int k2 = 0; k2 < 4; ++k2) S[4 * hk + k2] = MFMA16(ktf[k2][0], us0, S[4 * hk + k2] * gend);
#pragma unroll
            for (int k2 = 0; k2 < 4; ++k2) S[4 * hk + k2] = MFMA16(ktf[k2][1], us1, S[4 * hk + k2]);
        }
    }
#undef DN_PERMROW
#undef DN_CHUNK
}
__device__ __forceinline__ void dn_chunk_phase(const Params& P, int j, LAS unsigned char* lds) {
    PHASE_IDS();
    const bf16* QKV = (const bf16*)(P.ws + WS_QKV); const bf16* TA = (const bf16*)(P.ws + WS_TA); const float* GS = (const float*)(P.ws + WS_GS);
    bf16* OF = (bf16*)(P.ws + WS_OF); bf16* OB = (bf16*)(P.ws + WS_OB);
    const int r = lane & 15, g = lane >> 4;
    const int bxp = (gridDim.x == 256) ? ({ const int x = blockIdx.x & 7, y = blockIdx.x >> 3, grp = x + 8 * (y >> 1), mem = y & 1; (grp >> 5) * 64 + (2 * ((grp >> 1) & 15) + mem) * 2 + (grp & 1); }) : (int)blockIdx.x;
    for (int unit0 = blockIdx.x; unit0 < 256 + 2048; unit0 += gridDim.x) {
        const int unit = (gridDim.x == 256) ? (unit0 - (int)blockIdx.x + bxp) : unit0;
        const bool lat = unit < 256; const int u2 = lat ? unit : unit - 256;
        const int b = u2 >> 6, h = (u2 >> 1) & 31, d = u2 & 1, T = lat ? 2048 : 256, row0 = lat ? MCTX + b * 2048 : b * 256, kh = h >> 1, nchunk = T / 64;
        bf16* O = d ? OB : OF;
        f32x4 S[8];
        { const float* s0 = P.in[3] + ((((size_t)b * 2 + j) * 2 + d) * 32 + h) * 128 * 128 + 16 * wave + r;
          if (lat) {
#pragma unroll
              for (int kt = 0; kt < 8; ++kt)
#pragma unroll
                  for (int e = 0; e < 4; ++e) S[kt][e] = s0[(size_t)(16 * kt + 4 * g + e) * 128];
          } else {
#pragma unroll
              for (int kt = 0; kt < 8; ++kt) S[kt] = (f32x4){0.f, 0.f, 0.f, 0.f};
          } }
        constexpr int DN_HSZ = DN_OFF_S + 768;
        DnStage sa;
        __syncthreads();
        dn_stage_load(sa, QKV, TA, GS, tid, 0, d, T, row0, kh, h, nchunk);
        dn_stage_store(sa, lds, tid);
        dn_stage_load(sa, QKV, TA, GS, tid, 1, d, T, row0, kh, h, nchunk);
        __syncthreads();
        for (int c = 0; c < nchunk; ++c) {
            LAS unsigned char* cur = lds + (c & 1) * DN_HSZ; LAS unsigned char* nxt = lds + ((c + 1) & 1) * DN_HSZ;
            if (c + 1 < nchunk) dn_stage_store(sa, nxt, tid);
            if (c + 2 < nchunk) dn_stage_load(sa, QKV, TA, GS, tid, c + 2, d, T, row0, kh, h, nchunk);
            dn_step_compute(S, cur, O, c, d, T, row0, h, wave, lane);
            __syncthreads();
        }
        if (!lat) { float* sd = P.out + OUT_SDN + ((((size_t)b * 2 + j) * 2 + d) * 32 + h) * 128 * 128 + 16 * wave + r;
#pragma unroll
            for (int kt = 0; kt < 8; ++kt)
#pragma unroll
                for (int e = 0; e < 4; ++e) sd[(size_t)(16 * kt + 4 * g + e) * 128] = S[kt][e]; }
    }
}


#ifndef R_CONV
#define R_CONV 1
#endif
#ifndef R_MOD
#define R_MOD 1
#endif
#ifndef R_NORM
#define R_NORM 1
#endif
#ifndef R_GATE
#define R_GATE 1
#endif
#ifndef R_DNPREP
#define R_DNPREP 1
#endif
#ifndef R_WU
#define R_WU 1
#endif
#ifndef R_GLAPREP
#define R_GLAPREP 1
#endif
#ifndef R_DNSCAN
#define R_DNSCAN 1
#endif
#ifndef R_GSCAN
#define R_GSCAN 1
#endif
#ifndef R_FINAL
#define R_FINAL 1
#endif
#ifndef R_BAR
#define R_BAR 1
#endif
#ifndef R_GEMM
#define R_GEMM 1
#endif
#define REPN(n_) for (int rep_ = 0; rep_ < (n_); ++rep_)
#ifndef REP_THIN
#define REP_THIN 1
#endif
#ifndef REP_SCAN
#define REP_SCAN 1
#endif
#ifndef REP_A
#define REP_A 1
#endif
#ifndef REP_B
#define REP_B 1
#endif
#ifndef REP_C
#define REP_C 1
#endif
#define RT for (int rep_ = 0; rep_ < REP_THIN; ++rep_)
#define RA for (int rep_ = 0; rep_ < REP_A; ++rep_)
#define RB for (int rep_ = 0; rep_ < REP_B; ++rep_)
#define RC for (int rep_ = 0; rep_ < REP_C; ++rep_)
#define RS for (int rep_ = 0; rep_ < REP_SCAN; ++rep_)
template <int LAYER> __device__ __forceinline__ void layer_body(const Params& P, LAS unsigned char* lds, const XcdBarrier& bar) {
    bf16* X = (bf16*)(P.ws + WS_X); bf16* H = (bf16*)(P.ws + WS_H); bf16* BIG = (bf16*)(P.ws + WS_BIG); float* GATE = (float*)(P.ws + WS_GATE);
    bf16* Y = (bf16*)(P.ws + WS_QKV); bf16* OF = (bf16*)(P.ws + WS_OF); bf16* OB = (bf16*)(P.ws + WS_OB);
    const float* MOD = (const float*)(P.ws + WS_MOD);
    const bf16* Tin = (const bf16*)(P.ws + WS_W + WOFF_IN); const bf16* Tout = (const bf16*)(P.ws + WS_W + WOFF_OUT); const bf16* Tup = (const bf16*)(P.ws + WS_W + WOFF_UP); const bf16* Tdn = (const bf16*)(P.ws + WS_W + WOFF_DOWN);

        constexpr int layer = LAYER, kind = LAYER % 3, j = LAYER / 3;
        const float* modl = MOD + (size_t)layer * 5 * MODW;
        const void* xc = layer == 0 ? (const void*)P.in[0] : (const void*)X; const void* xl = layer == 0 ? (const void*)P.in[1] : (const void*)X;
#ifndef NO_CONV
        REPN(R_CONV) convert_layer_weights(P, layer, lds);
#endif
        if (layer == 0) REPN(R_BAR) xcd_barrier(bar);
        REPN(R_NORM) norm_mod_phase<layer == 0>(xc, xl, P.in[9] + layer * D, modl, 0, 2048, H);
        REPN(R_BAR) xcd_barrier(bar);
        {
            constexpr int Npad = kind == 0 ? DN_NPAD : (kind == 1 ? GLA_NPAD : HG_NIN), nmain = kind == 0 ? DN_NMAIN : (kind == 1 ? GLA_NMAIN : HG_NIN);
            { pg8::Gemm g = pg8::mk_gemm(H, Tin, MROWS, nmain, D); pg8::StaticOrder S; S.init(MROWS, nmain, (int)gridDim.x, (int)blockIdx.x);
              pg8::EpiBf16<0> E{BIG, nmain, nmain, GATE};
              REPN(R_GEMM) pg8::gemm_phase<pg8::EpiBf16<0>, pg8::StaticOrder, true, true>(lds, g, S, E); }
            if constexpr (Npad > nmain) {
              pg8::Gemm g{H, Tin + (size_t)nmain * D, MROWS, 4 * 256, D, (size_t)512 * 2, (size_t)512 * 2, 8}; pg8::StaticOrder S; S.init(MROWS, 4 * 256, (int)gridDim.x, (int)blockIdx.x);
              pg8::EpiGateP E{(float*)(P.ws + WS_GP)};
              pg8::gemm_phase<pg8::EpiGateP, pg8::StaticOrder, true, true>(lds, g, S, E); }
        }
        REPN(R_BAR) xcd_barrier(bar);
        if constexpr (kind == 0) {
#ifndef NO_DNPREP
            REPN(R_DNPREP) dn_prep_phase(P, j, rep_ == 0);
#endif
            REPN(R_BAR) xcd_barrier(bar);
            REPN(R_WU) dn_wu_prep_phase(P, lds);
            REPN(R_BAR) xcd_barrier(bar);
            REPN(R_DNSCAN) dn_chunk_phase(P, j, lds);
            REPN(R_BAR) xcd_barrier(bar);
            REPN(R_GATE) gate_phase<128>(OF, OB, BIG, DN_NMAIN, 8192, P.in[18] + j * 128, Y, 4096);
        } else if constexpr (kind == 1) {
            REPN(R_GLAPREP) gla_prep_phase<1>(P, lds);
            REPN(R_BAR) xcd_barrier(bar);
            REPN(R_GSCAN) gla_chunk_phase<1>(P, lds);
            REPN(R_BAR) xcd_barrier(bar);
            REPN(R_GATE) gate_phase<512>(OF, OB, BIG, GLA_NMAIN, 4096, P.in[23] + j * 512, Y, 2048);
        } else {
            REPN(R_GLAPREP) gla_prep_phase<2>(P, lds);
            REPN(R_BAR) xcd_barrier(bar);
            REPN(R_GSCAN) gla_chunk_phase<2>(P, lds);
            REPN(R_BAR) xcd_barrier(bar);
            REPN(R_GATE) gate_phase<128>(OF, OB, BIG, HG_NIN, 4096, P.in[27] + j * 128, Y, 2048);
        }
        REPN(R_BAR) xcd_barrier(bar);
        {
            const int Kout = kind == 0 ? 4096 : 2048;
            pg8::Gemm g = pg8::mk_gemm(Y, Tout, MROWS, D, Kout); pg8::StaticOrder S; S.init(MROWS, D, (int)gridDim.x, (int)blockIdx.x);
            pg8::EpiRes<layer == 0> E{xc, xl, X, modl + 4096};
            pg8::gemm_phase<pg8::EpiRes<layer == 0>, pg8::StaticOrder, true, true>(lds, g, S, E);
        }
        REPN(R_BAR) xcd_barrier(bar);
        REPN(R_NORM) norm_mod_phase<false>(X, X, P.in[10] + layer * D, modl, 6144, 8192, H);
        REPN(R_BAR) xcd_barrier(bar);
#pragma unroll
        for (int hf = 0; hf < 2; ++hf) {
            {
                pg8::Gemm g = pg8::mk_gemm(H, Tup, MROWS / 2, DFF, D); pg8::StaticOrder S; S.init(MROWS / 2, DFF, (int)gridDim.x, (int)blockIdx.x, hf * 32);
                pg8::EpiBf16<1> E{BIG, DFF, DFF, nullptr};
                REPN(R_GEMM) pg8::gemm_phase<pg8::EpiBf16<1>, pg8::StaticOrder, true, true>(lds, g, S, E);
            }
            REPN(R_BAR) xcd_barrier(bar);
            {
                pg8::Gemm g = pg8::mk_gemm(BIG, Tdn, MROWS / 2, D, DFF); pg8::StaticOrder S; S.init(MROWS / 2, D, (int)gridDim.x, (int)blockIdx.x, hf * 32);
                pg8::EpiRes<false> E{X, X, X, modl + 10240};
                pg8::gemm_phase<pg8::EpiRes<false>, pg8::StaticOrder, true, true>(lds, g, S, E);
            }
            REPN(R_BAR) xcd_barrier(bar);
        }
    }

__global__ void __launch_bounds__(NT, 2) fwd_kernel(Params P) {
    extern __shared__ __attribute__((aligned(16))) unsigned char lds_raw[];
    LAS unsigned char* lds = (LAS unsigned char*)lds_raw;
    const int tid = threadIdx.x;
    volatile LAS unsigned* misc = (volatile LAS unsigned*)(lds + LDS_MISC);
    if (tid < 64) misc[tid] = 0u;
    __syncthreads();
    XcdBarrier bar = xcd_barrier_post((unsigned*)(P.ws + WS_CTL) + 1024, misc + 8);

#ifndef NO_MOD
    REPN(R_MOD) mod_phase(P, lds);
#endif
    __syncthreads();

    layer_body<0>(P, lds, bar);
    layer_body<1>(P, lds, bar);
    layer_body<2>(P, lds, bar);
    layer_body<3>(P, lds, bar);
    REPN(R_FINAL) final_norm_phase((const bf16*)(P.ws + WS_X), P.in[11], P.out + OUT_Y);
}

extern "C" void kernel_launch(void* const* d_in, const int* in_sizes, int n_in, void* d_out, int out_size, void* d_ws, size_t ws_size, hipStream_t stream) {
    static int grid = 0;
    if (grid == 0) {
        if (n_in != 29 || (size_t)out_size != OUT_END || ws_size < WS_END) {
            fprintf(stderr, "kernel_launch: unexpected shapes: n_in %d out %d (want %zu) ws %zu (want %zu)\n", n_in, out_size, (size_t)OUT_END, ws_size, (size_t)WS_END); grid = -1; return; }
        int dev = 0, cus = 0, per_cu = 0;
        if (hipGetDevice(&dev) != hipSuccess || hipDeviceGetAttribute(&cus, hipDeviceAttributeMultiprocessorCount, dev) != hipSuccess) { grid = -1; return; }
        if (hipFuncSetAttribute((const void*)fwd_kernel, hipFuncAttributeMaxDynamicSharedMemorySize, LDS_BYTES) != hipSuccess) { fprintf(stderr, "kernel_launch: hipFuncSetAttribute failed\n"); grid = -1; return; }
        if (hipOccupancyMaxActiveBlocksPerMultiprocessor(&per_cu, (const void*)fwd_kernel, NT, LDS_BYTES) != hipSuccess || per_cu < 1) { fprintf(stderr, "kernel_launch: occupancy query says %d\n", per_cu); }
        (void)hipGetLastError();
        grid = cus;
    }
    if (grid < 0) return;
    hipMemsetAsync((char*)d_ws + WS_CTL, 0, CTL_BYTES, stream);
    Params p{};
    for (int i = 0; i < 29; ++i) p.in[i] = (const float*)d_in[i];
    p.out = (float*)d_out; p.ws = (unsigned char*)d_ws;
    hipLaunchKernelGGL(fwd_kernel, dim3(grid), dim3(NT), LDS_BYTES, stream, p);
}
```

```cpp
#include <hip/hip_runtime.h>
#include <cstdio>
#include <cstdint>

__device__ __forceinline__ int opaque_v(int x) { asm volatile("" : "+v"(x)); return x; }
#define PHASE_IDS() const int tid = opaque_v((int)threadIdx.x), lane = tid & 63, wave = __builtin_amdgcn_readfirstlane(tid >> 6), gw = (int)blockIdx.x * 8 + wave, NGW = (int)gridDim.x * 8; (void)lane; (void)wave; (void)gw; (void)NGW
namespace pg8 {
#define PG8_LAS __attribute__((address_space(3)))
typedef unsigned short bf16_t;
typedef short bf16x8 __attribute__((ext_vector_type(8)));
typedef float f32x4 __attribute__((ext_vector_type(4)));
typedef unsigned u32x4 __attribute__((ext_vector_type(4)));
constexpr int BM = 256, BK = 64, HALF = 128, HTB = HALF * BK * 2, STAGE_BYTES = 8 * HTB, NXCD = 8, WGM = 8;

__host__ __device__ __forceinline__ int lds_byte(int r, int c) { const int st = (r >> 4) * 2 + (c >> 5), rr = r & 15, cc = c & 31, ob = rr * 64 + cc * 2; return st * 1024 + (ob ^ (((ob >> 9) & 1) << 5)); }
__host__ __device__ __forceinline__ void stage_rc(int b, int& R, int& C) { const int st = b / 1024, sb = b % 1024, swz = sb ^ (((sb >> 9) & 1) << 5); R = (st >> 1) * 16 + swz / 64; C = (st & 1) * 32 + (swz % 64) / 2; }
__host__ __device__ __forceinline__ int perm32(int rho) { const int n = rho >> 4, i = rho & 15; return 8 * (i >> 2) + 4 * n + (i & 3); }

struct Unit { int pm, pn; };
struct Gemm { const bf16_t* A; const bf16_t* Bt; int M, N, K; size_t a_pn_step, b_pn_step; int nt; };
__host__ __device__ __forceinline__ Gemm mk_gemm(const bf16_t* A, const bf16_t* Bt, int M, int N, int K) { return Gemm{A, Bt, M, N, K, 0, (size_t)256 * K * 2, K / 64}; }

struct StaticOrder {
    int nM, nN, nwg, G, c, pm0;
    __host__ __device__ void init(int M, int N, int G_, int c_, int pm0_ = 0) { nM = M / BM; nN = N / BM; nwg = nM * nN; G = G_; c = c_; pm0 = pm0_; }
    __host__ __device__ bool next(int i, Unit& u) const {
        const long L = (long)i * G + c; if (L >= nwg) return false;
        int wgid = (int)L; { const int q = nwg / NXCD, r = nwg % NXCD, xcd = wgid % NXCD, off = wgid / NXCD; wgid = (xcd < r ? xcd * (q + 1) : r * (q + 1) + (xcd - r) * q) + off; }
        const int nig = WGM * nN, gid = wgid / nig, fm = gid * WGM, gsz = (nM - fm) < WGM ? (nM - fm) : WGM;
        u.pm = pm0 + fm + ((wgid % nig) % gsz); u.pn = (wgid % nig) / gsz; return true;
    }
    __device__ __forceinline__ void a_ready(const Unit&) const {}
    __device__ __forceinline__ void done(const Unit&) const {}
};

__device__ __forceinline__ unsigned cvt_pk_bf16(float lo, float hi) { unsigned r; asm volatile("v_cvt_pk_bf16_f32 %0, %1, %2" : "=v"(r) : "v"(lo), "v"(hi)); return r; }

template <int ACT> struct EpiBf16 {
    static constexpr bool PERM = true, AFTER_DRAIN = false;
    bf16_t* O; int ldc; int n_main; float* G;
    __device__ __forceinline__ void operator()(const f32x4 (&acc)[2][2][4][2], const Unit& u, int wr, int wc, int fr, int fq) const {
        const int row0 = u.pm * BM + wr * 64 + fr; const int colt = u.pn * BM;
        const int col0 = colt + wc * 32 + 8 * fq;
#pragma unroll
        for (int ai = 0; ai < 2; ++ai)
#pragma unroll
            for (int m = 0; m < 4; ++m) { bf16_t* rowp = O + (size_t)(row0 + ai * HALF + m * 16) * ldc + col0;
#pragma unroll
                for (int bj = 0; bj < 2; ++bj) { f32x4 v0 = acc[ai][bj][m][0], v1 = acc[ai][bj][m][1];
                    if (ACT == 1) {
#pragma unroll
                        for (int j = 0; j < 4; ++j) { const float a = fmaxf(v0[j], 0.f), b = fmaxf(v1[j], 0.f); v0[j] = a * a; v1[j] = b * b; } }
                    u32x4 w; w.x = cvt_pk_bf16(v0[0], v0[1]); w.y = cvt_pk_bf16(v0[2], v0[3]); w.z = cvt_pk_bf16(v1[0], v1[1]); w.w = cvt_pk_bf16(v1[2], v1[3]);
                    *(u32x4*)(rowp + bj * HALF) = w;
#ifdef PROBE_DOUBLE_STORE
                    asm volatile("" ::: "memory"); *(u32x4*)(rowp + bj * HALF) = w; asm volatile("" ::: "memory");
#endif
                    } }
    }
};
struct EpiGateP {
    static constexpr bool PERM = true, AFTER_DRAIN = false;
    float* GP;
    __device__ __forceinline__ void operator()(const f32x4 (&acc)[2][2][4][2], const Unit& u, int wr, int wc, int fr, int fq) const {
        const int row0 = u.pm * BM + wr * 64 + fr; const int col0 = wc * 32 + 8 * fq; float* base = GP + (size_t)u.pn * 16384 * 128;
#pragma unroll
        for (int ai = 0; ai < 2; ++ai)
#pragma unroll
            for (int m = 0; m < 4; ++m) { float* rowp = base + (size_t)(row0 + ai * HALF + m * 16) * 128 + col0;
                *(f32x4*)(rowp) = acc[ai][0][m][0]; *(f32x4*)(rowp + 4) = acc[ai][0][m][1]; }
    }
};
template <bool BASE_F32> struct EpiRes {
    static constexpr bool PERM = true, AFTER_DRAIN = false;
    const void* base_ctx; const void* base_lat; bf16_t* out; const float* gate;
    __device__ __forceinline__ void operator()(const f32x4 (&acc)[2][2][4][2], const Unit& u, int wr, int wc, int fr, int fq) const {
        const int row0 = u.pm * BM + wr * 64 + fr, col0 = u.pn * BM + wc * 32 + 8 * fq;
        const bool ctx = u.pm < 32; const int grp = ctx ? 0 : 1 + ((u.pm - 32) >> 3);
        const float* gp = gate + (size_t)grp * 12288 + col0;
        const void* base = ctx ? base_ctx : base_lat; const int rsub = (BASE_F32 && !ctx) ? 8192 : 0;
        f32x4 gv[2][2];
#pragma unroll
        for (int bj = 0; bj < 2; ++bj)
#pragma unroll
            for (int n = 0; n < 2; ++n) gv[bj][n] = *(const f32x4*)(gp + bj * HALF + 4 * n);
#pragma unroll
        for (int ai = 0; ai < 2; ++ai) {
            f32x4 bs[4][2][2];
#pragma unroll
            for (int m = 0; m < 4; ++m) { const size_t offb = (size_t)(row0 + ai * HALF + m * 16 - rsub) * 2048 + col0;
#pragma unroll
                for (int bj = 0; bj < 2; ++bj) {
                    if (BASE_F32) { bs[m][bj][0] = *(const f32x4*)((const float*)base + offb + bj * HALF); bs[m][bj][1] = *(const f32x4*)((const float*)base + offb + bj * HALF + 4); }
                    else { const u32x4 w = *(const u32x4*)((const bf16_t*)base + offb + bj * HALF);
                        bs[m][bj][0] = (f32x4){__uint_as_float(w.x << 16), __uint_as_float(w.x & 0xffff0000u), __uint_as_float(w.y << 16), __uint_as_float(w.y & 0xffff0000u)};
                        bs[m][bj][1] = (f32x4){__uint_as_float(w.z << 16), __uint_as_float(w.z & 0xffff0000u), __uint_as_float(w.w << 16), __uint_as_float(w.w & 0xffff0000u)}; } } }
#pragma unroll
            for (int m = 0; m < 4; ++m) { const size_t offo = (size_t)(row0 + ai * HALF + m * 16) * 2048 + col0;
#pragma unroll
                for (int bj = 0; bj < 2; ++bj) { const f32x4 v0 = bs[m][bj][0] + gv[bj][0] * acc[ai][bj][m][0], v1 = bs[m][bj][1] + gv[bj][1] * acc[ai][bj][m][1];
                    u32x4 w; w.x = cvt_pk_bf16(v0[0], v0[1]); w.y = cvt_pk_bf16(v0[2], v0[3]); w.z = cvt_pk_bf16(v1[0], v1[1]); w.w = cvt_pk_bf16(v1[2], v1[3]);
                    *(u32x4*)(out + offo + bj * HALF) = w; } }
            asm volatile("" ::: "memory");
        }
    }
};

template <class Epi, class Sched, bool ALIGN_EPI = false, bool SP2 = false>
__device__ __forceinline__ void gemm_phase(PG8_LAS unsigned char* lds, const Gemm g, const Sched& S, const Epi& E) {
    const int tid = opaque_v((int)threadIdx.x), wid = __builtin_amdgcn_readfirstlane(tid >> 6), lane = tid & 63, wr = wid >> 2, wc = wid & 3, fr = lane & 15, fq = lane >> 4;
    const int K = g.K, nt = g.nt;
    unsigned voffA[2], voffB[2];
#pragma unroll
    for (int i = 0; i < 2; ++i) { int R, C; stage_rc(tid * 16 + i * 8192, R, C); const int Rb = Epi::PERM ? ((R & ~31) + perm32(R & 31)) : R;
        voffA[i] = (unsigned)(R * K + C) * 2u; voffB[i] = (unsigned)(Rb * K + C) * 2u; }
    const size_t kstep = (size_t)(BK * 2);
    const size_t hstep = (size_t)HALF * K * 2;
    const size_t tstep = 2 * hstep;
    const unsigned ldsw = (unsigned)wid * 1024u;
    const int aoff = lds_byte(wr * 64 + fr, fq * 8), boff = lds_byte(wc * 32 + fr, fq * 8);
#define PG8_SA(b, h) (((b) * 2 + (h)) * HTB)
#define PG8_SB(b, h) ((4 + (b) * 2 + (h)) * HTB)
#define PG8_STAGE(bufoff, gbase, voff) do { _Pragma("unroll") for (int _i = 0; _i < 2; ++_i) \
        __builtin_amdgcn_global_load_lds((const unsigned*)((const char*)(gbase) + (voff)[_i]), (PG8_LAS unsigned*)(lds + (bufoff) + ldsw + _i * 8192), 16, 0, 0); } while (0)
#define PG8_LDA(dst, b, h) do { _Pragma("unroll") for (int m = 0; m < 4; ++m) _Pragma("unroll") for (int k = 0; k < 2; ++k) dst[m][k] = *(const PG8_LAS bf16x8*)(lds + PG8_SA(b, h) + aoff + m * 2048 + k * 1024); } while (0)
#define PG8_LDB(dst, b, h) do { _Pragma("unroll") for (int n = 0; n < 2; ++n) _Pragma("unroll") for (int k = 0; k < 2; ++k) dst[n][k] = *(const PG8_LAS bf16x8*)(lds + PG8_SB(b, h) + boff + n * 2048 + k * 1024); } while (0)
#define PG8_MMA(ai, bj, At, Bt) do { __builtin_amdgcn_s_setprio(1); _Pragma("unroll") for (int m = 0; m < 4; ++m) _Pragma("unroll") for (int n = 0; n < 2; ++n) _Pragma("unroll") for (int k = 0; k < 2; ++k) \
        acc[ai][bj][m][n] = __builtin_amdgcn_mfma_f32_16x16x32_bf16(Bt[n][k], At[m][k], acc[ai][bj][m][n], 0, 0, 0); __builtin_amdgcn_s_setprio(0); } while (0)
#define PG8_WAIT_V(n) asm volatile("s_waitcnt vmcnt(" #n ")" ::: "memory")
#define PG8_WAIT_L(n) asm volatile("s_waitcnt lgkmcnt(" #n ")" ::: "memory")
#define PG8_BAR __builtin_amdgcn_s_barrier()
#define PG8_SCHED __builtin_amdgcn_sched_barrier(0)
    Unit cur, nxt; int ui = 0;
    if (!S.next(0, cur)) return;
    f32x4 acc[2][2][4][2];
#pragma unroll
    for (int a = 0; a < 2; ++a)
#pragma unroll
        for (int b = 0; b < 2; ++b)
#pragma unroll
            for (int m = 0; m < 4; ++m)
#pragma unroll
                for (int n = 0; n < 2; ++n) acc[a][b][m][n] = (f32x4){0.f, 0.f, 0.f, 0.f};
    bf16x8 At[4][2], B0[2][2], B1[2][2];
    const char* cA = (const char*)g.A + (size_t)cur.pm * tstep + (size_t)cur.pn * g.a_pn_step; const char* cB = (const char*)g.Bt + (size_t)cur.pn * g.b_pn_step;
    S.a_ready(cur);
    if constexpr (SP2) {
        PG8_STAGE(PG8_SB(0, 0), cB, voffB); PG8_STAGE(PG8_SB(0, 1), cB + hstep, voffB); PG8_STAGE(PG8_SA(0, 0), cA, voffA); PG8_STAGE(PG8_SA(0, 1), cA + hstep, voffA);
        if (wr == 1) PG8_BAR;
        PG8_WAIT_V(2); PG8_BAR;
        PG8_STAGE(PG8_SB(1, 0), cB + kstep, voffB); PG8_STAGE(PG8_SA(1, 0), cA + kstep, voffA); PG8_STAGE(PG8_SB(1, 1), cB + hstep + kstep, voffB);
        PG8_WAIT_V(6); PG8_BAR;
    } else {
        PG8_STAGE(PG8_SB(0, 0), cB, voffB); PG8_STAGE(PG8_SA(0, 0), cA, voffA); PG8_STAGE(PG8_SB(0, 1), cB + hstep, voffB); PG8_STAGE(PG8_SA(0, 1), cA + hstep, voffA);
        if (wr == 1) PG8_BAR;
        PG8_WAIT_V(4); PG8_BAR;
        PG8_STAGE(PG8_SB(1, 0), cB + kstep, voffB); PG8_STAGE(PG8_SA(1, 0), cA + kstep, voffA); PG8_STAGE(PG8_SB(1, 1), cB + hstep + kstep, voffB);
        PG8_WAIT_V(6); PG8_BAR;
    }
    for (;;) {
        const bool has_next = S.next(ui + 1, nxt);
        const char* nA = has_next ? (const char*)g.A + (size_t)nxt.pm * tstep + (size_t)nxt.pn * g.a_pn_step : cA; const char* nB = has_next ? (const char*)g.Bt + (size_t)nxt.pn * g.b_pn_step : cB;
        for (int t = 0; t < nt; t += 2) {
            const bool last = (t == nt - 2);
            const char* a1 = cA + (size_t)(t + 1) * kstep;
            const char* a2 = last ? nA : cA + (size_t)(t + 2) * kstep; const char* b2 = last ? nB : cB + (size_t)(t + 2) * kstep;
            const char* a3 = a2 + kstep; const char* b3 = b2 + kstep;
            if (last && has_next) S.a_ready(nxt);
            if constexpr (SP2) {
            PG8_LDB(B0, 0, 0); PG8_LDB(B1, 0, 1); PG8_SCHED; PG8_LDA(At, 0, 0); PG8_STAGE(PG8_SA(1, 1), a1 + hstep, voffA);
            PG8_WAIT_V(8); PG8_WAIT_L(0); PG8_BAR; PG8_MMA(0, 0, At, B0); PG8_MMA(0, 1, At, B1); PG8_BAR; PG8_SCHED;
            PG8_LDA(At, 0, 1); PG8_STAGE(PG8_SB(0, 0), b2, voffB); PG8_STAGE(PG8_SB(0, 1), b2 + hstep, voffB); PG8_STAGE(PG8_SA(0, 0), a2, voffA);
            PG8_WAIT_V(8); PG8_WAIT_L(0); PG8_BAR; PG8_MMA(1, 0, At, B0); PG8_MMA(1, 1, At, B1); PG8_BAR; PG8_SCHED;
            PG8_LDB(B0, 1, 0); PG8_LDB(B1, 1, 1); PG8_SCHED; PG8_LDA(At, 1, 0); PG8_STAGE(PG8_SA(0, 1), a2 + hstep, voffA);
            PG8_WAIT_V(8); PG8_WAIT_L(0); PG8_BAR; PG8_MMA(0, 0, At, B0); PG8_MMA(0, 1, At, B1); PG8_BAR; PG8_SCHED;
            PG8_LDA(At, 1, 1); PG8_STAGE(PG8_SB(1, 0), b3, voffB); PG8_STAGE(PG8_SB(1, 1), b3 + hstep, voffB); PG8_STAGE(PG8_SA(1, 0), a3, voffA);
            PG8_WAIT_V(8); PG8_WAIT_L(0); PG8_BAR; PG8_MMA(1, 0, At, B0); PG8_MMA(1, 1, At, B1); PG8_BAR; PG8_SCHED;
            } else {
            PG8_LDB(B0, 0, 0); PG8_SCHED; PG8_LDA(At, 0, 0); PG8_STAGE(PG8_SA(1, 1), a1 + hstep, voffA);
            PG8_WAIT_L(8); PG8_BAR; PG8_WAIT_L(0); PG8_MMA(0, 0, At, B0); PG8_BAR; PG8_SCHED;
            PG8_LDB(B1, 0, 1); PG8_STAGE(PG8_SB(0, 0), b2, voffB);
            PG8_BAR; PG8_WAIT_L(0); PG8_MMA(0, 1, At, B1); PG8_BAR;
            PG8_LDA(At, 0, 1); PG8_STAGE(PG8_SA(0, 0), a2, voffA);
            PG8_BAR; PG8_WAIT_L(0); PG8_MMA(1, 0, At, B0); PG8_BAR; PG8_SCHED;
            PG8_STAGE(PG8_SB(0, 1), b2 + hstep, voffB);
            PG8_WAIT_V(6); PG8_BAR; PG8_MMA(1, 1, At, B1); PG8_BAR;
            PG8_LDB(B0, 1, 0); PG8_SCHED; PG8_LDA(At, 1, 0); PG8_STAGE(PG8_SA(0, 1), a2 + hstep, voffA);
            PG8_WAIT_L(8); PG8_BAR; PG8_WAIT_L(0); PG8_MMA(0, 0, At, B0); PG8_BAR; PG8_SCHED;
            PG8_LDB(B1, 1, 1); PG8_STAGE(PG8_SB(1, 0), b3, voffB);
            PG8_BAR; PG8_WAIT_L(0); PG8_MMA(0, 1, At, B1); PG8_BAR;
            PG8_LDA(At, 1, 1); PG8_STAGE(PG8_SA(1, 0), a3, voffA);
            PG8_BAR; PG8_WAIT_L(0); PG8_MMA(1, 0, At, B0); PG8_BAR; PG8_SCHED;
            PG8_STAGE(PG8_SB(1, 1), b3 + hstep, voffB);
            PG8_WAIT_V(6); PG8_BAR; PG8_MMA(1, 1, At, B1); PG8_BAR;
            }
        }
        if constexpr (ALIGN_EPI) { if (wr == 0) PG8_BAR; }
        if constexpr (!Epi::AFTER_DRAIN) { E(acc, cur, wr, wc, fr, fq); S.done(cur); }
        if (!has_next) break;
#pragma unroll
        for (int a = 0; a < 2; ++a)
#pragma unroll
            for (int b = 0; b < 2; ++b)
#pragma unroll
                for (int m = 0; m < 4; ++m)
#pragma unroll
                    for (int n = 0; n < 2; ++n) acc[a][b][m][n] = (f32x4){0.f, 0.f, 0.f, 0.f};
        cur = nxt; cA = nA; cB = nB; ++ui;
        if constexpr (ALIGN_EPI) { if (wr == 1) PG8_BAR; }
    }
    PG8_WAIT_V(0);
    if constexpr (!ALIGN_EPI) { if (wr == 0) PG8_BAR; }
    PG8_BAR;
#undef PG8_SA
#undef PG8_SB
#undef PG8_STAGE
#undef PG8_LDA
#undef PG8_LDB
#undef PG8_MMA
#undef PG8_WAIT_V
#undef PG8_WAIT_L
#undef PG8_BAR
#undef PG8_SCHED
}
}

#define XB_TMO      128
#define XB_XCNT(j)  (256  + 64 * (j))
#define XB_XSUB(j)  (1280 + 64 * (j))
#define XB_XGEN(j)  (2304 + 64 * (j))
#define XB_TOP      3328
#define XB_TOPGEN   3392
#define XCD_BAR_WORDS 3456
#define XB_SPIN_CAP (1u << 21)
#define LAS __attribute__((address_space(3)))

__device__ __forceinline__ unsigned xb_ld(unsigned* p)              { return __hip_atomic_load(p, __ATOMIC_RELAXED, __HIP_MEMORY_SCOPE_AGENT); }
__device__ __forceinline__ unsigned xb_add(unsigned* p, unsigned v) { return __hip_atomic_fetch_add(p, v, __ATOMIC_RELAXED, __HIP_MEMORY_SCOPE_AGENT); }
__device__ __forceinline__ unsigned xb_xcc_id() { return (unsigned)__builtin_amdgcn_s_getreg((3 << 11) | 20) & 0xFu; }
#define XB_SPIN(cond, bar) do { unsigned _sp = 0; while (cond) { __builtin_amdgcn_s_sleep(1); \
    if ((++_sp & 255u) == 0u) { if (xb_ld(&(bar)[XB_TMO])) break; if (_sp > XB_SPIN_CAP) { atomicAdd(&(bar)[XB_TMO], 1u); break; } } } } while (0)

struct XcdBarrier { unsigned* bar; unsigned x; volatile LAS unsigned* st; };

__device__ __forceinline__ XcdBarrier xcd_barrier_post(unsigned* bar, volatile LAS unsigned* st) {
    XcdBarrier b; b.bar = bar; b.x = xb_xcc_id(); b.st = st;
    if (threadIdx.x == 0) (void)xb_add(&bar[XB_XCNT(b.x)], 1u);
    return b;
}
__device__ __forceinline__ void xcd_barrier_complete(unsigned* bar, unsigned x, unsigned& nloc, unsigned& nx) {
    const unsigned G = gridDim.x * gridDim.y * gridDim.z;
    unsigned sum, cnt, mine, sp = 0u;
    for (;;) {
        sum = 0u; cnt = 0u; mine = 0u;
#pragma unroll
        for (unsigned j = 0; j < 16; ++j) { const unsigned c = xb_ld(&bar[XB_XCNT(j)]); sum += c; cnt += (c > 0u) ? 1u : 0u; mine = (j == x) ? c : mine; }
        if (sum == G) break;
        __builtin_amdgcn_s_sleep(1);
        if ((++sp & 255u) == 0u) { if (xb_ld(&bar[XB_TMO])) break; if (sp > XB_SPIN_CAP) { atomicAdd(&bar[XB_TMO], 1u); break; } }
    }
    nloc = mine > 0u ? mine : 1u; nx = cnt > 0u ? cnt : 1u;
}
__device__ __forceinline__ void xcd_barrier(const XcdBarrier& b) {
    asm volatile("s_waitcnt vmcnt(0)" ::: "memory");
    __syncthreads();
    if (threadIdx.x == 0) {
        unsigned* bar = b.bar;
        __builtin_amdgcn_s_waitcnt(0);
        unsigned nloc = b.st[0], nx = b.st[1];
        if (nloc == 0u) { xcd_barrier_complete(bar, b.x, nloc, nx); b.st[0] = nloc; b.st[1] = nx; }
        const unsigned old = xb_add(&bar[XB_XSUB(b.x)], 1u);
        const unsigned gen = old / nloc;
        if (old + 1u == (gen + 1u) * nloc) {
            __builtin_amdgcn_fence(__ATOMIC_RELEASE, "agent");
            asm volatile("s_waitcnt vmcnt(0)" ::: "memory");
            const unsigned og = xb_add(&bar[XB_TOP], 1u);
            const unsigned tg = og / nx;
            if (og + 1u == (tg + 1u) * nx) xb_add(&bar[XB_TOPGEN], 1u);
            else XB_SPIN(xb_ld(&bar[XB_TOPGEN]) == tg, bar);
            __builtin_amdgcn_fence(__ATOMIC_ACQUIRE, "agent");
            xb_add(&bar[XB_XGEN(b.x)], 1u);
            asm volatile("s_waitcnt vmcnt(0)" ::: "memory");
        } else {
            XB_SPIN(xb_ld(&bar[XB_XGEN(b.x)]) == gen, bar);
            __builtin_amdgcn_fence(__ATOMIC_ACQUIRE, "agent");
            asm volatile("s_waitcnt vmcnt(0)" ::: "memory");
        }
    }
    __syncthreads();
}

typedef unsigned short bf16;
typedef float f32x4 __attribute__((ext_vector_type(4)));
typedef unsigned u32x4 __attribute__((ext_vector_type(4)));
typedef unsigned u32x2 __attribute__((ext_vector_type(2)));

constexpr int D = 2048, DFF = 8192, MROWS = 16384, MCTX = 8192;
constexpr int NT = 512;
constexpr float EPS = 1e-6f;
constexpr int DN_NIN = 12416, DN_NMAIN = 12288, DN_NPAD = 12544;
constexpr int GLA_NIN = 6176, GLA_NMAIN = 6144, GLA_NPAD = 6400;
constexpr int HG_NIN = 10240;
constexpr int MODW = 12288;

constexpr size_t MiB = 1u << 20;
constexpr size_t WS_CTL = 0, CTL_BYTES = 1 * MiB;
constexpr size_t WS_MOD = 1 * MiB;
constexpr size_t WS_X = 2 * MiB;
constexpr size_t WS_H = WS_X + 128 * MiB;
constexpr size_t WS_BIG = WS_H + 64 * MiB;
constexpr size_t WS_GATE = WS_BIG + 384 * MiB;
constexpr size_t WS_QKV = WS_GATE + 8 * MiB;
constexpr size_t WS_OF = WS_QKV + 256 * MiB;
constexpr size_t WS_OB = WS_OF + 128 * MiB;
constexpr size_t WS_W = WS_OB + 128 * MiB;
constexpr size_t WOFF_IN = 0, WOFF_OUT = (size_t)DN_NPAD * D * 2, WOFF_UP = WOFF_OUT + (size_t)D * 4096 * 2, WOFF_DOWN = WOFF_UP + (size_t)DFF * D * 2;
constexpr size_t WS_TA = ((WS_W + WOFF_DOWN + (size_t)D * DFF * 2 + MiB - 1) / MiB) * MiB;
constexpr size_t WS_GS = WS_TA + 256 * MiB;
constexpr size_t WS_GP = WS_GS + 12 * MiB;
constexpr size_t WS_END = WS_GP + 32 * MiB;

constexpr size_t OUT_Y = 0;
constexpr size_t OUT_SDN = (size_t)MROWS * D;
constexpr size_t OUT_SGLA = OUT_SDN + (size_t)32 * 2 * 2 * 32 * 128 * 128;
constexpr size_t OUT_SHG = OUT_SGLA + (size_t)32 * 2 * 4 * 256 * 512;
constexpr size_t OUT_END = OUT_SHG + (size_t)32 * 2 * 16 * 128 * 128;

constexpr int LDS_BYTES = 151552;
constexpr int LDS_MISC = 150528;

struct Params {
    const float* in[29];
    float* out;
    unsigned char* ws;
};

__device__ __forceinline__ float bf2f(unsigned short b) { return __uint_as_float(((unsigned)b) << 16); }
typedef __bf16 bfv2_ __attribute__((ext_vector_type(2)));
typedef float f32x2_ __attribute__((ext_vector_type(2)));
__device__ __forceinline__ unsigned f2bf(float f) { return (unsigned)__builtin_bit_cast(unsigned short, (__bf16)f); }
__device__ __forceinline__ unsigned pk2(float lo, float hi) { const f32x2_ v = {lo, hi}; return __builtin_bit_cast(unsigned, __builtin_convertvector(v, bfv2_)); }
__device__ __forceinline__ float bflo(unsigned w) { return __uint_as_float(w << 16); }
__device__ __forceinline__ float bfhi(unsigned w) { return __uint_as_float(w & 0xffff0000u); }
__device__ __forceinline__ float wave_sum(float v) {
#pragma unroll
    for (int o = 1; o < 64; o <<= 1) v += __shfl_xor(v, o);
    return v;
}
__device__ __forceinline__ float rdlane(float v, int l) { return __builtin_bit_cast(float, __builtin_amdgcn_readlane(__builtin_bit_cast(int, v), l)); }
__device__ __forceinline__ float sigmoidf_(float x) { return __builtin_amdgcn_rcpf(1.f + __expf(-x)); }
__device__ __forceinline__ float siluf_(float x) { return x * __builtin_amdgcn_rcpf(1.f + __expf(-x)); }
__device__ __forceinline__ float softplusf_(float x) { return fmaxf(x, 0.f) + log1pf(__expf(-fabsf(x))); }

__device__ __forceinline__ void transpose_item(const float* W, int K, int N, bf16* WT, LAS float* scr, int item, int lane) {
    const int nblk = N / 32, kb = item / nblk, nb = item % nblk, k0 = 64 * kb, n0 = 32 * nb;
    { f32x4 v[8]; const int kr = lane >> 3, c4 = (lane & 7) * 4;
#pragma unroll
      for (int i = 0; i < 8; ++i) v[i] = *(const f32x4*)(W + (size_t)(k0 + kr + 8 * i) * N + n0 + c4);
#pragma unroll
      for (int i = 0; i < 8; ++i) { LAS float* d = scr + (kr + 8 * i) * 33 + c4; d[0] = v[i].x; d[1] = v[i].y; d[2] = v[i].z; d[3] = v[i].w; } }
    asm volatile("s_waitcnt lgkmcnt(0)" ::: "memory");
    const int c = lane & 7;
#pragma unroll
    for (int j = 0; j < 4; ++j) { const int n = (lane >> 3) + 8 * j; const LAS float* s = scr + (8 * c) * 33 + n;
        u32x4 o; o.x = pk2(s[0 * 33], s[1 * 33]); o.y = pk2(s[2 * 33], s[3 * 33]); o.z = pk2(s[4 * 33], s[5 * 33]); o.w = pk2(s[6 * 33], s[7 * 33]);
        *(u32x4*)(WT + (size_t)(n0 + n) * K + k0 + 8 * c) = o; }
    asm volatile("s_waitcnt lgkmcnt(0)" ::: "memory");
}

__device__ __forceinline__ void convert_layer_weights(const Params& P, int layer, LAS unsigned char* lds) {
    PHASE_IDS();
    LAS float* scr = (LAS float*)(lds + wave * 16384);
    const int kind = layer % 3, j = layer / 3;
    const float* Win; int Nin, Npad; const float* Wout; int Kout;
    if (kind == 0) { Win = P.in[14] + (size_t)j * D * DN_NIN; Nin = DN_NIN; Npad = DN_NPAD; Wout = P.in[19] + (size_t)j * 4096 * D; Kout = 4096; }
    else if (kind == 1) { Win = P.in[20] + (size_t)j * D * GLA_NIN; Nin = GLA_NIN; Npad = GLA_NPAD; Wout = P.in[24] + (size_t)j * D * D; Kout = 2048; }
    else { Win = P.in[25] + (size_t)j * D * HG_NIN; Nin = HG_NIN; Npad = HG_NIN; Wout = P.in[28] + (size_t)j * D * D; Kout = 2048; }
    const float* Wup = P.in[12] + (size_t)layer * D * DFF; const float* Wdn = P.in[13] + (size_t)layer * DFF * D;
    bf16* Tin = (bf16*)(P.ws + WS_W + WOFF_IN); bf16* Tout = (bf16*)(P.ws + WS_W + WOFF_OUT); bf16* Tup = (bf16*)(P.ws + WS_W + WOFF_UP); bf16* Tdn = (bf16*)(P.ws + WS_W + WOFF_DOWN);
    const int I_in = (D / 64) * (Nin / 32), I_out = (Kout / 64) * (D / 32), I_up = (D / 64) * (DFF / 32), I_dn = (DFF / 64) * (D / 32);
    const int NI = I_in + I_out + I_up + I_dn;
    for (int it = gw; it < NI; it += NGW) {
        int r = it;
        if (r < I_in) { transpose_item(Win, D, Nin, Tin, scr, r, lane); continue; } r -= I_in;
        if (r < I_out) { transpose_item(Wout, Kout, D, Tout, scr, r, lane); continue; } r -= I_out;
        if (r < I_up) { transpose_item(Wup, D, DFF, Tup, scr, r, lane); continue; } r -= I_up;
        transpose_item(Wdn, DFF, D, Tdn, scr, r, lane);
    }
    const int npadrows = Npad - Nin;
    if (npadrows > 0) {
        u32x4* z = (u32x4*)(Tin + (size_t)Nin * D); const int n16 = npadrows * D / 8;
        for (int i = gw * 64 + lane; i < n16; i += NGW * 64) z[i] = (u32x4){0u, 0u, 0u, 0u};
    }
}

__device__ __forceinline__ void mod_phase(const Params& P, LAS unsigned char* lds) {
    PHASE_IDS();
    LAS float* scond = (LAS float*)lds;
    LAS float* red = (LAS float*)(lds + 40960 + 1024);
    for (int i = tid; i < 5 * 2048; i += NT) { const int g = i / 2048, k = i % 2048; const float v = g == 0 ? P.in[6][k] : P.in[2][(g - 1) * 2048 + k]; scond[k * 5 + g] = siluf_(v); }
    __syncthreads();
    float* mod = (float*)(P.ws + WS_MOD);
    const int c4 = tid & 15, kg = tid >> 4;
    for (int cg = blockIdx.x; cg < 4 * MODW / 64; cg += gridDim.x) {
        const int layer = cg / (MODW / 64), colbase = (cg % (MODW / 64)) * 64;
        const float* W = P.in[7] + (size_t)layer * D * MODW + colbase + c4 * 4;
        f32x4 acc[5];
#pragma unroll
        for (int g = 0; g < 5; ++g) acc[g] = (f32x4){0.f, 0.f, 0.f, 0.f};
#pragma unroll 8
        for (int kk = 0; kk < 64; ++kk) {
            const int k = kg * 64 + kk;
            const f32x4 w = *(const f32x4*)(W + (size_t)k * MODW);
#pragma unroll
            for (int g = 0; g < 5; ++g) acc[g] += w * scond[k * 5 + g];
        }
#pragma unroll
        for (int g = 0; g < 5; ++g)
#pragma unroll
            for (int e = 0; e < 4; ++e) red[(kg * 64 + c4 * 4 + e) * 5 + g] = acc[g][e];
        __syncthreads();
        if (tid < 64 * 5) { const int c = tid / 5, g = tid % 5; float sum = 0.f;
#pragma unroll 8
            for (int q = 0; q < 32; ++q) sum += red[(q * 64 + c) * 5 + g];
            mod[((size_t)layer * 5 + g) * MODW + colbase + c] = sum + P.in[8][(size_t)layer * MODW + colbase + c]; }
        __syncthreads();
    }
}

template <bool XF32> __device__ __forceinline__ void norm_mod_phase(const void* xc, const void* xl, const float* w, const float* mod, int sh_off, int sc_off, bf16* H) {
    PHASE_IDS();
    for (int m = gw; m < MROWS; m += NGW) {
        const bool ctx = m < MCTX; const int grp = ctx ? 0 : 1 + ((m - MCTX) >> 11);
        f32x4 v[8]; float ss = 0.f;
        if (XF32) { const float* xr = ctx ? (const float*)xc + (size_t)m * D : (const float*)xl + (size_t)(m - MCTX) * D;
#pragma unroll
            for (int jx = 0; jx < 4; ++jx) { v[2 * jx] = *(const f32x4*)(xr + 8 * (lane + 64 * jx)); v[2 * jx + 1] = *(const f32x4*)(xr + 8 * (lane + 64 * jx) + 4); } }
        else { const bf16* xr = (const bf16*)xc + (size_t)m * D;
#pragma unroll
            for (int jx = 0; jx < 4; ++jx) { const u32x4 q = *(const u32x4*)(xr + 8 * (lane + 64 * jx));
                v[2 * jx] = (f32x4){bflo(q.x), bfhi(q.x), bflo(q.y), bfhi(q.y)}; v[2 * jx + 1] = (f32x4){bflo(q.z), bfhi(q.z), bflo(q.w), bfhi(q.w)}; } }
#pragma unroll
        for (int i = 0; i < 8; ++i) ss += (v[i].x * v[i].x + v[i].y * v[i].y) + (v[i].z * v[i].z + v[i].w * v[i].w);
        const float rstd = rsqrtf(wave_sum(ss) * (1.f / D) + EPS);
        const float* mg = mod + (size_t)grp * MODW;
#pragma unroll
        for (int jx = 0; jx < 4; ++jx) { const int c = 8 * (lane + 64 * jx);
            const f32x4 y0 = v[2 * jx] * rstd * *(const f32x4*)(w + c) * (*(const f32x4*)(mg + sc_off + c) + 1.f) + *(const f32x4*)(mg + sh_off + c);
            const f32x4 y1 = v[2 * jx + 1] * rstd * *(const f32x4*)(w + c + 4) * (*(const f32x4*)(mg + sc_off + c + 4) + 1.f) + *(const f32x4*)(mg + sh_off + c + 4);
            u32x4 o; o.x = pk2(y0.x, y0.y); o.y = pk2(y0.z, y0.w); o.z = pk2(y1.x, y1.y); o.w = pk2(y1.z, y1.w);
            *(u32x4*)(H + (size_t)m * D + c) = o; }
    }
}
__device__ __forceinline__ void final_norm_phase(const bf16* X, const float* w, float* out) {
    PHASE_IDS();
    for (int m = gw; m < MROWS; m += NGW) {
        f32x4 v[8]; float ss = 0.f;
#pragma unroll
        for (int jx = 0; jx < 4; ++jx) { const u32x4 q = *(const u32x4*)(X + (size_t)m * D + 8 * (lane + 64 * jx));
            v[2 * jx] = (f32x4){bflo(q.x), bfhi(q.x), bflo(q.y), bfhi(q.y)}; v[2 * jx + 1] = (f32x4){bflo(q.z), bfhi(q.z), bflo(q.w), bfhi(q.w)}; }
#pragma unroll
        for (int i = 0; i < 8; ++i) ss += (v[i].x * v[i].x + v[i].y * v[i].y) + (v[i].z * v[i].z + v[i].w * v[i].w);
        const float rstd = rsqrtf(wave_sum(ss) * (1.f / D) + EPS);
#pragma unroll
        for (int jx = 0; jx < 4; ++jx) { const int c = 8 * (lane + 64 * jx);
            *(f32x4*)(out + (size_t)m * D + c) = v[2 * jx] * rstd * *(const f32x4*)(w + c); *(f32x4*)(out + (size_t)m * D + c + 4) = v[2 * jx + 1] * rstd * *(const f32x4*)(w + c + 4); }
    }
}

template <int DV> __device__ __forceinline__ void gate_phase(const bf16* OF, const bf16* OB, const bf16* proj, int ldp, int gcol0, const float* nw, bf16* Y, int W) {
    PHASE_IDS();
    const int ncg = W / 512;
    const int nitems = MROWS * ncg;
    for (int it0 = gw; it0 < nitems; it0 += 2 * NGW) {
        u32x4 a[2], b[2], gz[2]; int mm[2], cc[2]; bool ok[2];
#pragma unroll
        for (int u = 0; u < 2; ++u) { const int it = it0 + u * NGW; ok[u] = it < nitems; const int itc = ok[u] ? it : it0; mm[u] = itc / ncg; cc[u] = (itc % ncg) * 512 + lane * 8;
            a[u] = *(const u32x4*)(OF + (size_t)mm[u] * W + cc[u]); b[u] = *(const u32x4*)(OB + (size_t)mm[u] * W + cc[u]); gz[u] = *(const u32x4*)(proj + (size_t)mm[u] * ldp + gcol0 + cc[u]); }
#pragma unroll
        for (int u = 0; u < 2; ++u) {
            float o[8], z[8];
            o[0] = bflo(a[u].x) + bflo(b[u].x); o[1] = bfhi(a[u].x) + bfhi(b[u].x); o[2] = bflo(a[u].y) + bflo(b[u].y); o[3] = bfhi(a[u].y) + bfhi(b[u].y);
            o[4] = bflo(a[u].z) + bflo(b[u].z); o[5] = bfhi(a[u].z) + bfhi(b[u].z); o[6] = bflo(a[u].w) + bflo(b[u].w); o[7] = bfhi(a[u].w) + bfhi(b[u].w);
            z[0] = bflo(gz[u].x); z[1] = bfhi(gz[u].x); z[2] = bflo(gz[u].y); z[3] = bfhi(gz[u].y); z[4] = bflo(gz[u].z); z[5] = bfhi(gz[u].z); z[6] = bflo(gz[u].w); z[7] = bfhi(gz[u].w);
            float ss = 0.f;
#pragma unroll
            for (int i = 0; i < 8; ++i) ss += o[i] * o[i];
#pragma unroll
            for (int sft = 1; sft < DV / 8; sft <<= 1) ss += __shfl_xor(ss, sft);
            const float rstd = rsqrtf(ss * (1.f / DV) + EPS);
            const int cw = cc[u] % DV;
            const f32x4 w0 = *(const f32x4*)(nw + cw), w1 = *(const f32x4*)(nw + cw + 4);
            const float wv[8] = {w0.x, w0.y, w0.z, w0.w, w1.x, w1.y, w1.z, w1.w};
            float y[8];
#pragma unroll
            for (int i = 0; i < 8; ++i) y[i] = o[i] * rstd * wv[i] * siluf_(z[i]);
            u32x4 rr; rr.x = pk2(y[0], y[1]); rr.y = pk2(y[2], y[3]); rr.z = pk2(y[4], y[5]); rr.w = pk2(y[6], y[7]);
            if (ok[u]) *(u32x4*)(Y + (size_t)mm[u] * W + cc[u]) = rr;
        }
    }
}

__device__ __forceinline__ void dn_prep_phase(const Params& P, int j, bool do_gates = true) {
    PHASE_IDS();
    const bf16* proj = (const bf16*)(P.ws + WS_BIG); bf16* QKV = (bf16*)(P.ws + WS_QKV);
    const float* cw = P.in[15] + (size_t)j * 5 * 8192;
    for (int it = gw; it < 16 * 128; it += NGW) {
        const int cg = it & 15, chunk = it >> 4, c = cg * 512 + lane * 8;
        float w[5][8];
#pragma unroll
        for (int s = 0; s < 5; ++s) { const f32x4 a = *(const f32x4*)(cw + s * 8192 + c), b = *(const f32x4*)(cw + s * 8192 + c + 4);
            w[s][0] = a.x; w[s][1] = a.y; w[s][2] = a.z; w[s][3] = a.w; w[s][4] = b.x; w[s][5] = b.y; w[s][6] = b.z; w[s][7] = b.w; }
        const float qsc = cg < 4 ? 0.08838834764831845f : 1.f;
        for (int bt = 0; bt < 16; ++bt) {
            const int r0 = chunk * 128 + bt * 8;
            const int L = r0 < MCTX ? 256 : 64, pos0 = r0 < MCTX ? (r0 & 255) : ((r0 - MCTX) & 63);
            u32x4 xw[12];
#pragma unroll
            for (int i = 0; i < 12; ++i) { const int pp = pos0 + i - 2;
                xw[i] = (pp >= 0 && pp < L) ? *(const u32x4*)(proj + (size_t)(r0 + i - 2) * DN_NMAIN + c) : (u32x4){0u, 0u, 0u, 0u}; }
#pragma unroll
            for (int o = 0; o < 8; ++o) {
                float acc[8];
#pragma unroll
                for (int i = 0; i < 8; ++i) acc[i] = 0.f;
#pragma unroll
                for (int s = 0; s < 5; ++s) { const u32x4 x = xw[o + s];
                    acc[0] += bflo(x.x) * w[s][0]; acc[1] += bfhi(x.x) * w[s][1]; acc[2] += bflo(x.y) * w[s][2]; acc[3] += bfhi(x.y) * w[s][3];
                    acc[4] += bflo(x.z) * w[s][4]; acc[5] += bfhi(x.z) * w[s][5]; acc[6] += bflo(x.w) * w[s][6]; acc[7] += bfhi(x.w) * w[s][7]; }
                float ss = 0.f;
#pragma unroll
                for (int i = 0; i < 8; ++i) { acc[i] = siluf_(acc[i]); ss += acc[i] * acc[i]; }
                if (cg < 8) {
                    ss += __shfl_xor(ss, 1); ss += __shfl_xor(ss, 2); ss += __shfl_xor(ss, 4); ss += __shfl_xor(ss, 8);
                    const float sc = rsqrtf(ss + EPS) * qsc;
#pragma unroll
                    for (int i = 0; i < 8; ++i) acc[i] *= sc;
                }
                u32x4 ov; ov.x = pk2(acc[0], acc[1]); ov.y = pk2(acc[2], acc[3]); ov.z = pk2(acc[4], acc[5]); ov.w = pk2(acc[6], acc[7]);
                *(u32x4*)(QKV + (size_t)(r0 + o) * 8192 + c) = ov;
            }
        }
    }
    if (!do_gates) return;
    float* G = (float*)(P.ws + WS_GATE);
    const float* Alog = P.in[16] + j * 64; const float* dtb = P.in[17] + j * 64;
    const float* GPp = (const float*)(P.ws + WS_GP);
    for (int i = gw * 64 + lane; i < MROWS * 128; i += NGW * 64) {
        const int col = i & 127; const float x = (GPp[i] + GPp[i + (size_t)MROWS * 128]) + (GPp[i + (size_t)2 * MROWS * 128] + GPp[i + (size_t)3 * MROWS * 128]); float y;
        if (col < 64) y = sigmoidf_(x);
        else { const int dh = col - 64; y = -__expf(Alog[dh]) * softplusf_(x + dtb[dh]); }
        G[i] = y;
    }
}

typedef short bf16x8 __attribute__((ext_vector_type(8)));
typedef short s16x4 __attribute__((ext_vector_type(4)));
typedef __bf16 bfv8 __attribute__((ext_vector_type(8)));
typedef float f32x8 __attribute__((ext_vector_type(8)));
__device__ __forceinline__ bf16x8 pack8(f32x4 a, f32x4 b) { const f32x8 v = {a[0], a[1], a[2], a[3], b[0], b[1], b[2], b[3]}; return __builtin_bit_cast(bf16x8, __builtin_convertvector(v, bfv8)); }
__device__ __forceinline__ bf16x8 cat4(s16x4 a, s16x4 b) { return (bf16x8){a[0], a[1], a[2], a[3], b[0], b[1], b[2], b[3]}; }
__device__ __forceinline__ s16x4 ld_tr(const LAS unsigned char* p) { return __builtin_amdgcn_ds_read_tr16_b64_v4i16((LAS s16x4*)p); }
__device__ __forceinline__ s16x4 ld_b64(const LAS unsigned char* p) { return *(const volatile LAS s16x4*)p; }
__device__ __forceinline__ bf16x8 ld_b128(const LAS unsigned char* p) { return *(const LAS bf16x8*)p; }
#define MFMA16(a, b, c) __builtin_amdgcn_mfma_f32_16x16x32_bf16((a), (b), (c), 0, 0, 0)

template <int KIND> __device__ __forceinline__ void gla_prep_phase(const Params& P, LAS unsigned char* lds) {
    PHASE_IDS();
    constexpr int NCH = KIND == 1 ? 1024 : 2048, LDP = KIND == 1 ? GLA_NMAIN : HG_NIN, NCB = NCH / 1024;
    const bf16* proj = (const bf16*)(P.ws + WS_BIG); const float* G = (const float*)(P.ws + WS_GATE);
    bf16* QT = (bf16*)(P.ws + WS_QKV); bf16* KT = QT + (size_t)2 * MROWS * NCH; float* E = (float*)(P.ws + WS_OF + 64 * MiB);
    constexpr int DKH = KIND == 1 ? 256 : 128, NHB = 1024 / DKH  , NHT = NCH / DKH  , PL = 2064  ;
    LAS unsigned char* QL = lds; LAS unsigned char* KL = lds + 32 * PL;
    LAS float* sa1 = (LAS float*)(lds + 2 * 32 * PL);
    unsigned* PG = (unsigned*)(P.ws + WS_OF + 72 * MiB);
    for (int it = blockIdx.x; it < 2 * 512 * NCB; it += gridDim.x) {
        const int cb_ = it % NCB, cidx = (it / NCB) % 512, d = it / (NCB * 512);
        const int c0 = cb_ * 1024 + 2 * tid, rbase = cidx * 32;
        float w0[16], w1[16], b0 = 0.f, b1 = 0.f, lb0 = 0.f, lb1 = 0.f;
        if (KIND == 1) {
            __syncthreads();
            { const int p = tid >> 4, r = tid & 15; const int row = rbase + (d ? 31 - p : p); const size_t gi = (size_t)row * 128 + d * 16 + r; const float* GPp = (const float*)(P.ws + WS_GP); sa1[tid] = (GPp[gi] + GPp[gi + (size_t)MROWS * 128]) + (GPp[gi + (size_t)2 * MROWS * 128] + GPp[gi + (size_t)3 * MROWS * 128]); }
            __syncthreads();
            const float* w2 = P.in[21] + (size_t)d * 16 * 1024 + c0;
#pragma unroll
            for (int r = 0; r < 16; ++r) { w0[r] = w2[(size_t)r * 1024]; w1[r] = w2[(size_t)r * 1024 + 1]; }
            b0 = P.in[22][d * 1024 + c0]; b1 = P.in[22][d * 1024 + c0 + 1];
        } else {
            const float* lg = P.in[26];
            { const float l0 = lg[c0], l1 = lg[2048 + c0], l2 = lg[4096 + c0], l3 = lg[6144 + c0]; const float mx = fmaxf(fmaxf(l0, l1), fmaxf(l2, l3));
              const float e0 = __expf(l0 - mx), e1 = __expf(l1 - mx), e2 = __expf(l2 - mx), e3 = __expf(l3 - mx); lb0 = (e1 + e2) / ((e0 + e1) + (e2 + e3)); }
            { const float l0 = lg[c0 + 1], l1 = lg[2048 + c0 + 1], l2 = lg[4096 + c0 + 1], l3 = lg[6144 + c0 + 1]; const float mx = fmaxf(fmaxf(l0, l1), fmaxf(l2, l3));
              const float e0 = __expf(l0 - mx), e1 = __expf(l1 - mx), e2 = __expf(l2 - mx), e3 = __expf(l3 - mx); lb1 = (e1 + e2) / ((e0 + e1) + (e2 + e3)); }
        }
        float cs0 = KIND == 1 ? 0.f : 1.f, cs1 = cs0;
#pragma unroll 8
        for (int p = 0; p < 32; ++p) {
            const int row = rbase + (d ? 31 - p : p); const bf16* pr = proj + (size_t)row * LDP;
            float q0, q1, k0, k1, la0, la1;
            if (KIND == 1) {
                const unsigned qw = *(const unsigned*)(pr + c0), kw = *(const unsigned*)(pr + 1024 + c0);
                q0 = bflo(qw) * 0.0625f; q1 = bfhi(qw) * 0.0625f; k0 = bflo(kw); k1 = bfhi(kw);
                float x0 = b0, x1 = b1;
#pragma unroll
                for (int r = 0; r < 16; ++r) { const float a = sa1[p * 16 + r]; x0 = __builtin_fmaf(a, w0[r], x0); x1 = __builtin_fmaf(a, w1[r], x1); }
                la0 = (fminf(x0, 0.f) - __logf(1.f + __expf(-fabsf(x0)))) * 0.0625f; la1 = (fminf(x1, 0.f) - __logf(1.f + __expf(-fabsf(x1)))) * 0.0625f;
            } else {
                const unsigned qw = *(const unsigned*)(pr + c0), fw = *(const unsigned*)(pr + (d ? 8192 : 6144) + c0);
                q0 = siluf_(bflo(qw)) * 0.08838834764831845f; q1 = siluf_(bfhi(qw)) * 0.08838834764831845f;
                const float a0 = lb0 + (1.f - lb0) * sigmoidf_(bflo(fw)), a1 = lb1 + (1.f - lb1) * sigmoidf_(bfhi(fw));
                k0 = 1.f - a0; k1 = 1.f - a1; la0 = a0; la1 = a1;
            }
            float e0, e1, i0, i1;
            if (KIND == 1) { cs0 += la0; cs1 += la1; e0 = __expf(cs0); e1 = __expf(cs1); i0 = __expf(-cs0); i1 = __expf(-cs1); }
            else { cs0 *= la0; cs1 *= la1; e0 = cs0; e1 = cs1; i0 = __builtin_amdgcn_rcpf(cs0); i1 = __builtin_amdgcn_rcpf(cs1); }
            const size_t o = ((size_t)d * MROWS + row) * NCH + c0;
            const unsigned qb = pk2(q0 * e0, q1 * e1), kb = pk2(k0 * i0, k1 * i1);
            *(unsigned*)(QT + o) = qb; *(unsigned*)(KT + o) = kb;
            *(LAS unsigned*)(QL + p * PL + 4 * tid) = qb; *(LAS unsigned*)(KL + p * PL + 4 * tid) = kb;
        }
        { float* e = E + ((size_t)d * 512 + cidx) * NCH + c0; e[0] = KIND == 1 ? __expf(cs0) : cs0; e[1] = KIND == 1 ? __expf(cs1) : cs1; }
        __syncthreads();
        {
            const int r = lane & 15, g = lane >> 4;
            const int hl = KIND == 1 ? (wave >> 1) : wave; const int cbase = hl * DKH;
            f32x4 t0 = {0.f, 0.f, 0.f, 0.f}, t1 = t0, t2 = t0;
            const bool do02 = KIND == 1 ? ((wave & 1) == 0) : true, do1 = KIND == 1 ? ((wave & 1) == 1) : true;
#pragma unroll
            for (int sx = 0; sx < DKH / 32; ++sx) {
                const int cb2 = (cbase + 32 * sx + 8 * g) * 2;
                const bf16x8 k0 = ld_b128(KL + r * PL + cb2), q1 = ld_b128(QL + (16 + r) * PL + cb2);
                if (do02) { const bf16x8 q0 = ld_b128(QL + r * PL + cb2), k1 = ld_b128(KL + (16 + r) * PL + cb2); t0 = MFMA16(k0, q0, t0); t2 = MFMA16(k1, q1, t2); }
                if (do1) t1 = MFMA16(k0, q1, t1);
            }
#pragma unroll
            for (int e = 0; e < 4; ++e) { if (r < 4 * g + e) { t0[e] = 0.f; t2[e] = 0.f; } }
            unsigned* pg = PG + (((size_t)d * 512 + cidx) * NHT + cb_ * NHB + hl) * 384 + lane * 2;
            if (do02) { pg[0] = pk2(t0[0], t0[1]); pg[1] = pk2(t0[2], t0[3]); pg[256] = pk2(t2[0], t2[1]); pg[257] = pk2(t2[2], t2[3]); }
            if (do1) { pg[128] = pk2(t1[0], t1[1]); pg[129] = pk2(t1[2], t1[3]); }
        }
        __syncthreads();
    }
}

template <int KIND> __device__ __forceinline__ void gla_chunk_phase(const Params& P, LAS unsigned char* lds) {
    PHASE_IDS();
    constexpr int DK = KIND == 1 ? 256 : 128, DV = KIND == 1 ? 512 : 128, NH = KIND == 1 ? 4 : 16, NSL = DV / 128, NKT = DK / 16, NCH = NH * DK;
    constexpr int LDP = KIND == 1 ? GLA_NMAIN : HG_NIN, W = 2048;
    constexpr int PQ = DK * 2 + 16, PV = 256 + 16;
    constexpr int OFF_Q = 0, OFF_K = 32 * PQ, OFF_V = 2 * 32 * PQ, OFF_E = OFF_V + 32 * PV;
    constexpr int NPQ = 32 * DK / 8 / NT;
    const bf16* proj = (const bf16*)(P.ws + WS_BIG);
    const bf16* QT = (const bf16*)(P.ws + WS_QKV); const bf16* KT = QT + (size_t)2 * MROWS * NCH; const float* Eg = (const float*)(P.ws + WS_OF + 64 * MiB);
    bf16* OF = (bf16*)(P.ws + WS_OF); bf16* OB = (bf16*)(P.ws + WS_OB);
    const u32x2* PG = (const u32x2*)(P.ws + WS_OF + 72 * MiB);
    const int r = lane & 15, g = lane >> 4, q4 = (lane & 15) >> 2, p4 = lane & 3;
    constexpr int UL = 4 * NH * 2 * NSL  , UC = 32 * NH * 2 * NSL  ;
    const int G = gridDim.x, bx = blockIdx.x;
    const bool bal = (G == 2 * UL);
    const int nun = bal ? (bx < UL ? 1 : UC / UL) : (UL + UC - bx + G - 1) / G;
    for (int ui = 0; ui < nun; ++ui) {
        const int bxl = bx < UL ? bx : bx - UL;
        const int bxq = (bal && NSL == 4) ? (((bxl & 7) + 8 * (bxl >> 5)) * 4 + ((bxl >> 3) & 3)) : bxl;
        const int unit = bal ? (bx < UL ? bxq : UL + bxq + UL * ui) : bx + ui * G;
        const bool lat = unit < UL; int u2 = lat ? unit : unit - UL;
        const int sl = u2 % NSL; u2 /= NSL; const int d = u2 & 1; u2 >>= 1; const int h = u2 % NH; const int b = u2 / NH;
        const int T = lat ? 2048 : 256, row0 = lat ? MCTX + b * 2048 : b * 256, nchunk = T / 32;
        bf16* O = d ? OB : OF;
        f32x4 S[NKT];
        { const float* s0 = (KIND == 1 ? P.in[4] : P.in[5]) + ((((size_t)b * 2 + d) * NH + h) * DK) * DV + sl * 128 + 16 * wave + r;
#pragma unroll
          for (int kt = 0; kt < NKT; ++kt)
#pragma unroll
              for (int e = 0; e < 4; ++e) S[kt][e] = lat ? s0[(size_t)(16 * kt + 4 * g + e) * DV] : 0.f; }
        u32x4 rq[NPQ], rk[NPQ], rv; f32x4 re = {0.f, 0.f, 0.f, 0.f}; u32x2 rp0 = {0u, 0u}, rp1 = rp0, rp2 = rp0;
#define GLC_PREFETCH(c_) do { \
            _Pragma("unroll") for (int x = 0; x < NPQ; ++x) { const int pi = tid + x * NT, pr = pi / (DK / 8), pc = pi % (DK / 8); const int pp = (c_) * 32 + pr; const int t = d ? T - 1 - pp : pp; \
                const size_t o = ((size_t)d * MROWS + row0 + t) * NCH + h * DK + pc * 8; rq[x] = *(const u32x4*)(QT + o); rk[x] = *(const u32x4*)(KT + o); } \
            { const int pr = tid >> 4, pc = tid & 15; const int pp = (c_) * 32 + pr; const int t = d ? T - 1 - pp : pp; rv = *(const u32x4*)(proj + (size_t)(row0 + t) * LDP + 2048 + h * DV + sl * 128 + pc * 8); } \
            { const int cg = d ? (row0 + T) / 32 - 1 - (c_) : row0 / 32 + (c_); if (tid < DK / 4) re = *(const f32x4*)(Eg + ((size_t)d * 512 + cg) * NCH + h * DK + tid * 4); \
              const u32x2* pg = PG + (((size_t)d * 512 + cg) * NH + h) * 192 + lane; rp0 = pg[0]; rp1 = pg[64]; rp2 = pg[128]; } } while (0)
        GLC_PREFETCH(0);
        for (int c = 0; c < nchunk; ++c) {
            __syncthreads();
#pragma unroll
            for (int x = 0; x < NPQ; ++x) { const int pi = tid + x * NT, pr = pi / (DK / 8), pc = pi % (DK / 8);
                *(LAS u32x4*)(lds + OFF_Q + pr * PQ + pc * 16) = rq[x]; *(LAS u32x4*)(lds + OFF_K + pr * PQ + pc * 16) = rk[x]; }
            { const int pr = tid >> 4, pc = tid & 15; *(LAS u32x4*)(lds + OFF_V + pr * PV + pc * 16) = rv; }
            if (tid < DK / 4) *(LAS f32x4*)(lds + OFF_E + tid * 16) = re;
            __syncthreads();
            const u32x2 cp0 = rp0, cp1 = rp1, cp2 = rp2;
            if (c + 1 < nchunk) GLC_PREFETCH(c + 1);
            const f32x4 zero4 = {0.f, 0.f, 0.f, 0.f};
            const bf16x8 vpa = cat4(ld_tr(lds + OFF_V + (4 * g + q4) * PV + (16 * wave + 4 * p4) * 2), ld_tr(lds + OFF_V + (16 + 4 * g + q4) * PV + (16 * wave + 4 * p4) * 2));
            const bf16x8 pb0 = __builtin_bit_cast(bf16x8, (u32x4){cp0.x, cp0.y, 0u, 0u}), pb1 = __builtin_bit_cast(bf16x8, (u32x4){cp1.x, cp1.y, cp2.x, cp2.y});
            f32x4 o0 = MFMA16(vpa, pb0, zero4), o1 = MFMA16(vpa, pb1, zero4);
#pragma unroll
            for (int s = 0; s < DK / 32; ++s) {
                const bf16x8 sb = pack8(S[2 * s], S[2 * s + 1]);
                const bf16x8 a0 = cat4(ld_b64(lds + OFF_Q + r * PQ + (32 * s + 4 * g) * 2), ld_b64(lds + OFF_Q + r * PQ + (32 * s + 16 + 4 * g) * 2));
                const bf16x8 a1 = cat4(ld_b64(lds + OFF_Q + (16 + r) * PQ + (32 * s + 4 * g) * 2), ld_b64(lds + OFF_Q + (16 + r) * PQ + (32 * s + 16 + 4 * g) * 2));
                o0 = MFMA16(sb, a0, o0); o1 = MFMA16(sb, a1, o1);
                if (KIND == 1 && (s & 3) == 3) asm volatile("" ::: "memory");
            }
            { const int colo = h * DV + sl * 128 + 16 * wave + 4 * g; const int pp0 = c * 32 + r, pp1 = c * 32 + 16 + r; const int t0 = d ? T - 1 - pp0 : pp0, t1 = d ? T - 1 - pp1 : pp1;
              u32x2 w0, w1; w0.x = pk2(o0[0], o0[1]); w0.y = pk2(o0[2], o0[3]); w1.x = pk2(o1[0], o1[1]); w1.y = pk2(o1[2], o1[3]);
              *(u32x2*)(O + (size_t)(row0 + t0) * W + colo) = w0; *(u32x2*)(O + (size_t)(row0 + t1) * W + colo) = w1; }
            const bf16x8 vb = cat4(ld_tr(lds + OFF_V + (8 * g + q4) * PV + (16 * wave + 4 * p4) * 2), ld_tr(lds + OFF_V + (8 * g + 4 + q4) * PV + (16 * wave + 4 * p4) * 2));
#pragma unroll
            for (int kt = 0; kt < NKT; ++kt) {
                const bf16x8 ka = cat4(ld_tr(lds + OFF_K + (8 * g + q4) * PQ + (16 * kt + 4 * p4) * 2), ld_tr(lds + OFF_K + (8 * g + 4 + q4) * PQ + (16 * kt + 4 * p4) * 2));
                const f32x4 ev = *(const LAS f32x4*)(lds + OFF_E + (16 * kt + 4 * g) * 4);
                S[kt] = MFMA16(ka, vb, S[kt]) * ev;
                if (KIND == 1 && (kt & 7) == 7) asm volatile("" ::: "memory");
            }
        }
#undef GLC_PREFETCH
        if (!lat) { float* sd = P.out + (KIND == 1 ? OUT_SGLA : OUT_SHG) + ((((size_t)b * 2 + d) * NH + h) * DK) * DV + sl * 128 + 16 * wave + r;
#pragma unroll
            for (int kt = 0; kt < NKT; ++kt)
#pragma unroll
                for (int e = 0; e < 4; ++e) sd[(size_t)(16 * kt + 4 * g + e) * DV] = S[kt][e]; }
    }
}

#define MFMA4F(a, b, c) __builtin_amdgcn_mfma_f32_16x16x4f32((a), (b), (c), 0, 0, 0)
template <int I> __device__ __forceinline__ float row_share(float v) { return __builtin_bit_cast(float, __builtin_amdgcn_mov_dpp(__builtin_bit_cast(int, v), 0x150 + I, 0xf, 0xf, false)); }
template <int I> struct DiagStep {
    static __device__ __forceinline__ void run(const float (&Ld)[16], float (&x)[16], int cc) {
        DiagStep<I - 1>::run(Ld, x, cc);
        float a0 = 0.f, a1 = 0.f;
#pragma unroll
        for (int m = 0; m < I; ++m) { const float lv = row_share<I>(Ld[m]); if (m & 1) a1 += lv * x[m]; else a0 += lv * x[m]; }
        x[I] = ((I == cc) ? 1.f : 0.f) - (a0 + a1);
    }
};
template <> struct DiagStep<-1> { static __device__ __forceinline__ void run(const float (&)[16], float (&)[16], int) {} };
__device__ __forceinline__ void dn_wu_prep_phase(const Params& P, LAS unsigned char* lds) {
    PHASE_IDS();
    constexpr int PKQ = 272;
    constexpr int LP = 68;
    constexpr int OFF_K = 0, OFF_Q = 64 * PKQ, OFF_L = 0  , OFF_KK = 4 * 64 * LP * 4, OFF_QK = OFF_KK + 64 * LP * 4, OFF_G = OFF_QK + 64 * LP * 4;
    const bf16* QKV = (const bf16*)(P.ws + WS_QKV); const float* G = (const float*)(P.ws + WS_GATE);
    bf16* TA = (bf16*)(P.ws + WS_TA); float* GS = (float*)(P.ws + WS_GS);
    const int r = lane & 15, g = lane >> 4;
    LAS float* KKs = (LAS float*)(lds + OFF_KK); LAS float* QKs = (LAS float*)(lds + OFF_QK); LAS float* Gs = (LAS float*)(lds + OFF_G);
    u32x4 pq[2], pk[2]; float pgv = 0.f;
#define WU_PREFETCH(grp_) do { const int cidx_ = (grp_) >> 4, kh_ = (grp_) & 15, rb_ = cidx_ * 64; \
        _Pragma("unroll") for (int x = 0; x < 2; ++x) { const int pi = tid + x * NT, pr = pi >> 4, pc = pi & 15; const size_t o = (size_t)(rb_ + pr) * 8192 + kh_ * 128 + pc * 8; pq[x] = *(const u32x4*)(QKV + o); pk[x] = *(const u32x4*)(QKV + o + 2048); } \
        { const int c4 = tid >> 7, which = (tid >> 6) & 1, i = tid & 63, hv = c4 >> 1, d = c4 & 1, h = 2 * kh_ + hv; pgv = G[(size_t)(rb_ + i) * 128 + (which ? 0 : 64) + d * 32 + h]; } } while (0)
    if ((int)blockIdx.x < 256 * 16) WU_PREFETCH(blockIdx.x);
    for (int grp = blockIdx.x; grp < 256 * 16; grp += gridDim.x) {
        const int cidx = grp >> 4, kh = grp & 15;
        __syncthreads();
#pragma unroll
        for (int x = 0; x < 2; ++x) { const int pi = tid + x * NT, pr = pi >> 4, pc = pi & 15;
            *(LAS u32x4*)(lds + OFF_Q + pr * PKQ + pc * 16) = pq[x]; *(LAS u32x4*)(lds + OFF_K + pr * PKQ + pc * 16) = pk[x]; }
        Gs[tid] = pgv;
        __syncthreads();
        if (grp + (int)gridDim.x < 256 * 16) WU_PREFETCH(grp + (int)gridDim.x);
        {
            const int it = wave & 3; const int offx = (wave >> 2) ? OFF_Q : OFF_K; LAS float* dst = (wave >> 2) ? QKs : KKs;
            f32x4 acc[4];
#pragma unroll
            for (int jt = 0; jt < 4; ++jt) acc[jt] = (f32x4){0.f, 0.f, 0.f, 0.f};
#pragma unroll
            for (int sx = 0; sx < 4; ++sx) { const bf16x8 a = ld_b128(lds + offx + (16 * it + r) * PKQ + (32 * sx + 8 * g) * 2);
#pragma unroll
                for (int jt = 0; jt < 4; ++jt) acc[jt] = MFMA16(a, ld_b128(lds + OFF_K + (16 * jt + r) * PKQ + (32 * sx + 8 * g) * 2), acc[jt]); }
#pragma unroll
            for (int jt = 0; jt < 4; ++jt)
#pragma unroll
                for (int e = 0; e < 4; ++e) dst[(16 * it + 4 * g + e) * LP + 16 * jt + r] = acc[jt][e];
        }
        __syncthreads();
        {
            const int c4 = wave & 3, hv = c4 >> 1, d = c4 & 1, h = 2 * kh + hv;
            const int nl = d ? 63 - lane : lane;
            float gcv = Gs[(c4 * 2 + 0) * 64 + nl];
#pragma unroll
            for (int o = 1; o < 64; o <<= 1) { const float t = __shfl_up(gcv, o); if (lane >= o) gcv += t; }
            const float betav = Gs[(c4 * 2 + 1) * 64 + nl];
            const size_t item = ((size_t)(cidx * 32 + h) * 2 + d);
            LAS float* W = (LAS float*)(lds + OFF_L) + c4 * 64 * LP;
            {
                bf16* Ag = TA + item * 8192 + 4096;
                const int pb = (wave >> 2) * 32;
#define WU_LA_TRIPS(REV_) \
                _Pragma("unroll 1") for (int p0 = pb; p0 < pb + 32; p0 += 8) { \
                    const LAS float* kb_ = KKs + ((REV_) ? 56 - p0 : p0) * LP + nl; const LAS float* qb_ = QKs + ((REV_) ? 56 - p0 : p0) * LP + nl; \
                    LAS float* wb_ = W + p0 * LP + lane; bf16* ab_ = Ag + p0 * 64 + lane; const int lrel_ = lane - p0; \
                    float kkv[8], qkv[8]; \
                    _Pragma("unroll") for (int u = 0; u < 8; ++u) { kkv[u] = kb_[((REV_) ? 7 - u : u) * LP]; qkv[u] = qb_[((REV_) ? 7 - u : u) * LP]; } \
                    _Pragma("unroll") for (int u = 0; u < 8; ++u) { const int p = p0 + u; const float gp = rdlane(gcv, p), bp = rdlane(betav, p); const float ex = __expf(gp - gcv); \
                        float lv = bp * kkv[u] * ex, av = qkv[u] * ex; \
                        asm volatile("" : "+v"(lv), "+v"(av)); \
                        wb_[u * LP] = lrel_ < u ? lv : 0.f; \
                        ab_[u * 64] = (bf16)f2bf(lrel_ <= u ? av : 0.f); } \
                }
                if (d) { WU_LA_TRIPS(1) } else { WU_LA_TRIPS(0) }
#undef WU_LA_TRIPS
            }
            if (wave >= 4) {
                float* gs = GS + item * 192; const float gend = rdlane(gcv, 63);
                gs[lane] = __expf(gcv); gs[64 + lane] = betav; gs[128 + lane] = __expf(gend - gcv);
            }
            __syncthreads();
            if (wave < 4) {
                {
                    const int lane2 = opaque_v(lane); const int bb = lane2 >> 4, cc = lane2 & 15;
                    float Ld[16];
#pragma unroll
                    for (int m4 = 0; m4 < 4; ++m4) { const f32x4 v = *(const LAS f32x4*)(W + (16 * bb + cc) * LP + 16 * bb + 4 * m4); Ld[4 * m4] = v[0]; Ld[4 * m4 + 1] = v[1]; Ld[4 * m4 + 2] = v[2]; Ld[4 * m4 + 3] = v[3]; }
                    float x[16];
                    DiagStep<15>::run(Ld, x, cc);
#pragma unroll
                    for (int i = 0; i < 16; ++i) W[(16 * bb + i) * LP + 16 * bb + cc] = x[i];
                }
#define WU_PN(ar, ac, br, bc, acc_) do { _Pragma("unroll") for (int sx = 0; sx < 4; ++sx) acc_ = MFMA4F(W[((ar) + r) * LP + (ac) + 4 * sx + g], W[((br) + 4 * sx + g) * LP + (bc) + r], acc_); } while (0)
#define WU_PA(ar, ac, M_, acc_) do { _Pragma("unroll") for (int e = 0; e < 4; ++e) acc_ = MFMA4F(W[((ar) + r) * LP + (ac) + 4 * g + e], M_[e], acc_); } while (0)
#define WU_ST(r0, c0, acc_) do { _Pragma("unroll") for (int e = 0; e < 4; ++e) W[((r0) + 4 * g + e) * LP + (c0) + r] = -acc_[e]; } while (0)
                const f32x4 z4 = {0.f, 0.f, 0.f, 0.f};
                { f32x4 m1a = z4, m1b = z4; WU_PN(16, 0, 0, 0, m1a); WU_PN(48, 32, 32, 32, m1b);
                  f32x4 t10 = z4, t32 = z4; WU_PA(16, 16, m1a, t10); WU_PA(48, 48, m1b, t32);
                  WU_ST(16, 0, t10); WU_ST(48, 32, t32); }
                { f32x4 m00 = z4, m01 = z4, m10 = z4, m11 = z4;
                  WU_PN(32, 0, 0, 0, m00); WU_PN(32, 16, 16, 0, m00); WU_PN(32, 16, 16, 16, m01);
                  WU_PN(48, 0, 0, 0, m10); WU_PN(48, 16, 16, 0, m10); WU_PN(48, 16, 16, 16, m11);
                  f32x4 t00 = z4, t01 = z4, t10 = z4, t11 = z4;
                  WU_PA(32, 32, m00, t00); WU_PA(32, 32, m01, t01);
                  WU_PA(48, 32, m00, t10); WU_PA(48, 48, m10, t10); WU_PA(48, 32, m01, t11); WU_PA(48, 48, m11, t11);
                  WU_ST(32, 0, t00); WU_ST(32, 16, t01); WU_ST(48, 0, t10); WU_ST(48, 16, t11); }
#undef WU_PN
#undef WU_PA
#undef WU_ST
                bf16* Tg = TA + item * 8192;
#pragma unroll
                for (int x8 = 0; x8 < 8; ++x8) { const int piece = lane + 64 * x8, row = piece >> 3, pc = piece & 7;
                    const f32x4 v0 = *(const LAS f32x4*)(W + row * LP + pc * 8), v1 = *(const LAS f32x4*)(W + row * LP + pc * 8 + 4);
                    u32x4 o; o.x = pk2(v0[0], v0[1]); o.y = pk2(v0[2], v0[3]); o.z = pk2(v1[0], v1[1]); o.w = pk2(v1[2], v1[3]);
                    if (pc * 8 <= row) *(u32x4*)(Tg + row * 64 + pc * 8) = o; }
            }
        }
    }
#undef WU_PREFETCH
}

constexpr int DN_PQ = 272;
constexpr int DN_PXQ = 144, DN_XQ = 64 * DN_PXQ, DN_PXT = 80, DN_XT = 64 * DN_PXT;
constexpr int DN_OFF_Q = 0, DN_OFF_K = 2 * DN_XQ, DN_OFF_V = DN_OFF_K + 64 * DN_PQ, DN_OFF_T = DN_OFF_V + 64 * DN_PQ, DN_OFF_A = DN_OFF_T + 2 * DN_XT, DN_OFF_S = DN_OFF_A + 2 * DN_XT;
struct DnStage { u32x4 rq[2], rk[2], rv[2], rt, ra; f32x4 rs; };
__device__ __forceinline__ void dn_stage_load(DnStage& st, const bf16* QKV, const bf16* TA, const float* GS, int tid, int c, int d, int T, int row0, int kh, int h, int nchunk) {
#pragma unroll
    for (int x = 0; x < 2; ++x) { const int pi = tid + x * NT, pr = pi >> 4, pc = pi & 15; const int pp = c * 64 + pr; const int t = d ? T - 1 - pp : pp;
        const size_t o = (size_t)(row0 + t) * 8192 + pc * 8; st.rq[x] = *(const u32x4*)(QKV + o + kh * 128); st.rk[x] = *(const u32x4*)(QKV + o + 2048 + kh * 128); st.rv[x] = *(const u32x4*)(QKV + o + 4096 + h * 128); }
    const int nc = d ? nchunk - 1 - c : c; const size_t item = ((size_t)((row0 >> 6) + nc) * 32 + h) * 2 + d;
    const bool nz = ((tid & 7) * 8) <= (tid >> 3);
    st.rt = nz ? *(const u32x4*)(TA + item * 8192 + tid * 8) : (u32x4){0u, 0u, 0u, 0u}; st.ra = nz ? *(const u32x4*)(TA + item * 8192 + 4096 + tid * 8) : (u32x4){0u, 0u, 0u, 0u};
    st.rs = (f32x4){0.f, 0.f, 0.f, 0.f}; if (tid < 48) st.rs = *(const f32x4*)(GS + item * 192 + tid * 4);
}
__device__ __forceinline__ void dn_stage_store(const DnStage& st, LAS unsigned char* lds, int tid) {
#pragma unroll
    for (int x = 0; x < 2; ++x) { const int pi = tid + x * NT, pr = pi >> 4, pc = pi & 15;
        { LAS unsigned char* qd = lds + DN_OFF_Q + pr * DN_PXQ + (2 * (pc >> 2) + (pc & 1)) * 16 + ((pc >> 1) & 1) * 8;
          *(LAS u32x2*)qd = (u32x2){st.rq[x].x, st.rq[x].y}; *(LAS u32x2*)(qd + DN_XQ) = (u32x2){st.rq[x].z, st.rq[x].w}; }
        *(LAS u32x4*)(lds + DN_OFF_K + pr * DN_PQ + pc * 16) = st.rk[x]; *(LAS u32x4*)(lds + DN_OFF_V + pr * DN_PQ + pc * 16) = st.rv[x]; }
    { const int pr = tid >> 3, pc = tid & 7; const int o = pr * DN_PXT + (2 * (pc >> 2) + (pc & 1)) * 16 + ((pc >> 1) & 1) * 8;
      *(LAS u32x2*)(lds + DN_OFF_T + o) = (u32x2){st.rt.x, st.rt.y}; *(LAS u32x2*)(lds + DN_OFF_T + o + DN_XT) = (u32x2){st.rt.z, st.rt.w};
      *(LAS u32x2*)(lds + DN_OFF_A + o) = (u32x2){st.ra.x, st.ra.y}; *(LAS u32x2*)(lds + DN_OFF_A + o + DN_XT) = (u32x2){st.ra.z, st.ra.w}; }
    if (tid < 48) *(LAS f32x4*)(lds + DN_OFF_S + tid * 16) = st.rs;
}
__device__ __forceinline__ void dn_step_compute(f32x4 (&S)[8], LAS unsigned char* lds, bf16* O, int c, int d, int T, int row0, int h, int wave, int lane) {
    constexpr int PQ = DN_PQ, OFF_Q = DN_OFF_Q, OFF_K = DN_OFF_K, OFF_V = DN_OFF_V, OFF_T = DN_OFF_T, OFF_A = DN_OFF_A, OFF_S = DN_OFF_S;
    const int r = lane & 15, g = lane >> 4, q4 = (lane & 15) >> 2, p4 = lane & 3;
#define DN_PERMROW(off_, pitch_, row_, col_) cat4(ld_b64(lds + (off_) + (row_) * (pitch_) + ((col_) + 4 * g) * 2), ld_b64(lds + (off_) + (row_) * (pitch_) + ((col_) + 16 + 4 * g) * 2))
#define DN_CHUNK(off_, xsz_, pitch_, row_, sx_) ld_b128(lds + (off_) + (g & 1) * (xsz_) + (row_) * (pitch_) + (2 * (sx_) + (g >> 1)) * 16)
    const f32x4 zero4 = {0.f, 0.f, 0.f, 0.f};
    bf16x8 sb[4];
    f32x4 R[4];
    {
        bf16x8 kf[4][4];
#pragma unroll
        for (int jt = 0; jt < 4; ++jt)
#pragma unroll
            for (int sx = 0; sx < 4; ++sx) kf[jt][sx] = DN_PERMROW(OFF_K, PQ, 16 * jt + r, 32 * sx);
#pragma unroll
        for (int sx = 0; sx < 4; ++sx) sb[sx] = pack8(S[2 * sx], S[2 * sx + 1]);
#pragma unroll
        for (int jt = 0; jt < 4; ++jt) R[jt] = zero4;
#pragma unroll
        for (int sx = 0; sx < 4; ++sx)
#pragma unroll
            for (int jt = 0; jt < 4; ++jt) R[jt] = MFMA16(kf[jt][sx], sb[sx], R[jt]);
    }
    __builtin_amdgcn_sched_barrier(0);
    f32x4 U[4];
    {
        bf16x8 tf[4][2]; s16x4 vt[4]; f32x4 eg[4], bt[4];
#pragma unroll
        for (int jt = 0; jt < 4; ++jt) { vt[jt] = ld_tr(lds + OFF_V + (16 * jt + 4 * g + q4) * PQ + (16 * wave + 4 * p4) * 2);
            eg[jt] = *(const LAS f32x4*)(lds + OFF_S + (16 * jt + 4 * g) * 4); bt[jt] = *(const LAS f32x4*)(lds + OFF_S + 256 + (16 * jt + 4 * g) * 4); }
#pragma unroll
        for (int it = 0; it < 4; ++it) { tf[it][0] = DN_CHUNK(OFF_T, DN_XT, DN_PXT, 16 * it + r, 0); tf[it][1] = DN_CHUNK(OFF_T, DN_XT, DN_PXT, 16 * it + r, 1); }
#pragma unroll
        for (int jt = 0; jt < 4; ++jt)
#pragma unroll
            for (int e = 0; e < 4; ++e) R[jt][e] = bt[jt][e] * (bf2f((unsigned short)vt[jt][e]) - eg[jt][e] * R[jt][e]);
        const bf16x8 rb0 = pack8(R[0], R[1]), rb1 = pack8(R[2], R[3]);
#pragma unroll
        for (int it = 0; it < 4; ++it) U[it] = MFMA16(tf[it][0], rb0, zero4);
#pragma unroll
        for (int it = 0; it < 4; ++it) U[it] = MFMA16(tf[it][1], rb1, U[it]);
    }
    __builtin_amdgcn_sched_barrier(0);
    {
        f32x4 Ot[4];
#pragma unroll
        for (int it = 0; it < 4; ++it) Ot[it] = zero4;
#pragma unroll
        for (int hq = 0; hq < 2; ++hq) {
            bf16x8 qf[2][4];
#pragma unroll
            for (int i2 = 0; i2 < 2; ++i2)
#pragma unroll
                for (int sx = 0; sx < 4; ++sx) qf[i2][sx] = DN_CHUNK(OFF_Q, DN_XQ, DN_PXQ, 16 * (2 * hq + i2) + r, sx);
#pragma unroll
            for (int sx = 0; sx < 4; ++sx)
#pragma unroll
                for (int i2 = 0; i2 < 2; ++i2) Ot[2 * hq + i2] = MFMA16(sb[sx], qf[i2][sx], Ot[2 * hq + i2]);
        }
        bf16x8 af[4][2]; float egi[4];
#pragma unroll
        for (int it = 0; it < 4; ++it) { af[it][0] = DN_CHUNK(OFF_A, DN_XT, DN_PXT, 16 * it + r, 0); af[it][1] = DN_CHUNK(OFF_A, DN_XT, DN_PXT, 16 * it + r, 1); egi[it] = *(const LAS float*)(lds + OFF_S + (16 * it + r) * 4); }
        const bf16x8 ub0 = pack8(U[0], U[1]), ub1 = pack8(U[2], U[3]);
#pragma unroll
        for (int it = 0; it < 4; ++it) Ot[it] = Ot[it] * egi[it];
#pragma unroll
        for (int it = 0; it < 4; ++it) Ot[it] = MFMA16(ub0, af[it][0], Ot[it]);
#pragma unroll
        for (int it = 0; it < 4; ++it) Ot[it] = MFMA16(ub1, af[it][1], Ot[it]);
#pragma unroll
        for (int it = 0; it < 4; ++it) { const int pp = c * 64 + 16 * it + r; const int t = d ? T - 1 - pp : pp; u32x2 w; w.x = pk2(Ot[it][0], Ot[it][1]); w.y = pk2(Ot[it][2], Ot[it][3]);
            *(u32x2*)(O + (size_t)(row0 + t) * 4096 + h * 128 + 16 * wave + 4 * g) = w; }
    }
    __builtin_amdgcn_sched_barrier(0);
    {
#pragma unroll
        for (int jt = 0; jt < 4; ++jt) { const f32x4 dc = *(const LAS f32x4*)(lds + OFF_S + 512 + (16 * jt + 4 * g) * 4); U[jt] = U[jt] * dc; }
        const bf16x8 us0 = pack8(U[0], U[1]), us1 = pack8(U[2], U[3]);
        const float gend = *(const LAS float*)(lds + OFF_S + 63 * 4);
#pragma unroll
        for (int hk = 0; hk < 2; ++hk) {
            bf16x8 ktf[4][2];
#pragma unroll
            for (int k2 = 0; k2 < 4; ++k2) { const int kt = 4 * hk + k2;
                ktf[k2][0] = cat4(ld_tr(lds + OFF_K + (4 * g + q4) * PQ + (16 * kt + 4 * p4) * 2), ld_tr(lds + OFF_K + (16 + 4 * g + q4) * PQ + (16 * kt + 4 * p4) * 2));
                ktf[k2][1] = cat4(ld_tr(lds + OFF_K + (32 + 4 * g + q4) * PQ + (16 * kt + 4 * p4) * 2), ld_tr(lds + OFF_K + (48 + 4 * g + q4) * PQ + (16 * kt + 4 * p4) * 2)); }
#pragma unroll
            for (int k2 = 0; k2 < 4; ++k2) S[4 * hk + k2] = MFMA16(ktf[k2][0], us0, S[4 * hk + k2] * gend);
#pragma unroll
            for (int k2 = 0; k2 < 4; ++k2) S[4 * hk + k2] = MFMA16(ktf[k2][1], us1, S[4 * hk + k2]);
        }
    }
#undef DN_PERMROW
#undef DN_CHUNK
}
__device__ __forceinline__ void dn_chunk_phase(const Params& P, int j, LAS unsigned char* lds) {
    PHASE_IDS();
    const bf16* QKV = (const bf16*)(P.ws + WS_QKV); const bf16* TA = (const bf16*)(P.ws + WS_TA); const float* GS = (const float*)(P.ws + WS_GS);
    bf16* OF = (bf16*)(P.ws + WS_OF); bf16* OB = (bf16*)(P.ws + WS_OB);
    const int r = lane & 15, g = lane >> 4;
    const int bxp = (gridDim.x == 256) ? ({ const int x = blockIdx.x & 7, y = blockIdx.x >> 3, grp = x + 8 * (y >> 1), mem = y & 1; (grp >> 5) * 64 + (2 * ((grp >> 1) & 15) + mem) * 2 + (grp & 1); }) : (int)blockIdx.x;
    for (int unit0 = blockIdx.x; unit0 < 256 + 2048; unit0 += gridDim.x) {
        const int unit = (gridDim.x == 256) ? (unit0 - (int)blockIdx.x + bxp) : unit0;
        const bool lat = unit < 256; const int u2 = lat ? unit : unit - 256;
        const int b = u2 >> 6, h = (u2 >> 1) & 31, d = u2 & 1, T = lat ? 2048 : 256, row0 = lat ? MCTX + b * 2048 : b * 256, kh = h >> 1, nchunk = T / 64;
        bf16* O = d ? OB : OF;
        f32x4 S[8];
        { const float* s0 = P.in[3] + ((((size_t)b * 2 + j) * 2 + d) * 32 + h) * 128 * 128 + 16 * wave + r;
          if (lat) {
#pragma unroll
              for (int kt = 0; kt < 8; ++kt)
#pragma unroll
                  for (int e = 0; e < 4; ++e) S[kt][e] = s0[(size_t)(16 * kt + 4 * g + e) * 128];
          } else {
#pragma unroll
              for (int kt = 0; kt < 8; ++kt) S[kt] = (f32x4){0.f, 0.f, 0.f, 0.f};
          } }
        constexpr int DN_HSZ = DN_OFF_S + 768;
        DnStage sa;
        __syncthreads();
        dn_stage_load(sa, QKV, TA, GS, tid, 0, d, T, row0, kh, h, nchunk);
        dn_stage_store(sa, lds, tid);
        dn_stage_load(sa, QKV, TA, GS, tid, 1, d, T, row0, kh, h, nchunk);
        __syncthreads();
        for (int c = 0; c < nchunk; ++c) {
            LAS unsigned char* cur = lds + (c & 1) * DN_HSZ; LAS unsigned char* nxt = lds + ((c + 1) & 1) * DN_HSZ;
            if (c + 1 < nchunk) dn_stage_store(sa, nxt, tid);
            if (c + 2 < nchunk) dn_stage_load(sa, QKV, TA, GS, tid, c + 2, d, T, row0, kh, h, nchunk);
            dn_step_compute(S, cur, O, c, d, T, row0, h, wave, lane);
            __syncthreads();
        }
        if (!lat) { float* sd = P.out + OUT_SDN + ((((size_t)b * 2 + j) * 2 + d) * 32 + h) * 128 * 128 + 16 * wave + r;
#pragma unroll
            for (int kt = 0; kt < 8; ++kt)
#pragma unroll
                for (int e = 0; e < 4; ++e) sd[(size_t)(16 * kt + 4 * g + e) * 128] = S[kt][e]; }
    }
}


#ifndef R_CONV
#define R_CONV 1
#endif
#ifndef R_MOD
#define R_MOD 1
#endif
#ifndef R_NORM
#define R_NORM 1
#endif
#ifndef R_GATE
#define R_GATE 1
#endif
#ifndef R_DNPREP
#define R_DNPREP 1
#endif
#ifndef R_WU
#define R_WU 1
#endif
#ifndef R_GLAPREP
#define R_GLAPREP 1
#endif
#ifndef R_DNSCAN
#define R_DNSCAN 1
#endif
#ifndef R_GSCAN
#define R_GSCAN 1
#endif
#ifndef R_FINAL
#define R_FINAL 1
#endif
#ifndef R_BAR
#define R_BAR 1
#endif
#ifndef R_GEMM
#define R_GEMM 1
#endif
#define REPN(n_) for (int rep_ = 0; rep_ < (n_); ++rep_)
#ifndef REP_THIN
#define REP_THIN 1
#endif
#ifndef REP_SCAN
#define REP_SCAN 1
#endif
#ifndef REP_A
#define REP_A 1
#endif
#ifndef REP_B
#define REP_B 1
#endif
#ifndef REP_C
#define REP_C 1
#endif
#define RT for (int rep_ = 0; rep_ < REP_THIN; ++rep_)
#define RA for (int rep_ = 0; rep_ < REP_A; ++rep_)
#define RB for (int rep_ = 0; rep_ < REP_B; ++rep_)
#define RC for (int rep_ = 0; rep_ < REP_C; ++rep_)
#define RS for (int rep_ = 0; rep_ < REP_SCAN; ++rep_)
template <int LAYER> __device__ __forceinline__ void layer_body(const Params& P, LAS unsigned char* lds, const XcdBarrier& bar) {
    bf16* X = (bf16*)(P.ws + WS_X); bf16* H = (bf16*)(P.ws + WS_H); bf16* BIG = (bf16*)(P.ws + WS_BIG); float* GATE = (float*)(P.ws + WS_GATE);
    bf16* Y = (bf16*)(P.ws + WS_QKV); bf16* OF = (bf16*)(P.ws + WS_OF); bf16* OB = (bf16*)(P.ws + WS_OB);
    const float* MOD = (const float*)(P.ws + WS_MOD);
    const bf16* Tin = (const bf16*)(P.ws + WS_W + WOFF_IN); const bf16* Tout = (const bf16*)(P.ws + WS_W + WOFF_OUT); const bf16* Tup = (const bf16*)(P.ws + WS_W + WOFF_UP); const bf16* Tdn = (const bf16*)(P.ws + WS_W + WOFF_DOWN);

        constexpr int layer = LAYER, kind = LAYER % 3, j = LAYER / 3;
        const float* modl = MOD + (size_t)layer * 5 * MODW;
        const void* xc = layer == 0 ? (const void*)P.in[0] : (const void*)X; const void* xl = layer == 0 ? (const void*)P.in[1] : (const void*)X;
#ifndef NO_CONV
        REPN(R_CONV) convert_layer_weights(P, layer, lds);
#endif
        if (layer == 0) REPN(R_BAR) xcd_barrier(bar);
        REPN(R_NORM) norm_mod_phase<layer == 0>(xc, xl, P.in[9] + layer * D, modl, 0, 2048, H);
        REPN(R_BAR) xcd_barrier(bar);
        {
            constexpr int Npad = kind == 0 ? DN_NPAD : (kind == 1 ? GLA_NPAD : HG_NIN), nmain = kind == 0 ? DN_NMAIN : (kind == 1 ? GLA_NMAIN : HG_NIN);
            { pg8::Gemm g = pg8::mk_gemm(H, Tin, MROWS, nmain, D); pg8::StaticOrder S; S.init(MROWS, nmain, (int)gridDim.x, (int)blockIdx.x);
              pg8::EpiBf16<0> E{BIG, nmain, nmain, GATE};
              REPN(R_GEMM) pg8::gemm_phase<pg8::EpiBf16<0>, pg8::StaticOrder, true, true>(lds, g, S, E); }
            if constexpr (Npad > nmain) {
              pg8::Gemm g{H, Tin + (size_t)nmain * D, MROWS, 4 * 256, D, (size_t)512 * 2, (size_t)512 * 2, 8}; pg8::StaticOrder S; S.init(MROWS, 4 * 256, (int)gridDim.x, (int)blockIdx.x);
              pg8::EpiGateP E{(float*)(P.ws + WS_GP)};
              pg8::gemm_phase<pg8::EpiGateP, pg8::StaticOrder, true, true>(lds, g, S, E); }
        }
        REPN(R_BAR) xcd_barrier(bar);
        if constexpr (kind == 0) {
#ifndef NO_DNPREP
            REPN(R_DNPREP) dn_prep_phase(P, j, rep_ == 0);
#endif
            REPN(R_BAR) xcd_barrier(bar);
            REPN(R_WU) dn_wu_prep_phase(P, lds);
            REPN(R_BAR) xcd_barrier(bar);
            REPN(R_DNSCAN) dn_chunk_phase(P, j, lds);
            REPN(R_BAR) xcd_barrier(bar);
            REPN(R_GATE) gate_phase<128>(OF, OB, BIG, DN_NMAIN, 8192, P.in[18] + j * 128, Y, 4096);
        } else if constexpr (kind == 1) {
            REPN(R_GLAPREP) gla_prep_phase<1>(P, lds);
            REPN(R_BAR) xcd_barrier(bar);
            REPN(R_GSCAN) gla_chunk_phase<1>(P, lds);
            REPN(R_BAR) xcd_barrier(bar);
            REPN(R_GATE) gate_phase<512>(OF, OB, BIG, GLA_NMAIN, 4096, P.in[23] + j * 512, Y, 2048);
        } else {
            REPN(R_GLAPREP) gla_prep_phase<2>(P, lds);
            REPN(R_BAR) xcd_barrier(bar);
            REPN(R_GSCAN) gla_chunk_phase<2>(P, lds);
            REPN(R_BAR) xcd_barrier(bar);
            REPN(R_GATE) gate_phase<128>(OF, OB, BIG, HG_NIN, 4096, P.in[27] + j * 128, Y, 2048);
        }
        REPN(R_BAR) xcd_barrier(bar);
        {
            const int Kout = kind == 0 ? 4096 : 2048;
            pg8::Gemm g = pg8::mk_gemm(Y, Tout, MROWS, D, Kout); pg8::StaticOrder S; S.init(MROWS, D, (int)gridDim.x, (int)blockIdx.x);
            pg8::EpiRes<layer == 0> E{xc, xl, X, modl + 4096};
            pg8::gemm_phase<pg8::EpiRes<layer == 0>, pg8::StaticOrder, true, true>(lds, g, S, E);
        }
        REPN(R_BAR) xcd_barrier(bar);
        REPN(R_NORM) norm_mod_phase<false>(X, X, P.in[10] + layer * D, modl, 6144, 8192, H);
        REPN(R_BAR) xcd_barrier(bar);
#pragma unroll
        for (int hf = 0; hf < 2; ++hf) {
            {
                pg8::Gemm g = pg8::mk_gemm(H, Tup, MROWS / 2, DFF, D); pg8::StaticOrder S; S.init(MROWS / 2, DFF, (int)gridDim.x, (int)blockIdx.x, hf * 32);
                pg8::EpiBf16<1> E{BIG, DFF, DFF, nullptr};
                REPN(R_GEMM) pg8::gemm_phase<pg8::EpiBf16<1>, pg8::StaticOrder, true, true>(lds, g, S, E);
            }
            REPN(R_BAR) xcd_barrier(bar);
            {
                pg8::Gemm g = pg8::mk_gemm(BIG, Tdn, MROWS / 2, D, DFF); pg8::StaticOrder S; S.init(MROWS / 2, D, (int)gridDim.x, (int)blockIdx.x, hf * 32);
                pg8::EpiRes<false> E{X, X, X, modl + 10240};
                pg8::gemm_phase<pg8::EpiRes<false>, pg8::StaticOrder, true, true>(lds, g, S, E);
            }
            REPN(R_BAR) xcd_barrier(bar);
        }
    }

__global__ void __launch_bounds__(NT, 2) fwd_kernel(Params P) {
    extern __shared__ __attribute__((aligned(16))) unsigned char lds_raw[];
    LAS unsigned char* lds = (LAS unsigned char*)lds_raw;
    const int tid = threadIdx.x;
    volatile LAS unsigned* misc = (volatile LAS unsigned*)(lds + LDS_MISC);
    if (tid < 64) misc[tid] = 0u;
    __syncthreads();
    XcdBarrier bar = xcd_barrier_post((unsigned*)(P.ws + WS_CTL) + 1024, misc + 8);

#ifndef NO_MOD
    REPN(R_MOD) mod_phase(P, lds);
#endif
    __syncthreads();

    layer_body<0>(P, lds, bar);
    layer_body<1>(P, lds, bar);
    layer_body<2>(P, lds, bar);
    layer_body<3>(P, lds, bar);
    REPN(R_FINAL) final_norm_phase((const bf16*)(P.ws + WS_X), P.in[11], P.out + OUT_Y);
}

extern "C" void kernel_launch(void* const* d_in, const int* in_sizes, int n_in, void* d_out, int out_size, void* d_ws, size_t ws_size, hipStream_t stream) {
    static int grid = 0;
    if (grid == 0) {
        if (n_in != 29 || (size_t)out_size != OUT_END || ws_size < WS_END) {
            fprintf(stderr, "kernel_launch: unexpected shapes: n_in %d out %d (want %zu) ws %zu (want %zu)\n", n_in, out_size, (size_t)OUT_END, ws_size, (size_t)WS_END); grid = -1; return; }
        int dev = 0, cus = 0, per_cu = 0;
        if (hipGetDevice(&dev) != hipSuccess || hipDeviceGetAttribute(&cus, hipDeviceAttributeMultiprocessorCount, dev) != hipSuccess) { grid = -1; return; }
        if (hipFuncSetAttribute((const void*)fwd_kernel, hipFuncAttributeMaxDynamicSharedMemorySize, LDS_BYTES) != hipSuccess) { fprintf(stderr, "kernel_launch: hipFuncSetAttribute failed\n"); grid = -1; return; }
        if (hipOccupancyMaxActiveBlocksPerMultiprocessor(&per_cu, (const void*)fwd_kernel, NT, LDS_BYTES) != hipSuccess || per_cu < 1) { fprintf(stderr, "kernel_launch: occupancy query says %d\n", per_cu); }
        (void)hipGetLastError();
        grid = cus;
    }
    if (grid < 0) return;
    hipMemsetAsync((char*)d_ws + WS_CTL, 0, CTL_BYTES, stream);
    Params p{};
    for (int i = 0; i < 29; ++i) p.in[i] = (const float*)d_in[i];
    p.out = (float*)d_out; p.ws = (unsigned char*)d_ws;
    hipLaunchKernelGGL(fwd_kernel, dim3(grid), dim3(NT), LDS_BYTES, stream, p);
}
```

```cpp
#include <hip/hip_runtime.h>
#include <cstdio>
#include <cstdint>

__device__ __forceinline__ int opaque_v(int x) { asm volatile("" : "+v"(x)); return x; }
#define PHASE_IDS() const int tid = opaque_v((int)threadIdx.x), lane = tid & 63, wave = __builtin_amdgcn_readfirstlane(tid >> 6), gw = (int)blockIdx.x * 8 + wave, NGW = (int)gridDim.x * 8; (void)lane; (void)wave; (void)gw; (void)NGW
namespace pg8 {
#define PG8_LAS __attribute__((address_space(3)))
typedef unsigned short bf16_t;
typedef short bf16x8 __attribute__((ext_vector_type(8)));
typedef float f32x4 __attribute__((ext_vector_type(4)));
typedef unsigned u32x4 __attribute__((ext_vector_type(4)));
constexpr int BM = 256, BK = 64, HALF = 128, HTB = HALF * BK * 2, STAGE_BYTES = 8 * HTB, NXCD = 8, WGM = 8;

__host__ __device__ __forceinline__ int lds_byte(int r, int c) { const int st = (r >> 4) * 2 + (c >> 5), rr = r & 15, cc = c & 31, ob = rr * 64 + cc * 2; return st * 1024 + (ob ^ (((ob >> 9) & 1) << 5)); }
__host__ __device__ __forceinline__ void stage_rc(int b, int& R, int& C) { const int st = b / 1024, sb = b % 1024, swz = sb ^ (((sb >> 9) & 1) << 5); R = (st >> 1) * 16 + swz / 64; C = (st & 1) * 32 + (swz % 64) / 2; }
__host__ __device__ __forceinline__ int perm32(int rho) { const int n = rho >> 4, i = rho & 15; return 8 * (i >> 2) + 4 * n + (i & 3); }

struct Unit { int pm, pn; };
struct Gemm { const bf16_t* A; const bf16_t* Bt; int M, N, K; size_t a_pn_step, b_pn_step; int nt; };
__host__ __device__ __forceinline__ Gemm mk_gemm(const bf16_t* A, const bf16_t* Bt, int M, int N, int K) { return Gemm{A, Bt, M, N, K, 0, (size_t)256 * K * 2, K / 64}; }

struct StaticOrder {
    int nM, nN, nwg, G, c, pm0;
    __host__ __device__ void init(int M, int N, int G_, int c_, int pm0_ = 0) { nM = M / BM; nN = N / BM; nwg = nM * nN; G = G_; c = c_; pm0 = pm0_; }
    __host__ __device__ bool next(int i, Unit& u) const {
        const long L = (long)i * G + c; if (L >= nwg) return false;
        int wgid = (int)L; { const int q = nwg / NXCD, r = nwg % NXCD, xcd = wgid % NXCD, off = wgid / NXCD; wgid = (xcd < r ? xcd * (q + 1) : r * (q + 1) + (xcd - r) * q) + off; }
        const int nig = WGM * nN, gid = wgid / nig, fm = gid * WGM, gsz = (nM - fm) < WGM ? (nM - fm) : WGM;
        u.pm = pm0 + fm + ((wgid % nig) % gsz); u.pn = (wgid % nig) / gsz; return true;
    }
    __device__ __forceinline__ void a_ready(const Unit&) const {}
    __device__ __forceinline__ void done(const Unit&) const {}
};

__device__ __forceinline__ unsigned cvt_pk_bf16(float lo, float hi) { unsigned r; asm volatile("v_cvt_pk_bf16_f32 %0, %1, %2" : "=v"(r) : "v"(lo), "v"(hi)); return r; }

template <int ACT> struct EpiBf16 {
    static constexpr bool PERM = true, AFTER_DRAIN = false;
    bf16_t* O; int ldc; int n_main; float* G;
    __device__ __forceinline__ void operator()(const f32x4 (&acc)[2][2][4][2], const Unit& u, int wr, int wc, int fr, int fq) const {
        const int row0 = u.pm * BM + wr * 64 + fr; const int colt = u.pn * BM;
        const int col0 = colt + wc * 32 + 8 * fq;
#pragma unroll
        for (int ai = 0; ai < 2; ++ai)
#pragma unroll
            for (int m = 0; m < 4; ++m) { bf16_t* rowp = O + (size_t)(row0 + ai * HALF + m * 16) * ldc + col0;
#pragma unroll
                for (int bj = 0; bj < 2; ++bj) { f32x4 v0 = acc[ai][bj][m][0], v1 = acc[ai][bj][m][1];
                    if (ACT == 1) {
#pragma unroll
                        for (int j = 0; j < 4; ++j) { const float a = fmaxf(v0[j], 0.f), b = fmaxf(v1[j], 0.f); v0[j] = a * a; v1[j] = b * b; } }
                    u32x4 w; w.x = cvt_pk_bf16(v0[0], v0[1]); w.y = cvt_pk_bf16(v0[2], v0[3]); w.z = cvt_pk_bf16(v1[0], v1[1]); w.w = cvt_pk_bf16(v1[2], v1[3]);
                    *(u32x4*)(rowp + bj * HALF) = w;
#ifdef PROBE_DOUBLE_STORE
                    asm volatile("" ::: "memory"); *(u32x4*)(rowp + bj * HALF) = w; asm volatile("" ::: "memory");
#endif
                    } }
    }
};
struct EpiGateP {
    static constexpr bool PERM = true, AFTER_DRAIN = false;
    float* GP;
    __device__ __forceinline__ void operator()(const f32x4 (&acc)[2][2][4][2], const Unit& u, int wr, int wc, int fr, int fq) const {
        const int row0 = u.pm * BM + wr * 64 + fr; const int col0 = wc * 32 + 8 * fq; float* base = GP + (size_t)u.pn * 16384 * 128;
#pragma unroll
        for (int ai = 0; ai < 2; ++ai)
#pragma unroll
            for (int m = 0; m < 4; ++m) { float* rowp = base + (size_t)(row0 + ai * HALF + m * 16) * 128 + col0;
                *(f32x4*)(rowp) = acc[ai][0][m][0]; *(f32x4*)(rowp + 4) = acc[ai][0][m][1]; }
    }
};
template <bool BASE_F32> struct EpiRes {
    static constexpr bool PERM = true, AFTER_DRAIN = false;
    const void* base_ctx; const void* base_lat; bf16_t* out; const float* gate;
    __device__ __forceinline__ void operator()(const f32x4 (&acc)[2][2][4][2], const Unit& u, int wr, int wc, int fr, int fq) const {
        const int row0 = u.pm * BM + wr * 64 + fr, col0 = u.pn * BM + wc * 32 + 8 * fq;
        const bool ctx = u.pm < 32; const int grp = ctx ? 0 : 1 + ((u.pm - 32) >> 3);
        const float* gp = gate + (size_t)grp * 12288 + col0;
        const void* base = ctx ? base_ctx : base_lat; const int rsub = (BASE_F32 && !ctx) ? 8192 : 0;
        f32x4 gv[2][2];
#pragma unroll
        for (int bj = 0; bj < 2; ++bj)
#pragma unroll
            for (int n = 0; n < 2; ++n) gv[bj][n] = *(const f32x4*)(gp + bj * HALF + 4 * n);
#pragma unroll
        for (int ai = 0; ai < 2; ++ai) {
            f32x4 bs[4][2][2];
#pragma unroll
            for (int m = 0; m < 4; ++m) { const size_t offb = (size_t)(row0 + ai * HALF + m * 16 - rsub) * 2048 + col0;
#pragma unroll
                for (int bj = 0; bj < 2; ++bj) {
                    if (BASE_F32) { bs[m][bj][0] = *(const f32x4*)((const float*)base + offb + bj * HALF); bs[m][bj][1] = *(const f32x4*)((const float*)base + offb + bj * HALF + 4); }
                    else { const u32x4 w = *(const u32x4*)((const bf16_t*)base + offb + bj * HALF);
                        bs[m][bj][0] = (f32x4){__uint_as_float(w.x << 16), __uint_as_float(w.x & 0xffff0000u), __uint_as_float(w.y << 16), __uint_as_float(w.y & 0xffff0000u)};
                        bs[m][bj][1] = (f32x4){__uint_as_float(w.z << 16), __uint_as_float(w.z & 0xffff0000u), __uint_as_float(w.w << 16), __uint_as_float(w.w & 0xffff0000u)}; } } }
#pragma unroll
            for (int m = 0; m < 4; ++m) { const size_t offo = (size_t)(row0 + ai * HALF + m * 16) * 2048 + col0;
#pragma unroll
                for (int bj = 0; bj < 2; ++bj) { const f32x4 v0 = bs[m][bj][0] + gv[bj][0] * acc[ai][bj][m][0], v1 = bs[m][bj][1] + gv[bj][1] * acc[ai][bj][m][1];
                    u32x4 w; w.x = cvt_pk_bf16(v0[0], v0[1]); w.y = cvt_pk_bf16(v0[2], v0[3]); w.z = cvt_pk_bf16(v1[0], v1[1]); w.w = cvt_pk_bf16(v1[2], v1[3]);
                    *(u32x4*)(out + offo + bj * HALF) = w; } }
            asm volatile("" ::: "memory");
        }
    }
};

template <class Epi, class Sched, bool ALIGN_EPI = false, bool SP2 = false>
__device__ __forceinline__ void gemm_phase(PG8_LAS unsigned char* lds, const Gemm g, const Sched& S, const Epi& E) {
    const int tid = opaque_v((int)threadIdx.x), wid = __builtin_amdgcn_readfirstlane(tid >> 6), lane = tid & 63, wr = wid >> 2, wc = wid & 3, fr = lane & 15, fq = lane >> 4;
    const int K = g.K, nt = g.nt;
    unsigned voffA[2], voffB[2];
#pragma unroll
    for (int i = 0; i < 2; ++i) { int R, C; stage_rc(tid * 16 + i * 8192, R, C); const int Rb = Epi::PERM ? ((R & ~31) + perm32(R & 31)) : R;
        voffA[i] = (unsigned)(R * K + C) * 2u; voffB[i] = (unsigned)(Rb * K + C) * 2u; }
    const size_t kstep = (size_t)(BK * 2);
    const size_t hstep = (size_t)HALF * K * 2;
    const size_t tstep = 2 * hstep;
    const unsigned ldsw = (unsigned)wid * 1024u;
    const int aoff = lds_byte(wr * 64 + fr, fq * 8), boff = lds_byte(wc * 32 + fr, fq * 8);
#define PG8_SA(b, h) (((b) * 2 + (h)) * HTB)
#define PG8_SB(b, h) ((4 + (b) * 2 + (h)) * HTB)
#define PG8_STAGE(bufoff, gbase, voff) do { _Pragma("unroll") for (int _i = 0; _i < 2; ++_i) \
        __builtin_amdgcn_global_load_lds((const unsigned*)((const char*)(gbase) + (voff)[_i]), (PG8_LAS unsigned*)(lds + (bufoff) + ldsw + _i * 8192), 16, 0, 0); } while (0)
#define PG8_LDA(dst, b, h) do { _Pragma("unroll") for (int m = 0; m < 4; ++m) _Pragma("unroll") for (int k = 0; k < 2; ++k) dst[m][k] = *(const PG8_LAS bf16x8*)(lds + PG8_SA(b, h) + aoff + m * 2048 + k * 1024); } while (0)
#define PG8_LDB(dst, b, h) do { _Pragma("unroll") for (int n = 0; n < 2; ++n) _Pragma("unroll") for (int k = 0; k < 2; ++k) dst[n][k] = *(const PG8_LAS bf16x8*)(lds + PG8_SB(b, h) + boff + n * 2048 + k * 1024); } while (0)
#define PG8_MMA(ai, bj, At, Bt) do { __builtin_amdgcn_s_setprio(1); _Pragma("unroll") for (int m = 0; m < 4; ++m) _Pragma("unroll") for (int n = 0; n < 2; ++n) _Pragma("unroll") for (int k = 0; k < 2; ++k) \
        acc[ai][bj][m][n] = __builtin_amdgcn_mfma_f32_16x16x32_bf16(Bt[n][k], At[m][k], acc[ai][bj][m][n], 0, 0, 0); __builtin_amdgcn_s_setprio(0); } while (0)
#define PG8_WAIT_V(n) asm volatile("s_waitcnt vmcnt(" #n ")" ::: "memory")
#define PG8_WAIT_L(n) asm volatile("s_waitcnt lgkmcnt(" #n ")" ::: "memory")
#define PG8_BAR __builtin_amdgcn_s_barrier()
#define PG8_SCHED __builtin_amdgcn_sched_barrier(0)
    Unit cur, nxt; int ui = 0;
    if (!S.next(0, cur)) return;
    f32x4 acc[2][2][4][2];
#pragma unroll
    for (int a = 0; a < 2; ++a)
#pragma unroll
        for (int b = 0; b < 2; ++b)
#pragma unroll
            for (int m = 0; m < 4; ++m)
#pragma unroll
                for (int n = 0; n < 2; ++n) acc[a][b][m][n] = (f32x4){0.f, 0.f, 0.f, 0.f};
    bf16x8 At[4][2], B0[2][2], B1[2][2];
    const char* cA = (const char*)g.A + (size_t)cur.pm * tstep + (size_t)cur.pn * g.a_pn_step; const char* cB = (const char*)g.Bt + (size_t)cur.pn * g.b_pn_step;
    S.a_ready(cur);
    if constexpr (SP2) {
        PG8_STAGE(PG8_SB(0, 0), cB, voffB); PG8_STAGE(PG8_SB(0, 1), cB + hstep, voffB); PG8_STAGE(PG8_SA(0, 0), cA, voffA); PG8_STAGE(PG8_SA(0, 1), cA + hstep, voffA);
        if (wr == 1) PG8_BAR;
        PG8_WAIT_V(2); PG8_BAR;
        PG8_STAGE(PG8_SB(1, 0), cB + kstep, voffB); PG8_STAGE(PG8_SA(1, 0), cA + kstep, voffA); PG8_STAGE(PG8_SB(1, 1), cB + hstep + kstep, voffB);
        PG8_WAIT_V(6); PG8_BAR;
    } else {
        PG8_STAGE(PG8_SB(0, 0), cB, voffB); PG8_STAGE(PG8_SA(0, 0), cA, voffA); PG8_STAGE(PG8_SB(0, 1), cB + hstep, voffB); PG8_STAGE(PG8_SA(0, 1), cA + hstep, voffA);
        if (wr == 1) PG8_BAR;
        PG8_WAIT_V(4); PG8_BAR;
        PG8_STAGE(PG8_SB(1, 0), cB + kstep, voffB); PG8_STAGE(PG8_SA(1, 0), cA + kstep, voffA); PG8_STAGE(PG8_SB(1, 1), cB + hstep + kstep, voffB);
        PG8_WAIT_V(6); PG8_BAR;
    }
    for (;;) {
        const bool has_next = S.next(ui + 1, nxt);
        const char* nA = has_next ? (const char*)g.A + (size_t)nxt.pm * tstep + (size_t)nxt.pn * g.a_pn_step : cA; const char* nB = has_next ? (const char*)g.Bt + (size_t)nxt.pn * g.b_pn_step : cB;
        for (int t = 0; t < nt; t += 2) {
            const bool last = (t == nt - 2);
            const char* a1 = cA + (size_t)(t + 1) * kstep;
            const char* a2 = last ? nA : cA + (size_t)(t + 2) * kstep; const char* b2 = last ? nB : cB + (size_t)(t + 2) * kstep;
            const char* a3 = a2 + kstep; const char* b3 = b2 + kstep;
            if (last && has_next) S.a_ready(nxt);
            if constexpr (SP2) {
            PG8_LDB(B0, 0, 0); PG8_LDB(B1, 0, 1); PG8_SCHED; PG8_LDA(At, 0, 0); PG8_STAGE(PG8_SA(1, 1), a1 + hstep, voffA);
            PG8_WAIT_V(8); PG8_WAIT_L(0); PG8_BAR; PG8_MMA(0, 0, At, B0); PG8_MMA(0, 1, At, B1); PG8_BAR; PG8_SCHED;
            PG8_LDA(At, 0, 1); PG8_STAGE(PG8_SB(0, 0), b2, voffB); PG8_STAGE(PG8_SB(0, 1), b2 + hstep, voffB); PG8_STAGE(PG8_SA(0, 0), a2, voffA);
            PG8_WAIT_V(8); PG8_WAIT_L(0); PG8_BAR; PG8_MMA(1, 0, At, B0); PG8_MMA(1, 1, At, B1); PG8_BAR; PG8_SCHED;
            PG8_LDB(B0, 1, 0); PG8_LDB(B1, 1, 1); PG8_SCHED; PG8_LDA(At, 1, 0); PG8_STAGE(PG8_SA(0, 1), a2 + hstep, voffA);
            PG8_WAIT_V(8); PG8_WAIT_L(0); PG8_BAR; PG8_MMA(0, 0, At, B0); PG8_MMA(0, 1, At, B1); PG8_BAR; PG8_SCHED;
            PG8_LDA(At, 1, 1); PG8_STAGE(PG8_SB(1, 0), b3, voffB); PG8_STAGE(PG8_SB(1, 1), b3 + hstep, voffB); PG8_STAGE(PG8_SA(1, 0), a3, voffA);
            PG8_WAIT_V(8); PG8_WAIT_L(0); PG8_BAR; PG8_MMA(1, 0, At, B0); PG8_MMA(1, 1, At, B1); PG8_BAR; PG8_SCHED;
            } else {
            PG8_LDB(B0, 0, 0); PG8_SCHED; PG8_LDA(At, 0, 0); PG8_STAGE(PG8_SA(1, 1), a1 + hstep, voffA);
            PG8_WAIT_L(8); PG8_BAR; PG8_WAIT_L(0); PG8_MMA(0, 0, At, B0); PG8_BAR; PG8_SCHED;
            PG8_LDB(B1, 0, 1); PG8_STAGE(PG8_SB(0, 0), b2, voffB);
            PG8_BAR; PG8_WAIT_L(0); PG8_MMA(0, 1, At, B1); PG8_BAR;
            PG8_LDA(At, 0, 1); PG8_STAGE(PG8_SA(0, 0), a2, voffA);
            PG8_BAR; PG8_WAIT_L(0); PG8_MMA(1, 0, At, B0); PG8_BAR; PG8_SCHED;
            PG8_STAGE(PG8_SB(0, 1), b2 + hstep, voffB);
            PG8_WAIT_V(6); PG8_BAR; PG8_MMA(1, 1, At, B1); PG8_BAR;
            PG8_LDB(B0, 1, 0); PG8_SCHED; PG8_LDA(At, 1, 0); PG8_STAGE(PG8_SA(0, 1), a2 + hstep, voffA);
            PG8_WAIT_L(8); PG8_BAR; PG8_WAIT_L(0); PG8_MMA(0, 0, At, B0); PG8_BAR; PG8_SCHED;
            PG8_LDB(B1, 1, 1); PG8_STAGE(PG8_SB(1, 0), b3, voffB);
            PG8_BAR; PG8_WAIT_L(0); PG8_MMA(0, 1, At, B1); PG8_BAR;
            PG8_LDA(At, 1, 1); PG8_STAGE(PG8_SA(1, 0), a3, voffA);
            PG8_BAR; PG8_WAIT_L(0); PG8_MMA(1, 0, At, B0); PG8_BAR; PG8_SCHED;
            PG8_STAGE(PG8_SB(1, 1), b3 + hstep, voffB);
            PG8_WAIT_V(6); PG8_BAR; PG8_MMA(1, 1, At, B1); PG8_BAR;
            }
        }
        if constexpr (ALIGN_EPI) { if (wr == 0) PG8_BAR; }
        if constexpr (!Epi::AFTER_DRAIN) { E(acc, cur, wr, wc, fr, fq); S.done(cur); }
        if (!has_next) break;
#pragma unroll
        for (int a = 0; a < 2; ++a)
#pragma unroll
            for (int b = 0; b < 2; ++b)
#pragma unroll
                for (int m = 0; m < 4; ++m)
#pragma unroll
                    for (int n = 0; n < 2; ++n) acc[a][b][m][n] = (f32x4){0.f, 0.f, 0.f, 0.f};
        cur = nxt; cA = nA; cB = nB; ++ui;
        if constexpr (ALIGN_EPI) { if (wr == 1) PG8_BAR; }
    }
    PG8_WAIT_V(0);
    if constexpr (!ALIGN_EPI) { if (wr == 0) PG8_BAR; }
    PG8_BAR;
#undef PG8_SA
#undef PG8_SB
#undef PG8_STAGE
#undef PG8_LDA
#undef PG8_LDB
#undef PG8_MMA
#undef PG8_WAIT_V
#undef PG8_WAIT_L
#undef PG8_BAR
#undef PG8_SCHED
}
}

#define XB_TMO      128
#define XB_XCNT(j)  (256  + 64 * (j))
#define XB_XSUB(j)  (1280 + 64 * (j))
#define XB_XGEN(j)  (2304 + 64 * (j))
#define XB_TOP      3328
#define XB_TOPGEN   3392
#define XCD_BAR_WORDS 3456
#define XB_SPIN_CAP (1u << 21)
#define LAS __attribute__((address_space(3)))

__device__ __forceinline__ unsigned xb_ld(unsigned* p)              { return __hip_atomic_load(p, __ATOMIC_RELAXED, __HIP_MEMORY_SCOPE_AGENT); }
__device__ __forceinline__ unsigned xb_add(unsigned* p, unsigned v) { return __hip_atomic_fetch_add(p, v, __ATOMIC_RELAXED, __HIP_MEMORY_SCOPE_AGENT); }
__device__ __forceinline__ unsigned xb_xcc_id() { return (unsigned)__builtin_amdgcn_s_getreg((3 << 11) | 20) & 0xFu; }
#define XB_SPIN(cond, bar) do { unsigned _sp = 0; while (cond) { __builtin_amdgcn_s_sleep(1); \
    if ((++_sp & 255u) == 0u) { if (xb_ld(&(bar)[XB_TMO])) break; if (_sp > XB_SPIN_CAP) { atomicAdd(&(bar)[XB_TMO], 1u); break; } } } } while (0)

struct XcdBarrier { unsigned* bar; unsigned x; volatile LAS unsigned* st; };

__device__ __forceinline__ XcdBarrier xcd_barrier_post(unsigned* bar, volatile LAS unsigned* st) {
    XcdBarrier b; b.bar = bar; b.x = xb_xcc_id(); b.st = st;
    if (threadIdx.x == 0) (void)xb_add(&bar[XB_XCNT(b.x)], 1u);
    return b;
}
__device__ __forceinline__ void xcd_barrier_complete(unsigned* bar, unsigned x, unsigned& nloc, unsigned& nx) {
    const unsigned G = gridDim.x * gridDim.y * gridDim.z;
    unsigned sum, cnt, mine, sp = 0u;
    for (;;) {
        sum = 0u; cnt = 0u; mine = 0u;
#pragma unroll
        for (unsigned j = 0; j < 16; ++j) { const unsigned c = xb_ld(&bar[XB_XCNT(j)]); sum += c; cnt += (c > 0u) ? 1u : 0u; mine = (j == x) ? c : mine; }
        if (sum == G) break;
        __builtin_amdgcn_s_sleep(1);
        if ((++sp & 255u) == 0u) { if (xb_ld(&bar[XB_TMO])) break; if (sp > XB_SPIN_CAP) { atomicAdd(&bar[XB_TMO], 1u); break; } }
    }
    nloc = mine > 0u ? mine : 1u; nx = cnt > 0u ? cnt : 1u;
}
__device__ __forceinline__ void xcd_barrier(const XcdBarrier& b) {
    asm volatile("s_waitcnt vmcnt(0)" ::: "memory");
    __syncthreads();
    if (threadIdx.x == 0) {
        unsigned* bar = b.bar;
        __builtin_amdgcn_s_waitcnt(0);
        unsigned nloc = b.st[0], nx = b.st[1];
        if (nloc == 0u) { xcd_barrier_complete(bar, b.x, nloc, nx); b.st[0] = nloc; b.st[1] = nx; }
        const unsigned old = xb_add(&bar[XB_XSUB(b.x)], 1u);
        const unsigned gen = old / nloc;
        if (old + 1u == (gen + 1u) * nloc) {
            __builtin_amdgcn_fence(__ATOMIC_RELEASE, "agent");
            asm volatile("s_waitcnt vmcnt(0)" ::: "memory");
            const unsigned og = xb_add(&bar[XB_TOP], 1u);
            const unsigned tg = og / nx;
            if (og + 1u == (tg + 1u) * nx) xb_add(&bar[XB_TOPGEN], 1u);
            else XB_SPIN(xb_ld(&bar[XB_TOPGEN]) == tg, bar);
            __builtin_amdgcn_fence(__ATOMIC_ACQUIRE, "agent");
            xb_add(&bar[XB_XGEN(b.x)], 1u);
            asm volatile("s_waitcnt vmcnt(0)" ::: "memory");
        } else {
            XB_SPIN(xb_ld(&bar[XB_XGEN(b.x)]) == gen, bar);
            __builtin_amdgcn_fence(__ATOMIC_ACQUIRE, "agent");
            asm volatile("s_waitcnt vmcnt(0)" ::: "memory");
        }
    }
    __syncthreads();
}

typedef unsigned short bf16;
typedef float f32x4 __attribute__((ext_vector_type(4)));
typedef unsigned u32x4 __attribute__((ext_vector_type(4)));
typedef unsigned u32x2 __attribute__((ext_vector_type(2)));

constexpr int D = 2048, DFF = 8192, MROWS = 16384, MCTX = 8192;
constexpr int NT = 512;
constexpr float EPS = 1e-6f;
constexpr int DN_NIN = 12416, DN_NMAIN = 12288, DN_NPAD = 12544;
constexpr int GLA_NIN = 6176, GLA_NMAIN = 6144, GLA_NPAD = 6400;
constexpr int HG_NIN = 10240;
constexpr int MODW = 12288;

constexpr size_t MiB = 1u << 20;
constexpr size_t WS_CTL = 0, CTL_BYTES = 1 * MiB;
constexpr size_t WS_MOD = 1 * MiB;
constexpr size_t WS_X = 2 * MiB;
constexpr size_t WS_H = WS_X + 128 * MiB;
constexpr size_t WS_BIG = WS_H + 64 * MiB;
constexpr size_t WS_GATE = WS_BIG + 384 * MiB;
constexpr size_t WS_QKV = WS_GATE + 8 * MiB;
constexpr size_t WS_OF = WS_QKV + 256 * MiB;
constexpr size_t WS_OB = WS_OF + 128 * MiB;
constexpr size_t WS_W = WS_OB + 128 * MiB;
constexpr size_t WOFF_IN = 0, WOFF_OUT = (size_t)DN_NPAD * D * 2, WOFF_UP = WOFF_OUT + (size_t)D * 4096 * 2, WOFF_DOWN = WOFF_UP + (size_t)DFF * D * 2;
constexpr size_t WS_TA = ((WS_W + WOFF_DOWN + (size_t)D * DFF * 2 + MiB - 1) / MiB) * MiB;
constexpr size_t WS_GS = WS_TA + 256 * MiB;
constexpr size_t WS_GP = WS_GS + 12 * MiB;
constexpr size_t WS_END = WS_GP + 32 * MiB;

constexpr size_t OUT_Y = 0;
constexpr size_t OUT_SDN = (size_t)MROWS * D;
constexpr size_t OUT_SGLA = OUT_SDN + (size_t)32 * 2 * 2 * 32 * 128 * 128;
constexpr size_t OUT_SHG = OUT_SGLA + (size_t)32 * 2 * 4 * 256 * 512;
constexpr size_t OUT_END = OUT_SHG + (size_t)32 * 2 * 16 * 128 * 128;

constexpr int LDS_BYTES = 151552;
constexpr int LDS_MISC = 150528;

struct Params {
    const float* in[29];
    float* out;
    unsigned char* ws;
};

__device__ __forceinline__ float bf2f(unsigned short b) { return __uint_as_float(((unsigned)b) << 16); }
typedef __bf16 bfv2_ __attribute__((ext_vector_type(2)));
typedef float f32x2_ __attribute__((ext_vector_type(2)));
__device__ __forceinline__ unsigned f2bf(float f) { return (unsigned)__builtin_bit_cast(unsigned short, (__bf16)f); }
__device__ __forceinline__ unsigned pk2(float lo, float hi) { const f32x2_ v = {lo, hi}; return __builtin_bit_cast(unsigned, __builtin_convertvector(v, bfv2_)); }
__device__ __forceinline__ float bflo(unsigned w) { return __uint_as_float(w << 16); }
__device__ __forceinline__ float bfhi(unsigned w) { return __uint_as_float(w & 0xffff0000u); }
__device__ __forceinline__ float wave_sum(float v) {
#pragma unroll
    for (int o = 1; o < 64; o <<= 1) v += __shfl_xor(v, o);
    return v;
}
__device__ __forceinline__ float rdlane(float v, int l) { return __builtin_bit_cast(float, __builtin_amdgcn_readlane(__builtin_bit_cast(int, v), l)); }
__device__ __forceinline__ float sigmoidf_(float x) { return __builtin_amdgcn_rcpf(1.f + __expf(-x)); }
__device__ __forceinline__ float siluf_(float x) { return x * __builtin_amdgcn_rcpf(1.f + __expf(-x)); }
__device__ __forceinline__ float softplusf_(float x) { return fmaxf(x, 0.f) + log1pf(__expf(-fabsf(x))); }

__device__ __forceinline__ void transpose_item(const float* W, int K, int N, bf16* WT, LAS float* scr, int item, int lane) {
    const int nblk = N / 32, kb = item / nblk, nb = item % nblk, k0 = 64 * kb, n0 = 32 * nb;
    { f32x4 v[8]; const int kr = lane >> 3, c4 = (lane & 7) * 4;
#pragma unroll
      for (int i = 0; i < 8; ++i) v[i] = *(const f32x4*)(W + (size_t)(k0 + kr + 8 * i) * N + n0 + c4);
#pragma unroll
      for (int i = 0; i < 8; ++i) { LAS float* d = scr + (kr + 8 * i) * 33 + c4; d[0] = v[i].x; d[1] = v[i].y; d[2] = v[i].z; d[3] = v[i].w; } }
    asm volatile("s_waitcnt lgkmcnt(0)" ::: "memory");
    const int c = lane & 7;
#pragma unroll
    for (int j = 0; j < 4; ++j) { const int n = (lane >> 3) + 8 * j; const LAS float* s = scr + (8 * c) * 33 + n;
        u32x4 o; o.x = pk2(s[0 * 33], s[1 * 33]); o.y = pk2(s[2 * 33], s[3 * 33]); o.z = pk2(s[4 * 33], s[5 * 33]); o.w = pk2(s[6 * 33], s[7 * 33]);
        *(u32x4*)(WT + (size_t)(n0 + n) * K + k0 + 8 * c) = o; }
    asm volatile("s_waitcnt lgkmcnt(0)" ::: "memory");
}

__device__ __forceinline__ void convert_layer_weights(const Params& P, int layer, LAS unsigned char* lds) {
    PHASE_IDS();
    LAS float* scr = (LAS float*)(lds + wave * 16384);
    const int kind = layer % 3, j = layer / 3;
    const float* Win; int Nin, Npad; const float* Wout; int Kout;
    if (kind == 0) { Win = P.in[14] + (size_t)j * D * DN_NIN; Nin = DN_NIN; Npad = DN_NPAD; Wout = P.in[19] + (size_t)j * 4096 * D; Kout = 4096; }
    else if (kind == 1) { Win = P.in[20] + (size_t)j * D * GLA_NIN; Nin = GLA_NIN; Npad = GLA_NPAD; Wout = P.in[24] + (size_t)j * D * D; Kout = 2048; }
    else { Win = P.in[25] + (size_t)j * D * HG_NIN; Nin = HG_NIN; Npad = HG_NIN; Wout = P.in[28] + (size_t)j * D * D; Kout = 2048; }
    const float* Wup = P.in[12] + (size_t)layer * D * DFF; const float* Wdn = P.in[13] + (size_t)layer * DFF * D;
    bf16* Tin = (bf16*)(P.ws + WS_W + WOFF_IN); bf16* Tout = (bf16*)(P.ws + WS_W + WOFF_OUT); bf16* Tup = (bf16*)(P.ws + WS_W + WOFF_UP); bf16* Tdn = (bf16*)(P.ws + WS_W + WOFF_DOWN);
    const int I_in = (D / 64) * (Nin / 32), I_out = (Kout / 64) * (D / 32), I_up = (D / 64) * (DFF / 32), I_dn = (DFF / 64) * (D / 32);
    const int NI = I_in + I_out + I_up + I_dn;
    for (int it = gw; it < NI; it += NGW) {
        int r = it;
        if (r < I_in) { transpose_item(Win, D, Nin, Tin, scr, r, lane); continue; } r -= I_in;
        if (r < I_out) { transpose_item(Wout, Kout, D, Tout, scr, r, lane); continue; } r -= I_out;
        if (r < I_up) { transpose_item(Wup, D, DFF, Tup, scr, r, lane); continue; } r -= I_up;
        transpose_item(Wdn, DFF, D, Tdn, scr, r, lane);
    }
    const int npadrows = Npad - Nin;
    if (npadrows > 0) {
        u32x4* z = (u32x4*)(Tin + (size_t)Nin * D); const int n16 = npadrows * D / 8;
        for (int i = gw * 64 + lane; i < n16; i += NGW * 64) z[i] = (u32x4){0u, 0u, 0u, 0u};
    }
}

__device__ __forceinline__ void mod_phase(const Params& P, LAS unsigned char* lds) {
    PHASE_IDS();
    LAS float* scond = (LAS float*)lds;
    LAS float* red = (LAS float*)(lds + 40960 + 1024);
    for (int i = tid; i < 5 * 2048; i += NT) { const int g = i / 2048, k = i % 2048; const float v = g == 0 ? P.in[6][k] : P.in[2][(g - 1) * 2048 + k]; scond[k * 5 + g] = siluf_(v); }
    __syncthreads();
    float* mod = (float*)(P.ws + WS_MOD);
    const int c4 = tid & 15, kg = tid >> 4;
    for (int cg = blockIdx.x; cg < 4 * MODW / 64; cg += gridDim.x) {
        const int layer = cg / (MODW / 64), colbase = (cg % (MODW / 64)) * 64;
        const float* W = P.in[7] + (size_t)layer * D * MODW + colbase + c4 * 4;
        f32x4 acc[5];
#pragma unroll
        for (int g = 0; g < 5; ++g) acc[g] = (f32x4){0.f, 0.f, 0.f, 0.f};
#pragma unroll 8
        for (int kk = 0; kk < 64; ++kk) {
            const int k = kg * 64 + kk;
            const f32x4 w = *(const f32x4*)(W + (size_t)k * MODW);
#pragma unroll
            for (int g = 0; g < 5; ++g) acc[g] += w * scond[k * 5 + g];
        }
#pragma unroll
        for (int g = 0; g < 5; ++g)
#pragma unroll
            for (int e = 0; e < 4; ++e) red[(kg * 64 + c4 * 4 + e) * 5 + g] = acc[g][e];
        __syncthreads();
        if (tid < 64 * 5) { const int c = tid / 5, g = tid % 5; float sum = 0.f;
#pragma unroll 8
            for (int q = 0; q < 32; ++q) sum += red[(q * 64 + c) * 5 + g];
            mod[((size_t)layer * 5 + g) * MODW + colbase + c] = sum + P.in[8][(size_t)layer * MODW + colbase + c]; }
        __syncthreads();
    }
}

template <bool XF32> __device__ __forceinline__ void norm_mod_phase(const void* xc, const void* xl, const float* w, const float* mod, int sh_off, int sc_off, bf16* H) {
    PHASE_IDS();
    for (int m = gw; m < MROWS; m += NGW) {
        const bool ctx = m < MCTX; const int grp = ctx ? 0 : 1 + ((m - MCTX) >> 11);
        f32x4 v[8]; float ss = 0.f;
        if (XF32) { const float* xr = ctx ? (const float*)xc + (size_t)m * D : (const float*)xl + (size_t)(m - MCTX) * D;
#pragma unroll
            for (int jx = 0; jx < 4; ++jx) { v[2 * jx] = *(const f32x4*)(xr + 8 * (lane + 64 * jx)); v[2 * jx + 1] = *(const f32x4*)(xr + 8 * (lane + 64 * jx) + 4); } }
        else { const bf16* xr = (const bf16*)xc + (size_t)m * D;
#pragma unroll
            for (int jx = 0; jx < 4; ++jx) { const u32x4 q = *(const u32x4*)(xr + 8 * (lane + 64 * jx));
                v[2 * jx] = (f32x4){bflo(q.x), bfhi(q.x), bflo(q.y), bfhi(q.y)}; v[2 * jx + 1] = (f32x4){bflo(q.z), bfhi(q.z), bflo(q.w), bfhi(q.w)}; } }
#pragma unroll
        for (int i = 0; i < 8; ++i) ss += (v[i].x * v[i].x + v[i].y * v[i].y) + (v[i].z * v[i].z + v[i].w * v[i].w);
        const float rstd = rsqrtf(wave_sum(ss) * (1.f / D) + EPS);
        const float* mg = mod + (size_t)grp * MODW;
#pragma unroll
        for (int jx = 0; jx < 4; ++jx) { const int c = 8 * (lane + 64 * jx);
            const f32x4 y0 = v[2 * jx] * rstd * *(const f32x4*)(w + c) * (*(const f32x4*)(mg + sc_off + c) + 1.f) + *(const f32x4*)(mg + sh_off + c);
            const f32x4 y1 = v[2 * jx + 1] * rstd * *(const f32x4*)(w + c + 4) * (*(const f32x4*)(mg + sc_off + c + 4) + 1.f) + *(const f32x4*)(mg + sh_off + c + 4);
            u32x4 o; o.x = pk2(y0.x, y0.y); o.y = pk2(y0.z, y0.w); o.z = pk2(y1.x, y1.y); o.w = pk2(y1.z, y1.w);
            *(u32x4*)(H + (size_t)m * D + c) = o; }
    }
}
__device__ __forceinline__ void final_norm_phase(const bf16* X, const float* w, float* out) {
    PHASE_IDS();
    for (int m = gw; m < MROWS; m += NGW) {
        f32x4 v[8]; float ss = 0.f;
#pragma unroll
        for (int jx = 0; jx < 4; ++jx) { const u32x4 q = *(const u32x4*)(X + (size_t)m * D + 8 * (lane + 64 * jx));
            v[2 * jx] = (f32x4){bflo(q.x), bfhi(q.x), bflo(q.y), bfhi(q.y)}; v[2 * jx + 1] = (f32x4){bflo(q.z), bfhi(q.z), bflo(q.w), bfhi(q.w)}; }
#pragma unroll
        for (int i = 0; i < 8; ++i) ss += (v[i].x * v[i].x + v[i].y * v[i].y) + (v[i].z * v[i].z + v[i].w * v[i].w);
        const float rstd = rsqrtf(wave_sum(ss) * (1.f / D) + EPS);
#pragma unroll
        for (int jx = 0; jx < 4; ++jx) { const int c = 8 * (lane + 64 * jx);
            *(f32x4*)(out + (size_t)m * D + c) = v[2 * jx] * rstd * *(const f32x4*)(w + c); *(f32x4*)(out + (size_t)m * D + c + 4) = v[2 * jx + 1] * rstd * *(const f32x4*)(w + c + 4); }
    }
}

template <int DV> __device__ __forceinline__ void gate_phase(const bf16* OF, const bf16* OB, const bf16* proj, int ldp, int gcol0, const float* nw, bf16* Y, int W) {
    PHASE_IDS();
    const int ncg = W / 512;
    const int nitems = MROWS * ncg;
    for (int it0 = gw; it0 < nitems; it0 += 2 * NGW) {
        u32x4 a[2], b[2], gz[2]; int mm[2], cc[2]; bool ok[2];
#pragma unroll
        for (int u = 0; u < 2; ++u) { const int it = it0 + u * NGW; ok[u] = it < nitems; const int itc = ok[u] ? it : it0; mm[u] = itc / ncg; cc[u] = (itc % ncg) * 512 + lane * 8;
            a[u] = *(const u32x4*)(OF + (size_t)mm[u] * W + cc[u]); b[u] = *(const u32x4*)(OB + (size_t)mm[u] * W + cc[u]); gz[u] = *(const u32x4*)(proj + (size_t)mm[u] * ldp + gcol0 + cc[u]); }
#pragma unroll
        for (int u = 0; u < 2; ++u) {
            float o[8], z[8];
            o[0] = bflo(a[u].x) + bflo(b[u].x); o[1] = bfhi(a[u].x) + bfhi(b[u].x); o[2] = bflo(a[u].y) + bflo(b[u].y); o[3] = bfhi(a[u].y) + bfhi(b[u].y);
            o[4] = bflo(a[u].z) + bflo(b[u].z); o[5] = bfhi(a[u].z) + bfhi(b[u].z); o[6] = bflo(a[u].w) + bflo(b[u].w); o[7] = bfhi(a[u].w) + bfhi(b[u].w);
            z[0] = bflo(gz[u].x); z[1] = bfhi(gz[u].x); z[2] = bflo(gz[u].y); z[3] = bfhi(gz[u].y); z[4] = bflo(gz[u].z); z[5] = bfhi(gz[u].z); z[6] = bflo(gz[u].w); z[7] = bfhi(gz[u].w);
            float ss = 0.f;
#pragma unroll
            for (int i = 0; i < 8; ++i) ss += o[i] * o[i];
#pragma unroll
            for (int sft = 1; sft < DV / 8; sft <<= 1) ss += __shfl_xor(ss, sft);
            const float rstd = rsqrtf(ss * (1.f / DV) + EPS);
            const int cw = cc[u] % DV;
            const f32x4 w0 = *(const f32x4*)(nw + cw), w1 = *(const f32x4*)(nw + cw + 4);
            const float wv[8] = {w0.x, w0.y, w0.z, w0.w, w1.x, w1.y, w1.z, w1.w};
            float y[8];
#pragma unroll
            for (int i = 0; i < 8; ++i) y[i] = o[i] * rstd * wv[i] * siluf_(z[i]);
            u32x4 rr; rr.x = pk2(y[0], y[1]); rr.y = pk2(y[2], y[3]); rr.z = pk2(y[4], y[5]); rr.w = pk2(y[6], y[7]);
            if (ok[u]) *(u32x4*)(Y + (size_t)mm[u] * W + cc[u]) = rr;
        }
    }
}

__device__ __forceinline__ void dn_prep_phase(const Params& P, int j, bool do_gates = true) {
    PHASE_IDS();
    const bf16* proj = (const bf16*)(P.ws + WS_BIG); bf16* QKV = (bf16*)(P.ws + WS_QKV);
    const float* cw = P.in[15] + (size_t)j * 5 * 8192;
    for (int it = gw; it < 16 * 128; it += NGW) {
        const int cg = it & 15, chunk = it >> 4, c = cg * 512 + lane * 8;
        float w[5][8];
#pragma unroll
        for (int s = 0; s < 5; ++s) { const f32x4 a = *(const f32x4*)(cw + s * 8192 + c), b = *(const f32x4*)(cw + s * 8192 + c + 4);
            w[s][0] = a.x; w[s][1] = a.y; w[s][2] = a.z; w[s][3] = a.w; w[s][4] = b.x; w[s][5] = b.y; w[s][6] = b.z; w[s][7] = b.w; }
        const float qsc = cg < 4 ? 0.08838834764831845f : 1.f;
        for (int bt = 0; bt < 16; ++bt) {
            const int r0 = chunk * 128 + bt * 8;
            const int L = r0 < MCTX ? 256 : 64, pos0 = r0 < MCTX ? (r0 & 255) : ((r0 - MCTX) & 63);
            u32x4 xw[12];
#pragma unroll
            for (int i = 0; i < 12; ++i) { const int pp = pos0 + i - 2;
                xw[i] = (pp >= 0 && pp < L) ? *(const u32x4*)(proj + (size_t)(r0 + i - 2) * DN_NMAIN + c) : (u32x4){0u, 0u, 0u, 0u}; }
#pragma unroll
            for (int o = 0; o < 8; ++o) {
                float acc[8];
#pragma unroll
                for (int i = 0; i < 8; ++i) acc[i] = 0.f;
#pragma unroll
                for (int s = 0; s < 5; ++s) { const u32x4 x = xw[o + s];
                    acc[0] += bflo(x.x) * w[s][0]; acc[1] += bfhi(x.x) * w[s][1]; acc[2] += bflo(x.y) * w[s][2]; acc[3] += bfhi(x.y) * w[s][3];
                    acc[4] += bflo(x.z) * w[s][4]; acc[5] += bfhi(x.z) * w[s][5]; acc[6] += bflo(x.w) * w[s][6]; acc[7] += bfhi(x.w) * w[s][7]; }
                float ss = 0.f;
#pragma unroll
                for (int i = 0; i < 8; ++i) { acc[i] = siluf_(acc[i]); ss += acc[i] * acc[i]; }
                if (cg < 8) {
                    ss += __shfl_xor(ss, 1); ss += __shfl_xor(ss, 2); ss += __shfl_xor(ss, 4); ss += __shfl_xor(ss, 8);
                    const float sc = rsqrtf(ss + EPS) * qsc;
#pragma unroll
                    for (int i = 0; i < 8; ++i) acc[i] *= sc;
                }
                u32x4 ov; ov.x = pk2(acc[0], acc[1]); ov.y = pk2(acc[2], acc[3]); ov.z = pk2(acc[4], acc[5]); ov.w = pk2(acc[6], acc[7]);
                *(u32x4*)(QKV + (size_t)(r0 + o) * 8192 + c) = ov;
            }
        }
    }
    if (!do_gates) return;
    float* G = (float*)(P.ws + WS_GATE);
    const float* Alog = P.in[16] + j * 64; const float* dtb = P.in[17] + j * 64;
    const float* GPp = (const float*)(P.ws + WS_GP);
    for (int i = gw * 64 + lane; i < MROWS * 128; i += NGW * 64) {
        const int col = i & 127; const float x = (GPp[i] + GPp[i + (size_t)MROWS * 128]) + (GPp[i + (size_t)2 * MROWS * 128] + GPp[i + (size_t)3 * MROWS * 128]); float y;
        if (col < 64) y = sigmoidf_(x);
        else { const int dh = col - 64; y = -__expf(Alog[dh]) * softplusf_(x + dtb[dh]); }
        G[i] = y;
    }
}

typedef short bf16x8 __attribute__((ext_vector_type(8)));
typedef short s16x4 __attribute__((ext_vector_type(4)));
typedef __bf16 bfv8 __attribute__((ext_vector_type(8)));
typedef float f32x8 __attribute__((ext_vector_type(8)));
__device__ __forceinline__ bf16x8 pack8(f32x4 a, f32x4 b) { const f32x8 v = {a[0], a[1], a[2], a[3], b[0], b[1], b[2], b[3]}; return __builtin_bit_cast(bf16x8, __builtin_convertvector(v, bfv8)); }
__device__ __forceinline__ bf16x8 cat4(s16x4 a, s16x4 b) { return (bf16x8){a[0], a[1], a[2], a[3], b[0], b[1], b[2], b[3]}; }
__device__ __forceinline__ s16x4 ld_tr(const LAS unsigned char* p) { return __builtin_amdgcn_ds_read_tr16_b64_v4i16((LAS s16x4*)p); }
__device__ __forceinline__ s16x4 ld_b64(const LAS unsigned char* p) { return *(const volatile LAS s16x4*)p; }
__device__ __forceinline__ bf16x8 ld_b128(const LAS unsigned char* p) { return *(const LAS bf16x8*)p; }
#define MFMA16(a, b, c) __builtin_amdgcn_mfma_f32_16x16x32_bf16((a), (b), (c), 0, 0, 0)

template <int KIND> __device__ __forceinline__ void gla_prep_phase(const Params& P, LAS unsigned char* lds) {
    PHASE_IDS();
    constexpr int NCH = KIND == 1 ? 1024 : 2048, LDP = KIND == 1 ? GLA_NMAIN : HG_NIN, NCB = NCH / 1024;
    const bf16* proj = (const bf16*)(P.ws + WS_BIG); const float* G = (const float*)(P.ws + WS_GATE);
    bf16* QT = (bf16*)(P.ws + WS_QKV); bf16* KT = QT + (size_t)2 * MROWS * NCH; float* E = (float*)(P.ws + WS_OF + 64 * MiB);
    constexpr int DKH = KIND == 1 ? 256 : 128, NHB = 1024 / DKH  , NHT = NCH / DKH  , PL = 2064  ;
    LAS unsigned char* QL = lds; LAS unsigned char* KL = lds + 32 * PL;
    LAS float* sa1 = (LAS float*)(lds + 2 * 32 * PL);
    unsigned* PG = (unsigned*)(P.ws + WS_OF + 72 * MiB);
    for (int it = blockIdx.x; it < 2 * 512 * NCB; it += gridDim.x) {
        const int cb_ = it % NCB, cidx = (it / NCB) % 512, d = it / (NCB * 512);
        const int c0 = cb_ * 1024 + 2 * tid, rbase = cidx * 32;
        float w0[16], w1[16], b0 = 0.f, b1 = 0.f, lb0 = 0.f, lb1 = 0.f;
        if (KIND == 1) {
            __syncthreads();
            { const int p = tid >> 4, r = tid & 15; const int row = rbase + (d ? 31 - p : p); const size_t gi = (size_t)row * 128 + d * 16 + r; const float* GPp = (const float*)(P.ws + WS_GP); sa1[tid] = (GPp[gi] + GPp[gi + (size_t)MROWS * 128]) + (GPp[gi + (size_t)2 * MROWS * 128] + GPp[gi + (size_t)3 * MROWS * 128]); }
            __syncthreads();
            const float* w2 = P.in[21] + (size_t)d * 16 * 1024 + c0;
#pragma unroll
            for (int r = 0; r < 16; ++r) { w0[r] = w2[(size_t)r * 1024]; w1[r] = w2[(size_t)r * 1024 + 1]; }
            b0 = P.in[22][d * 1024 + c0]; b1 = P.in[22][d * 1024 + c0 + 1];
        } else {
            const float* lg = P.in[26];
            { const float l0 = lg[c0], l1 = lg[2048 + c0], l2 = lg[4096 + c0], l3 = lg[6144 + c0]; const float mx = fmaxf(fmaxf(l0, l1), fmaxf(l2, l3));
              const float e0 = __expf(l0 - mx), e1 = __expf(l1 - mx), e2 = __expf(l2 - mx), e3 = __expf(l3 - mx); lb0 = (e1 + e2) / ((e0 + e1) + (e2 + e3)); }
            { const float l0 = lg[c0 + 1], l1 = lg[2048 + c0 + 1], l2 = lg[4096 + c0 + 1], l3 = lg[6144 + c0 + 1]; const float mx = fmaxf(fmaxf(l0, l1), fmaxf(l2, l3));
              const float e0 = __expf(l0 - mx), e1 = __expf(l1 - mx), e2 = __expf(l2 - mx), e3 = __expf(l3 - mx); lb1 = (e1 + e2) / ((e0 + e1) + (e2 + e3)); }
        }
        float cs0 = KIND == 1 ? 0.f : 1.f, cs1 = cs0;
        constexpr int XOFF_G = 1024;
        const int xoff = KIND == 1 ? XOFF_G : (d ? 8192 : 6144);
        unsigned nq[8], nx[8];
#define GP_LOAD(pb_) do { _Pragma("unroll") for (int u = 0; u < 8; ++u) { const int pp_ = (pb_) + u; const bf16* pr_ = proj + (size_t)(rbase + (d ? 31 - pp_ : pp_)) * LDP + c0; nq[u] = *(const unsigned*)pr_; nx[u] = *(const unsigned*)(pr_ + xoff); } } while (0)
        GP_LOAD(0);
#pragma unroll 1
        for (int pb8 = 0; pb8 < 32; pb8 += 8) {
          unsigned cq[8], cx[8];
#pragma unroll
          for (int u = 0; u < 8; ++u) { cq[u] = nq[u]; cx[u] = nx[u]; }
          { const int pn = pb8 + 8 < 32 ? pb8 + 8 : pb8; GP_LOAD(pn); }
#pragma unroll
          for (int u = 0; u < 8; ++u) {
            const int p = pb8 + u;
            const int row = rbase + (d ? 31 - p : p);
            float q0, q1, k0, k1, la0, la1;
            if (KIND == 1) {
                const unsigned qw = cq[u], kw = cx[u];
                q0 = bflo(qw) * 0.0625f; q1 = bfhi(qw) * 0.0625f; k0 = bflo(kw); k1 = bfhi(kw);
                float x0 = b0, x1 = b1;
#pragma unroll
                for (int r = 0; r < 16; ++r) { const float a = sa1[p * 16 + r]; x0 = __builtin_fmaf(a, w0[r], x0); x1 = __builtin_fmaf(a, w1[r], x1); }
                la0 = (fminf(x0, 0.f) - __logf(1.f + __expf(-fabsf(x0)))) * 0.0625f; la1 = (fminf(x1, 0.f) - __logf(1.f + __expf(-fabsf(x1)))) * 0.0625f;
            } else {
                const unsigned qw = cq[u], fw = cx[u];
                q0 = siluf_(bflo(qw)) * 0.08838834764831845f; q1 = siluf_(bfhi(qw)) * 0.08838834764831845f;
                const float a0 = lb0 + (1.f - lb0) * sigmoidf_(bflo(fw)), a1 = lb1 + (1.f - lb1) * sigmoidf_(bfhi(fw));
                k0 = 1.f - a0; k1 = 1.f - a1; la0 = a0; la1 = a1;
            }
            float e0, e1, i0, i1;
            if (KIND == 1) { cs0 += la0; cs1 += la1; e0 = __expf(cs0); e1 = __expf(cs1); i0 = __expf(-cs0); i1 = __expf(-cs1); }
            else { cs0 *= la0; cs1 *= la1; e0 = cs0; e1 = cs1; i0 = __builtin_amdgcn_rcpf(cs0); i1 = __builtin_amdgcn_rcpf(cs1); }
            const size_t o = ((size_t)d * MROWS + row) * NCH + c0;
            const unsigned qb = pk2(q0 * e0, q1 * e1), kb = pk2(k0 * i0, k1 * i1);
            *(unsigned*)(QT + o) = qb; *(unsigned*)(KT + o) = kb;
            *(LAS unsigned*)(QL + p * PL + 4 * tid) = qb; *(LAS unsigned*)(KL + p * PL + 4 * tid) = kb;
          }
        }
#undef GP_LOAD
        { float* e = E + ((size_t)d * 512 + cidx) * NCH + c0; e[0] = KIND == 1 ? __expf(cs0) : cs0; e[1] = KIND == 1 ? __expf(cs1) : cs1; }
        __syncthreads();
        {
            const int r = lane & 15, g = lane >> 4;
            const int hl = KIND == 1 ? (wave >> 1) : wave; const int cbase = hl * DKH;
            f32x4 t0 = {0.f, 0.f, 0.f, 0.f}, t1 = t0, t2 = t0;
            const bool do02 = KIND == 1 ? ((wave & 1) == 0) : true, do1 = KIND == 1 ? ((wave & 1) == 1) : true;
#pragma unroll
            for (int sx = 0; sx < DKH / 32; ++sx) {
                const int cb2 = (cbase + 32 * sx + 8 * g) * 2;
                const bf16x8 k0 = ld_b128(KL + r * PL + cb2), q1 = ld_b128(QL + (16 + r) * PL + cb2);
                if (do02) { const bf16x8 q0 = ld_b128(QL + r * PL + cb2), k1 = ld_b128(KL + (16 + r) * PL + cb2); t0 = MFMA16(k0, q0, t0); t2 = MFMA16(k1, q1, t2); }
                if (do1) t1 = MFMA16(k0, q1, t1);
            }
#pragma unroll
            for (int e = 0; e < 4; ++e) { if (r < 4 * g + e) { t0[e] = 0.f; t2[e] = 0.f; } }
            unsigned* pg = PG + (((size_t)d * 512 + cidx) * NHT + cb_ * NHB + hl) * 384 + lane * 2;
            if (do02) { pg[0] = pk2(t0[0], t0[1]); pg[1] = pk2(t0[2], t0[3]); pg[256] = pk2(t2[0], t2[1]); pg[257] = pk2(t2[2], t2[3]); }
            if (do1) { pg[128] = pk2(t1[0], t1[1]); pg[129] = pk2(t1[2], t1[3]); }
        }
        __syncthreads();
    }
}

template <int KIND> __device__ __forceinline__ void gla_chunk_phase(const Params& P, LAS unsigned char* lds) {
    PHASE_IDS();
    constexpr int DK = KIND == 1 ? 256 : 128, DV = KIND == 1 ? 512 : 128, NH = KIND == 1 ? 4 : 16, NSL = DV / 128, NKT = DK / 16, NCH = NH * DK;
    constexpr int LDP = KIND == 1 ? GLA_NMAIN : HG_NIN, W = 2048;
    constexpr int PQ = DK * 2 + 16, PV = 256 + 16;
    constexpr int OFF_Q = 0, OFF_K = 32 * PQ, OFF_V = 2 * 32 * PQ, OFF_E = OFF_V + 32 * PV;
    constexpr int NPQ = 32 * DK / 8 / NT;
    const bf16* proj = (const bf16*)(P.ws + WS_BIG);
    const bf16* QT = (const bf16*)(P.ws + WS_QKV); const bf16* KT = QT + (size_t)2 * MROWS * NCH; const float* Eg = (const float*)(P.ws + WS_OF + 64 * MiB);
    bf16* OF = (bf16*)(P.ws + WS_OF); bf16* OB = (bf16*)(P.ws + WS_OB);
    const u32x2* PG = (const u32x2*)(P.ws + WS_OF + 72 * MiB);
    const int r = lane & 15, g = lane >> 4, q4 = (lane & 15) >> 2, p4 = lane & 3;
    constexpr int UL = 4 * NH * 2 * NSL  , UC = 32 * NH * 2 * NSL  ;
    const int G = gridDim.x, bx = blockIdx.x;
    const bool bal = (G == 2 * UL);
    const int nun = bal ? (bx < UL ? 1 : UC / UL) : (UL + UC - bx + G - 1) / G;
    for (int ui = 0; ui < nun; ++ui) {
        const int bxl = bx < UL ? bx : bx - UL;
        const int bxq = (bal && NSL == 4) ? (((bxl & 7) + 8 * (bxl >> 5)) * 4 + ((bxl >> 3) & 3)) : bxl;
        const int unit = bal ? (bx < UL ? bxq : UL + bxq + UL * ui) : bx + ui * G;
        const bool lat = unit < UL; int u2 = lat ? unit : unit - UL;
        const int sl = u2 % NSL; u2 /= NSL; const int d = u2 & 1; u2 >>= 1; const int h = u2 % NH; const int b = u2 / NH;
        const int T = lat ? 2048 : 256, row0 = lat ? MCTX + b * 2048 : b * 256, nchunk = T / 32;
        bf16* O = d ? OB : OF;
        f32x4 S[NKT];
        { const float* s0 = (KIND == 1 ? P.in[4] : P.in[5]) + ((((size_t)b * 2 + d) * NH + h) * DK) * DV + sl * 128 + 16 * wave + r;
#pragma unroll
          for (int kt = 0; kt < NKT; ++kt)
#pragma unroll
              for (int e = 0; e < 4; ++e) S[kt][e] = lat ? s0[(size_t)(16 * kt + 4 * g + e) * DV] : 0.f; }
        u32x4 rq[NPQ], rk[NPQ], rv; f32x4 re = {0.f, 0.f, 0.f, 0.f}; u32x2 rp0 = {0u, 0u}, rp1 = rp0, rp2 = rp0;
#define GLC_PREFETCH(c_) do { \
            _Pragma("unroll") for (int x = 0; x < NPQ; ++x) { const int pi = tid + x * NT, pr = pi / (DK / 8), pc = pi % (DK / 8); const int pp = (c_) * 32 + pr; const int t = d ? T - 1 - pp : pp; \
                const size_t o = ((size_t)d * MROWS + row0 + t) * NCH + h * DK + pc * 8; rq[x] = *(const u32x4*)(QT + o); rk[x] = *(const u32x4*)(KT + o); } \
            { const int pr = tid >> 4, pc = tid & 15; const int pp = (c_) * 32 + pr; const int t = d ? T - 1 - pp : pp; rv = *(const u32x4*)(proj + (size_t)(row0 + t) * LDP + 2048 + h * DV + sl * 128 + pc * 8); } \
            { const int cg = d ? (row0 + T) / 32 - 1 - (c_) : row0 / 32 + (c_); if (tid < DK / 4) re = *(const f32x4*)(Eg + ((size_t)d * 512 + cg) * NCH + h * DK + tid * 4); \
              const u32x2* pg = PG + (((size_t)d * 512 + cg) * NH + h) * 192 + lane; rp0 = pg[0]; rp1 = pg[64]; rp2 = pg[128]; } } while (0)
        GLC_PREFETCH(0);
        for (int c = 0; c < nchunk; ++c) {
            __syncthreads();
#pragma unroll
            for (int x = 0; x < NPQ; ++x) { const int pi = tid + x * NT, pr = pi / (DK / 8), pc = pi % (DK / 8);
                *(LAS u32x4*)(lds + OFF_Q + pr * PQ + pc * 16) = rq[x]; *(LAS u32x4*)(lds + OFF_K + pr * PQ + pc * 16) = rk[x]; }
            { const int pr = tid >> 4, pc = tid & 15; *(LAS u32x4*)(lds + OFF_V + pr * PV + pc * 16) = rv; }
            if (tid < DK / 4) *(LAS f32x4*)(lds + OFF_E + tid * 16) = re;
            __syncthreads();
            const u32x2 cp0 = rp0, cp1 = rp1, cp2 = rp2;
            if (c + 1 < nchunk) GLC_PREFETCH(c + 1);
            const f32x4 zero4 = {0.f, 0.f, 0.f, 0.f};
            const bf16x8 vpa = cat4(ld_tr(lds + OFF_V + (4 * g + q4) * PV + (16 * wave + 4 * p4) * 2), ld_tr(lds + OFF_V + (16 + 4 * g + q4) * PV + (16 * wave + 4 * p4) * 2));
            const bf16x8 pb0 = __builtin_bit_cast(bf16x8, (u32x4){cp0.x, cp0.y, 0u, 0u}), pb1 = __builtin_bit_cast(bf16x8, (u32x4){cp1.x, cp1.y, cp2.x, cp2.y});
            f32x4 o0 = MFMA16(vpa, pb0, zero4), o1 = MFMA16(vpa, pb1, zero4);
#pragma unroll
            for (int s = 0; s < DK / 32; ++s) {
                const bf16x8 sb = pack8(S[2 * s], S[2 * s + 1]);
                const bf16x8 a0 = cat4(ld_b64(lds + OFF_Q + r * PQ + (32 * s + 4 * g) * 2), ld_b64(lds + OFF_Q + r * PQ + (32 * s + 16 + 4 * g) * 2));
                const bf16x8 a1 = cat4(ld_b64(lds + OFF_Q + (16 + r) * PQ + (32 * s + 4 * g) * 2), ld_b64(lds + OFF_Q + (16 + r) * PQ + (32 * s + 16 + 4 * g) * 2));
                o0 = MFMA16(sb, a0, o0); o1 = MFMA16(sb, a1, o1);
                if (KIND == 1 && (s & 3) == 3) asm volatile("" ::: "memory");
            }
            { const int colo = h * DV + sl * 128 + 16 * wave + 4 * g; const int pp0 = c * 32 + r, pp1 = c * 32 + 16 + r; const int t0 = d ? T - 1 - pp0 : pp0, t1 = d ? T - 1 - pp1 : pp1;
              u32x2 w0, w1; w0.x = pk2(o0[0], o0[1]); w0.y = pk2(o0[2], o0[3]); w1.x = pk2(o1[0], o1[1]); w1.y = pk2(o1[2], o1[3]);
              *(u32x2*)(O + (size_t)(row0 + t0) * W + colo) = w0; *(u32x2*)(O + (size_t)(row0 + t1) * W + colo) = w1; }
            const bf16x8 vb = cat4(ld_tr(lds + OFF_V + (8 * g + q4) * PV + (16 * wave + 4 * p4) * 2), ld_tr(lds + OFF_V + (8 * g + 4 + q4) * PV + (16 * wave + 4 * p4) * 2));
#pragma unroll
            for (int kt = 0; kt < NKT; ++kt) {
                const bf16x8 ka = cat4(ld_tr(lds + OFF_K + (8 * g + q4) * PQ + (16 * kt + 4 * p4) * 2), ld_tr(lds + OFF_K + (8 * g + 4 + q4) * PQ + (16 * kt + 4 * p4) * 2));
                const f32x4 ev = *(const LAS f32x4*)(lds + OFF_E + (16 * kt + 4 * g) * 4);
                S[kt] = MFMA16(ka, vb, S[kt]) * ev;
                if (KIND == 1 && (kt & 7) == 7) asm volatile("" ::: "memory");
            }
        }
#undef GLC_PREFETCH
        if (!lat) { float* sd = P.out + (KIND == 1 ? OUT_SGLA : OUT_SHG) + ((((size_t)b * 2 + d) * NH + h) * DK) * DV + sl * 128 + 16 * wave + r;
#pragma unroll
            for (int kt = 0; kt < NKT; ++kt)
#pragma unroll
                for (int e = 0; e < 4; ++e) sd[(size_t)(16 * kt + 4 * g + e) * DV] = S[kt][e]; }
    }
}

#define MFMA4F(a, b, c) __builtin_amdgcn_mfma_f32_16x16x4f32((a), (b), (c), 0, 0, 0)
template <int I> __device__ __forceinline__ float row_share(float v) { return __builtin_bit_cast(float, __builtin_amdgcn_mov_dpp(__builtin_bit_cast(int, v), 0x150 + I, 0xf, 0xf, false)); }
template <int I> struct DiagStep {
    static __device__ __forceinline__ void run(const float (&Ld)[16], float (&x)[16], int cc) {
        DiagStep<I - 1>::run(Ld, x, cc);
        float a0 = 0.f, a1 = 0.f;
#pragma unroll
        for (int m = 0; m < I; ++m) { const float lv = row_share<I>(Ld[m]); if (m & 1) a1 += lv * x[m]; else a0 += lv * x[m]; }
        x[I] = ((I == cc) ? 1.f : 0.f) - (a0 + a1);
    }
};
template <> struct DiagStep<-1> { static __device__ __forceinline__ void run(const float (&)[16], float (&)[16], int) {} };
__device__ __forceinline__ void dn_wu_prep_phase(const Params& P, LAS unsigned char* lds) {
    PHASE_IDS();
    constexpr int PKQ = 272;
    constexpr int LP = 68;
    constexpr int OFF_K = 0, OFF_Q = 64 * PKQ, OFF_L = 0  , OFF_KK = 4 * 64 * LP * 4, OFF_QK = OFF_KK + 64 * LP * 4, OFF_G = OFF_QK + 64 * LP * 4;
    const bf16* QKV = (const bf16*)(P.ws + WS_QKV); const float* G = (const float*)(P.ws + WS_GATE);
    bf16* TA = (bf16*)(P.ws + WS_TA); float* GS = (float*)(P.ws + WS_GS);
    const int r = lane & 15, g = lane >> 4;
    LAS float* KKs = (LAS float*)(lds + OFF_KK); LAS float* QKs = (LAS float*)(lds + OFF_QK); LAS float* Gs = (LAS float*)(lds + OFF_G);
    u32x4 pq[2], pk[2]; float pgv = 0.f;
#define WU_PREFETCH(grp_) do { const int cidx_ = (grp_) >> 4, kh_ = (grp_) & 15, rb_ = cidx_ * 64; \
        _Pragma("unroll") for (int x = 0; x < 2; ++x) { const int pi = tid + x * NT, pr = pi >> 4, pc = pi & 15; const size_t o = (size_t)(rb_ + pr) * 8192 + kh_ * 128 + pc * 8; pq[x] = *(const u32x4*)(QKV + o); pk[x] = *(const u32x4*)(QKV + o + 2048); } \
        { const int c4 = tid >> 7, which = (tid >> 6) & 1, i = tid & 63, hv = c4 >> 1, d = c4 & 1, h = 2 * kh_ + hv; pgv = G[(size_t)(rb_ + i) * 128 + (which ? 0 : 64) + d * 32 + h]; } } while (0)
    if ((int)blockIdx.x < 256 * 16) WU_PREFETCH(blockIdx.x);
    for (int grp = blockIdx.x; grp < 256 * 16; grp += gridDim.x) {
        const int cidx = grp >> 4, kh = grp & 15;
        __syncthreads();
#pragma unroll
        for (int x = 0; x < 2; ++x) { const int pi = tid + x * NT, pr = pi >> 4, pc = pi & 15;
            *(LAS u32x4*)(lds + OFF_Q + pr * PKQ + pc * 16) = pq[x]; *(LAS u32x4*)(lds + OFF_K + pr * PKQ + pc * 16) = pk[x]; }
        Gs[tid] = pgv;
        __syncthreads();
        if (grp + (int)gridDim.x < 256 * 16) WU_PREFETCH(grp + (int)gridDim.x);
        {
            const int it = wave & 3; const int offx = (wave >> 2) ? OFF_Q : OFF_K; LAS float* dst = (wave >> 2) ? QKs : KKs;
            f32x4 acc[4];
#pragma unroll
            for (int jt = 0; jt < 4; ++jt) acc[jt] = (f32x4){0.f, 0.f, 0.f, 0.f};
#pragma unroll
            for (int sx = 0; sx < 4; ++sx) { const bf16x8 a = ld_b128(lds + offx + (16 * it + r) * PKQ + (32 * sx + 8 * g) * 2);
#pragma unroll
                for (int jt = 0; jt < 4; ++jt) acc[jt] = MFMA16(a, ld_b128(lds + OFF_K + (16 * jt + r) * PKQ + (32 * sx + 8 * g) * 2), acc[jt]); }
#pragma unroll
            for (int jt = 0; jt < 4; ++jt)
#pragma unroll
                for (int e = 0; e < 4; ++e) dst[(16 * it + 4 * g + e) * LP + 16 * jt + r] = acc[jt][e];
        }
        __syncthreads();
        {
            const int c4 = wave & 3, hv = c4 >> 1, d = c4 & 1, h = 2 * kh + hv;
            const int nl = d ? 63 - lane : lane;
            float gcv = Gs[(c4 * 2 + 0) * 64 + nl];
#pragma unroll
            for (int o = 1; o < 64; o <<= 1) { const float t = __shfl_up(gcv, o); if (lane >= o) gcv += t; }
            const float betav = Gs[(c4 * 2 + 1) * 64 + nl];
            const size_t item = ((size_t)(cidx * 32 + h) * 2 + d);
            LAS float* W = (LAS float*)(lds + OFF_L) + c4 * 64 * LP;
            {
                bf16* Ag = TA + item * 8192 + 4096;
                const int pb = (wave >> 2) * 32;
#define WU_LA_TRIPS(REV_) \
                _Pragma("unroll 1") for (int p0 = pb; p0 < pb + 32; p0 += 8) { \
                    const LAS float* kb_ = KKs + ((REV_) ? 56 - p0 : p0) * LP + nl; const LAS float* qb_ = QKs + ((REV_) ? 56 - p0 : p0) * LP + nl; \
                    LAS float* wb_ = W + p0 * LP + lane; bf16* ab_ = Ag + p0 * 64 + lane; const int lrel_ = lane - p0; \
                    float kkv[8], qkv[8]; \
                    _Pragma("unroll") for (int u = 0; u < 8; ++u) { kkv[u] = kb_[((REV_) ? 7 - u : u) * LP]; qkv[u] = qb_[((REV_) ? 7 - u : u) * LP]; } \
                    _Pragma("unroll") for (int u = 0; u < 8; ++u) { const int p = p0 + u; const float gp = rdlane(gcv, p), bp = rdlane(betav, p); const float ex = __expf(gp - gcv); \
                        float lv = bp * kkv[u] * ex, av = qkv[u] * ex; \
                        asm volatile("" : "+v"(lv), "+v"(av)); \
                        wb_[u * LP] = lrel_ < u ? lv : 0.f; \
                        ab_[u * 64] = (bf16)f2bf(lrel_ <= u ? av : 0.f); } \
                }
                if (d) { WU_LA_TRIPS(1) } else { WU_LA_TRIPS(0) }
#undef WU_LA_TRIPS
            }
            if (wave >= 4) {
                float* gs = GS + item * 192; const float gend = rdlane(gcv, 63);
                gs[lane] = __expf(gcv); gs[64 + lane] = betav; gs[128 + lane] = __expf(gend - gcv);
            }
            __syncthreads();
            if (wave < 4) {
                {
                    const int lane2 = opaque_v(lane); const int bb = lane2 >> 4, cc = lane2 & 15;
                    float Ld[16];
#pragma unroll
                    for (int m4 = 0; m4 < 4; ++m4) { const f32x4 v = *(const LAS f32x4*)(W + (16 * bb + cc) * LP + 16 * bb + 4 * m4); Ld[4 * m4] = v[0]; Ld[4 * m4 + 1] = v[1]; Ld[4 * m4 + 2] = v[2]; Ld[4 * m4 + 3] = v[3]; }
                    float x[16];
                    DiagStep<15>::run(Ld, x, cc);
#pragma unroll
                    for (int i = 0; i < 16; ++i) W[(16 * bb + i) * LP + 16 * bb + cc] = x[i];
                }
#define WU_PN(ar, ac, br, bc, acc_) do { _Pragma("unroll") for (int sx = 0; sx < 4; ++sx) acc_ = MFMA4F(W[((ar) + r) * LP + (ac) + 4 * sx + g], W[((br) + 4 * sx + g) * LP + (bc) + r], acc_); } while (0)
#define WU_PA(ar, ac, M_, acc_) do { _Pragma("unroll") for (int e = 0; e < 4; ++e) acc_ = MFMA4F(W[((ar) + r) * LP + (ac) + 4 * g + e], M_[e], acc_); } while (0)
#define WU_ST(r0, c0, acc_) do { _Pragma("unroll") for (int e = 0; e < 4; ++e) W[((r0) + 4 * g + e) * LP + (c0) + r] = -acc_[e]; } while (0)
                const f32x4 z4 = {0.f, 0.f, 0.f, 0.f};
                { f32x4 m1a = z4, m1b = z4; WU_PN(16, 0, 0, 0, m1a); WU_PN(48, 32, 32, 32, m1b);
                  f32x4 t10 = z4, t32 = z4; WU_PA(16, 16, m1a, t10); WU_PA(48, 48, m1b, t32);
                  WU_ST(16, 0, t10); WU_ST(48, 32, t32); }
                { f32x4 m00 = z4, m01 = z4, m10 = z4, m11 = z4;
                  WU_PN(32, 0, 0, 0, m00); WU_PN(32, 16, 16, 0, m00); WU_PN(32, 16, 16, 16, m01);
                  WU_PN(48, 0, 0, 0, m10); WU_PN(48, 16, 16, 0, m10); WU_PN(48, 16, 16, 16, m11);
                  f32x4 t00 = z4, t01 = z4, t10 = z4, t11 = z4;
                  WU_PA(32, 32, m00, t00); WU_PA(32, 32, m01, t01);
                  WU_PA(48, 32, m00, t10); WU_PA(48, 48, m10, t10); WU_PA(48, 32, m01, t11); WU_PA(48, 48, m11, t11);
                  WU_ST(32, 0, t00); WU_ST(32, 16, t01); WU_ST(48, 0, t10); WU_ST(48, 16, t11); }
#undef WU_PN
#undef WU_PA
#undef WU_ST
                bf16* Tg = TA + item * 8192;
#pragma unroll
                for (int x8 = 0; x8 < 8; ++x8) { const int piece = lane + 64 * x8, row = piece >> 3, pc = piece & 7;
                    const f32x4 v0 = *(const LAS f32x4*)(W + row * LP + pc * 8), v1 = *(const LAS f32x4*)(W + row * LP + pc * 8 + 4);
                    u32x4 o; o.x = pk2(v0[0], v0[1]); o.y = pk2(v0[2], v0[3]); o.z = pk2(v1[0], v1[1]); o.w = pk2(v1[2], v1[3]);
                    if (pc * 8 <= row) *(u32x4*)(Tg + row * 64 + pc * 8) = o; }
            }
        }
    }
#undef WU_PREFETCH
}

constexpr int DN_PQ = 272;
constexpr int DN_PXQ = 144, DN_XQ = 64 * DN_PXQ, DN_PXT = 80, DN_XT = 64 * DN_PXT;
constexpr int DN_OFF_Q = 0, DN_OFF_K = 2 * DN_XQ, DN_OFF_V = DN_OFF_K + 64 * DN_PQ, DN_OFF_T = DN_OFF_V + 64 * DN_PQ, DN_OFF_A = DN_OFF_T + 2 * DN_XT, DN_OFF_S = DN_OFF_A + 2 * DN_XT;
struct DnStage { u32x4 rq[2], rk[2], rv[2], rt, ra; f32x4 rs; };
__device__ __forceinline__ void dn_stage_load(DnStage& st, const bf16* QKV, const bf16* TA, const float* GS, int tid, int c, int d, int T, int row0, int kh, int h, int nchunk) {
#pragma unroll
    for (int x = 0; x < 2; ++x) { const int pi = tid + x * NT, pr = pi >> 4, pc = pi & 15; const int pp = c * 64 + pr; const int t = d ? T - 1 - pp : pp;
        const size_t o = (size_t)(row0 + t) * 8192 + pc * 8; st.rq[x] = *(const u32x4*)(QKV + o + kh * 128); st.rk[x] = *(const u32x4*)(QKV + o + 2048 + kh * 128); st.rv[x] = *(const u32x4*)(QKV + o + 4096 + h * 128); }
    const int nc = d ? nchunk - 1 - c : c; const size_t item = ((size_t)((row0 >> 6) + nc) * 32 + h) * 2 + d;
    const bool nz = ((tid & 7) * 8) <= (tid >> 3);
    st.rt = nz ? *(const u32x4*)(TA + item * 8192 + tid * 8) : (u32x4){0u, 0u, 0u, 0u}; st.ra = nz ? *(const u32x4*)(TA + item * 8192 + 4096 + tid * 8) : (u32x4){0u, 0u, 0u, 0u};
    st.rs = (f32x4){0.f, 0.f, 0.f, 0.f}; if (tid < 48) st.rs = *(const f32x4*)(GS + item * 192 + tid * 4);
}
__device__ __forceinline__ void dn_stage_store(const DnStage& st, LAS unsigned char* lds, int tid) {
#pragma unroll
    for (int x = 0; x < 2; ++x) { const int pi = tid + x * NT, pr = pi >> 4, pc = pi & 15;
        { LAS unsigned char* qd = lds + DN_OFF_Q + pr * DN_PXQ + (2 * (pc >> 2) + (pc & 1)) * 16 + ((pc >> 1) & 1) * 8;
          *(LAS u32x2*)qd = (u32x2){st.rq[x].x, st.rq[x].y}; *(LAS u32x2*)(qd + DN_XQ) = (u32x2){st.rq[x].z, st.rq[x].w}; }
        *(LAS u32x4*)(lds + DN_OFF_K + pr * DN_PQ + pc * 16) = st.rk[x]; *(LAS u32x4*)(lds + DN_OFF_V + pr * DN_PQ + pc * 16) = st.rv[x]; }
    { const int pr = tid >> 3, pc = tid & 7; const int o = pr * DN_PXT + (2 * (pc >> 2) + (pc & 1)) * 16 + ((pc >> 1) & 1) * 8;
      *(LAS u32x2*)(lds + DN_OFF_T + o) = (u32x2){st.rt.x, st.rt.y}; *(LAS u32x2*)(lds + DN_OFF_T + o + DN_XT) = (u32x2){st.rt.z, st.rt.w};
      *(LAS u32x2*)(lds + DN_OFF_A + o) = (u32x2){st.ra.x, st.ra.y}; *(LAS u32x2*)(lds + DN_OFF_A + o + DN_XT) = (u32x2){st.ra.z, st.ra.w}; }
    if (tid < 48) *(LAS f32x4*)(lds + DN_OFF_S + tid * 16) = st.rs;
}
__device__ __forceinline__ void dn_step_compute(f32x4 (&S)[8], LAS unsigned char* lds, bf16* O, int c, int d, int T, int row0, int h, int wave, int lane) {
    constexpr int PQ = DN_PQ, OFF_Q = DN_OFF_Q, OFF_K = DN_OFF_K, OFF_V = DN_OFF_V, OFF_T = DN_OFF_T, OFF_A = DN_OFF_A, OFF_S = DN_OFF_S;
    const int r = lane & 15, g = lane >> 4, q4 = (lane & 15) >> 2, p4 = lane & 3;
#define DN_PERMROW(off_, pitch_, row_, col_) cat4(ld_b64(lds + (off_) + (row_) * (pitch_) + ((col_) + 4 * g) * 2), ld_b64(lds + (off_) + (row_) * (pitch_) + ((col_) + 16 + 4 * g) * 2))
#define DN_CHUNK(off_, xsz_, pitch_, row_, sx_) ld_b128(lds + (off_) + (g & 1) * (xsz_) + (row_) * (pitch_) + (2 * (sx_) + (g >> 1)) * 16)
    const f32x4 zero4 = {0.f, 0.f, 0.f, 0.f};
    bf16x8 sb[4];
    f32x4 R[4];
    {
        bf16x8 kf[4][4];
#pragma unroll
        for (int jt = 0; jt < 4; ++jt)
#pragma unroll
            for (int sx = 0; sx < 4; ++sx) kf[jt][sx] = DN_PERMROW(OFF_K, PQ, 16 * jt + r, 32 * sx);
#pragma unroll
        for (int sx = 0; sx < 4; ++sx) sb[sx] = pack8(S[2 * sx], S[2 * sx + 1]);
#pragma unroll
        for (int jt = 0; jt < 4; ++jt) R[jt] = zero4;
#pragma unroll
        for (int sx = 0; sx < 4; ++sx)
#pragma unroll
            for (int jt = 0; jt < 4; ++jt) R[jt] = MFMA16(kf[jt][sx], sb[sx], R[jt]);
    }
    __builtin_amdgcn_sched_barrier(0);
    f32x4 U[4];
    {
        bf16x8 tf[4][2]; s16x4 vt[4]; f32x4 eg[4], bt[4];
#pragma unroll
        for (int jt = 0; jt < 4; ++jt) { vt[jt] = ld_tr(lds + OFF_V + (16 * jt + 4 * g + q4) * PQ + (16 * wave + 4 * p4) * 2);
            eg[jt] = *(const LAS f32x4*)(lds + OFF_S + (16 * jt + 4 * g) * 4); bt[jt] = *(const LAS f32x4*)(lds + OFF_S + 256 + (16 * jt + 4 * g) * 4); }
#pragma unroll
        for (int it = 0; it < 4; ++it) { tf[it][0] = DN_CHUNK(OFF_T, DN_XT, DN_PXT, 16 * it + r, 0); tf[it][1] = DN_CHUNK(OFF_T, DN_XT, DN_PXT, 16 * it + r, 1); }
#pragma unroll
        for (int jt = 0; jt < 4; ++jt)
#pragma unroll
            for (int e = 0; e < 4; ++e) R[jt][e] = bt[jt][e] * (bf2f((unsigned short)vt[jt][e]) - eg[jt][e] * R[jt][e]);
        const bf16x8 rb0 = pack8(R[0], R[1]), rb1 = pack8(R[2], R[3]);
#pragma unroll
        for (int it = 0; it < 4; ++it) U[it] = MFMA16(tf[it][0], rb0, zero4);
#pragma unroll
        for (int it = 0; it < 4; ++it) U[it] = MFMA16(tf[it][1], rb1, U[it]);
    }
    __builtin_amdgcn_sched_barrier(0);
    {
        f32x4 Ot[4];
#pragma unroll
        for (int it = 0; it < 4; ++it) Ot[it] = zero4;
#pragma unroll
        for (int hq = 0; hq < 2; ++hq) {
            bf16x8 qf[2][4];
#pragma unroll
            for (int i2 = 0; i2 < 2; ++i2)
#pragma unroll
                for (int sx = 0; sx < 4; ++sx) qf[i2][sx] = DN_CHUNK(OFF_Q, DN_XQ, DN_PXQ, 16 * (2 * hq + i2) + r, sx);
#pragma unroll
            for (int sx = 0; sx < 4; ++sx)
#pragma unroll
                for (int i2 = 0; i2 < 2; ++i2) Ot[2 * hq + i2] = MFMA16(sb[sx], qf[i2][sx], Ot[2 * hq + i2]);
        }
        bf16x8 af[4][2]; float egi[4];
#pragma unroll
        for (int it = 0; it < 4; ++it) { af[it][0] = DN_CHUNK(OFF_A, DN_XT, DN_PXT, 16 * it + r, 0); af[it][1] = DN_CHUNK(OFF_A, DN_XT, DN_PXT, 16 * it + r, 1); egi[it] = *(const LAS float*)(lds + OFF_S + (16 * it + r) * 4); }
        const bf16x8 ub0 = pack8(U[0], U[1]), ub1 = pack8(U[2], U[3]);
#pragma unroll
        for (int it = 0; it < 4; ++it) Ot[it] = Ot[it] * egi[it];
#pragma unroll
        for (int it = 0; it < 4; ++it) Ot[it] = MFMA16(ub0, af[it][0], Ot[it]);
#pragma unroll
        for (int it = 0; it < 4; ++it) Ot[it] = MFMA16(ub1, af[it][1], Ot[it]);
#pragma unroll
        for (int it = 0; it < 4; ++it) { const int pp = c * 64 + 16 * it + r; const int t = d ? T - 1 - pp : pp; u32x2 w; w.x = pk2(Ot[it][0], Ot[it][1]); w.y = pk2(Ot[it][2], Ot[it][3]);
            *(u32x2*)(O + (size_t)(row0 + t) * 4096 + h * 128 + 16 * wave + 4 * g) = w; }
    }
    __builtin_amdgcn_sched_barrier(0);
    {
#pragma unroll
        for (int jt = 0; jt < 4; ++jt) { const f32x4 dc = *(const LAS f32x4*)(lds + OFF_S + 512 + (16 * jt + 4 * g) * 4); U[jt] = U[jt] * dc; }
        const bf16x8 us0 = pack8(U[0], U[1]), us1 = pack8(U[2], U[3]);
        const float gend = *(const LAS float*)(lds + OFF_S + 63 * 4);
#pragma unroll
        for (int hk = 0; hk < 2; ++hk) {
            bf16x8 ktf[4][2];
#pragma unroll
            for (int k2 = 0; k2 < 4; ++k2) { const int kt = 4 * hk + k2;
                ktf[k2][0] = cat4(ld_tr(lds + OFF_K + (4 * g + q4) * PQ + (16 * kt + 4 * p4) * 2), ld_tr(lds + OFF_K + (16 + 4 * g + q4) * PQ + (16 * kt + 4 * p4) * 2));
                ktf[k2][1] = cat4(ld_tr(lds + OFF_K + (32 + 4 * g + q4) * PQ + (16 * kt + 4 * p4) * 2), ld_tr(lds + OFF_K + (48 + 4 * g + q4) * PQ + (16 * kt + 4 * p4) * 2)); }
#pragma unroll
            for (int k2 = 0; k2 < 4; ++k2) S[4 * hk + k2] = MFMA16(ktf[k2][0], us0, S[4 * hk + k2] * gend);
#pragma unroll
            for (int k2 = 0; k2 < 4; ++k2) S[4 * hk + k2] = MFMA16(ktf[k2][1], us1, S[4 * hk + k2]);
        }
    }
#undef DN_PERMROW
#undef DN_CHUNK
}
__device__ __forceinline__ void dn_chunk_phase(const Params& P, int j, LAS unsigned char* lds) {
    PHASE_IDS();
    const bf16* QKV = (const bf16*)(P.ws + WS_QKV); const bf16* TA = (const bf16*)(P.ws + WS_TA); const float* GS = (const float*)(P.ws + WS_GS);
    bf16* OF = (bf16*)(P.ws + WS_OF); bf16* OB = (bf16*)(P.ws + WS_OB);
    const int r = lane & 15, g = lane >> 4;
    const int bxp = (gridDim.x == 256) ? ({ const int x = blockIdx.x & 7, y = blockIdx.x >> 3, grp = x + 8 * (y >> 1), mem = y & 1; (grp >> 5) * 64 + (2 * ((grp >> 1) & 15) + mem) * 2 + (grp & 1); }) : (int)blockIdx.x;
    for (int unit0 = blockIdx.x; unit0 < 256 + 2048; unit0 += gridDim.x) {
        const int unit = (gridDim.x == 256) ? (unit0 - (int)blockIdx.x + bxp) : unit0;
        const bool lat = unit < 256; const int u2 = lat ? unit : unit - 256;
        const int b = u2 >> 6, h = (u2 >> 1) & 31, d = u2 & 1, T = lat ? 2048 : 256, row0 = lat ? MCTX + b * 2048 : b * 256, kh = h >> 1, nchunk = T / 64;
        bf16* O = d ? OB : OF;
        f32x4 S[8];
        { const float* s0 = P.in[3] + ((((size_t)b * 2 + j) * 2 + d) * 32 + h) * 128 * 128 + 16 * wave + r;
          if (lat) {
#pragma unroll
              for (int kt = 0; kt < 8; ++kt)
#pragma unroll
                  for (int e = 0; e < 4; ++e) S[kt][e] = s0[(size_t)(16 * kt + 4 * g + e) * 128];
          } else {
#pragma unroll
              for (int kt = 0; kt < 8; ++kt) S[kt] = (f32x4){0.f, 0.f, 0.f, 0.f};
          } }
        constexpr int DN_HSZ = DN_OFF_S + 768;
        DnStage sa;
        __syncthreads();
        dn_stage_load(sa, QKV, TA, GS, tid, 0, d, T, row0, kh, h, nchunk);
        dn_stage_store(sa, lds, tid);
        dn_stage_load(sa, QKV, TA, GS, tid, 1, d, T, row0, kh, h, nchunk);
        __syncthreads();
        for (int c = 0; c < nchunk; ++c) {
            LAS unsigned char* cur = lds + (c & 1) * DN_HSZ; LAS unsigned char* nxt = lds + ((c + 1) & 1) * DN_HSZ;
            if (c + 1 < nchunk) dn_stage_store(sa, nxt, tid);
            if (c + 2 < nchunk) dn_stage_load(sa, QKV, TA, GS, tid, c + 2, d, T, row0, kh, h, nchunk);
            dn_step_compute(S, cur, O, c, d, T, row0, h, wave, lane);
            __syncthreads();
        }
        if (!lat) { float* sd = P.out + OUT_SDN + ((((size_t)b * 2 + j) * 2 + d) * 32 + h) * 128 * 128 + 16 * wave + r;
#pragma unroll
            for (int kt = 0; kt < 8; ++kt)
#pragma unroll
                for (int e = 0; e < 4; ++e) sd[(size_t)(16 * kt + 4 * g + e) * 128] = S[kt][e]; }
    }
}


#ifndef R_CONV
#define R_CONV 1
#endif
#ifndef R_MOD
#define R_MOD 1
#endif
#ifndef R_NORM
#define R_NORM 1
#endif
#ifndef R_GATE
#define R_GATE 1
#endif
#ifndef R_DNPREP
#define R_DNPREP 1
#endif
#ifndef R_WU
#define R_WU 1
#endif
#ifndef R_GLAPREP
#define R_GLAPREP 1
#endif
#ifndef R_DNSCAN
#define R_DNSCAN 1
#endif
#ifndef R_GSCAN
#define R_GSCAN 1
#endif
#ifndef R_FINAL
#define R_FINAL 1
#endif
#ifndef R_BAR
#define R_BAR 1
#endif
#ifndef R_GEMM
#define R_GEMM 1
#endif
#define REPN(n_) for (int rep_ = 0; rep_ < (n_); ++rep_)
#ifndef REP_THIN
#define REP_THIN 1
#endif
#ifndef REP_SCAN
#define REP_SCAN 1
#endif
#ifndef REP_A
#define REP_A 1
#endif
#ifndef REP_B
#define REP_B 1
#endif
#ifndef REP_C
#define REP_C 1
#endif
#define RT for (int rep_ = 0; rep_ < REP_THIN; ++rep_)
#define RA for (int rep_ = 0; rep_ < REP_A; ++rep_)
#define RB for (int rep_ = 0; rep_ < REP_B; ++rep_)
#define RC for (int rep_ = 0; rep_ < REP_C; ++rep_)
#define RS for (int rep_ = 0; rep_ < REP_SCAN; ++rep_)
template <int LAYER> __device__ __forceinline__ void layer_body(const Params& P, LAS unsigned char* lds, const XcdBarrier& bar) {
    bf16* X = (bf16*)(P.ws + WS_X); bf16* H = (bf16*)(P.ws + WS_H); bf16* BIG = (bf16*)(P.ws + WS_BIG); float* GATE = (float*)(P.ws + WS_GATE);
    bf16* Y = (bf16*)(P.ws + WS_QKV); bf16* OF = (bf16*)(P.ws + WS_OF); bf16* OB = (bf16*)(P.ws + WS_OB);
    const float* MOD = (const float*)(P.ws + WS_MOD);
    const bf16* Tin = (const bf16*)(P.ws + WS_W + WOFF_IN); const bf16* Tout = (const bf16*)(P.ws + WS_W + WOFF_OUT); const bf16* Tup = (const bf16*)(P.ws + WS_W + WOFF_UP); const bf16* Tdn = (const bf16*)(P.ws + WS_W + WOFF_DOWN);

        constexpr int layer = LAYER, kind = LAYER % 3, j = LAYER / 3;
        const float* modl = MOD + (size_t)layer * 5 * MODW;
        const void* xc = layer == 0 ? (const void*)P.in[0] : (const void*)X; const void* xl = layer == 0 ? (const void*)P.in[1] : (const void*)X;
#ifndef NO_CONV
        REPN(R_CONV) convert_layer_weights(P, layer, lds);
#endif
        if (layer == 0) REPN(R_BAR) xcd_barrier(bar);
        REPN(R_NORM) norm_mod_phase<layer == 0>(xc, xl, P.in[9] + layer * D, modl, 0, 2048, H);
        REPN(R_BAR) xcd_barrier(bar);
        {
            constexpr int Npad = kind == 0 ? DN_NPAD : (kind == 1 ? GLA_NPAD : HG_NIN), nmain = kind == 0 ? DN_NMAIN : (kind == 1 ? GLA_NMAIN : HG_NIN);
            { pg8::Gemm g = pg8::mk_gemm(H, Tin, MROWS, nmain, D); pg8::StaticOrder S; S.init(MROWS, nmain, (int)gridDim.x, (int)blockIdx.x);
              pg8::EpiBf16<0> E{BIG, nmain, nmain, GATE};
              REPN(R_GEMM) pg8::gemm_phase<pg8::EpiBf16<0>, pg8::StaticOrder, true, true>(lds, g, S, E); }
            if constexpr (Npad > nmain) {
              pg8::Gemm g{H, Tin + (size_t)nmain * D, MROWS, 4 * 256, D, (size_t)512 * 2, (size_t)512 * 2, 8}; pg8::StaticOrder S; S.init(MROWS, 4 * 256, (int)gridDim.x, (int)blockIdx.x);
              pg8::EpiGateP E{(float*)(P.ws + WS_GP)};
              pg8::gemm_phase<pg8::EpiGateP, pg8::StaticOrder, true, true>(lds, g, S, E); }
        }
        REPN(R_BAR) xcd_barrier(bar);
        if constexpr (kind == 0) {
#ifndef NO_DNPREP
            REPN(R_DNPREP) dn_prep_phase(P, j, rep_ == 0);
#endif
            REPN(R_BAR) xcd_barrier(bar);
            REPN(R_WU) dn_wu_prep_phase(P, lds);
            REPN(R_BAR) xcd_barrier(bar);
            REPN(R_DNSCAN) dn_chunk_phase(P, j, lds);
            REPN(R_BAR) xcd_barrier(bar);
            REPN(R_GATE) gate_phase<128>(OF, OB, BIG, DN_NMAIN, 8192, P.in[18] + j * 128, Y, 4096);
        } else if constexpr (kind == 1) {
            REPN(R_GLAPREP) gla_prep_phase<1>(P, lds);
            REPN(R_BAR) xcd_barrier(bar);
            REPN(R_GSCAN) gla_chunk_phase<1>(P, lds);
            REPN(R_BAR) xcd_barrier(bar);
            REPN(R_GATE) gate_phase<512>(OF, OB, BIG, GLA_NMAIN, 4096, P.in[23] + j * 512, Y, 2048);
        } else {
            REPN(R_GLAPREP) gla_prep_phase<2>(P, lds);
            REPN(R_BAR) xcd_barrier(bar);
            REPN(R_GSCAN) gla_chunk_phase<2>(P, lds);
            REPN(R_BAR) xcd_barrier(bar);
            REPN(R_GATE) gate_phase<128>(OF, OB, BIG, HG_NIN, 4096, P.in[27] + j * 128, Y, 2048);
        }
        REPN(R_BAR) xcd_barrier(bar);
        {
            const int Kout = kind == 0 ? 4096 : 2048;
            pg8::Gemm g = pg8::mk_gemm(Y, Tout, MROWS, D, Kout); pg8::StaticOrder S; S.init(MROWS, D, (int)gridDim.x, (int)blockIdx.x);
            pg8::EpiRes<layer == 0> E{xc, xl, X, modl + 4096};
            pg8::gemm_phase<pg8::EpiRes<layer == 0>, pg8::StaticOrder, true, true>(lds, g, S, E);
        }
        REPN(R_BAR) xcd_barrier(bar);
        REPN(R_NORM) norm_mod_phase<false>(X, X, P.in[10] + layer * D, modl, 6144, 8192, H);
        REPN(R_BAR) xcd_barrier(bar);
#pragma unroll
        for (int hf = 0; hf < 2; ++hf) {
            {
                pg8::Gemm g = pg8::mk_gemm(H, Tup, MROWS / 2, DFF, D); pg8::StaticOrder S; S.init(MROWS / 2, DFF, (int)gridDim.x, (int)blockIdx.x, hf * 32);
                pg8::EpiBf16<1> E{BIG, DFF, DFF, nullptr};
                REPN(R_GEMM) pg8::gemm_phase<pg8::EpiBf16<1>, pg8::StaticOrder, true, true>(lds, g, S, E);
            }
            REPN(R_BAR) xcd_barrier(bar);
            {
                pg8::Gemm g = pg8::mk_gemm(BIG, Tdn, MROWS / 2, D, DFF); pg8::StaticOrder S; S.init(MROWS / 2, D, (int)gridDim.x, (int)blockIdx.x, hf * 32);
                pg8::EpiRes<false> E{X, X, X, modl + 10240};
                pg8::gemm_phase<pg8::EpiRes<false>, pg8::StaticOrder, true, true>(lds, g, S, E);
            }
            REPN(R_BAR) xcd_barrier(bar);
        }
    }

__global__ void __launch_bounds__(NT, 2) fwd_kernel(Params P) {
    extern __shared__ __attribute__((aligned(16))) unsigned char lds_raw[];
    LAS unsigned char* lds = (LAS unsigned char*)lds_raw;
    const int tid = threadIdx.x;
    volatile LAS unsigned* misc = (volatile LAS unsigned*)(lds + LDS_MISC);
    if (tid < 64) misc[tid] = 0u;
    __syncthreads();
    XcdBarrier bar = xcd_barrier_post((unsigned*)(P.ws + WS_CTL) + 1024, misc + 8);

#ifndef NO_MOD
    REPN(R_MOD) mod_phase(P, lds);
#endif
    __syncthreads();

    layer_body<0>(P, lds, bar);
    layer_body<1>(P, lds, bar);
    layer_body<2>(P, lds, bar);
    layer_body<3>(P, lds, bar);
    REPN(R_FINAL) final_norm_phase((const bf16*)(P.ws + WS_X), P.in[11], P.out + OUT_Y);
}

extern "C" void kernel_launch(void* const* d_in, const int* in_sizes, int n_in, void* d_out, int out_size, void* d_ws, size_t ws_size, hipStream_t stream) {
    static int grid = 0;
    if (grid == 0) {
        if (n_in != 29 || (size_t)out_size != OUT_END || ws_size < WS_END) {
            fprintf(stderr, "kernel_launch: unexpected shapes: n_in %d out %d (want %zu) ws %zu (want %zu)\n", n_in, out_size, (size_t)OUT_END, ws_size, (size_t)WS_END); grid = -1; return; }
        int dev = 0, cus = 0, per_cu = 0;
        if (hipGetDevice(&dev) != hipSuccess || hipDeviceGetAttribute(&cus, hipDeviceAttributeMultiprocessorCount, dev) != hipSuccess) { grid = -1; return; }
        if (hipFuncSetAttribute((const void*)fwd_kernel, hipFuncAttributeMaxDynamicSharedMemorySize, LDS_BYTES) != hipSuccess) { fprintf(stderr, "kernel_launch: hipFuncSetAttribute failed\n"); grid = -1; return; }
        if (hipOccupancyMaxActiveBlocksPerMultiprocessor(&per_cu, (const void*)fwd_kernel, NT, LDS_BYTES) != hipSuccess || per_cu < 1) { fprintf(stderr, "kernel_launch: occupancy query says %d\n", per_cu); }
        (void)hipGetLastError();
        grid = cus;
    }
    if (grid < 0) return;
    hipMemsetAsync((char*)d_ws + WS_CTL, 0, CTL_BYTES, stream);
    Params p{};
    for (int i = 0; i < 29; ++i) p.in[i] = (const float*)d_in[i];
    p.out = (float*)d_out; p.ws = (unsigned char*)d_ws;
    hipLaunchKernelGGL(fwd_kernel, dim3(grid), dim3(NT), LDS_BYTES, stream, p);
}
```

```cpp
#include <hip/hip_runtime.h>
#include <cstdio>
#include <cstdint>

__device__ __forceinline__ int opaque_v(int x) { asm volatile("" : "+v"(x)); return x; }
#define PHASE_IDS() const int tid = opaque_v((int)threadIdx.x), lane = tid & 63, wave = __builtin_amdgcn_readfirstlane(tid >> 6), gw = (int)blockIdx.x * 8 + wave, NGW = (int)gridDim.x * 8; (void)lane; (void)wave; (void)gw; (void)NGW
namespace pg8 {
#define PG8_LAS __attribute__((address_space(3)))
typedef unsigned short bf16_t;
typedef short bf16x8 __attribute__((ext_vector_type(8)));
typedef float f32x4 __attribute__((ext_vector_type(4)));
typedef unsigned u32x4 __attribute__((ext_vector_type(4)));
constexpr int BM = 256, BK = 64, HALF = 128, HTB = HALF * BK * 2, STAGE_BYTES = 8 * HTB, NXCD = 8, WGM = 8;

__host__ __device__ __forceinline__ int lds_byte(int r, int c) { const int st = (r >> 4) * 2 + (c >> 5), rr = r & 15, cc = c & 31, ob = rr * 64 + cc * 2; return st * 1024 + (ob ^ (((ob >> 9) & 1) << 5)); }
__host__ __device__ __forceinline__ void stage_rc(int b, int& R, int& C) { const int st = b / 1024, sb = b % 1024, swz = sb ^ (((sb >> 9) & 1) << 5); R = (st >> 1) * 16 + swz / 64; C = (st & 1) * 32 + (swz % 64) / 2; }
__host__ __device__ __forceinline__ int perm32(int rho) { const int n = rho >> 4, i = rho & 15; return 8 * (i >> 2) + 4 * n + (i & 3); }

struct Unit { int pm, pn; };
struct Gemm { const bf16_t* A; const bf16_t* Bt; int M, N, K; size_t a_pn_step, b_pn_step; int nt; };
__host__ __device__ __forceinline__ Gemm mk_gemm(const bf16_t* A, const bf16_t* Bt, int M, int N, int K) { return Gemm{A, Bt, M, N, K, 0, (size_t)256 * K * 2, K / 64}; }

struct StaticOrder {
    int nM, nN, nwg, G, c, pm0;
    __host__ __device__ void init(int M, int N, int G_, int c_, int pm0_ = 0) { nM = M / BM; nN = N / BM; nwg = nM * nN; G = G_; c = c_; pm0 = pm0_; }
    __host__ __device__ bool next(int i, Unit& u) const {
        const long L = (long)i * G + c; if (L >= nwg) return false;
        int wgid = (int)L; { const int q = nwg / NXCD, r = nwg % NXCD, xcd = wgid % NXCD, off = wgid / NXCD; wgid = (xcd < r ? xcd * (q + 1) : r * (q + 1) + (xcd - r) * q) + off; }
        const int nig = WGM * nN, gid = wgid / nig, fm = gid * WGM, gsz = (nM - fm) < WGM ? (nM - fm) : WGM;
        u.pm = pm0 + fm + ((wgid % nig) % gsz); u.pn = (wgid % nig) / gsz; return true;
    }
    __device__ __forceinline__ void a_ready(const Unit&) const {}
    __device__ __forceinline__ void done(const Unit&) const {}
};

__device__ __forceinline__ unsigned cvt_pk_bf16(float lo, float hi) { unsigned r; asm volatile("v_cvt_pk_bf16_f32 %0, %1, %2" : "=v"(r) : "v"(lo), "v"(hi)); return r; }

template <int ACT> struct EpiBf16 {
    static constexpr bool PERM = true, AFTER_DRAIN = false;
    bf16_t* O; int ldc; int n_main; float* G;
    __device__ __forceinline__ void operator()(const f32x4 (&acc)[2][2][4][2], const Unit& u, int wr, int wc, int fr, int fq) const {
        const int row0 = u.pm * BM + wr * 64 + fr; const int colt = u.pn * BM;
        const int col0 = colt + wc * 32 + 8 * fq;
#pragma unroll
        for (int ai = 0; ai < 2; ++ai)
#pragma unroll
            for (int m = 0; m < 4; ++m) { bf16_t* rowp = O + (size_t)(row0 + ai * HALF + m * 16) * ldc + col0;
#pragma unroll
                for (int bj = 0; bj < 2; ++bj) { f32x4 v0 = acc[ai][bj][m][0], v1 = acc[ai][bj][m][1];
                    if (ACT == 1) {
#pragma unroll
                        for (int j = 0; j < 4; ++j) { const float a = fmaxf(v0[j], 0.f), b = fmaxf(v1[j], 0.f); v0[j] = a * a; v1[j] = b * b; } }
                    u32x4 w; w.x = cvt_pk_bf16(v0[0], v0[1]); w.y = cvt_pk_bf16(v0[2], v0[3]); w.z = cvt_pk_bf16(v1[0], v1[1]); w.w = cvt_pk_bf16(v1[2], v1[3]);
                    *(u32x4*)(rowp + bj * HALF) = w;
#ifdef PROBE_DOUBLE_STORE
                    asm volatile("" ::: "memory"); *(u32x4*)(rowp + bj * HALF) = w; asm volatile("" ::: "memory");
#endif
                    } }
    }
};
struct EpiGateP {
    static constexpr bool PERM = true, AFTER_DRAIN = false;
    float* GP;
    __device__ __forceinline__ void operator()(const f32x4 (&acc)[2][2][4][2], const Unit& u, int wr, int wc, int fr, int fq) const {
        const int row0 = u.pm * BM + wr * 64 + fr; const int col0 = wc * 32 + 8 * fq; float* base = GP + (size_t)u.pn * 16384 * 128;
#pragma unroll
        for (int ai = 0; ai < 2; ++ai)
#pragma unroll
            for (int m = 0; m < 4; ++m) { float* rowp = base + (size_t)(row0 + ai * HALF + m * 16) * 128 + col0;
                *(f32x4*)(rowp) = acc[ai][0][m][0]; *(f32x4*)(rowp + 4) = acc[ai][0][m][1]; }
    }
};
template <bool BASE_F32> struct EpiRes {
    static constexpr bool PERM = true, AFTER_DRAIN = false;
    const void* base_ctx; const void* base_lat; bf16_t* out; const float* gate;
    __device__ __forceinline__ void operator()(const f32x4 (&acc)[2][2][4][2], const Unit& u, int wr, int wc, int fr, int fq) const {
        const int row0 = u.pm * BM + wr * 64 + fr, col0 = u.pn * BM + wc * 32 + 8 * fq;
        const bool ctx = u.pm < 32; const int grp = ctx ? 0 : 1 + ((u.pm - 32) >> 3);
        const float* gp = gate + (size_t)grp * 12288 + col0;
        const void* base = ctx ? base_ctx : base_lat; const int rsub = (BASE_F32 && !ctx) ? 8192 : 0;
        f32x4 gv[2][2];
#pragma unroll
        for (int bj = 0; bj < 2; ++bj)
#pragma unroll
            for (int n = 0; n < 2; ++n) gv[bj][n] = *(const f32x4*)(gp + bj * HALF + 4 * n);
#pragma unroll
        for (int ai = 0; ai < 2; ++ai) {
            f32x4 bs[4][2][2];
#pragma unroll
            for (int m = 0; m < 4; ++m) { const size_t offb = (size_t)(row0 + ai * HALF + m * 16 - rsub) * 2048 + col0;
#pragma unroll
                for (int bj = 0; bj < 2; ++bj) {
                    if (BASE_F32) { bs[m][bj][0] = *(const f32x4*)((const float*)base + offb + bj * HALF); bs[m][bj][1] = *(const f32x4*)((const float*)base + offb + bj * HALF + 4); }
                    else { const u32x4 w = *(const u32x4*)((const bf16_t*)base + offb + bj * HALF);
                        bs[m][bj][0] = (f32x4){__uint_as_float(w.x << 16), __uint_as_float(w.x & 0xffff0000u), __uint_as_float(w.y << 16), __uint_as_float(w.y & 0xffff0000u)};
                        bs[m][bj][1] = (f32x4){__uint_as_float(w.z << 16), __uint_as_float(w.z & 0xffff0000u), __uint_as_float(w.w << 16), __uint_as_float(w.w & 0xffff0000u)}; } } }
#pragma unroll
            for (int m = 0; m < 4; ++m) { const size_t offo = (size_t)(row0 + ai * HALF + m * 16) * 2048 + col0;
#pragma unroll
                for (int bj = 0; bj < 2; ++bj) { const f32x4 v0 = bs[m][bj][0] + gv[bj][0] * acc[ai][bj][m][0], v1 = bs[m][bj][1] + gv[bj][1] * acc[ai][bj][m][1];
                    u32x4 w; w.x = cvt_pk_bf16(v0[0], v0[1]); w.y = cvt_pk_bf16(v0[2], v0[3]); w.z = cvt_pk_bf16(v1[0], v1[1]); w.w = cvt_pk_bf16(v1[2], v1[3]);
                    *(u32x4*)(out + offo + bj * HALF) = w; } }
            asm volatile("" ::: "memory");
        }
    }
};

template <class Epi, class Sched, bool ALIGN_EPI = false, bool SP2 = false>
__device__ __forceinline__ void gemm_phase(PG8_LAS unsigned char* lds, const Gemm g, const Sched& S, const Epi& E) {
    const int tid = opaque_v((int)threadIdx.x), wid = __builtin_amdgcn_readfirstlane(tid >> 6), lane = tid & 63, wr = wid >> 2, wc = wid & 3, fr = lane & 15, fq = lane >> 4;
    const int K = g.K, nt = g.nt;
    unsigned voffA[2], voffB[2];
#pragma unroll
    for (int i = 0; i < 2; ++i) { int R, C; stage_rc(tid * 16 + i * 8192, R, C); const int Rb = Epi::PERM ? ((R & ~31) + perm32(R & 31)) : R;
        voffA[i] = (unsigned)(R * K + C) * 2u; voffB[i] = (unsigned)(Rb * K + C) * 2u; }
    const size_t kstep = (size_t)(BK * 2);
    const size_t hstep = (size_t)HALF * K * 2;
    const size_t tstep = 2 * hstep;
    const unsigned ldsw = (unsigned)wid * 1024u;
    const int aoff = lds_byte(wr * 64 + fr, fq * 8), boff = lds_byte(wc * 32 + fr, fq * 8);
#define PG8_SA(b, h) (((b) * 2 + (h)) * HTB)
#define PG8_SB(b, h) ((4 + (b) * 2 + (h)) * HTB)
#define PG8_STAGE(bufoff, gbase, voff) do { _Pragma("unroll") for (int _i = 0; _i < 2; ++_i) \
        __builtin_amdgcn_global_load_lds((const unsigned*)((const char*)(gbase) + (voff)[_i]), (PG8_LAS unsigned*)(lds + (bufoff) + ldsw + _i * 8192), 16, 0, 0); } while (0)
#define PG8_LDA(dst, b, h) do { _Pragma("unroll") for (int m = 0; m < 4; ++m) _Pragma("unroll") for (int k = 0; k < 2; ++k) dst[m][k] = *(const PG8_LAS bf16x8*)(lds + PG8_SA(b, h) + aoff + m * 2048 + k * 1024); } while (0)
#define PG8_LDB(dst, b, h) do { _Pragma("unroll") for (int n = 0; n < 2; ++n) _Pragma("unroll") for (int k = 0; k < 2; ++k) dst[n][k] = *(const PG8_LAS bf16x8*)(lds + PG8_SB(b, h) + boff + n * 2048 + k * 1024); } while (0)
#define PG8_MMA(ai, bj, At, Bt) do { __builtin_amdgcn_s_setprio(1); _Pragma("unroll") for (int m = 0; m < 4; ++m) _Pragma("unroll") for (int n = 0; n < 2; ++n) _Pragma("unroll") for (int k = 0; k < 2; ++k) \
        acc[ai][bj][m][n] = __builtin_amdgcn_mfma_f32_16x16x32_bf16(Bt[n][k], At[m][k], acc[ai][bj][m][n], 0, 0, 0); __builtin_amdgcn_s_setprio(0); } while (0)
#define PG8_WAIT_V(n) asm volatile("s_waitcnt vmcnt(" #n ")" ::: "memory")
#define PG8_WAIT_L(n) asm volatile("s_waitcnt lgkmcnt(" #n ")" ::: "memory")
#define PG8_BAR __builtin_amdgcn_s_barrier()
#define PG8_SCHED __builtin_amdgcn_sched_barrier(0)
    Unit cur, nxt; int ui = 0;
    if (!S.next(0, cur)) return;
    f32x4 acc[2][2][4][2];
#pragma unroll
    for (int a = 0; a < 2; ++a)
#pragma unroll
        for (int b = 0; b < 2; ++b)
#pragma unroll
            for (int m = 0; m < 4; ++m)
#pragma unroll
                for (int n = 0; n < 2; ++n) acc[a][b][m][n] = (f32x4){0.f, 0.f, 0.f, 0.f};
    bf16x8 At[4][2], B0[2][2], B1[2][2];
    const char* cA = (const char*)g.A + (size_t)cur.pm * tstep + (size_t)cur.pn * g.a_pn_step; const char* cB = (const char*)g.Bt + (size_t)cur.pn * g.b_pn_step;
    S.a_ready(cur);
    if constexpr (SP2) {
        PG8_STAGE(PG8_SB(0, 0), cB, voffB); PG8_STAGE(PG8_SB(0, 1), cB + hstep, voffB); PG8_STAGE(PG8_SA(0, 0), cA, voffA); PG8_STAGE(PG8_SA(0, 1), cA + hstep, voffA);
        if (wr == 1) PG8_BAR;
        PG8_WAIT_V(2); PG8_BAR;
        PG8_STAGE(PG8_SB(1, 0), cB + kstep, voffB); PG8_STAGE(PG8_SA(1, 0), cA + kstep, voffA); PG8_STAGE(PG8_SB(1, 1), cB + hstep + kstep, voffB);
        PG8_WAIT_V(6); PG8_BAR;
    } else {
        PG8_STAGE(PG8_SB(0, 0), cB, voffB); PG8_STAGE(PG8_SA(0, 0), cA, voffA); PG8_STAGE(PG8_SB(0, 1), cB + hstep, voffB); PG8_STAGE(PG8_SA(0, 1), cA + hstep, voffA);
        if (wr == 1) PG8_BAR;
        PG8_WAIT_V(4); PG8_BAR;
        PG8_STAGE(PG8_SB(1, 0), cB + kstep, voffB); PG8_STAGE(PG8_SA(1, 0), cA + kstep, voffA); PG8_STAGE(PG8_SB(1, 1), cB + hstep + kstep, voffB);
        PG8_WAIT_V(6); PG8_BAR;
    }
    for (;;) {
        const bool has_next = S.next(ui + 1, nxt);
        const char* nA = has_next ? (const char*)g.A + (size_t)nxt.pm * tstep + (size_t)nxt.pn * g.a_pn_step : cA; const char* nB = has_next ? (const char*)g.Bt + (size_t)nxt.pn * g.b_pn_step : cB;
        for (int t = 0; t < nt; t += 2) {
            const bool last = (t == nt - 2);
            const char* a1 = cA + (size_t)(t + 1) * kstep;
            const char* a2 = last ? nA : cA + (size_t)(t + 2) * kstep; const char* b2 = last ? nB : cB + (size_t)(t + 2) * kstep;
            const char* a3 = a2 + kstep; const char* b3 = b2 + kstep;
            if (last && has_next) S.a_ready(nxt);
            if constexpr (SP2) {
            PG8_LDB(B0, 0, 0); PG8_LDB(B1, 0, 1); PG8_SCHED; PG8_LDA(At, 0, 0); PG8_STAGE(PG8_SA(1, 1), a1 + hstep, voffA);
            PG8_WAIT_V(8); PG8_WAIT_L(0); PG8_BAR; PG8_MMA(0, 0, At, B0); PG8_MMA(0, 1, At, B1); PG8_BAR; PG8_SCHED;
            PG8_LDA(At, 0, 1); PG8_STAGE(PG8_SB(0, 0), b2, voffB); PG8_STAGE(PG8_SB(0, 1), b2 + hstep, voffB); PG8_STAGE(PG8_SA(0, 0), a2, voffA);
            PG8_WAIT_V(8); PG8_WAIT_L(0); PG8_BAR; PG8_MMA(1, 0, At, B0); PG8_MMA(1, 1, At, B1); PG8_BAR; PG8_SCHED;
            PG8_LDB(B0, 1, 0); PG8_LDB(B1, 1, 1); PG8_SCHED; PG8_LDA(At, 1, 0); PG8_STAGE(PG8_SA(0, 1), a2 + hstep, voffA);
            PG8_WAIT_V(8); PG8_WAIT_L(0); PG8_BAR; PG8_MMA(0, 0, At, B0); PG8_MMA(0, 1, At, B1); PG8_BAR; PG8_SCHED;
            PG8_LDA(At, 1, 1); PG8_STAGE(PG8_SB(1, 0), b3, voffB); PG8_STAGE(PG8_SB(1, 1), b3 + hstep, voffB); PG8_STAGE(PG8_SA(1, 0), a3, voffA);
            PG8_WAIT_V(8); PG8_WAIT_L(0); PG8_BAR; PG8_MMA(1, 0, At, B0); PG8_MMA(1, 1, At, B1); PG8_BAR; PG8_SCHED;
            } else {
            PG8_LDB(B0, 0, 0); PG8_SCHED; PG8_LDA(At, 0, 0); PG8_STAGE(PG8_SA(1, 1), a1 + hstep, voffA);
            PG8_WAIT_L(8); PG8_BAR; PG8_WAIT_L(0); PG8_MMA(0, 0, At, B0); PG8_BAR; PG8_SCHED;
            PG8_LDB(B1, 0, 1); PG8_STAGE(PG8_SB(0, 0), b2, voffB);
            PG8_BAR; PG8_WAIT_L(0); PG8_MMA(0, 1, At, B1); PG8_BAR;
            PG8_LDA(At, 0, 1); PG8_STAGE(PG8_SA(0, 0), a2, voffA);
            PG8_BAR; PG8_WAIT_L(0); PG8_MMA(1, 0, At, B0); PG8_BAR; PG8_SCHED;
            PG8_STAGE(PG8_SB(0, 1), b2 + hstep, voffB);
            PG8_WAIT_V(6); PG8_BAR; PG8_MMA(1, 1, At, B1); PG8_BAR;
            PG8_LDB(B0, 1, 0); PG8_SCHED; PG8_LDA(At, 1, 0); PG8_STAGE(PG8_SA(0, 1), a2 + hstep, voffA);
            PG8_WAIT_L(8); PG8_BAR; PG8_WAIT_L(0); PG8_MMA(0, 0, At, B0); PG8_BAR; PG8_SCHED;
            PG8_LDB(B1, 1, 1); PG8_STAGE(PG8_SB(1, 0), b3, voffB);
            PG8_BAR; PG8_WAIT_L(0); PG8_MMA(0, 1, At, B1); PG8_BAR;
            PG8_LDA(At, 1, 1); PG8_STAGE(PG8_SA(1, 0), a3, voffA);
            PG8_BAR; PG8_WAIT_L(0); PG8_MMA(1, 0, At, B0); PG8_BAR; PG8_SCHED;
            PG8_STAGE(PG8_SB(1, 1), b3 + hstep, voffB);
            PG8_WAIT_V(6); PG8_BAR; PG8_MMA(1, 1, At, B1); PG8_BAR;
            }
        }
        if constexpr (ALIGN_EPI) { if (wr == 0) PG8_BAR; }
        if constexpr (!Epi::AFTER_DRAIN) { E(acc, cur, wr, wc, fr, fq); S.done(cur); }
        if (!has_next) break;
#pragma unroll
        for (int a = 0; a < 2; ++a)
#pragma unroll
            for (int b = 0; b < 2; ++b)
#pragma unroll
                for (int m = 0; m < 4; ++m)
#pragma unroll
                    for (int n = 0; n < 2; ++n) acc[a][b][m][n] = (f32x4){0.f, 0.f, 0.f, 0.f};
        cur = nxt; cA = nA; cB = nB; ++ui;
        if constexpr (ALIGN_EPI) { if (wr == 1) PG8_BAR; }
    }
    PG8_WAIT_V(0);
    if constexpr (!ALIGN_EPI) { if (wr == 0) PG8_BAR; }
    PG8_BAR;
#undef PG8_SA
#undef PG8_SB
#undef PG8_STAGE
#undef PG8_LDA
#undef PG8_LDB
#undef PG8_MMA
#undef PG8_WAIT_V
#undef PG8_WAIT_L
#undef PG8_BAR
#undef PG8_SCHED
}
}

#define XB_TMO      128
#define XB_XCNT(j)  (256  + 64 * (j))
#define XB_XSUB(j)  (1280 + 64 * (j))
#define XB_XGEN(j)  (2304 + 64 * (j))
#define XB_TOP      3328
#define XB_TOPGEN   3392
#define XCD_BAR_WORDS 3456
#define XB_SPIN_CAP (1u << 21)
#define LAS __attribute__((address_space(3)))

__device__ __forceinline__ unsigned xb_ld(unsigned* p)              { return __hip_atomic_load(p, __ATOMIC_RELAXED, __HIP_MEMORY_SCOPE_AGENT); }
__device__ __forceinline__ unsigned xb_add(unsigned* p, unsigned v) { return __hip_atomic_fetch_add(p, v, __ATOMIC_RELAXED, __HIP_MEMORY_SCOPE_AGENT); }
__device__ __forceinline__ unsigned xb_xcc_id() { return (unsigned)__builtin_amdgcn_s_getreg((3 << 11) | 20) & 0xFu; }
#define XB_SPIN(cond, bar) do { unsigned _sp = 0; while (cond) { __builtin_amdgcn_s_sleep(1); \
    if ((++_sp & 255u) == 0u) { if (xb_ld(&(bar)[XB_TMO])) break; if (_sp > XB_SPIN_CAP) { atomicAdd(&(bar)[XB_TMO], 1u); break; } } } } while (0)

struct XcdBarrier { unsigned* bar; unsigned x; volatile LAS unsigned* st; };

__device__ __forceinline__ XcdBarrier xcd_barrier_post(unsigned* bar, volatile LAS unsigned* st) {
    XcdBarrier b; b.bar = bar; b.x = xb_xcc_id(); b.st = st;
    if (threadIdx.x == 0) (void)xb_add(&bar[XB_XCNT(b.x)], 1u);
    return b;
}
__device__ __forceinline__ void xcd_barrier_complete(unsigned* bar, unsigned x, unsigned& nloc, unsigned& nx) {
    const unsigned G = gridDim.x * gridDim.y * gridDim.z;
    unsigned sum, cnt, mine, sp = 0u;
    for (;;) {
        sum = 0u; cnt = 0u; mine = 0u;
#pragma unroll
        for (unsigned j = 0; j < 16; ++j) { const unsigned c = xb_ld(&bar[XB_XCNT(j)]); sum += c; cnt += (c > 0u) ? 1u : 0u; mine = (j == x) ? c : mine; }
        if (sum == G) break;
        __builtin_amdgcn_s_sleep(1);
        if ((++sp & 255u) == 0u) { if (xb_ld(&bar[XB_TMO])) break; if (sp > XB_SPIN_CAP) { atomicAdd(&bar[XB_TMO], 1u); break; } }
    }
    nloc = mine > 0u ? mine : 1u; nx = cnt > 0u ? cnt : 1u;
}
__device__ __forceinline__ void xcd_barrier(const XcdBarrier& b) {
    asm volatile("s_waitcnt vmcnt(0)" ::: "memory");
    __syncthreads();
    if (threadIdx.x == 0) {
        unsigned* bar = b.bar;
        __builtin_amdgcn_s_waitcnt(0);
        unsigned nloc = b.st[0], nx = b.st[1];
        if (nloc == 0u) { xcd_barrier_complete(bar, b.x, nloc, nx); b.st[0] = nloc; b.st[1] = nx; }
        const unsigned old = xb_add(&bar[XB_XSUB(b.x)], 1u);
        const unsigned gen = old / nloc;
        if (old + 1u == (gen + 1u) * nloc) {
            __builtin_amdgcn_fence(__ATOMIC_RELEASE, "agent");
            asm volatile("s_waitcnt vmcnt(0)" ::: "memory");
            const unsigned og = xb_add(&bar[XB_TOP], 1u);
            const unsigned tg = og / nx;
            if (og + 1u == (tg + 1u) * nx) xb_add(&bar[XB_TOPGEN], 1u);
            else XB_SPIN(xb_ld(&bar[XB_TOPGEN]) == tg, bar);
            __builtin_amdgcn_fence(__ATOMIC_ACQUIRE, "agent");
            xb_add(&bar[XB_XGEN(b.x)], 1u);
            asm volatile("s_waitcnt vmcnt(0)" ::: "memory");
        } else {
            XB_SPIN(xb_ld(&bar[XB_XGEN(b.x)]) == gen, bar);
            __builtin_amdgcn_fence(__ATOMIC_ACQUIRE, "agent");
            asm volatile("s_waitcnt vmcnt(0)" ::: "memory");
        }
    }
    __syncthreads();
}

typedef unsigned short bf16;
typedef float f32x4 __attribute__((ext_vector_type(4)));
typedef unsigned u32x4 __attribute__((ext_vector_type(4)));
typedef unsigned u32x2 __attribute__((ext_vector_type(2)));

constexpr int D = 2048, DFF = 8192, MROWS = 16384, MCTX = 8192;
constexpr int NT = 512;
constexpr float EPS = 1e-6f;
constexpr int DN_NIN = 12416, DN_NMAIN = 12288, DN_NPAD = 12544;
constexpr int GLA_NIN = 6176, GLA_NMAIN = 6144, GLA_NPAD = 6400;
constexpr int HG_NIN = 10240;
constexpr int MODW = 12288;

constexpr size_t MiB = 1u << 20;
constexpr size_t WS_CTL = 0, CTL_BYTES = 1 * MiB;
constexpr size_t WS_MOD = 1 * MiB;
constexpr size_t WS_X = 2 * MiB;
constexpr size_t WS_H = WS_X + 128 * MiB;
constexpr size_t WS_BIG = WS_H + 64 * MiB;
constexpr size_t WS_GATE = WS_BIG + 384 * MiB;
constexpr size_t WS_QKV = WS_GATE + 8 * MiB;
constexpr size_t WS_OF = WS_QKV + 256 * MiB;
constexpr size_t WS_OB = WS_OF + 128 * MiB;
constexpr size_t WS_W = WS_OB + 128 * MiB;
constexpr size_t WOFF_IN = 0, WOFF_OUT = (size_t)DN_NPAD * D * 2, WOFF_UP = WOFF_OUT + (size_t)D * 4096 * 2, WOFF_DOWN = WOFF_UP + (size_t)DFF * D * 2;
constexpr size_t WS_TA = ((WS_W + WOFF_DOWN + (size_t)D * DFF * 2 + MiB - 1) / MiB) * MiB;
constexpr size_t WS_GS = WS_TA + 256 * MiB;
constexpr size_t WS_GP = WS_GS + 12 * MiB;
constexpr size_t WS_END = WS_GP + 32 * MiB;

constexpr size_t OUT_Y = 0;
constexpr size_t OUT_SDN = (size_t)MROWS * D;
constexpr size_t OUT_SGLA = OUT_SDN + (size_t)32 * 2 * 2 * 32 * 128 * 128;
constexpr size_t OUT_SHG = OUT_SGLA + (size_t)32 * 2 * 4 * 256 * 512;
constexpr size_t OUT_END = OUT_SHG + (size_t)32 * 2 * 16 * 128 * 128;

constexpr int LDS_BYTES = 151552;
constexpr int LDS_MISC = 150528;

struct Params {
    const float* in[29];
    float* out;
    unsigned char* ws;
};

__device__ __forceinline__ float bf2f(unsigned short b) { return __uint_as_float(((unsigned)b) << 16); }
typedef __bf16 bfv2_ __attribute__((ext_vector_type(2)));
typedef float f32x2_ __attribute__((ext_vector_type(2)));
__device__ __forceinline__ unsigned f2bf(float f) { return (unsigned)__builtin_bit_cast(unsigned short, (__bf16)f); }
__device__ __forceinline__ unsigned pk2(float lo, float hi) { const f32x2_ v = {lo, hi}; return __builtin_bit_cast(unsigned, __builtin_convertvector(v, bfv2_)); }
__device__ __forceinline__ float bflo(unsigned w) { return __uint_as_float(w << 16); }
__device__ __forceinline__ float bfhi(unsigned w) { return __uint_as_float(w & 0xffff0000u); }
__device__ __forceinline__ float wave_sum(float v) {
#pragma unroll
    for (int o = 1; o < 64; o <<= 1) v += __shfl_xor(v, o);
    return v;
}
__device__ __forceinline__ float rdlane(float v, int l) { return __builtin_bit_cast(float, __builtin_amdgcn_readlane(__builtin_bit_cast(int, v), l)); }
__device__ __forceinline__ float sigmoidf_(float x) { return __builtin_amdgcn_rcpf(1.f + __expf(-x)); }
__device__ __forceinline__ float siluf_(float x) { return x * __builtin_amdgcn_rcpf(1.f + __expf(-x)); }
__device__ __forceinline__ float softplusf_(float x) { return fmaxf(x, 0.f) + log1pf(__expf(-fabsf(x))); }

__device__ __forceinline__ void transpose_item(const float* W, int K, int N, bf16* WT, LAS float* scr, int item, int lane) {
    const int nblk = N / 32, kb = item / nblk, nb = item % nblk, k0 = 64 * kb, n0 = 32 * nb;
    { f32x4 v[8]; const int kr = lane >> 3, c4 = (lane & 7) * 4;
#pragma unroll
      for (int i = 0; i < 8; ++i) v[i] = *(const f32x4*)(W + (size_t)(k0 + kr + 8 * i) * N + n0 + c4);
#pragma unroll
      for (int i = 0; i < 8; ++i) { LAS float* d = scr + (kr + 8 * i) * 33 + c4; d[0] = v[i].x; d[1] = v[i].y; d[2] = v[i].z; d[3] = v[i].w; } }
    asm volatile("s_waitcnt lgkmcnt(0)" ::: "memory");
    const int c = lane & 7;
#pragma unroll
    for (int j = 0; j < 4; ++j) { const int n = (lane >> 3) + 8 * j; const LAS float* s = scr + (8 * c) * 33 + n;
        u32x4 o; o.x = pk2(s[0 * 33], s[1 * 33]); o.y = pk2(s[2 * 33], s[3 * 33]); o.z = pk2(s[4 * 33], s[5 * 33]); o.w = pk2(s[6 * 33], s[7 * 33]);
        *(u32x4*)(WT + (size_t)(n0 + n) * K + k0 + 8 * c) = o; }
    asm volatile("s_waitcnt lgkmcnt(0)" ::: "memory");
}

__device__ __forceinline__ void convert_layer_weights(const Params& P, int layer, LAS unsigned char* lds) {
    PHASE_IDS();
    LAS float* scr = (LAS float*)(lds + wave * 16384);
    const int kind = layer % 3, j = layer / 3;
    const float* Win; int Nin, Npad; const float* Wout; int Kout;
    if (kind == 0) { Win = P.in[14] + (size_t)j * D * DN_NIN; Nin = DN_NIN; Npad = DN_NPAD; Wout = P.in[19] + (size_t)j * 4096 * D; Kout = 4096; }
    else if (kind == 1) { Win = P.in[20] + (size_t)j * D * GLA_NIN; Nin = GLA_NIN; Npad = GLA_NPAD; Wout = P.in[24] + (size_t)j * D * D; Kout = 2048; }
    else { Win = P.in[25] + (size_t)j * D * HG_NIN; Nin = HG_NIN; Npad = HG_NIN; Wout = P.in[28] + (size_t)j * D * D; Kout = 2048; }
    const float* Wup = P.in[12] + (size_t)layer * D * DFF; const float* Wdn = P.in[13] + (size_t)layer * DFF * D;
    bf16* Tin = (bf16*)(P.ws + WS_W + WOFF_IN); bf16* Tout = (bf16*)(P.ws + WS_W + WOFF_OUT); bf16* Tup = (bf16*)(P.ws + WS_W + WOFF_UP); bf16* Tdn = (bf16*)(P.ws + WS_W + WOFF_DOWN);
    const int I_in = (D / 64) * (Nin / 32), I_out = (Kout / 64) * (D / 32), I_up = (D / 64) * (DFF / 32), I_dn = (DFF / 64) * (D / 32);
    const int NI = I_in + I_out + I_up + I_dn;
    for (int it = gw; it < NI; it += NGW) {
        int r = it;
        if (r < I_in) { transpose_item(Win, D, Nin, Tin, scr, r, lane); continue; } r -= I_in;
        if (r < I_out) { transpose_item(Wout, Kout, D, Tout, scr, r, lane); continue; } r -= I_out;
        if (r < I_up) { transpose_item(Wup, D, DFF, Tup, scr, r, lane); continue; } r -= I_up;
        transpose_item(Wdn, DFF, D, Tdn, scr, r, lane);
    }
    const int npadrows = Npad - Nin;
    if (npadrows > 0) {
        u32x4* z = (u32x4*)(Tin + (size_t)Nin * D); const int n16 = npadrows * D / 8;
        for (int i = gw * 64 + lane; i < n16; i += NGW * 64) z[i] = (u32x4){0u, 0u, 0u, 0u};
    }
}

__device__ __forceinline__ void mod_phase(const Params& P, LAS unsigned char* lds) {
    PHASE_IDS();
    LAS float* scond = (LAS float*)lds;
    LAS float* red = (LAS float*)(lds + 40960 + 1024);
    for (int i = tid; i < 5 * 2048; i += NT) { const int g = i / 2048, k = i % 2048; const float v = g == 0 ? P.in[6][k] : P.in[2][(g - 1) * 2048 + k]; scond[k * 5 + g] = siluf_(v); }
    __syncthreads();
    float* mod = (float*)(P.ws + WS_MOD);
    const int c4 = tid & 15, kg = tid >> 4;
    for (int cg = blockIdx.x; cg < 4 * MODW / 64; cg += gridDim.x) {
        const int layer = cg / (MODW / 64), colbase = (cg % (MODW / 64)) * 64;
        const float* W = P.in[7] + (size_t)layer * D * MODW + colbase + c4 * 4;
        f32x4 acc[5];
#pragma unroll
        for (int g = 0; g < 5; ++g) acc[g] = (f32x4){0.f, 0.f, 0.f, 0.f};
#pragma unroll 8
        for (int kk = 0; kk < 64; ++kk) {
            const int k = kg * 64 + kk;
            const f32x4 w = *(const f32x4*)(W + (size_t)k * MODW);
#pragma unroll
            for (int g = 0; g < 5; ++g) acc[g] += w * scond[k * 5 + g];
        }
#pragma unroll
        for (int g = 0; g < 5; ++g)
#pragma unroll
            for (int e = 0; e < 4; ++e) red[(kg * 64 + c4 * 4 + e) * 5 + g] = acc[g][e];
        __syncthreads();
        if (tid < 64 * 5) { const int c = tid / 5, g = tid % 5; float sum = 0.f;
#pragma unroll 8
            for (int q = 0; q < 32; ++q) sum += red[(q * 64 + c) * 5 + g];
            mod[((size_t)layer * 5 + g) * MODW + colbase + c] = sum + P.in[8][(size_t)layer * MODW + colbase + c]; }
        __syncthreads();
    }
}

template <bool XF32> __device__ __forceinline__ void norm_mod_phase(const void* xc, const void* xl, const float* w, const float* mod, int sh_off, int sc_off, bf16* H) {
    PHASE_IDS();
    for (int m = gw; m < MROWS; m += NGW) {
        const bool ctx = m < MCTX; const int grp = ctx ? 0 : 1 + ((m - MCTX) >> 11);
        f32x4 v[8]; float ss = 0.f;
        if (XF32) { const float* xr = ctx ? (const float*)xc + (size_t)m * D : (const float*)xl + (size_t)(m - MCTX) * D;
#pragma unroll
            for (int jx = 0; jx < 4; ++jx) { v[2 * jx] = *(const f32x4*)(xr + 8 * (lane + 64 * jx)); v[2 * jx + 1] = *(const f32x4*)(xr + 8 * (lane + 64 * jx) + 4); } }
        else { const bf16* xr = (const bf16*)xc + (size_t)m * D;
#pragma unroll
            for (int jx = 0; jx < 4; ++jx) { const u32x4 q = *(const u32x4*)(xr + 8 * (lane + 64 * jx));
                v[2 * jx] = (f32x4){bflo(q.x), bfhi(q.x), bflo(q.y), bfhi(q.y)}; v[2 * jx + 1] = (f32x4){bflo(q.z), bfhi(q.z), bflo(q.w), bfhi(q.w)}; } }
#pragma unroll
        for (int i = 0; i < 8; ++i) ss += (v[i].x * v[i].x + v[i].y * v[i].y) + (v[i].z * v[i].z + v[i].w * v[i].w);
        const float rstd = rsqrtf(wave_sum(ss) * (1.f / D) + EPS);
        const float* mg = mod + (size_t)grp * MODW;
#pragma unroll
        for (int jx = 0; jx < 4; ++jx) { const int c = 8 * (lane + 64 * jx);
            const f32x4 y0 = v[2 * jx] * rstd * *(const f32x4*)(w + c) * (*(const f32x4*)(mg + sc_off + c) + 1.f) + *(const f32x4*)(mg + sh_off + c);
            const f32x4 y1 = v[2 * jx + 1] * rstd * *(const f32x4*)(w + c + 4) * (*(const f32x4*)(mg + sc_off + c + 4) + 1.f) + *(const f32x4*)(mg + sh_off + c + 4);
            u32x4 o; o.x = pk2(y0.x, y0.y); o.y = pk2(y0.z, y0.w); o.z = pk2(y1.x, y1.y); o.w = pk2(y1.z, y1.w);
            *(u32x4*)(H + (size_t)m * D + c) = o; }
    }
}
__device__ __forceinline__ void final_norm_phase(const bf16* X, const float* w, float* out) {
    PHASE_IDS();
    for (int m = gw; m < MROWS; m += NGW) {
        f32x4 v[8]; float ss = 0.f;
#pragma unroll
        for (int jx = 0; jx < 4; ++jx) { const u32x4 q = *(const u32x4*)(X + (size_t)m * D + 8 * (lane + 64 * jx));
            v[2 * jx] = (f32x4){bflo(q.x), bfhi(q.x), bflo(q.y), bfhi(q.y)}; v[2 * jx + 1] = (f32x4){bflo(q.z), bfhi(q.z), bflo(q.w), bfhi(q.w)}; }
#pragma unroll
        for (int i = 0; i < 8; ++i) ss += (v[i].x * v[i].x + v[i].y * v[i].y) + (v[i].z * v[i].z + v[i].w * v[i].w);
        const float rstd = rsqrtf(wave_sum(ss) * (1.f / D) + EPS);
#pragma unroll
        for (int jx = 0; jx < 4; ++jx) { const int c = 8 * (lane + 64 * jx);
            *(f32x4*)(out + (size_t)m * D + c) = v[2 * jx] * rstd * *(const f32x4*)(w + c); *(f32x4*)(out + (size_t)m * D + c + 4) = v[2 * jx + 1] * rstd * *(const f32x4*)(w + c + 4); }
    }
}

template <int DV> __device__ __forceinline__ void gate_phase(const bf16* OF, const bf16* OB, const bf16* proj, int ldp, int gcol0, const float* nw, bf16* Y, int W) {
    PHASE_IDS();
    const int ncg = W / 512;
    const int nitems = MROWS * ncg;
    for (int it0 = gw; it0 < nitems; it0 += 2 * NGW) {
        u32x4 a[2], b[2], gz[2]; int mm[2], cc[2]; bool ok[2];
#pragma unroll
        for (int u = 0; u < 2; ++u) { const int it = it0 + u * NGW; ok[u] = it < nitems; const int itc = ok[u] ? it : it0; mm[u] = itc / ncg; cc[u] = (itc % ncg) * 512 + lane * 8;
            a[u] = *(const u32x4*)(OF + (size_t)mm[u] * W + cc[u]); b[u] = *(const u32x4*)(OB + (size_t)mm[u] * W + cc[u]); gz[u] = *(const u32x4*)(proj + (size_t)mm[u] * ldp + gcol0 + cc[u]); }
#pragma unroll
        for (int u = 0; u < 2; ++u) {
            float o[8], z[8];
            o[0] = bflo(a[u].x) + bflo(b[u].x); o[1] = bfhi(a[u].x) + bfhi(b[u].x); o[2] = bflo(a[u].y) + bflo(b[u].y); o[3] = bfhi(a[u].y) + bfhi(b[u].y);
            o[4] = bflo(a[u].z) + bflo(b[u].z); o[5] = bfhi(a[u].z) + bfhi(b[u].z); o[6] = bflo(a[u].w) + bflo(b[u].w); o[7] = bfhi(a[u].w) + bfhi(b[u].w);
            z[0] = bflo(gz[u].x); z[1] = bfhi(gz[u].x); z[2] = bflo(gz[u].y); z[3] = bfhi(gz[u].y); z[4] = bflo(gz[u].z); z[5] = bfhi(gz[u].z); z[6] = bflo(gz[u].w); z[7] = bfhi(gz[u].w);
            float ss = 0.f;
#pragma unroll
            for (int i = 0; i < 8; ++i) ss += o[i] * o[i];
#pragma unroll
            for (int sft = 1; sft < DV / 8; sft <<= 1) ss += __shfl_xor(ss, sft);
            const float rstd = rsqrtf(ss * (1.f / DV) + EPS);
            const int cw = cc[u] % DV;
            const f32x4 w0 = *(const f32x4*)(nw + cw), w1 = *(const f32x4*)(nw + cw + 4);
            const float wv[8] = {w0.x, w0.y, w0.z, w0.w, w1.x, w1.y, w1.z, w1.w};
            float y[8];
#pragma unroll
            for (int i = 0; i < 8; ++i) y[i] = o[i] * rstd * wv[i] * siluf_(z[i]);
            u32x4 rr; rr.x = pk2(y[0], y[1]); rr.y = pk2(y[2], y[3]); rr.z = pk2(y[4], y[5]); rr.w = pk2(y[6], y[7]);
            if (ok[u]) *(u32x4*)(Y + (size_t)mm[u] * W + cc[u]) = rr;
        }
    }
}

__device__ __forceinline__ void dn_prep_phase(const Params& P, int j, bool do_gates = true) {
    PHASE_IDS();
    const bf16* proj = (const bf16*)(P.ws + WS_BIG); bf16* QKV = (bf16*)(P.ws + WS_QKV);
    const float* cw = P.in[15] + (size_t)j * 5 * 8192;
    for (int it = gw; it < 16 * 128; it += NGW) {
        const int cg = it & 15, chunk = it >> 4, c = cg * 512 + lane * 8;
        float w[5][8];
#pragma unroll
        for (int s = 0; s < 5; ++s) { const f32x4 a = *(const f32x4*)(cw + s * 8192 + c), b = *(const f32x4*)(cw + s * 8192 + c + 4);
            w[s][0] = a.x; w[s][1] = a.y; w[s][2] = a.z; w[s][3] = a.w; w[s][4] = b.x; w[s][5] = b.y; w[s][6] = b.z; w[s][7] = b.w; }
        const float qsc = cg < 4 ? 0.08838834764831845f : 1.f;
        for (int bt = 0; bt < 16; ++bt) {
            const int r0 = chunk * 128 + bt * 8;
            const int L = r0 < MCTX ? 256 : 64, pos0 = r0 < MCTX ? (r0 & 255) : ((r0 - MCTX) & 63);
            u32x4 xw[12];
#pragma unroll
            for (int i = 0; i < 12; ++i) { const int pp = pos0 + i - 2;
                xw[i] = (pp >= 0 && pp < L) ? *(const u32x4*)(proj + (size_t)(r0 + i - 2) * DN_NMAIN + c) : (u32x4){0u, 0u, 0u, 0u}; }
#pragma unroll
            for (int o = 0; o < 8; ++o) {
                float acc[8];
#pragma unroll
                for (int i = 0; i < 8; ++i) acc[i] = 0.f;
#pragma unroll
                for (int s = 0; s < 5; ++s) { const u32x4 x = xw[o + s];
                    acc[0] += bflo(x.x) * w[s][0]; acc[1] += bfhi(x.x) * w[s][1]; acc[2] += bflo(x.y) * w[s][2]; acc[3] += bfhi(x.y) * w[s][3];
                    acc[4] += bflo(x.z) * w[s][4]; acc[5] += bfhi(x.z) * w[s][5]; acc[6] += bflo(x.w) * w[s][6]; acc[7] += bfhi(x.w) * w[s][7]; }
                float ss = 0.f;
#pragma unroll
                for (int i = 0; i < 8; ++i) { acc[i] = siluf_(acc[i]); ss += acc[i] * acc[i]; }
                if (cg < 8) {
                    ss += __shfl_xor(ss, 1); ss += __shfl_xor(ss, 2); ss += __shfl_xor(ss, 4); ss += __shfl_xor(ss, 8);
                    const float sc = rsqrtf(ss + EPS) * qsc;
#pragma unroll
                    for (int i = 0; i < 8; ++i) acc[i] *= sc;
                }
                u32x4 ov; ov.x = pk2(acc[0], acc[1]); ov.y = pk2(acc[2], acc[3]); ov.z = pk2(acc[4], acc[5]); ov.w = pk2(acc[6], acc[7]);
                *(u32x4*)(QKV + (size_t)(r0 + o) * 8192 + c) = ov;
            }
        }
    }
    if (!do_gates) return;
    float* G = (float*)(P.ws + WS_GATE);
    const float* Alog = P.in[16] + j * 64; const float* dtb = P.in[17] + j * 64;
    const float* GPp = (const float*)(P.ws + WS_GP);
    for (int i = gw * 64 + lane; i < MROWS * 128; i += NGW * 64) {
        const int col = i & 127; const float x = (GPp[i] + GPp[i + (size_t)MROWS * 128]) + (GPp[i + (size_t)2 * MROWS * 128] + GPp[i + (size_t)3 * MROWS * 128]); float y;
        if (col < 64) y = sigmoidf_(x);
        else { const int dh = col - 64; y = -__expf(Alog[dh]) * softplusf_(x + dtb[dh]); }
        G[i] = y;
    }
}

typedef short bf16x8 __attribute__((ext_vector_type(8)));
typedef short s16x4 __attribute__((ext_vector_type(4)));
typedef __bf16 bfv8 __attribute__((ext_vector_type(8)));
typedef float f32x8 __attribute__((ext_vector_type(8)));
__device__ __forceinline__ bf16x8 pack8(f32x4 a, f32x4 b) { const f32x8 v = {a[0], a[1], a[2], a[3], b[0], b[1], b[2], b[3]}; return __builtin_bit_cast(bf16x8, __builtin_convertvector(v, bfv8)); }
__device__ __forceinline__ bf16x8 cat4(s16x4 a, s16x4 b) { return (bf16x8){a[0], a[1], a[2], a[3], b[0], b[1], b[2], b[3]}; }
__device__ __forceinline__ s16x4 ld_tr(const LAS unsigned char* p) { return __builtin_amdgcn_ds_read_tr16_b64_v4i16((LAS s16x4*)p); }
__device__ __forceinline__ s16x4 ld_b64(const LAS unsigned char* p) { return *(const volatile LAS s16x4*)p; }
__device__ __forceinline__ bf16x8 ld_b128(const LAS unsigned char* p) { return *(const LAS bf16x8*)p; }
#define MFMA16(a, b, c) __builtin_amdgcn_mfma_f32_16x16x32_bf16((a), (b), (c), 0, 0, 0)

template <int KIND> __device__ __forceinline__ void gla_prep_phase(const Params& P, LAS unsigned char* lds) {
    PHASE_IDS();
    constexpr int NCH = KIND == 1 ? 1024 : 2048, LDP = KIND == 1 ? GLA_NMAIN : HG_NIN, NCB = NCH / 1024;
    const bf16* proj = (const bf16*)(P.ws + WS_BIG); const float* G = (const float*)(P.ws + WS_GATE);
    bf16* QT = (bf16*)(P.ws + WS_QKV); bf16* KT = QT + (size_t)2 * MROWS * NCH; float* E = (float*)(P.ws + WS_OF + 64 * MiB);
    constexpr int DKH = KIND == 1 ? 256 : 128, NHB = 1024 / DKH  , NHT = NCH / DKH  , PL = 2064  ;
    LAS unsigned char* QL = lds; LAS unsigned char* KL = lds + 32 * PL;
    LAS float* sa1 = (LAS float*)(lds + 2 * 32 * PL);
    unsigned* PG = (unsigned*)(P.ws + WS_OF + 72 * MiB);
    for (int it = blockIdx.x; it < 2 * 512 * NCB; it += gridDim.x) {
        const int cb_ = it % NCB, cidx = (it / NCB) % 512, d = it / (NCB * 512);
        const int c0 = cb_ * 1024 + 2 * tid, rbase = cidx * 32;
        float w0[16], w1[16], b0 = 0.f, b1 = 0.f, lb0 = 0.f, lb1 = 0.f;
        if (KIND == 1) {
            __syncthreads();
            { const int p = tid >> 4, r = tid & 15; const int row = rbase + (d ? 31 - p : p); const size_t gi = (size_t)row * 128 + d * 16 + r; const float* GPp = (const float*)(P.ws + WS_GP); sa1[tid] = (GPp[gi] + GPp[gi + (size_t)MROWS * 128]) + (GPp[gi + (size_t)2 * MROWS * 128] + GPp[gi + (size_t)3 * MROWS * 128]); }
            __syncthreads();
            const float* w2 = P.in[21] + (size_t)d * 16 * 1024 + c0;
#pragma unroll
            for (int r = 0; r < 16; ++r) { w0[r] = w2[(size_t)r * 1024]; w1[r] = w2[(size_t)r * 1024 + 1]; }
            b0 = P.in[22][d * 1024 + c0]; b1 = P.in[22][d * 1024 + c0 + 1];
        } else {
            const float* lg = P.in[26];
            { const float l0 = lg[c0], l1 = lg[2048 + c0], l2 = lg[4096 + c0], l3 = lg[6144 + c0]; const float mx = fmaxf(fmaxf(l0, l1), fmaxf(l2, l3));
              const float e0 = __expf(l0 - mx), e1 = __expf(l1 - mx), e2 = __expf(l2 - mx), e3 = __expf(l3 - mx); lb0 = (e1 + e2) / ((e0 + e1) + (e2 + e3)); }
            { const float l0 = lg[c0 + 1], l1 = lg[2048 + c0 + 1], l2 = lg[4096 + c0 + 1], l3 = lg[6144 + c0 + 1]; const float mx = fmaxf(fmaxf(l0, l1), fmaxf(l2, l3));
              const float e0 = __expf(l0 - mx), e1 = __expf(l1 - mx), e2 = __expf(l2 - mx), e3 = __expf(l3 - mx); lb1 = (e1 + e2) / ((e0 + e1) + (e2 + e3)); }
        }
        float cs0 = KIND == 1 ? 0.f : 1.f, cs1 = cs0;
        constexpr int XOFF_G = 1024;
        const int xoff = KIND == 1 ? XOFF_G : (d ? 8192 : 6144);
        unsigned nq[8], nx[8];
#define GP_LOAD(pb_) do { _Pragma("unroll") for (int u = 0; u < 8; ++u) { const int pp_ = (pb_) + u; const bf16* pr_ = proj + (size_t)(rbase + (d ? 31 - pp_ : pp_)) * LDP + c0; nq[u] = *(const unsigned*)pr_; nx[u] = *(const unsigned*)(pr_ + xoff); } } while (0)
        GP_LOAD(0);
#pragma unroll 1
        for (int pb8 = 0; pb8 < 32; pb8 += 8) {
          unsigned cq[8], cx[8];
#pragma unroll
          for (int u = 0; u < 8; ++u) { cq[u] = nq[u]; cx[u] = nx[u]; }
          { const int pn = pb8 + 8 < 32 ? pb8 + 8 : pb8; GP_LOAD(pn); }
#pragma unroll
          for (int u = 0; u < 8; ++u) {
            const int p = pb8 + u;
            const int row = rbase + (d ? 31 - p : p);
            float q0, q1, k0, k1, la0, la1;
            if (KIND == 1) {
                const unsigned qw = cq[u], kw = cx[u];
                q0 = bflo(qw) * 0.0625f; q1 = bfhi(qw) * 0.0625f; k0 = bflo(kw); k1 = bfhi(kw);
                float x0 = b0, x1 = b1;
#pragma unroll
                for (int r = 0; r < 16; ++r) { const float a = sa1[p * 16 + r]; x0 = __builtin_fmaf(a, w0[r], x0); x1 = __builtin_fmaf(a, w1[r], x1); }
                la0 = (fminf(x0, 0.f) - 0.6931471805599453f * __builtin_amdgcn_logf(1.f + __expf(-fabsf(x0)))) * 0.0625f; la1 = (fminf(x1, 0.f) - 0.6931471805599453f * __builtin_amdgcn_logf(1.f + __expf(-fabsf(x1)))) * 0.0625f;
            } else {
                const unsigned qw = cq[u], fw = cx[u];
                q0 = siluf_(bflo(qw)) * 0.08838834764831845f; q1 = siluf_(bfhi(qw)) * 0.08838834764831845f;
                const float a0 = lb0 + (1.f - lb0) * sigmoidf_(bflo(fw)), a1 = lb1 + (1.f - lb1) * sigmoidf_(bfhi(fw));
                k0 = 1.f - a0; k1 = 1.f - a1; la0 = a0; la1 = a1;
            }
            float e0, e1, i0, i1;
            if (KIND == 1) { cs0 += la0; cs1 += la1; e0 = __expf(cs0); e1 = __expf(cs1); i0 = __builtin_amdgcn_rcpf(e0); i1 = __builtin_amdgcn_rcpf(e1); }
            else { cs0 *= la0; cs1 *= la1; e0 = cs0; e1 = cs1; i0 = __builtin_amdgcn_rcpf(cs0); i1 = __builtin_amdgcn_rcpf(cs1); }
            const size_t o = ((size_t)d * MROWS + row) * NCH + c0;
            const unsigned qb = pk2(q0 * e0, q1 * e1), kb = pk2(k0 * i0, k1 * i1);
            *(unsigned*)(QT + o) = qb; *(unsigned*)(KT + o) = kb;
            *(LAS unsigned*)(QL + p * PL + 4 * tid) = qb; *(LAS unsigned*)(KL + p * PL + 4 * tid) = kb;
          }
        }
#undef GP_LOAD
        { float* e = E + ((size_t)d * 512 + cidx) * NCH + c0; e[0] = KIND == 1 ? __expf(cs0) : cs0; e[1] = KIND == 1 ? __expf(cs1) : cs1; }
        __syncthreads();
        {
            const int r = lane & 15, g = lane >> 4;
            const int hl = KIND == 1 ? (wave >> 1) : wave; const int cbase = hl * DKH;
            f32x4 t0 = {0.f, 0.f, 0.f, 0.f}, t1 = t0, t2 = t0;
            const bool do02 = KIND == 1 ? ((wave & 1) == 0) : true, do1 = KIND == 1 ? ((wave & 1) == 1) : true;
#pragma unroll
            for (int sx = 0; sx < DKH / 32; ++sx) {
                const int cb2 = (cbase + 32 * sx + 8 * g) * 2;
                const bf16x8 k0 = ld_b128(KL + r * PL + cb2), q1 = ld_b128(QL + (16 + r) * PL + cb2);
                if (do02) { const bf16x8 q0 = ld_b128(QL + r * PL + cb2), k1 = ld_b128(KL + (16 + r) * PL + cb2); t0 = MFMA16(k0, q0, t0); t2 = MFMA16(k1, q1, t2); }
                if (do1) t1 = MFMA16(k0, q1, t1);
            }
#pragma unroll
            for (int e = 0; e < 4; ++e) { if (r < 4 * g + e) { t0[e] = 0.f; t2[e] = 0.f; } }
            unsigned* pg = PG + (((size_t)d * 512 + cidx) * NHT + cb_ * NHB + hl) * 384 + lane * 2;
            if (do02) { pg[0] = pk2(t0[0], t0[1]); pg[1] = pk2(t0[2], t0[3]); pg[256] = pk2(t2[0], t2[1]); pg[257] = pk2(t2[2], t2[3]); }
            if (do1) { pg[128] = pk2(t1[0], t1[1]); pg[129] = pk2(t1[2], t1[3]); }
        }
        __syncthreads();
    }
}

template <int KIND> __device__ __forceinline__ void gla_chunk_phase(const Params& P, LAS unsigned char* lds) {
    PHASE_IDS();
    constexpr int DK = KIND == 1 ? 256 : 128, DV = KIND == 1 ? 512 : 128, NH = KIND == 1 ? 4 : 16, NSL = DV / 128, NKT = DK / 16, NCH = NH * DK;
    constexpr int LDP = KIND == 1 ? GLA_NMAIN : HG_NIN, W = 2048;
    constexpr int PQ = DK * 2 + 16, PV = 256 + 16;
    constexpr int OFF_Q = 0, OFF_K = 32 * PQ, OFF_V = 2 * 32 * PQ, OFF_E = OFF_V + 32 * PV;
    constexpr int NPQ = 32 * DK / 8 / NT;
    const bf16* proj = (const bf16*)(P.ws + WS_BIG);
    const bf16* QT = (const bf16*)(P.ws + WS_QKV); const bf16* KT = QT + (size_t)2 * MROWS * NCH; const float* Eg = (const float*)(P.ws + WS_OF + 64 * MiB);
    bf16* OF = (bf16*)(P.ws + WS_OF); bf16* OB = (bf16*)(P.ws + WS_OB);
    const u32x2* PG = (const u32x2*)(P.ws + WS_OF + 72 * MiB);
    const int r = lane & 15, g = lane >> 4, q4 = (lane & 15) >> 2, p4 = lane & 3;
    constexpr int UL = 4 * NH * 2 * NSL  , UC = 32 * NH * 2 * NSL  ;
    const int G = gridDim.x, bx = blockIdx.x;
    const bool bal = (G == 2 * UL);
    const int nun = bal ? (bx < UL ? 1 : UC / UL) : (UL + UC - bx + G - 1) / G;
    for (int ui = 0; ui < nun; ++ui) {
        const int bxl = bx < UL ? bx : bx - UL;
        const int bxq = (bal && NSL == 4) ? (((bxl & 7) + 8 * (bxl >> 5)) * 4 + ((bxl >> 3) & 3)) : bxl;
        const int unit = bal ? (bx < UL ? bxq : UL + bxq + UL * ui) : bx + ui * G;
        const bool lat = unit < UL; int u2 = lat ? unit : unit - UL;
        const int sl = u2 % NSL; u2 /= NSL; const int d = u2 & 1; u2 >>= 1; const int h = u2 % NH; const int b = u2 / NH;
        const int T = lat ? 2048 : 256, row0 = lat ? MCTX + b * 2048 : b * 256, nchunk = T / 32;
        bf16* O = d ? OB : OF;
        f32x4 S[NKT];
        { const float* s0 = (KIND == 1 ? P.in[4] : P.in[5]) + ((((size_t)b * 2 + d) * NH + h) * DK) * DV + sl * 128 + 16 * wave + r;
#pragma unroll
          for (int kt = 0; kt < NKT; ++kt)
#pragma unroll
              for (int e = 0; e < 4; ++e) S[kt][e] = lat ? s0[(size_t)(16 * kt + 4 * g + e) * DV] : 0.f; }
        u32x4 rq[NPQ], rk[NPQ], rv; f32x4 re = {0.f, 0.f, 0.f, 0.f}; u32x2 rp0 = {0u, 0u}, rp1 = rp0, rp2 = rp0;
#define GLC_PREFETCH(c_) do { \
            _Pragma("unroll") for (int x = 0; x < NPQ; ++x) { const int pi = tid + x * NT, pr = pi / (DK / 8), pc = pi % (DK / 8); const int pp = (c_) * 32 + pr; const int t = d ? T - 1 - pp : pp; \
                const size_t o = ((size_t)d * MROWS + row0 + t) * NCH + h * DK + pc * 8; rq[x] = *(const u32x4*)(QT + o); rk[x] = *(const u32x4*)(KT + o); } \
            { const int pr = tid >> 4, pc = tid & 15; const int pp = (c_) * 32 + pr; const int t = d ? T - 1 - pp : pp; rv = *(const u32x4*)(proj + (size_t)(row0 + t) * LDP + 2048 + h * DV + sl * 128 + pc * 8); } \
            { const int cg = d ? (row0 + T) / 32 - 1 - (c_) : row0 / 32 + (c_); if (tid < DK / 4) re = *(const f32x4*)(Eg + ((size_t)d * 512 + cg) * NCH + h * DK + tid * 4); \
              const u32x2* pg = PG + (((size_t)d * 512 + cg) * NH + h) * 192 + lane; rp0 = pg[0]; rp1 = pg[64]; rp2 = pg[128]; } } while (0)
        GLC_PREFETCH(0);
        for (int c = 0; c < nchunk; ++c) {
            __syncthreads();
#pragma unroll
            for (int x = 0; x < NPQ; ++x) { const int pi = tid + x * NT, pr = pi / (DK / 8), pc = pi % (DK / 8);
                *(LAS u32x4*)(lds + OFF_Q + pr * PQ + pc * 16) = rq[x]; *(LAS u32x4*)(lds + OFF_K + pr * PQ + pc * 16) = rk[x]; }
            { const int pr = tid >> 4, pc = tid & 15; *(LAS u32x4*)(lds + OFF_V + pr * PV + pc * 16) = rv; }
            if (tid < DK / 4) *(LAS f32x4*)(lds + OFF_E + tid * 16) = re;
            __syncthreads();
            const u32x2 cp0 = rp0, cp1 = rp1, cp2 = rp2;
            if (c + 1 < nchunk) GLC_PREFETCH(c + 1);
            const f32x4 zero4 = {0.f, 0.f, 0.f, 0.f};
            const bf16x8 vpa = cat4(ld_tr(lds + OFF_V + (4 * g + q4) * PV + (16 * wave + 4 * p4) * 2), ld_tr(lds + OFF_V + (16 + 4 * g + q4) * PV + (16 * wave + 4 * p4) * 2));
            const bf16x8 pb0 = __builtin_bit_cast(bf16x8, (u32x4){cp0.x, cp0.y, 0u, 0u}), pb1 = __builtin_bit_cast(bf16x8, (u32x4){cp1.x, cp1.y, cp2.x, cp2.y});
            f32x4 o0 = MFMA16(vpa, pb0, zero4), o1 = MFMA16(vpa, pb1, zero4);
#pragma unroll
            for (int s = 0; s < DK / 32; ++s) {
                const bf16x8 sb = pack8(S[2 * s], S[2 * s + 1]);
                const bf16x8 a0 = cat4(ld_b64(lds + OFF_Q + r * PQ + (32 * s + 4 * g) * 2), ld_b64(lds + OFF_Q + r * PQ + (32 * s + 16 + 4 * g) * 2));
                const bf16x8 a1 = cat4(ld_b64(lds + OFF_Q + (16 + r) * PQ + (32 * s + 4 * g) * 2), ld_b64(lds + OFF_Q + (16 + r) * PQ + (32 * s + 16 + 4 * g) * 2));
                o0 = MFMA16(sb, a0, o0); o1 = MFMA16(sb, a1, o1);
                if (KIND == 1 && (s & 3) == 3) asm volatile("" ::: "memory");
            }
            { const int colo = h * DV + sl * 128 + 16 * wave + 4 * g; const int pp0 = c * 32 + r, pp1 = c * 32 + 16 + r; const int t0 = d ? T - 1 - pp0 : pp0, t1 = d ? T - 1 - pp1 : pp1;
              u32x2 w0, w1; w0.x = pk2(o0[0], o0[1]); w0.y = pk2(o0[2], o0[3]); w1.x = pk2(o1[0], o1[1]); w1.y = pk2(o1[2], o1[3]);
              *(u32x2*)(O + (size_t)(row0 + t0) * W + colo) = w0; *(u32x2*)(O + (size_t)(row0 + t1) * W + colo) = w1; }
            const bf16x8 vb = cat4(ld_tr(lds + OFF_V + (8 * g + q4) * PV + (16 * wave + 4 * p4) * 2), ld_tr(lds + OFF_V + (8 * g + 4 + q4) * PV + (16 * wave + 4 * p4) * 2));
#pragma unroll
            for (int kt = 0; kt < NKT; ++kt) {
                const bf16x8 ka = cat4(ld_tr(lds + OFF_K + (8 * g + q4) * PQ + (16 * kt + 4 * p4) * 2), ld_tr(lds + OFF_K + (8 * g + 4 + q4) * PQ + (16 * kt + 4 * p4) * 2));
                const f32x4 ev = *(const LAS f32x4*)(lds + OFF_E + (16 * kt + 4 * g) * 4);
                S[kt] = MFMA16(ka, vb, S[kt]) * ev;
                if (KIND == 1 && (kt & 7) == 7) asm volatile("" ::: "memory");
            }
        }
#undef GLC_PREFETCH
        if (!lat) { float* sd = P.out + (KIND == 1 ? OUT_SGLA : OUT_SHG) + ((((size_t)b * 2 + d) * NH + h) * DK) * DV + sl * 128 + 16 * wave + r;
#pragma unroll
            for (int kt = 0; kt < NKT; ++kt)
#pragma unroll
                for (int e = 0; e < 4; ++e) sd[(size_t)(16 * kt + 4 * g + e) * DV] = S[kt][e]; }
    }
}

#define MFMA4F(a, b, c) __builtin_amdgcn_mfma_f32_16x16x4f32((a), (b), (c), 0, 0, 0)
template <int I> __device__ __forceinline__ float row_share(float v) { return __builtin_bit_cast(float, __builtin_amdgcn_mov_dpp(__builtin_bit_cast(int, v), 0x150 + I, 0xf, 0xf, false)); }
template <int I> struct DiagStep {
    static __device__ __forceinline__ void run(const float (&Ld)[16], float (&x)[16], int cc) {
        DiagStep<I - 1>::run(Ld, x, cc);
        float a0 = 0.f, a1 = 0.f;
#pragma unroll
        for (int m = 0; m < I; ++m) { const float lv = row_share<I>(Ld[m]); if (m & 1) a1 += lv * x[m]; else a0 += lv * x[m]; }
        x[I] = ((I == cc) ? 1.f : 0.f) - (a0 + a1);
    }
};
template <> struct DiagStep<-1> { static __device__ __forceinline__ void run(const float (&)[16], float (&)[16], int) {} };
__device__ __forceinline__ void dn_wu_prep_phase(const Params& P, LAS unsigned char* lds) {
    PHASE_IDS();
    constexpr int PKQ = 272;
    constexpr int LP = 68;
    constexpr int OFF_K = 0, OFF_Q = 64 * PKQ, OFF_L = 0  , OFF_KK = 4 * 64 * LP * 4, OFF_QK = OFF_KK + 64 * LP * 4, OFF_G = OFF_QK + 64 * LP * 4;
    const bf16* QKV = (const bf16*)(P.ws + WS_QKV); const float* G = (const float*)(P.ws + WS_GATE);
    bf16* TA = (bf16*)(P.ws + WS_TA); float* GS = (float*)(P.ws + WS_GS);
    const int r = lane & 15, g = lane >> 4;
    LAS float* KKs = (LAS float*)(lds + OFF_KK); LAS float* QKs = (LAS float*)(lds + OFF_QK); LAS float* Gs = (LAS float*)(lds + OFF_G);
    u32x4 pq[2], pk[2]; float pgv = 0.f;
#define WU_PREFETCH(grp_) do { const int cidx_ = (grp_) >> 4, kh_ = (grp_) & 15, rb_ = cidx_ * 64; \
        _Pragma("unroll") for (int x = 0; x < 2; ++x) { const int pi = tid + x * NT, pr = pi >> 4, pc = pi & 15; const size_t o = (size_t)(rb_ + pr) * 8192 + kh_ * 128 + pc * 8; pq[x] = *(const u32x4*)(QKV + o); pk[x] = *(const u32x4*)(QKV + o + 2048); } \
        { const int c4 = tid >> 7, which = (tid >> 6) & 1, i = tid & 63, hv = c4 >> 1, d = c4 & 1, h = 2 * kh_ + hv; pgv = G[(size_t)(rb_ + i) * 128 + (which ? 0 : 64) + d * 32 + h]; } } while (0)
    if ((int)blockIdx.x < 256 * 16) WU_PREFETCH(blockIdx.x);
    for (int grp = blockIdx.x; grp < 256 * 16; grp += gridDim.x) {
        const int cidx = grp >> 4, kh = grp & 15;
        __syncthreads();
#pragma unroll
        for (int x = 0; x < 2; ++x) { const int pi = tid + x * NT, pr = pi >> 4, pc = pi & 15;
            *(LAS u32x4*)(lds + OFF_Q + pr * PKQ + pc * 16) = pq[x]; *(LAS u32x4*)(lds + OFF_K + pr * PKQ + pc * 16) = pk[x]; }
        Gs[tid] = pgv;
        __syncthreads();
        if (grp + (int)gridDim.x < 256 * 16) WU_PREFETCH(grp + (int)gridDim.x);
        {
            const int it = wave & 3; const int offx = (wave >> 2) ? OFF_Q : OFF_K; LAS float* dst = (wave >> 2) ? QKs : KKs;
            f32x4 acc[4];
#pragma unroll
            for (int jt = 0; jt < 4; ++jt) acc[jt] = (f32x4){0.f, 0.f, 0.f, 0.f};
#pragma unroll
            for (int sx = 0; sx < 4; ++sx) { const bf16x8 a = ld_b128(lds + offx + (16 * it + r) * PKQ + (32 * sx + 8 * g) * 2);
#pragma unroll
                for (int jt = 0; jt < 4; ++jt) acc[jt] = MFMA16(a, ld_b128(lds + OFF_K + (16 * jt + r) * PKQ + (32 * sx + 8 * g) * 2), acc[jt]); }
#pragma unroll
            for (int jt = 0; jt < 4; ++jt)
#pragma unroll
                for (int e = 0; e < 4; ++e) dst[(16 * it + 4 * g + e) * LP + 16 * jt + r] = acc[jt][e];
        }
        __syncthreads();
        {
            const int c4 = wave & 3, hv = c4 >> 1, d = c4 & 1, h = 2 * kh + hv;
            const int nl = d ? 63 - lane : lane;
            float gcv = Gs[(c4 * 2 + 0) * 64 + nl];
#pragma unroll
            for (int o = 1; o < 64; o <<= 1) { const float t = __shfl_up(gcv, o); if (lane >= o) gcv += t; }
            const float betav = Gs[(c4 * 2 + 1) * 64 + nl];
            const size_t item = ((size_t)(cidx * 32 + h) * 2 + d);
            LAS float* W = (LAS float*)(lds + OFF_L) + c4 * 64 * LP;
            {
                bf16* Ag = TA + item * 8192 + 4096;
                const int pb = (wave >> 2) * 32;
#define WU_LA_TRIPS(REV_) \
                _Pragma("unroll 1") for (int p0 = pb; p0 < pb + 32; p0 += 8) { \
                    const LAS float* kb_ = KKs + ((REV_) ? 56 - p0 : p0) * LP + nl; const LAS float* qb_ = QKs + ((REV_) ? 56 - p0 : p0) * LP + nl; \
                    LAS float* wb_ = W + p0 * LP + lane; bf16* ab_ = Ag + p0 * 64 + lane; const int lrel_ = lane - p0; \
                    float kkv[8], qkv[8]; \
                    _Pragma("unroll") for (int u = 0; u < 8; ++u) { kkv[u] = kb_[((REV_) ? 7 - u : u) * LP]; qkv[u] = qb_[((REV_) ? 7 - u : u) * LP]; } \
                    _Pragma("unroll") for (int u = 0; u < 8; ++u) { const int p = p0 + u; const float gp = rdlane(gcv, p), bp = rdlane(betav, p); const float ex = __expf(gp - gcv); \
                        float lv = bp * kkv[u] * ex, av = qkv[u] * ex; \
                        asm volatile("" : "+v"(lv), "+v"(av)); \
                        wb_[u * LP] = lrel_ < u ? lv : 0.f; \
                        ab_[u * 64] = (bf16)f2bf(lrel_ <= u ? av : 0.f); } \
                }
                if (d) { WU_LA_TRIPS(1) } else { WU_LA_TRIPS(0) }
#undef WU_LA_TRIPS
            }
            if (wave >= 4) {
                float* gs = GS + item * 192; const float gend = rdlane(gcv, 63);
                gs[lane] = __expf(gcv); gs[64 + lane] = betav; gs[128 + lane] = __expf(gend - gcv);
            }
            __syncthreads();
            if (wave < 4) {
                {
                    const int lane2 = opaque_v(lane); const int bb = lane2 >> 4, cc = lane2 & 15;
                    float Ld[16];
#pragma unroll
                    for (int m4 = 0; m4 < 4; ++m4) { const f32x4 v = *(const LAS f32x4*)(W + (16 * bb + cc) * LP + 16 * bb + 4 * m4); Ld[4 * m4] = v[0]; Ld[4 * m4 + 1] = v[1]; Ld[4 * m4 + 2] = v[2]; Ld[4 * m4 + 3] = v[3]; }
                    float x[16];
                    DiagStep<15>::run(Ld, x, cc);
#pragma unroll
                    for (int i = 0; i < 16; ++i) W[(16 * bb + i) * LP + 16 * bb + cc] = x[i];
                }
#define WU_PN(ar, ac, br, bc, acc_) do { _Pragma("unroll") for (int sx = 0; sx < 4; ++sx) acc_ = MFMA4F(W[((ar) + r) * LP + (ac) + 4 * sx + g], W[((br) + 4 * sx + g) * LP + (bc) + r], acc_); } while (0)
#define WU_PA(ar, ac, M_, acc_) do { _Pragma("unroll") for (int e = 0; e < 4; ++e) acc_ = MFMA4F(W[((ar) + r) * LP + (ac) + 4 * g + e], M_[e], acc_); } while (0)
#define WU_ST(r0, c0, acc_) do { _Pragma("unroll") for (int e = 0; e < 4; ++e) W[((r0) + 4 * g + e) * LP + (c0) + r] = -acc_[e]; } while (0)
                const f32x4 z4 = {0.f, 0.f, 0.f, 0.f};
                { f32x4 m1a = z4, m1b = z4; WU_PN(16, 0, 0, 0, m1a); WU_PN(48, 32, 32, 32, m1b);
                  f32x4 t10 = z4, t32 = z4; WU_PA(16, 16, m1a, t10); WU_PA(48, 48, m1b, t32);
                  WU_ST(16, 0, t10); WU_ST(48, 32, t32); }
                { f32x4 m00 = z4, m01 = z4, m10 = z4, m11 = z4;
                  WU_PN(32, 0, 0, 0, m00); WU_PN(32, 16, 16, 0, m00); WU_PN(32, 16, 16, 16, m01);
                  WU_PN(48, 0, 0, 0, m10); WU_PN(48, 16, 16, 0, m10); WU_PN(48, 16, 16, 16, m11);
                  f32x4 t00 = z4, t01 = z4, t10 = z4, t11 = z4;
                  WU_PA(32, 32, m00, t00); WU_PA(32, 32, m01, t01);
                  WU_PA(48, 32, m00, t10); WU_PA(48, 48, m10, t10); WU_PA(48, 32, m01, t11); WU_PA(48, 48, m11, t11);
                  WU_ST(32, 0, t00); WU_ST(32, 16, t01); WU_ST(48, 0, t10); WU_ST(48, 16, t11); }
#undef WU_PN
#undef WU_PA
#undef WU_ST
                bf16* Tg = TA + item * 8192;
#pragma unroll
                for (int x8 = 0; x8 < 8; ++x8) { const int piece = lane + 64 * x8, row = piece >> 3, pc = piece & 7;
                    const f32x4 v0 = *(const LAS f32x4*)(W + row * LP + pc * 8), v1 = *(const LAS f32x4*)(W + row * LP + pc * 8 + 4);
                    u32x4 o; o.x = pk2(v0[0], v0[1]); o.y = pk2(v0[2], v0[3]); o.z = pk2(v1[0], v1[1]); o.w = pk2(v1[2], v1[3]);
                    if (pc * 8 <= row) *(u32x4*)(Tg + row * 64 + pc * 8) = o; }
            }
        }
    }
#undef WU_PREFETCH
}

constexpr int DN_PQ = 272;
constexpr int DN_PXQ = 144, DN_XQ = 64 * DN_PXQ, DN_PXT = 80, DN_XT = 64 * DN_PXT;
constexpr int DN_OFF_Q = 0, DN_OFF_K = 2 * DN_XQ, DN_OFF_V = DN_OFF_K + 64 * DN_PQ, DN_OFF_T = DN_OFF_V + 64 * DN_PQ, DN_OFF_A = DN_OFF_T + 2 * DN_XT, DN_OFF_S = DN_OFF_A + 2 * DN_XT;
struct DnStage { u32x4 rq[2], rk[2], rv[2], rt, ra; f32x4 rs; };
__device__ __forceinline__ void dn_stage_load(DnStage& st, const bf16* QKV, const bf16* TA, const float* GS, int tid, int c, int d, int T, int row0, int kh, int h, int nchunk) {
#pragma unroll
    for (int x = 0; x < 2; ++x) { const int pi = tid + x * NT, pr = pi >> 4, pc = pi & 15; const int pp = c * 64 + pr; const int t = d ? T - 1 - pp : pp;
        const size_t o = (size_t)(row0 + t) * 8192 + pc * 8; st.rq[x] = *(const u32x4*)(QKV + o + kh * 128); st.rk[x] = *(const u32x4*)(QKV + o + 2048 + kh * 128); st.rv[x] = *(const u32x4*)(QKV + o + 4096 + h * 128); }
    const int nc = d ? nchunk - 1 - c : c; const size_t item = ((size_t)((row0 >> 6) + nc) * 32 + h) * 2 + d;
    const bool nz = ((tid & 7) * 8) <= (tid >> 3);
    st.rt = nz ? *(const u32x4*)(TA + item * 8192 + tid * 8) : (u32x4){0u, 0u, 0u, 0u}; st.ra = nz ? *(const u32x4*)(TA + item * 8192 + 4096 + tid * 8) : (u32x4){0u, 0u, 0u, 0u};
    st.rs = (f32x4){0.f, 0.f, 0.f, 0.f}; if (tid < 48) st.rs = *(const f32x4*)(GS + item * 192 + tid * 4);
}
__device__ __forceinline__ void dn_stage_store(const DnStage& st, LAS unsigned char* lds, int tid) {
#pragma unroll
    for (int x = 0; x < 2; ++x) { const int pi = tid + x * NT, pr = pi >> 4, pc = pi & 15;
        { LAS unsigned char* qd = lds + DN_OFF_Q + pr * DN_PXQ + (2 * (pc >> 2) + (pc & 1)) * 16 + ((pc >> 1) & 1) * 8;
          *(LAS u32x2*)qd = (u32x2){st.rq[x].x, st.rq[x].y}; *(LAS u32x2*)(qd + DN_XQ) = (u32x2){st.rq[x].z, st.rq[x].w}; }
        *(LAS u32x4*)(lds + DN_OFF_K + pr * DN_PQ + pc * 16) = st.rk[x]; *(LAS u32x4*)(lds + DN_OFF_V + pr * DN_PQ + pc * 16) = st.rv[x]; }
    { const int pr = tid >> 3, pc = tid & 7; const int o = pr * DN_PXT + (2 * (pc >> 2) + (pc & 1)) * 16 + ((pc >> 1) & 1) * 8;
      *(LAS u32x2*)(lds + DN_OFF_T + o) = (u32x2){st.rt.x, st.rt.y}; *(LAS u32x2*)(lds + DN_OFF_T + o + DN_XT) = (u32x2){st.rt.z, st.rt.w};
      *(LAS u32x2*)(lds + DN_OFF_A + o) = (u32x2){st.ra.x, st.ra.y}; *(LAS u32x2*)(lds + DN_OFF_A + o + DN_XT) = (u32x2){st.ra.z, st.ra.w}; }
    if (tid < 48) *(LAS f32x4*)(lds + DN_OFF_S + tid * 16) = st.rs;
}
__device__ __forceinline__ void dn_step_compute(f32x4 (&S)[8], LAS unsigned char* lds, bf16* O, int c, int d, int T, int row0, int h, int wave, int lane) {
    constexpr int PQ = DN_PQ, OFF_Q = DN_OFF_Q, OFF_K = DN_OFF_K, OFF_V = DN_OFF_V, OFF_T = DN_OFF_T, OFF_A = DN_OFF_A, OFF_S = DN_OFF_S;
    const int r = lane & 15, g = lane >> 4, q4 = (lane & 15) >> 2, p4 = lane & 3;
#define DN_PERMROW(off_, pitch_, row_, col_) cat4(ld_b64(lds + (off_) + (row_) * (pitch_) + ((col_) + 4 * g) * 2), ld_b64(lds + (off_) + (row_) * (pitch_) + ((col_) + 16 + 4 * g) * 2))
#define DN_CHUNK(off_, xsz_, pitch_, row_, sx_) ld_b128(lds + (off_) + (g & 1) * (xsz_) + (row_) * (pitch_) + (2 * (sx_) + (g >> 1)) * 16)
    const f32x4 zero4 = {0.f, 0.f, 0.f, 0.f};
    bf16x8 sb[4];
    f32x4 R[4];
    {
        bf16x8 kf[4][4];
#pragma unroll
        for (int jt = 0; jt < 4; ++jt)
#pragma unroll
            for (int sx = 0; sx < 4; ++sx) kf[jt][sx] = DN_PERMROW(OFF_K, PQ, 16 * jt + r, 32 * sx);
#pragma unroll
        for (int sx = 0; sx < 4; ++sx) sb[sx] = pack8(S[2 * sx], S[2 * sx + 1]);
#pragma unroll
        for (int jt = 0; jt < 4; ++jt) R[jt] = zero4;
#pragma unroll
        for (int sx = 0; sx < 4; ++sx)
#pragma unroll
            for (int jt = 0; jt < 4; ++jt) R[jt] = MFMA16(kf[jt][sx], sb[sx], R[jt]);
    }
    __builtin_amdgcn_sched_barrier(0);
    f32x4 U[4];
    {
        bf16x8 tf[4][2]; s16x4 vt[4]; f32x4 eg[4], bt[4];
#pragma unroll
        for (int jt = 0; jt < 4; ++jt) { vt[jt] = ld_tr(lds + OFF_V + (16 * jt + 4 * g + q4) * PQ + (16 * wave + 4 * p4) * 2);
            eg[jt] = *(const LAS f32x4*)(lds + OFF_S + (16 * jt + 4 * g) * 4); bt[jt] = *(const LAS f32x4*)(lds + OFF_S + 256 + (16 * jt + 4 * g) * 4); }
#pragma unroll
        for (int it = 0; it < 4; ++it) { tf[it][0] = DN_CHUNK(OFF_T, DN_XT, DN_PXT, 16 * it + r, 0); tf[it][1] = DN_CHUNK(OFF_T, DN_XT, DN_PXT, 16 * it + r, 1); }
#pragma unroll
        for (int jt = 0; jt < 4; ++jt)
#pragma unroll
            for (int e = 0; e < 4; ++e) R[jt][e] = bt[jt][e] * (bf2f((unsigned short)vt[jt][e]) - eg[jt][e] * R[jt][e]);
        const bf16x8 rb0 = pack8(R[0], R[1]), rb1 = pack8(R[2], R[3]);
#pragma unroll
        for (int it = 0; it < 4; ++it) U[it] = MFMA16(tf[it][0], rb0, zero4);
#pragma unroll
        for (int it = 0; it < 4; ++it) U[it] = MFMA16(tf[it][1], rb1, U[it]);
    }
    __builtin_amdgcn_sched_barrier(0);
    {
        f32x4 Ot[4];
#pragma unroll
        for (int it = 0; it < 4; ++it) Ot[it] = zero4;
#pragma unroll
        for (int hq = 0; hq < 2; ++hq) {
            bf16x8 qf[2][4];
#pragma unroll
            for (int i2 = 0; i2 < 2; ++i2)
#pragma unroll
                for (int sx = 0; sx < 4; ++sx) qf[i2][sx] = DN_CHUNK(OFF_Q, DN_XQ, DN_PXQ, 16 * (2 * hq + i2) + r, sx);
#pragma unroll
            for (int sx = 0; sx < 4; ++sx)
#pragma unroll
                for (int i2 = 0; i2 < 2; ++i2) Ot[2 * hq + i2] = MFMA16(sb[sx], qf[i2][sx], Ot[2 * hq + i2]);
        }
        bf16x8 af[4][2]; float egi[4];
#pragma unroll
        for (int it = 0; it < 4; ++it) { af[it][0] = DN_CHUNK(OFF_A, DN_XT, DN_PXT, 16 * it + r, 0); af[it][1] = DN_CHUNK(OFF_A, DN_XT, DN_PXT, 16 * it + r, 1); egi[it] = *(const LAS float*)(lds + OFF_S + (16 * it + r) * 4); }
        const bf16x8 ub0 = pack8(U[0], U[1]), ub1 = pack8(U[2], U[3]);
#pragma unroll
        for (int it = 0; it < 4; ++it) Ot[it] = Ot[it] * egi[it];
#pragma unroll
        for (int it = 0; it < 4; ++it) Ot[it] = MFMA16(ub0, af[it][0], Ot[it]);
#pragma unroll
        for (int it = 0; it < 4; ++it) Ot[it] = MFMA16(ub1, af[it][1], Ot[it]);
#pragma unroll
        for (int it = 0; it < 4; ++it) { const int pp = c * 64 + 16 * it + r; const int t = d ? T - 1 - pp : pp; u32x2 w; w.x = pk2(Ot[it][0], Ot[it][1]); w.y = pk2(Ot[it][2], Ot[it][3]);
            *(u32x2*)(O + (size_t)(row0 + t) * 4096 + h * 128 + 16 * wave + 4 * g) = w; }
    }
    __builtin_amdgcn_sched_barrier(0);
    {
#pragma unroll
        for (int jt = 0; jt < 4; ++jt) { const f32x4 dc = *(const LAS f32x4*)(lds + OFF_S + 512 + (16 * jt + 4 * g) * 4); U[jt] = U[jt] * dc; }
        const bf16x8 us0 = pack8(U[0], U[1]), us1 = pack8(U[2], U[3]);
        const float gend = *(const LAS float*)(lds + OFF_S + 63 * 4);
#pragma unroll
        for (int hk = 0; hk < 2; ++hk) {
            bf16x8 ktf[4][2];
#pragma unroll
            for (int k2 = 0; k2 < 4; ++k2) { const int kt = 4 * hk + k2;
                ktf[k2][0] = cat4(ld_tr(lds + OFF_K + (4 * g + q4) * PQ + (16 * kt + 4 * p4) * 2), ld_tr(lds + OFF_K + (16 + 4 * g + q4) * PQ + (16 * kt + 4 * p4) * 2));
                ktf[k2][1] = cat4(ld_tr(lds + OFF_K + (32 + 4 * g + q4) * PQ + (16 * kt + 4 * p4) * 2), ld_tr(lds + OFF_K + (48 + 4 * g + q4) * PQ + (16 * kt + 4 * p4) * 2)); }
#pragma unroll
            for (int k2 = 0; k2 < 4; ++k2) S[4 * hk + k2] = MFMA16(ktf[k2][0], us0, S[4 * hk + k2] * gend);
#pragma unroll
            for (int k2 = 0; k2 < 4; ++k2) S[4 * hk + k2] = MFMA16(ktf[k2][1], us1, S[4 * hk + k2]);
        }
    }
#undef DN_PERMROW
#undef DN_CHUNK
}
__device__ __forceinline__ void dn_chunk_phase(const Params& P, int j, LAS unsigned char* lds) {
    PHASE_IDS();
    const bf16* QKV = (const bf16*)(P.ws + WS_QKV); const bf16* TA = (const bf16*)(P.ws + WS_TA); const float* GS = (const float*)(P.ws + WS_GS);
    bf16* OF = (bf16*)(P.ws + WS_OF); bf16* OB = (bf16*)(P.ws + WS_OB);
    const int r = lane & 15, g = lane >> 4;
    const int bxp = (gridDim.x == 256) ? ({ const int x = blockIdx.x & 7, y = blockIdx.x >> 3, grp = x + 8 * (y >> 1), mem = y & 1; (grp >> 5) * 64 + (2 * ((grp >> 1) & 15) + mem) * 2 + (grp & 1); }) : (int)blockIdx.x;
    for (int unit0 = blockIdx.x; unit0 < 256 + 2048; unit0 += gridDim.x) {
        const int unit = (gridDim.x == 256) ? (unit0 - (int)blockIdx.x + bxp) : unit0;
        const bool lat = unit < 256; const int u2 = lat ? unit : unit - 256;
        const int b = u2 >> 6, h = (u2 >> 1) & 31, d = u2 & 1, T = lat ? 2048 : 256, row0 = lat ? MCTX + b * 2048 : b * 256, kh = h >> 1, nchunk = T / 64;
        bf16* O = d ? OB : OF;
        f32x4 S[8];
        { const float* s0 = P.in[3] + ((((size_t)b * 2 + j) * 2 + d) * 32 + h) * 128 * 128 + 16 * wave + r;
          if (lat) {
#pragma unroll
              for (int kt = 0; kt < 8; ++kt)
#pragma unroll
                  for (int e = 0; e < 4; ++e) S[kt][e] = s0[(size_t)(16 * kt + 4 * g + e) * 128];
          } else {
#pragma unroll
              for (int kt = 0; kt < 8; ++kt) S[kt] = (f32x4){0.f, 0.f, 0.f, 0.f};
          } }
        constexpr int DN_HSZ = DN_OFF_S + 768;
        DnStage sa;
        __syncthreads();
        dn_stage_load(sa, QKV, TA, GS, tid, 0, d, T, row0, kh, h, nchunk);
        dn_stage_store(sa, lds, tid);
        dn_stage_load(sa, QKV, TA, GS, tid, 1, d, T, row0, kh, h, nchunk);
        __syncthreads();
        for (int c = 0; c < nchunk; ++c) {
            LAS unsigned char* cur = lds + (c & 1) * DN_HSZ; LAS unsigned char* nxt = lds + ((c + 1) & 1) * DN_HSZ;
            if (c + 1 < nchunk) dn_stage_store(sa, nxt, tid);
            if (c + 2 < nchunk) dn_stage_load(sa, QKV, TA, GS, tid, c + 2, d, T, row0, kh, h, nchunk);
            dn_step_compute(S, cur, O, c, d, T, row0, h, wave, lane);
            __syncthreads();
        }
        if (!lat) { float* sd = P.out + OUT_SDN + ((((size_t)b * 2 + j) * 2 + d) * 32 + h) * 128 * 128 + 16 * wave + r;
#pragma unroll
            for (int kt = 0; kt < 8; ++kt)
#pragma unroll
                for (int e = 0; e < 4; ++e) sd[(size_t)(16 * kt + 4 * g + e) * 128] = S[kt][e]; }
    }
}


#ifndef R_CONV
#define R_CONV 1
#endif
#ifndef R_MOD
#define R_MOD 1
#endif
#ifndef R_NORM
#define R_NORM 1
#endif
#ifndef R_GATE
#define R_GATE 1
#endif
#ifndef R_DNPREP
#define R_DNPREP 1
#endif
#ifndef R_WU
#define R_WU 1
#endif
#ifndef R_GLAPREP
#define R_GLAPREP 1
#endif
#ifndef R_DNSCAN
#define R_DNSCAN 1
#endif
#ifndef R_GSCAN
#define R_GSCAN 1
#endif
#ifndef R_FINAL
#define R_FINAL 1
#endif
#ifndef R_BAR
#define R_BAR 1
#endif
#ifndef R_GEMM
#define R_GEMM 1
#endif
#define REPN(n_) for (int rep_ = 0; rep_ < (n_); ++rep_)
#ifndef REP_THIN
#define REP_THIN 1
#endif
#ifndef REP_SCAN
#define REP_SCAN 1
#endif
#ifndef REP_A
#define REP_A 1
#endif
#ifndef REP_B
#define REP_B 1
#endif
#ifndef REP_C
#define REP_C 1
#endif
#define RT for (int rep_ = 0; rep_ < REP_THIN; ++rep_)
#define RA for (int rep_ = 0; rep_ < REP_A; ++rep_)
#define RB for (int rep_ = 0; rep_ < REP_B; ++rep_)
#define RC for (int rep_ = 0; rep_ < REP_C; ++rep_)
#define RS for (int rep_ = 0; rep_ < REP_SCAN; ++rep_)
template <int LAYER> __device__ __forceinline__ void layer_body(const Params& P, LAS unsigned char* lds, const XcdBarrier& bar) {
    bf16* X = (bf16*)(P.ws + WS_X); bf16* H = (bf16*)(P.ws + WS_H); bf16* BIG = (bf16*)(P.ws + WS_BIG); float* GATE = (float*)(P.ws + WS_GATE);
    bf16* Y = (bf16*)(P.ws + WS_QKV); bf16* OF = (bf16*)(P.ws + WS_OF); bf16* OB = (bf16*)(P.ws + WS_OB);
    const float* MOD = (const float*)(P.ws + WS_MOD);
    const bf16* Tin = (const bf16*)(P.ws + WS_W + WOFF_IN); const bf16* Tout = (const bf16*)(P.ws + WS_W + WOFF_OUT); const bf16* Tup = (const bf16*)(P.ws + WS_W + WOFF_UP); const bf16* Tdn = (const bf16*)(P.ws + WS_W + WOFF_DOWN);

        constexpr int layer = LAYER, kind = LAYER % 3, j = LAYER / 3;
        const float* modl = MOD + (size_t)layer * 5 * MODW;
        const void* xc = layer == 0 ? (const void*)P.in[0] : (const void*)X; const void* xl = layer == 0 ? (const void*)P.in[1] : (const void*)X;
#ifndef NO_CONV
        REPN(R_CONV) convert_layer_weights(P, layer, lds);
#endif
        if (layer == 0) REPN(R_BAR) xcd_barrier(bar);
        REPN(R_NORM) norm_mod_phase<layer == 0>(xc, xl, P.in[9] + layer * D, modl, 0, 2048, H);
        REPN(R_BAR) xcd_barrier(bar);
        {
            constexpr int Npad = kind == 0 ? DN_NPAD : (kind == 1 ? GLA_NPAD : HG_NIN), nmain = kind == 0 ? DN_NMAIN : (kind == 1 ? GLA_NMAIN : HG_NIN);
            { pg8::Gemm g = pg8::mk_gemm(H, Tin, MROWS, nmain, D); pg8::StaticOrder S; S.init(MROWS, nmain, (int)gridDim.x, (int)blockIdx.x);
              pg8::EpiBf16<0> E{BIG, nmain, nmain, GATE};
              REPN(R_GEMM) pg8::gemm_phase<pg8::EpiBf16<0>, pg8::StaticOrder, true, true>(lds, g, S, E); }
            if constexpr (Npad > nmain) {
              pg8::Gemm g{H, Tin + (size_t)nmain * D, MROWS, 4 * 256, D, (size_t)512 * 2, (size_t)512 * 2, 8}; pg8::StaticOrder S; S.init(MROWS, 4 * 256, (int)gridDim.x, (int)blockIdx.x);
              pg8::EpiGateP E{(float*)(P.ws + WS_GP)};
              pg8::gemm_phase<pg8::EpiGateP, pg8::StaticOrder, true, true>(lds, g, S, E); }
        }
        REPN(R_BAR) xcd_barrier(bar);
        if constexpr (kind == 0) {
#ifndef NO_DNPREP
            REPN(R_DNPREP) dn_prep_phase(P, j, rep_ == 0);
#endif
            REPN(R_BAR) xcd_barrier(bar);
            REPN(R_WU) dn_wu_prep_phase(P, lds);
            REPN(R_BAR) xcd_barrier(bar);
            REPN(R_DNSCAN) dn_chunk_phase(P, j, lds);
            REPN(R_BAR) xcd_barrier(bar);
            REPN(R_GATE) gate_phase<128>(OF, OB, BIG, DN_NMAIN, 8192, P.in[18] + j * 128, Y, 4096);
        } else if constexpr (kind == 1) {
            REPN(R_GLAPREP) gla_prep_phase<1>(P, lds);
            REPN(R_BAR) xcd_barrier(bar);
            REPN(R_GSCAN) gla_chunk_phase<1>(P, lds);
            REPN(R_BAR) xcd_barrier(bar);
            REPN(R_GATE) gate_phase<512>(OF, OB, BIG, GLA_NMAIN, 4096, P.in[23] + j * 512, Y, 2048);
        } else {
            REPN(R_GLAPREP) gla_prep_phase<2>(P, lds);
            REPN(R_BAR) xcd_barrier(bar);
            REPN(R_GSCAN) gla_chunk_phase<2>(P, lds);
            REPN(R_BAR) xcd_barrier(bar);
            REPN(R_GATE) gate_phase<128>(OF, OB, BIG, HG_NIN, 4096, P.in[27] + j * 128, Y, 2048);
        }
        REPN(R_BAR) xcd_barrier(bar);
        {
            const int Kout = kind == 0 ? 4096 : 2048;
            pg8::Gemm g = pg8::mk_gemm(Y, Tout, MROWS, D, Kout); pg8::StaticOrder S; S.init(MROWS, D, (int)gridDim.x, (int)blockIdx.x);
            pg8::EpiRes<layer == 0> E{xc, xl, X, modl + 4096};
            pg8::gemm_phase<pg8::EpiRes<layer == 0>, pg8::StaticOrder, true, true>(lds, g, S, E);
        }
        REPN(R_BAR) xcd_barrier(bar);
        REPN(R_NORM) norm_mod_phase<false>(X, X, P.in[10] + layer * D, modl, 6144, 8192, H);
        REPN(R_BAR) xcd_barrier(bar);
#pragma unroll
        for (int hf = 0; hf < 2; ++hf) {
            {
                pg8::Gemm g = pg8::mk_gemm(H, Tup, MROWS / 2, DFF, D); pg8::StaticOrder S; S.init(MROWS / 2, DFF, (int)gridDim.x, (int)blockIdx.x, hf * 32);
                pg8::EpiBf16<1> E{BIG, DFF, DFF, nullptr};
                REPN(R_GEMM) pg8::gemm_phase<pg8::EpiBf16<1>, pg8::StaticOrder, true, true>(lds, g, S, E);
            }
            REPN(R_BAR) xcd_barrier(bar);
            {
                pg8::Gemm g = pg8::mk_gemm(BIG, Tdn, MROWS / 2, D, DFF); pg8::StaticOrder S; S.init(MROWS / 2, D, (int)gridDim.x, (int)blockIdx.x, hf * 32);
                pg8::EpiRes<false> E{X, X, X, modl + 10240};
                pg8::gemm_phase<pg8::EpiRes<false>, pg8::StaticOrder, true, true>(lds, g, S, E);
            }
            REPN(R_BAR) xcd_barrier(bar);
        }
    }

__global__ void __launch_bounds__(NT, 2) fwd_kernel(Params P) {
    extern __shared__ __attribute__((aligned(16))) unsigned char lds_raw[];
    LAS unsigned char* lds = (LAS unsigned char*)lds_raw;
    const int tid = threadIdx.x;
    volatile LAS unsigned* misc = (volatile LAS unsigned*)(lds + LDS_MISC);
    if (tid < 64) misc[tid] = 0u;
    __syncthreads();
    XcdBarrier bar = xcd_barrier_post((unsigned*)(P.ws + WS_CTL) + 1024, misc + 8);

#ifndef NO_MOD
    REPN(R_MOD) mod_phase(P, lds);
#endif
    __syncthreads();

    layer_body<0>(P, lds, bar);
    layer_body<1>(P, lds, bar);
    layer_body<2>(P, lds, bar);
    layer_body<3>(P, lds, bar);
    REPN(R_FINAL) final_norm_phase((const bf16*)(P.ws + WS_X), P.in[11], P.out + OUT_Y);
}

extern "C" void kernel_launch(void* const* d_in, const int* in_sizes, int n_in, void* d_out, int out_size, void* d_ws, size_t ws_size, hipStream_t stream) {
    static int grid = 0;
    if (grid == 0) {
        if (n_in != 29 || (size_t)out_size != OUT_END || ws_size < WS_END) {
            fprintf(stderr, "kernel_launch: unexpected shapes: n_in %d out %d (want %zu) ws %zu (want %zu)\n", n_in, out_size, (size_t)OUT_END, ws_size, (size_t)WS_END); grid = -1; return; }
        int dev = 0, cus = 0, per_cu = 0;
        if (hipGetDevice(&dev) != hipSuccess || hipDeviceGetAttribute(&cus, hipDeviceAttributeMultiprocessorCount, dev) != hipSuccess) { grid = -1; return; }
        if (hipFuncSetAttribute((const void*)fwd_kernel, hipFuncAttributeMaxDynamicSharedMemorySize, LDS_BYTES) != hipSuccess) { fprintf(stderr, "kernel_launch: hipFuncSetAttribute failed\n"); grid = -1; return; }
        if (hipOccupancyMaxActiveBlocksPerMultiprocessor(&per_cu, (const void*)fwd_kernel, NT, LDS_BYTES) != hipSuccess || per_cu < 1) { fprintf(stderr, "kernel_launch: occupancy query says %d\n", per_cu); }
        (void)hipGetLastError();
        grid = cus;
    }
    if (grid < 0) return;
    hipMemsetAsync((char*)d_ws + WS_CTL, 0, CTL_BYTES, stream);
    Params p{};
    for (int i = 0; i < 29; ++i) p.in[i] = (const float*)d_in[i];
    p.out = (float*)d_out; p.ws = (unsigned char*)d_ws;
    hipLaunchKernelGGL(fwd_kernel, dim3(grid), dim3(NT), LDS_BYTES, stream, p);
}
```

```cpp
#include <hip/hip_runtime.h>
#include <cstdio>
#include <cstdint>

__device__ __forceinline__ int opaque_v(int x) { asm volatile("" : "+v"(x)); return x; }
#define PHASE_IDS() const int tid = opaque_v((int)threadIdx.x), lane = tid & 63, wave = __builtin_amdgcn_readfirstlane(tid >> 6), gw = (int)blockIdx.x * 8 + wave, NGW = (int)gridDim.x * 8; (void)lane; (void)wave; (void)gw; (void)NGW
namespace pg8 {
#define PG8_LAS __attribute__((address_space(3)))
typedef unsigned short bf16_t;
typedef short bf16x8 __attribute__((ext_vector_type(8)));
typedef float f32x4 __attribute__((ext_vector_type(4)));
typedef unsigned u32x4 __attribute__((ext_vector_type(4)));
constexpr int BM = 256, BK = 64, HALF = 128, HTB = HALF * BK * 2, STAGE_BYTES = 8 * HTB, NXCD = 8, WGM = 8;

__host__ __device__ __forceinline__ int lds_byte(int r, int c) { const int st = (r >> 4) * 2 + (c >> 5), rr = r & 15, cc = c & 31, ob = rr * 64 + cc * 2; return st * 1024 + (ob ^ (((ob >> 9) & 1) << 5)); }
__host__ __device__ __forceinline__ void stage_rc(int b, int& R, int& C) { const int st = b / 1024, sb = b % 1024, swz = sb ^ (((sb >> 9) & 1) << 5); R = (st >> 1) * 16 + swz / 64; C = (st & 1) * 32 + (swz % 64) / 2; }
__host__ __device__ __forceinline__ int perm32(int rho) { const int n = rho >> 4, i = rho & 15; return 8 * (i >> 2) + 4 * n + (i & 3); }

struct Unit { int pm, pn; };
struct Gemm { const bf16_t* A; const bf16_t* Bt; int M, N, K; size_t a_pn_step, b_pn_step; int nt; };
__host__ __device__ __forceinline__ Gemm mk_gemm(const bf16_t* A, const bf16_t* Bt, int M, int N, int K) { return Gemm{A, Bt, M, N, K, 0, (size_t)256 * K * 2, K / 64}; }

struct StaticOrder {
    int nM, nN, nwg, G, c, pm0;
    __host__ __device__ void init(int M, int N, int G_, int c_, int pm0_ = 0) { nM = M / BM; nN = N / BM; nwg = nM * nN; G = G_; c = c_; pm0 = pm0_; }
    __host__ __device__ bool next(int i, Unit& u) const {
        const long L = (long)i * G + c; if (L >= nwg) return false;
        int wgid = (int)L; { const int q = nwg / NXCD, r = nwg % NXCD, xcd = wgid % NXCD, off = wgid / NXCD; wgid = (xcd < r ? xcd * (q + 1) : r * (q + 1) + (xcd - r) * q) + off; }
        const int nig = WGM * nN, gid = wgid / nig, fm = gid * WGM, gsz = (nM - fm) < WGM ? (nM - fm) : WGM;
        u.pm = pm0 + fm + ((wgid % nig) % gsz); u.pn = (wgid % nig) / gsz; return true;
    }
    __device__ __forceinline__ void a_ready(const Unit&) const {}
    __device__ __forceinline__ void done(const Unit&) const {}
};

__device__ __forceinline__ unsigned cvt_pk_bf16(float lo, float hi) { unsigned r; asm volatile("v_cvt_pk_bf16_f32 %0, %1, %2" : "=v"(r) : "v"(lo), "v"(hi)); return r; }

template <int ACT> struct EpiBf16 {
    static constexpr bool PERM = true, AFTER_DRAIN = false;
    bf16_t* O; int ldc; int n_main; float* G;
    __device__ __forceinline__ void operator()(const f32x4 (&acc)[2][2][4][2], const Unit& u, int wr, int wc, int fr, int fq) const {
        const int row0 = u.pm * BM + wr * 64 + fr; const int colt = u.pn * BM;
        const int col0 = colt + wc * 32 + 8 * fq;
#pragma unroll
        for (int ai = 0; ai < 2; ++ai)
#pragma unroll
            for (int m = 0; m < 4; ++m) { bf16_t* rowp = O + (size_t)(row0 + ai * HALF + m * 16) * ldc + col0;
#pragma unroll
                for (int bj = 0; bj < 2; ++bj) { f32x4 v0 = acc[ai][bj][m][0], v1 = acc[ai][bj][m][1];
                    if (ACT == 1) {
#pragma unroll
                        for (int j = 0; j < 4; ++j) { const float a = fmaxf(v0[j], 0.f), b = fmaxf(v1[j], 0.f); v0[j] = a * a; v1[j] = b * b; } }
                    u32x4 w; w.x = cvt_pk_bf16(v0[0], v0[1]); w.y = cvt_pk_bf16(v0[2], v0[3]); w.z = cvt_pk_bf16(v1[0], v1[1]); w.w = cvt_pk_bf16(v1[2], v1[3]);
                    *(u32x4*)(rowp + bj * HALF) = w;
#ifdef PROBE_DOUBLE_STORE
                    asm volatile("" ::: "memory"); *(u32x4*)(rowp + bj * HALF) = w; asm volatile("" ::: "memory");
#endif
                    } }
    }
};
struct EpiGateP {
    static constexpr bool PERM = true, AFTER_DRAIN = false;
    float* GP;
    __device__ __forceinline__ void operator()(const f32x4 (&acc)[2][2][4][2], const Unit& u, int wr, int wc, int fr, int fq) const {
        const int row0 = u.pm * BM + wr * 64 + fr; const int col0 = wc * 32 + 8 * fq; float* base = GP + (size_t)u.pn * 16384 * 128;
#pragma unroll
        for (int ai = 0; ai < 2; ++ai)
#pragma unroll
            for (int m = 0; m < 4; ++m) { float* rowp = base + (size_t)(row0 + ai * HALF + m * 16) * 128 + col0;
                *(f32x4*)(rowp) = acc[ai][0][m][0]; *(f32x4*)(rowp + 4) = acc[ai][0][m][1]; }
    }
};
template <bool BASE_F32> struct EpiRes {
    static constexpr bool PERM = true, AFTER_DRAIN = false;
    const void* base_ctx; const void* base_lat; bf16_t* out; const float* gate;
    __device__ __forceinline__ void operator()(const f32x4 (&acc)[2][2][4][2], const Unit& u, int wr, int wc, int fr, int fq) const {
        const int row0 = u.pm * BM + wr * 64 + fr, col0 = u.pn * BM + wc * 32 + 8 * fq;
        const bool ctx = u.pm < 32; const int grp = ctx ? 0 : 1 + ((u.pm - 32) >> 3);
        const float* gp = gate + (size_t)grp * 12288 + col0;
        const void* base = ctx ? base_ctx : base_lat; const int rsub = (BASE_F32 && !ctx) ? 8192 : 0;
        f32x4 gv[2][2];
#pragma unroll
        for (int bj = 0; bj < 2; ++bj)
#pragma unroll
            for (int n = 0; n < 2; ++n) gv[bj][n] = *(const f32x4*)(gp + bj * HALF + 4 * n);
#pragma unroll
        for (int ai = 0; ai < 2; ++ai) {
            f32x4 bs[4][2][2];
#pragma unroll
            for (int m = 0; m < 4; ++m) { const size_t offb = (size_t)(row0 + ai * HALF + m * 16 - rsub) * 2048 + col0;
#pragma unroll
                for (int bj = 0; bj < 2; ++bj) {
                    if (BASE_F32) { bs[m][bj][0] = *(const f32x4*)((const float*)base + offb + bj * HALF); bs[m][bj][1] = *(const f32x4*)((const float*)base + offb + bj * HALF + 4); }
                    else { const u32x4 w = *(const u32x4*)((const bf16_t*)base + offb + bj * HALF);
                        bs[m][bj][0] = (f32x4){__uint_as_float(w.x << 16), __uint_as_float(w.x & 0xffff0000u), __uint_as_float(w.y << 16), __uint_as_float(w.y & 0xffff0000u)};
                        bs[m][bj][1] = (f32x4){__uint_as_float(w.z << 16), __uint_as_float(w.z & 0xffff0000u), __uint_as_float(w.w << 16), __uint_as_float(w.w & 0xffff0000u)}; } } }
#pragma unroll
            for (int m = 0; m < 4; ++m) { const size_t offo = (size_t)(row0 + ai * HALF + m * 16) * 2048 + col0;
#pragma unroll
                for (int bj = 0; bj < 2; ++bj) { const f32x4 v0 = bs[m][bj][0] + gv[bj][0] * acc[ai][bj][m][0], v1 = bs[m][bj][1] + gv[bj][1] * acc[ai][bj][m][1];
                    u32x4 w; w.x = cvt_pk_bf16(v0[0], v0[1]); w.y = cvt_pk_bf16(v0[2], v0[3]); w.z = cvt_pk_bf16(v1[0], v1[1]); w.w = cvt_pk_bf16(v1[2], v1[3]);
                    *(u32x4*)(out + offo + bj * HALF) = w; } }
            asm volatile("" ::: "memory");
        }
    }
};

template <class Epi, class Sched, bool ALIGN_EPI = false, bool SP2 = false>
__device__ __forceinline__ void gemm_phase(PG8_LAS unsigned char* lds, const Gemm g, const Sched& S, const Epi& E) {
    const int tid = opaque_v((int)threadIdx.x), wid = __builtin_amdgcn_readfirstlane(tid >> 6), lane = tid & 63, wr = wid >> 2, wc = wid & 3, fr = lane & 15, fq = lane >> 4;
    const int K = g.K, nt = g.nt;
    unsigned voffA[2], voffB[2];
#pragma unroll
    for (int i = 0; i < 2; ++i) { int R, C; stage_rc(tid * 16 + i * 8192, R, C); const int Rb = Epi::PERM ? ((R & ~31) + perm32(R & 31)) : R;
        voffA[i] = (unsigned)(R * K + C) * 2u; voffB[i] = (unsigned)(Rb * K + C) * 2u; }
    const size_t kstep = (size_t)(BK * 2);
    const size_t hstep = (size_t)HALF * K * 2;
    const size_t tstep = 2 * hstep;
    const unsigned ldsw = (unsigned)wid * 1024u;
    const int aoff = lds_byte(wr * 64 + fr, fq * 8), boff = lds_byte(wc * 32 + fr, fq * 8);
#define PG8_SA(b, h) (((b) * 2 + (h)) * HTB)
#define PG8_SB(b, h) ((4 + (b) * 2 + (h)) * HTB)
#define PG8_STAGE(bufoff, gbase, voff) do { _Pragma("unroll") for (int _i = 0; _i < 2; ++_i) \
        __builtin_amdgcn_global_load_lds((const unsigned*)((const char*)(gbase) + (voff)[_i]), (PG8_LAS unsigned*)(lds + (bufoff) + ldsw + _i * 8192), 16, 0, 0); } while (0)
#define PG8_LDA(dst, b, h) do { _Pragma("unroll") for (int m = 0; m < 4; ++m) _Pragma("unroll") for (int k = 0; k < 2; ++k) dst[m][k] = *(const PG8_LAS bf16x8*)(lds + PG8_SA(b, h) + aoff + m * 2048 + k * 1024); } while (0)
#define PG8_LDB(dst, b, h) do { _Pragma("unroll") for (int n = 0; n < 2; ++n) _Pragma("unroll") for (int k = 0; k < 2; ++k) dst[n][k] = *(const PG8_LAS bf16x8*)(lds + PG8_SB(b, h) + boff + n * 2048 + k * 1024); } while (0)
#define PG8_MMA(ai, bj, At, Bt) do { __builtin_amdgcn_s_setprio(1); _Pragma("unroll") for (int m = 0; m < 4; ++m) _Pragma("unroll") for (int n = 0; n < 2; ++n) _Pragma("unroll") for (int k = 0; k < 2; ++k) \
        acc[ai][bj][m][n] = __builtin_amdgcn_mfma_f32_16x16x32_bf16(Bt[n][k], At[m][k], acc[ai][bj][m][n], 0, 0, 0); __builtin_amdgcn_s_setprio(0); } while (0)
#define PG8_WAIT_V(n) asm volatile("s_waitcnt vmcnt(" #n ")" ::: "memory")
#define PG8_WAIT_L(n) asm volatile("s_waitcnt lgkmcnt(" #n ")" ::: "memory")
#define PG8_BAR __builtin_amdgcn_s_barrier()
#define PG8_SCHED __builtin_amdgcn_sched_barrier(0)
    Unit cur, nxt; int ui = 0;
    if (!S.next(0, cur)) return;
    f32x4 acc[2][2][4][2];
#pragma unroll
    for (int a = 0; a < 2; ++a)
#pragma unroll
        for (int b = 0; b < 2; ++b)
#pragma unroll
            for (int m = 0; m < 4; ++m)
#pragma unroll
                for (int n = 0; n < 2; ++n) acc[a][b][m][n] = (f32x4){0.f, 0.f, 0.f, 0.f};
    bf16x8 At[4][2], B0[2][2], B1[2][2];
    const char* cA = (const char*)g.A + (size_t)cur.pm * tstep + (size_t)cur.pn * g.a_pn_step; const char* cB = (const char*)g.Bt + (size_t)cur.pn * g.b_pn_step;
    S.a_ready(cur);
    if constexpr (SP2) {
        PG8_STAGE(PG8_SB(0, 0), cB, voffB); PG8_STAGE(PG8_SB(0, 1), cB + hstep, voffB); PG8_STAGE(PG8_SA(0, 0), cA, voffA); PG8_STAGE(PG8_SA(0, 1), cA + hstep, voffA);
        if (wr == 1) PG8_BAR;
        PG8_WAIT_V(2); PG8_BAR;
        PG8_STAGE(PG8_SB(1, 0), cB + kstep, voffB); PG8_STAGE(PG8_SA(1, 0), cA + kstep, voffA); PG8_STAGE(PG8_SB(1, 1), cB + hstep + kstep, voffB);
        PG8_WAIT_V(6); PG8_BAR;
    } else {
        PG8_STAGE(PG8_SB(0, 0), cB, voffB); PG8_STAGE(PG8_SA(0, 0), cA, voffA); PG8_STAGE(PG8_SB(0, 1), cB + hstep, voffB); PG8_STAGE(PG8_SA(0, 1), cA + hstep, voffA);
        if (wr == 1) PG8_BAR;
        PG8_WAIT_V(4); PG8_BAR;
        PG8_STAGE(PG8_SB(1, 0), cB + kstep, voffB); PG8_STAGE(PG8_SA(1, 0), cA + kstep, voffA); PG8_STAGE(PG8_SB(1, 1), cB + hstep + kstep, voffB);
        PG8_WAIT_V(6); PG8_BAR;
    }
    for (;;) {
        const bool has_next = S.next(ui + 1, nxt);
        const char* nA = has_next ? (const char*)g.A + (size_t)nxt.pm * tstep + (size_t)nxt.pn * g.a_pn_step : cA; const char* nB = has_next ? (const char*)g.Bt + (size_t)nxt.pn * g.b_pn_step : cB;
        for (int t = 0; t < nt; t += 2) {
            const bool last = (t == nt - 2);
            const char* a1 = cA + (size_t)(t + 1) * kstep;
            const char* a2 = last ? nA : cA + (size_t)(t + 2) * kstep; const char* b2 = last ? nB : cB + (size_t)(t + 2) * kstep;
            const char* a3 = a2 + kstep; const char* b3 = b2 + kstep;
            if (last && has_next) S.a_ready(nxt);
            if constexpr (SP2) {
            PG8_LDB(B0, 0, 0); PG8_LDB(B1, 0, 1); PG8_SCHED; PG8_LDA(At, 0, 0); PG8_STAGE(PG8_SA(1, 1), a1 + hstep, voffA);
            PG8_WAIT_V(8); PG8_WAIT_L(0); PG8_BAR; PG8_MMA(0, 0, At, B0); PG8_MMA(0, 1, At, B1); PG8_BAR; PG8_SCHED;
            PG8_LDA(At, 0, 1); PG8_STAGE(PG8_SB(0, 0), b2, voffB); PG8_STAGE(PG8_SB(0, 1), b2 + hstep, voffB); PG8_STAGE(PG8_SA(0, 0), a2, voffA);
            PG8_WAIT_V(8); PG8_WAIT_L(0); PG8_BAR; PG8_MMA(1, 0, At, B0); PG8_MMA(1, 1, At, B1); PG8_BAR; PG8_SCHED;
            PG8_LDB(B0, 1, 0); PG8_LDB(B1, 1, 1); PG8_SCHED; PG8_LDA(At, 1, 0); PG8_STAGE(PG8_SA(0, 1), a2 + hstep, voffA);
            PG8_WAIT_V(8); PG8_WAIT_L(0); PG8_BAR; PG8_MMA(0, 0, At, B0); PG8_MMA(0, 1, At, B1); PG8_BAR; PG8_SCHED;
            PG8_LDA(At, 1, 1); PG8_STAGE(PG8_SB(1, 0), b3, voffB); PG8_STAGE(PG8_SB(1, 1), b3 + hstep, voffB); PG8_STAGE(PG8_SA(1, 0), a3, voffA);
            PG8_WAIT_V(8); PG8_WAIT_L(0); PG8_BAR; PG8_MMA(1, 0, At, B0); PG8_MMA(1, 1, At, B1); PG8_BAR; PG8_SCHED;
            } else {
            PG8_LDB(B0, 0, 0); PG8_SCHED; PG8_LDA(At, 0, 0); PG8_STAGE(PG8_SA(1, 1), a1 + hstep, voffA);
            PG8_WAIT_L(8); PG8_BAR; PG8_WAIT_L(0); PG8_MMA(0, 0, At, B0); PG8_BAR; PG8_SCHED;
            PG8_LDB(B1, 0, 1); PG8_STAGE(PG8_SB(0, 0), b2, voffB);
            PG8_BAR; PG8_WAIT_L(0); PG8_MMA(0, 1, At, B1); PG8_BAR;
            PG8_LDA(At, 0, 1); PG8_STAGE(PG8_SA(0, 0), a2, voffA);
            PG8_BAR; PG8_WAIT_L(0); PG8_MMA(1, 0, At, B0); PG8_BAR; PG8_SCHED;
            PG8_STAGE(PG8_SB(0, 1), b2 + hstep, voffB);
            PG8_WAIT_V(6); PG8_BAR; PG8_MMA(1, 1, At, B1); PG8_BAR;
            PG8_LDB(B0, 1, 0); PG8_SCHED; PG8_LDA(At, 1, 0); PG8_STAGE(PG8_SA(0, 1), a2 + hstep, voffA);
            PG8_WAIT_L(8); PG8_BAR; PG8_WAIT_L(0); PG8_MMA(0, 0, At, B0); PG8_BAR; PG8_SCHED;
            PG8_LDB(B1, 1, 1); PG8_STAGE(PG8_SB(1, 0), b3, voffB);
            PG8_BAR; PG8_WAIT_L(0); PG8_MMA(0, 1, At, B1); PG8_BAR;
            PG8_LDA(At, 1, 1); PG8_STAGE(PG8_SA(1, 0), a3, voffA);
            PG8_BAR; PG8_WAIT_L(0); PG8_MMA(1, 0, At, B0); PG8_BAR; PG8_SCHED;
            PG8_STAGE(PG8_SB(1, 1), b3 + hstep, voffB);
            PG8_WAIT_V(6); PG8_BAR; PG8_MMA(1, 1, At, B1); PG8_BAR;
            }
        }
        if constexpr (ALIGN_EPI) { if (wr == 0) PG8_BAR; }
        if constexpr (!Epi::AFTER_DRAIN) { E(acc, cur, wr, wc, fr, fq); S.done(cur); }
        if (!has_next) break;
#pragma unroll
        for (int a = 0; a < 2; ++a)
#pragma unroll
            for (int b = 0; b < 2; ++b)
#pragma unroll
                for (int m = 0; m < 4; ++m)
#pragma unroll
                    for (int n = 0; n < 2; ++n) acc[a][b][m][n] = (f32x4){0.f, 0.f, 0.f, 0.f};
        cur = nxt; cA = nA; cB = nB; ++ui;
        if constexpr (ALIGN_EPI) { if (wr == 1) PG8_BAR; }
    }
    PG8_WAIT_V(0);
    if constexpr (!ALIGN_EPI) { if (wr == 0) PG8_BAR; }
    PG8_BAR;
#undef PG8_SA
#undef PG8_SB
#undef PG8_STAGE
#undef PG8_LDA
#undef PG8_LDB
#undef PG8_MMA
#undef PG8_WAIT_V
#undef PG8_WAIT_L
#undef PG8_BAR
#undef PG8_SCHED
}
}

#define XB_TMO      128
#define XB_XCNT(j)  (256  + 64 * (j))
#define XB_XSUB(j)  (1280 + 64 * (j))
#define XB_XGEN(j)  (2304 + 64 * (j))
#define XB_TOP      3328
#define XB_TOPGEN   3392
#define XCD_BAR_WORDS 3456
#define XB_SPIN_CAP (1u << 21)
#define LAS __attribute__((address_space(3)))

__device__ __forceinline__ unsigned xb_ld(unsigned* p)              { return __hip_atomic_load(p, __ATOMIC_RELAXED, __HIP_MEMORY_SCOPE_AGENT); }
__device__ __forceinline__ unsigned xb_add(unsigned* p, unsigned v) { return __hip_atomic_fetch_add(p, v, __ATOMIC_RELAXED, __HIP_MEMORY_SCOPE_AGENT); }
__device__ __forceinline__ unsigned xb_xcc_id() { return (unsigned)__builtin_amdgcn_s_getreg((3 << 11) | 20) & 0xFu; }
#define XB_SPIN(cond, bar) do { unsigned _sp = 0; while (cond) { __builtin_amdgcn_s_sleep(1); \
    if ((++_sp & 255u) == 0u) { if (xb_ld(&(bar)[XB_TMO])) break; if (_sp > XB_SPIN_CAP) { atomicAdd(&(bar)[XB_TMO], 1u); break; } } } } while (0)

struct XcdBarrier { unsigned* bar; unsigned x; volatile LAS unsigned* st; };

__device__ __forceinline__ XcdBarrier xcd_barrier_post(unsigned* bar, volatile LAS unsigned* st) {
    XcdBarrier b; b.bar = bar; b.x = xb_xcc_id(); b.st = st;
    if (threadIdx.x == 0) (void)xb_add(&bar[XB_XCNT(b.x)], 1u);
    return b;
}
__device__ __forceinline__ void xcd_barrier_complete(unsigned* bar, unsigned x, unsigned& nloc, unsigned& nx) {
    const unsigned G = gridDim.x * gridDim.y * gridDim.z;
    unsigned sum, cnt, mine, sp = 0u;
    for (;;) {
        sum = 0u; cnt = 0u; mine = 0u;
#pragma unroll
        for (unsigned j = 0; j < 16; ++j) { const unsigned c = xb_ld(&bar[XB_XCNT(j)]); sum += c; cnt += (c > 0u) ? 1u : 0u; mine = (j == x) ? c : mine; }
        if (sum == G) break;
        __builtin_amdgcn_s_sleep(1);
        if ((++sp & 255u) == 0u) { if (xb_ld(&bar[XB_TMO])) break; if (sp > XB_SPIN_CAP) { atomicAdd(&bar[XB_TMO], 1u); break; } }
    }
    nloc = mine > 0u ? mine : 1u; nx = cnt > 0u ? cnt : 1u;
}
__device__ __forceinline__ void xcd_barrier(const XcdBarrier& b) {
    asm volatile("s_waitcnt vmcnt(0)" ::: "memory");
    __syncthreads();
    if (threadIdx.x == 0) {
        unsigned* bar = b.bar;
        __builtin_amdgcn_s_waitcnt(0);
        unsigned nloc = b.st[0], nx = b.st[1];
        if (nloc == 0u) { xcd_barrier_complete(bar, b.x, nloc, nx); b.st[0] = nloc; b.st[1] = nx; }
        const unsigned old = xb_add(&bar[XB_XSUB(b.x)], 1u);
        const unsigned gen = old / nloc;
        if (old + 1u == (gen + 1u) * nloc) {
            __builtin_amdgcn_fence(__ATOMIC_RELEASE, "agent");
            asm volatile("s_waitcnt vmcnt(0)" ::: "memory");
            const unsigned og = xb_add(&bar[XB_TOP], 1u);
            const unsigned tg = og / nx;
            if (og + 1u == (tg + 1u) * nx) xb_add(&bar[XB_TOPGEN], 1u);
            else XB_SPIN(xb_ld(&bar[XB_TOPGEN]) == tg, bar);
            __builtin_amdgcn_fence(__ATOMIC_ACQUIRE, "agent");
            xb_add(&bar[XB_XGEN(b.x)], 1u);
            asm volatile("s_waitcnt vmcnt(0)" ::: "memory");
        } else {
            XB_SPIN(xb_ld(&bar[XB_XGEN(b.x)]) == gen, bar);
            __builtin_amdgcn_fence(__ATOMIC_ACQUIRE, "agent");
            asm volatile("s_waitcnt vmcnt(0)" ::: "memory");
        }
    }
    __syncthreads();
}

typedef unsigned short bf16;
typedef float f32x4 __attribute__((ext_vector_type(4)));
typedef unsigned u32x4 __attribute__((ext_vector_type(4)));
typedef unsigned u32x2 __attribute__((ext_vector_type(2)));

constexpr int D = 2048, DFF = 8192, MROWS = 16384, MCTX = 8192;
constexpr int NT = 512;
constexpr float EPS = 1e-6f;
constexpr int DN_NIN = 12416, DN_NMAIN = 12288, DN_NPAD = 12544;
constexpr int GLA_NIN = 6176, GLA_NMAIN = 6144, GLA_NPAD = 6400;
constexpr int HG_NIN = 10240;
constexpr int MODW = 12288;

constexpr size_t MiB = 1u << 20;
constexpr size_t WS_CTL = 0, CTL_BYTES = 1 * MiB;
constexpr size_t WS_MOD = 1 * MiB;
constexpr size_t WS_X = 2 * MiB;
constexpr size_t WS_H = WS_X + 128 * MiB;
constexpr size_t WS_BIG = WS_H + 64 * MiB;
constexpr size_t WS_GATE = WS_BIG + 384 * MiB;
constexpr size_t WS_QKV = WS_GATE + 8 * MiB;
constexpr size_t WS_OF = WS_QKV + 256 * MiB;
constexpr size_t WS_OB = WS_OF + 128 * MiB;
constexpr size_t WS_W = WS_OB + 128 * MiB;
constexpr size_t WOFF_IN = 0, WOFF_OUT = (size_t)DN_NPAD * D * 2, WOFF_UP = WOFF_OUT + (size_t)D * 4096 * 2, WOFF_DOWN = WOFF_UP + (size_t)DFF * D * 2;
constexpr size_t WS_TA = ((WS_W + WOFF_DOWN + (size_t)D * DFF * 2 + MiB - 1) / MiB) * MiB;
constexpr size_t WS_GS = WS_TA + 256 * MiB;
constexpr size_t WS_GP = WS_GS + 12 * MiB;
constexpr size_t WS_END = WS_GP + 32 * MiB;

constexpr size_t OUT_Y = 0;
constexpr size_t OUT_SDN = (size_t)MROWS * D;
constexpr size_t OUT_SGLA = OUT_SDN + (size_t)32 * 2 * 2 * 32 * 128 * 128;
constexpr size_t OUT_SHG = OUT_SGLA + (size_t)32 * 2 * 4 * 256 * 512;
constexpr size_t OUT_END = OUT_SHG + (size_t)32 * 2 * 16 * 128 * 128;

constexpr int LDS_BYTES = 151552;
constexpr int LDS_MISC = 150528;

struct Params {
    const float* in[29];
    float* out;
    unsigned char* ws;
};

__device__ __forceinline__ float bf2f(unsigned short b) { return __uint_as_float(((unsigned)b) << 16); }
typedef __bf16 bfv2_ __attribute__((ext_vector_type(2)));
typedef float f32x2_ __attribute__((ext_vector_type(2)));
__device__ __forceinline__ unsigned f2bf(float f) { return (unsigned)__builtin_bit_cast(unsigned short, (__bf16)f); }
__device__ __forceinline__ unsigned pk2(float lo, float hi) { const f32x2_ v = {lo, hi}; return __builtin_bit_cast(unsigned, __builtin_convertvector(v, bfv2_)); }
__device__ __forceinline__ float bflo(unsigned w) { return __uint_as_float(w << 16); }
__device__ __forceinline__ float bfhi(unsigned w) { return __uint_as_float(w & 0xffff0000u); }
__device__ __forceinline__ float wave_sum(float v) {
#pragma unroll
    for (int o = 1; o < 64; o <<= 1) v += __shfl_xor(v, o);
    return v;
}
__device__ __forceinline__ float rdlane(float v, int l) { return __builtin_bit_cast(float, __builtin_amdgcn_readlane(__builtin_bit_cast(int, v), l)); }
__device__ __forceinline__ float sigmoidf_(float x) { return __builtin_amdgcn_rcpf(1.f + __expf(-x)); }
__device__ __forceinline__ float siluf_(float x) { return x * __builtin_amdgcn_rcpf(1.f + __expf(-x)); }
__device__ __forceinline__ float softplusf_(float x) { return fmaxf(x, 0.f) + log1pf(__expf(-fabsf(x))); }

__device__ __forceinline__ void transpose_item(const float* W, int K, int N, bf16* WT, LAS float* scr, int item, int lane) {
    const int nblk = N / 32, kb = item / nblk, nb = item % nblk, k0 = 64 * kb, n0 = 32 * nb;
    { f32x4 v[8]; const int kr = lane >> 3, c4 = (lane & 7) * 4;
#pragma unroll
      for (int i = 0; i < 8; ++i) v[i] = *(const f32x4*)(W + (size_t)(k0 + kr + 8 * i) * N + n0 + c4);
#pragma unroll
      for (int i = 0; i < 8; ++i) { LAS float* d = scr + (kr + 8 * i) * 33 + c4; d[0] = v[i].x; d[1] = v[i].y; d[2] = v[i].z; d[3] = v[i].w; } }
    asm volatile("s_waitcnt lgkmcnt(0)" ::: "memory");
    const int c = lane & 7;
#pragma unroll
    for (int j = 0; j < 4; ++j) { const int n = (lane >> 3) + 8 * j; const LAS float* s = scr + (8 * c) * 33 + n;
        u32x4 o; o.x = pk2(s[0 * 33], s[1 * 33]); o.y = pk2(s[2 * 33], s[3 * 33]); o.z = pk2(s[4 * 33], s[5 * 33]); o.w = pk2(s[6 * 33], s[7 * 33]);
        *(u32x4*)(WT + (size_t)(n0 + n) * K + k0 + 8 * c) = o; }
    asm volatile("s_waitcnt lgkmcnt(0)" ::: "memory");
}

__device__ __forceinline__ void convert_layer_weights(const Params& P, int layer, LAS unsigned char* lds) {
    PHASE_IDS();
    LAS float* scr = (LAS float*)(lds + wave * 16384);
    const int kind = layer % 3, j = layer / 3;
    const float* Win; int Nin, Npad; const float* Wout; int Kout;
    if (kind == 0) { Win = P.in[14] + (size_t)j * D * DN_NIN; Nin = DN_NIN; Npad = DN_NPAD; Wout = P.in[19] + (size_t)j * 4096 * D; Kout = 4096; }
    else if (kind == 1) { Win = P.in[20] + (size_t)j * D * GLA_NIN; Nin = GLA_NIN; Npad = GLA_NPAD; Wout = P.in[24] + (size_t)j * D * D; Kout = 2048; }
    else { Win = P.in[25] + (size_t)j * D * HG_NIN; Nin = HG_NIN; Npad = HG_NIN; Wout = P.in[28] + (size_t)j * D * D; Kout = 2048; }
    const float* Wup = P.in[12] + (size_t)layer * D * DFF; const float* Wdn = P.in[13] + (size_t)layer * DFF * D;
    bf16* Tin = (bf16*)(P.ws + WS_W + WOFF_IN); bf16* Tout = (bf16*)(P.ws + WS_W + WOFF_OUT); bf16* Tup = (bf16*)(P.ws + WS_W + WOFF_UP); bf16* Tdn = (bf16*)(P.ws + WS_W + WOFF_DOWN);
    const int I_in = (D / 64) * (Nin / 32), I_out = (Kout / 64) * (D / 32), I_up = (D / 64) * (DFF / 32), I_dn = (DFF / 64) * (D / 32);
    const int NI = I_in + I_out + I_up + I_dn;
    for (int it = gw; it < NI; it += NGW) {
        int r = it;
        if (r < I_in) { transpose_item(Win, D, Nin, Tin, scr, r, lane); continue; } r -= I_in;
        if (r < I_out) { transpose_item(Wout, Kout, D, Tout, scr, r, lane); continue; } r -= I_out;
        if (r < I_up) { transpose_item(Wup, D, DFF, Tup, scr, r, lane); continue; } r -= I_up;
        transpose_item(Wdn, DFF, D, Tdn, scr, r, lane);
    }
    const int npadrows = Npad - Nin;
    if (npadrows > 0) {
        u32x4* z = (u32x4*)(Tin + (size_t)Nin * D); const int n16 = npadrows * D / 8;
        for (int i = gw * 64 + lane; i < n16; i += NGW * 64) z[i] = (u32x4){0u, 0u, 0u, 0u};
    }
}

__device__ __forceinline__ void mod_phase(const Params& P, LAS unsigned char* lds) {
    PHASE_IDS();
    LAS float* scond = (LAS float*)lds;
    LAS float* red = (LAS float*)(lds + 40960 + 1024);
    for (int i = tid; i < 5 * 2048; i += NT) { const int g = i / 2048, k = i % 2048; const float v = g == 0 ? P.in[6][k] : P.in[2][(g - 1) * 2048 + k]; scond[k * 5 + g] = siluf_(v); }
    __syncthreads();
    float* mod = (float*)(P.ws + WS_MOD);
    const int c4 = tid & 15, kg = tid >> 4;
    for (int cg = blockIdx.x; cg < 4 * MODW / 64; cg += gridDim.x) {
        const int layer = cg / (MODW / 64), colbase = (cg % (MODW / 64)) * 64;
        const float* W = P.in[7] + (size_t)layer * D * MODW + colbase + c4 * 4;
        f32x4 acc[5];
#pragma unroll
        for (int g = 0; g < 5; ++g) acc[g] = (f32x4){0.f, 0.f, 0.f, 0.f};
#pragma unroll 8
        for (int kk = 0; kk < 64; ++kk) {
            const int k = kg * 64 + kk;
            const f32x4 w = *(const f32x4*)(W + (size_t)k * MODW);
#pragma unroll
            for (int g = 0; g < 5; ++g) acc[g] += w * scond[k * 5 + g];
        }
#pragma unroll
        for (int g = 0; g < 5; ++g)
#pragma unroll
            for (int e = 0; e < 4; ++e) red[(kg * 64 + c4 * 4 + e) * 5 + g] = acc[g][e];
        __syncthreads();
        if (tid < 64 * 5) { const int c = tid / 5, g = tid % 5; float sum = 0.f;
#pragma unroll 8
            for (int q = 0; q < 32; ++q) sum += red[(q * 64 + c) * 5 + g];
            mod[((size_t)layer * 5 + g) * MODW + colbase + c] = sum + P.in[8][(size_t)layer * MODW + colbase + c]; }
        __syncthreads();
    }
}

template <bool XF32> __device__ __forceinline__ void norm_mod_phase(const void* xc, const void* xl, const float* w, const float* mod, int sh_off, int sc_off, bf16* H) {
    PHASE_IDS();
    const int RPW = (MROWS + NGW - 1) / NGW;
    f32x4 ca[8], cb[8]; int cgrp = -1;
#pragma unroll
    for (int i = 0; i < 8; ++i) { ca[i] = (f32x4){0.f, 0.f, 0.f, 0.f}; cb[i] = ca[i]; }
    for (int kr = 0; kr < RPW; ++kr) {
        const int m = gw * RPW + kr; if (m >= MROWS) break;
        const bool ctx = m < MCTX; const int grp = ctx ? 0 : 1 + ((m - MCTX) >> 11);
        if (grp != cgrp) { cgrp = grp; const float* mg = mod + (size_t)grp * MODW;
#pragma unroll
            for (int jx = 0; jx < 4; ++jx) { const int c = 8 * (lane + 64 * jx);
                ca[2 * jx] = *(const f32x4*)(w + c) * (*(const f32x4*)(mg + sc_off + c) + 1.f); cb[2 * jx] = *(const f32x4*)(mg + sh_off + c);
                ca[2 * jx + 1] = *(const f32x4*)(w + c + 4) * (*(const f32x4*)(mg + sc_off + c + 4) + 1.f); cb[2 * jx + 1] = *(const f32x4*)(mg + sh_off + c + 4); } }
        f32x4 v[8]; float ss = 0.f;
        if (XF32) { const float* xr = ctx ? (const float*)xc + (size_t)m * D : (const float*)xl + (size_t)(m - MCTX) * D;
#pragma unroll
            for (int jx = 0; jx < 4; ++jx) { v[2 * jx] = *(const f32x4*)(xr + 8 * (lane + 64 * jx)); v[2 * jx + 1] = *(const f32x4*)(xr + 8 * (lane + 64 * jx) + 4); } }
        else { const bf16* xr = (const bf16*)xc + (size_t)m * D;
#pragma unroll
            for (int jx = 0; jx < 4; ++jx) { const u32x4 q = *(const u32x4*)(xr + 8 * (lane + 64 * jx));
                v[2 * jx] = (f32x4){bflo(q.x), bfhi(q.x), bflo(q.y), bfhi(q.y)}; v[2 * jx + 1] = (f32x4){bflo(q.z), bfhi(q.z), bflo(q.w), bfhi(q.w)}; } }
#pragma unroll
        for (int i = 0; i < 8; ++i) ss += (v[i].x * v[i].x + v[i].y * v[i].y) + (v[i].z * v[i].z + v[i].w * v[i].w);
        const float rstd = rsqrtf(wave_sum(ss) * (1.f / D) + EPS);
#pragma unroll
        for (int jx = 0; jx < 4; ++jx) { const int c = 8 * (lane + 64 * jx);
            const f32x4 y0 = v[2 * jx] * rstd * ca[2 * jx] + cb[2 * jx];
            const f32x4 y1 = v[2 * jx + 1] * rstd * ca[2 * jx + 1] + cb[2 * jx + 1];
            u32x4 o; o.x = pk2(y0.x, y0.y); o.y = pk2(y0.z, y0.w); o.z = pk2(y1.x, y1.y); o.w = pk2(y1.z, y1.w);
            *(u32x4*)(H + (size_t)m * D + c) = o; }
    }
}
__device__ __forceinline__ void final_norm_phase(const bf16* X, const float* w, float* out) {
    PHASE_IDS();
    f32x4 cw[8];
#pragma unroll
    for (int jx = 0; jx < 4; ++jx) { const int c = 8 * (lane + 64 * jx); cw[2 * jx] = *(const f32x4*)(w + c); cw[2 * jx + 1] = *(const f32x4*)(w + c + 4); }
    for (int m = gw; m < MROWS; m += NGW) {
        f32x4 v[8]; float ss = 0.f;
#pragma unroll
        for (int jx = 0; jx < 4; ++jx) { const u32x4 q = *(const u32x4*)(X + (size_t)m * D + 8 * (lane + 64 * jx));
            v[2 * jx] = (f32x4){bflo(q.x), bfhi(q.x), bflo(q.y), bfhi(q.y)}; v[2 * jx + 1] = (f32x4){bflo(q.z), bfhi(q.z), bflo(q.w), bfhi(q.w)}; }
#pragma unroll
        for (int i = 0; i < 8; ++i) ss += (v[i].x * v[i].x + v[i].y * v[i].y) + (v[i].z * v[i].z + v[i].w * v[i].w);
        const float rstd = rsqrtf(wave_sum(ss) * (1.f / D) + EPS);
#pragma unroll
        for (int jx = 0; jx < 4; ++jx) { const int c = 8 * (lane + 64 * jx);
            *(f32x4*)(out + (size_t)m * D + c) = v[2 * jx] * rstd * cw[2 * jx]; *(f32x4*)(out + (size_t)m * D + c + 4) = v[2 * jx + 1] * rstd * cw[2 * jx + 1]; }
    }
}

template <int DV> __device__ __forceinline__ void gate_phase(const bf16* OF, const bf16* OB, const bf16* proj, int ldp, int gcol0, const float* nw, bf16* Y, int W) {
    PHASE_IDS();
    const int ncg = W / 512;
    const int nitems = MROWS * ncg;
    for (int it0 = gw; it0 < nitems; it0 += 2 * NGW) {
        u32x4 a[2], b[2], gz[2]; int mm[2], cc[2]; bool ok[2];
#pragma unroll
        for (int u = 0; u < 2; ++u) { const int it = it0 + u * NGW; ok[u] = it < nitems; const int itc = ok[u] ? it : it0; mm[u] = itc / ncg; cc[u] = (itc % ncg) * 512 + lane * 8;
            a[u] = *(const u32x4*)(OF + (size_t)mm[u] * W + cc[u]); b[u] = *(const u32x4*)(OB + (size_t)mm[u] * W + cc[u]); gz[u] = *(const u32x4*)(proj + (size_t)mm[u] * ldp + gcol0 + cc[u]); }
#pragma unroll
        for (int u = 0; u < 2; ++u) {
            float o[8], z[8];
            o[0] = bflo(a[u].x) + bflo(b[u].x); o[1] = bfhi(a[u].x) + bfhi(b[u].x); o[2] = bflo(a[u].y) + bflo(b[u].y); o[3] = bfhi(a[u].y) + bfhi(b[u].y);
            o[4] = bflo(a[u].z) + bflo(b[u].z); o[5] = bfhi(a[u].z) + bfhi(b[u].z); o[6] = bflo(a[u].w) + bflo(b[u].w); o[7] = bfhi(a[u].w) + bfhi(b[u].w);
            z[0] = bflo(gz[u].x); z[1] = bfhi(gz[u].x); z[2] = bflo(gz[u].y); z[3] = bfhi(gz[u].y); z[4] = bflo(gz[u].z); z[5] = bfhi(gz[u].z); z[6] = bflo(gz[u].w); z[7] = bfhi(gz[u].w);
            float ss = 0.f;
#pragma unroll
            for (int i = 0; i < 8; ++i) ss += o[i] * o[i];
#pragma unroll
            for (int sft = 1; sft < DV / 8; sft <<= 1) ss += __shfl_xor(ss, sft);
            const float rstd = rsqrtf(ss * (1.f / DV) + EPS);
            const int cw = cc[u] % DV;
            const f32x4 w0 = *(const f32x4*)(nw + cw), w1 = *(const f32x4*)(nw + cw + 4);
            const float wv[8] = {w0.x, w0.y, w0.z, w0.w, w1.x, w1.y, w1.z, w1.w};
            float y[8];
#pragma unroll
            for (int i = 0; i < 8; ++i) y[i] = o[i] * rstd * wv[i] * siluf_(z[i]);
            u32x4 rr; rr.x = pk2(y[0], y[1]); rr.y = pk2(y[2], y[3]); rr.z = pk2(y[4], y[5]); rr.w = pk2(y[6], y[7]);
            if (ok[u]) *(u32x4*)(Y + (size_t)mm[u] * W + cc[u]) = rr;
        }
    }
}

__device__ __forceinline__ void dn_prep_phase(const Params& P, int j, bool do_gates = true) {
    PHASE_IDS();
    const bf16* proj = (const bf16*)(P.ws + WS_BIG); bf16* QKV = (bf16*)(P.ws + WS_QKV);
    const float* cw = P.in[15] + (size_t)j * 5 * 8192;
    for (int it = gw; it < 16 * 128; it += NGW) {
        const int cg = it & 15, chunk = it >> 4, c = cg * 512 + lane * 8;
        float w[5][8];
#pragma unroll
        for (int s = 0; s < 5; ++s) { const f32x4 a = *(const f32x4*)(cw + s * 8192 + c), b = *(const f32x4*)(cw + s * 8192 + c + 4);
            w[s][0] = a.x; w[s][1] = a.y; w[s][2] = a.z; w[s][3] = a.w; w[s][4] = b.x; w[s][5] = b.y; w[s][6] = b.z; w[s][7] = b.w; }
        const float qsc = cg < 4 ? 0.08838834764831845f : 1.f;
        for (int bt = 0; bt < 16; ++bt) {
            const int r0 = chunk * 128 + bt * 8;
            const int L = r0 < MCTX ? 256 : 64, pos0 = r0 < MCTX ? (r0 & 255) : ((r0 - MCTX) & 63);
            u32x4 xw[12];
#pragma unroll
            for (int i = 0; i < 12; ++i) { const int pp = pos0 + i - 2;
                xw[i] = (pp >= 0 && pp < L) ? *(const u32x4*)(proj + (size_t)(r0 + i - 2) * DN_NMAIN + c) : (u32x4){0u, 0u, 0u, 0u}; }
#pragma unroll
            for (int o = 0; o < 8; ++o) {
                float acc[8];
#pragma unroll
                for (int i = 0; i < 8; ++i) acc[i] = 0.f;
#pragma unroll
                for (int s = 0; s < 5; ++s) { const u32x4 x = xw[o + s];
                    acc[0] += bflo(x.x) * w[s][0]; acc[1] += bfhi(x.x) * w[s][1]; acc[2] += bflo(x.y) * w[s][2]; acc[3] += bfhi(x.y) * w[s][3];
                    acc[4] += bflo(x.z) * w[s][4]; acc[5] += bfhi(x.z) * w[s][5]; acc[6] += bflo(x.w) * w[s][6]; acc[7] += bfhi(x.w) * w[s][7]; }
                float ss = 0.f;
#pragma unroll
                for (int i = 0; i < 8; ++i) { acc[i] = siluf_(acc[i]); ss += acc[i] * acc[i]; }
                if (cg < 8) {
                    ss += __shfl_xor(ss, 1); ss += __shfl_xor(ss, 2); ss += __shfl_xor(ss, 4); ss += __shfl_xor(ss, 8);
                    const float sc = rsqrtf(ss + EPS) * qsc;
#pragma unroll
                    for (int i = 0; i < 8; ++i) acc[i] *= sc;
                }
                u32x4 ov; ov.x = pk2(acc[0], acc[1]); ov.y = pk2(acc[2], acc[3]); ov.z = pk2(acc[4], acc[5]); ov.w = pk2(acc[6], acc[7]);
                *(u32x4*)(QKV + (size_t)(r0 + o) * 8192 + c) = ov;
            }
        }
    }
    if (!do_gates) return;
    float* G = (float*)(P.ws + WS_GATE);
    const float* Alog = P.in[16] + j * 64; const float* dtb = P.in[17] + j * 64;
    const float* GPp = (const float*)(P.ws + WS_GP);
    for (int i = gw * 64 + lane; i < MROWS * 128; i += NGW * 64) {
        const int col = i & 127; const float x = (GPp[i] + GPp[i + (size_t)MROWS * 128]) + (GPp[i + (size_t)2 * MROWS * 128] + GPp[i + (size_t)3 * MROWS * 128]); float y;
        if (col < 64) y = sigmoidf_(x);
        else { const int dh = col - 64; y = -__expf(Alog[dh]) * softplusf_(x + dtb[dh]); }
        G[i] = y;
    }
}

typedef short bf16x8 __attribute__((ext_vector_type(8)));
typedef short s16x4 __attribute__((ext_vector_type(4)));
typedef __bf16 bfv8 __attribute__((ext_vector_type(8)));
typedef float f32x8 __attribute__((ext_vector_type(8)));
__device__ __forceinline__ bf16x8 pack8(f32x4 a, f32x4 b) { const f32x8 v = {a[0], a[1], a[2], a[3], b[0], b[1], b[2], b[3]}; return __builtin_bit_cast(bf16x8, __builtin_convertvector(v, bfv8)); }
__device__ __forceinline__ bf16x8 cat4(s16x4 a, s16x4 b) { return (bf16x8){a[0], a[1], a[2], a[3], b[0], b[1], b[2], b[3]}; }
__device__ __forceinline__ s16x4 ld_tr(const LAS unsigned char* p) { return __builtin_amdgcn_ds_read_tr16_b64_v4i16((LAS s16x4*)p); }
__device__ __forceinline__ s16x4 ld_b64(const LAS unsigned char* p) { return *(const volatile LAS s16x4*)p; }
__device__ __forceinline__ bf16x8 ld_b128(const LAS unsigned char* p) { return *(const LAS bf16x8*)p; }
#define MFMA16(a, b, c) __builtin_amdgcn_mfma_f32_16x16x32_bf16((a), (b), (c), 0, 0, 0)

template <int KIND> __device__ __forceinline__ void gla_prep_phase(const Params& P, LAS unsigned char* lds) {
    PHASE_IDS();
    constexpr int NCH = KIND == 1 ? 1024 : 2048, LDP = KIND == 1 ? GLA_NMAIN : HG_NIN, NCB = NCH / 1024;
    const bf16* proj = (const bf16*)(P.ws + WS_BIG); const float* G = (const float*)(P.ws + WS_GATE);
    bf16* QT = (bf16*)(P.ws + WS_QKV); bf16* KT = QT + (size_t)2 * MROWS * NCH; float* E = (float*)(P.ws + WS_OF + 64 * MiB);
    constexpr int DKH = KIND == 1 ? 256 : 128, NHB = 1024 / DKH  , NHT = NCH / DKH  , PL = 2064  ;
    LAS unsigned char* QL = lds; LAS unsigned char* KL = lds + 32 * PL;
    LAS float* sa1 = (LAS float*)(lds + 2 * 32 * PL);
    unsigned* PG = (unsigned*)(P.ws + WS_OF + 72 * MiB);
    for (int it = blockIdx.x; it < 2 * 512 * NCB; it += gridDim.x) {
        const int cb_ = it % NCB, cidx = (it / NCB) % 512, d = it / (NCB * 512);
        const int c0 = cb_ * 1024 + 2 * tid, rbase = cidx * 32;
        float w0[16], w1[16], b0 = 0.f, b1 = 0.f, lb0 = 0.f, lb1 = 0.f;
        if (KIND == 1) {
            __syncthreads();
            { const int p = tid >> 4, r = tid & 15; const int row = rbase + (d ? 31 - p : p); const size_t gi = (size_t)row * 128 + d * 16 + r; const float* GPp = (const float*)(P.ws + WS_GP); sa1[tid] = (GPp[gi] + GPp[gi + (size_t)MROWS * 128]) + (GPp[gi + (size_t)2 * MROWS * 128] + GPp[gi + (size_t)3 * MROWS * 128]); }
            __syncthreads();
            const float* w2 = P.in[21] + (size_t)d * 16 * 1024 + c0;
#pragma unroll
            for (int r = 0; r < 16; ++r) { w0[r] = w2[(size_t)r * 1024]; w1[r] = w2[(size_t)r * 1024 + 1]; }
            b0 = P.in[22][d * 1024 + c0]; b1 = P.in[22][d * 1024 + c0 + 1];
        } else {
            const float* lg = P.in[26];
            { const float l0 = lg[c0], l1 = lg[2048 + c0], l2 = lg[4096 + c0], l3 = lg[6144 + c0]; const float mx = fmaxf(fmaxf(l0, l1), fmaxf(l2, l3));
              const float e0 = __expf(l0 - mx), e1 = __expf(l1 - mx), e2 = __expf(l2 - mx), e3 = __expf(l3 - mx); lb0 = (e1 + e2) / ((e0 + e1) + (e2 + e3)); }
            { const float l0 = lg[c0 + 1], l1 = lg[2048 + c0 + 1], l2 = lg[4096 + c0 + 1], l3 = lg[6144 + c0 + 1]; const float mx = fmaxf(fmaxf(l0, l1), fmaxf(l2, l3));
              const float e0 = __expf(l0 - mx), e1 = __expf(l1 - mx), e2 = __expf(l2 - mx), e3 = __expf(l3 - mx); lb1 = (e1 + e2) / ((e0 + e1) + (e2 + e3)); }
        }
        float cs0 = KIND == 1 ? 0.f : 1.f, cs1 = cs0;
        constexpr int XOFF_G = 1024;
        const int xoff = KIND == 1 ? XOFF_G : (d ? 8192 : 6144);
        unsigned nq[8], nx[8];
#define GP_LOAD(pb_) do { _Pragma("unroll") for (int u = 0; u < 8; ++u) { const int pp_ = (pb_) + u; const bf16* pr_ = proj + (size_t)(rbase + (d ? 31 - pp_ : pp_)) * LDP + c0; nq[u] = *(const unsigned*)pr_; nx[u] = *(const unsigned*)(pr_ + xoff); } } while (0)
        GP_LOAD(0);
#pragma unroll 1
        for (int pb8 = 0; pb8 < 32; pb8 += 8) {
          unsigned cq[8], cx[8];
#pragma unroll
          for (int u = 0; u < 8; ++u) { cq[u] = nq[u]; cx[u] = nx[u]; }
          { const int pn = pb8 + 8 < 32 ? pb8 + 8 : pb8; GP_LOAD(pn); }
#pragma unroll
          for (int u = 0; u < 8; ++u) {
            const int p = pb8 + u;
            const int row = rbase + (d ? 31 - p : p);
            float q0, q1, k0, k1, la0, la1;
            if (KIND == 1) {
                const unsigned qw = cq[u], kw = cx[u];
                q0 = bflo(qw) * 0.0625f; q1 = bfhi(qw) * 0.0625f; k0 = bflo(kw); k1 = bfhi(kw);
                float x0 = b0, x1 = b1;
#pragma unroll
                for (int r = 0; r < 16; ++r) { const float a = sa1[p * 16 + r]; x0 = __builtin_fmaf(a, w0[r], x0); x1 = __builtin_fmaf(a, w1[r], x1); }
                la0 = (fminf(x0, 0.f) - 0.6931471805599453f * __builtin_amdgcn_logf(1.f + __expf(-fabsf(x0)))) * 0.0625f; la1 = (fminf(x1, 0.f) - 0.6931471805599453f * __builtin_amdgcn_logf(1.f + __expf(-fabsf(x1)))) * 0.0625f;
            } else {
                const unsigned qw = cq[u], fw = cx[u];
                q0 = siluf_(bflo(qw)) * 0.08838834764831845f; q1 = siluf_(bfhi(qw)) * 0.08838834764831845f;
                const float a0 = lb0 + (1.f - lb0) * sigmoidf_(bflo(fw)), a1 = lb1 + (1.f - lb1) * sigmoidf_(bfhi(fw));
                k0 = 1.f - a0; k1 = 1.f - a1; la0 = a0; la1 = a1;
            }
            float e0, e1, i0, i1;
            if (KIND == 1) { cs0 += la0; cs1 += la1; e0 = __expf(cs0); e1 = __expf(cs1); i0 = __builtin_amdgcn_rcpf(e0); i1 = __builtin_amdgcn_rcpf(e1); }
            else { cs0 *= la0; cs1 *= la1; e0 = cs0; e1 = cs1; i0 = __builtin_amdgcn_rcpf(cs0); i1 = __builtin_amdgcn_rcpf(cs1); }
            const size_t o = ((size_t)d * MROWS + row) * NCH + c0;
            const unsigned qb = pk2(q0 * e0, q1 * e1), kb = pk2(k0 * i0, k1 * i1);
            *(unsigned*)(QT + o) = qb; *(unsigned*)(KT + o) = kb;
            *(LAS unsigned*)(QL + p * PL + 4 * tid) = qb; *(LAS unsigned*)(KL + p * PL + 4 * tid) = kb;
          }
        }
#undef GP_LOAD
        { float* e = E + ((size_t)d * 512 + cidx) * NCH + c0; e[0] = KIND == 1 ? __expf(cs0) : cs0; e[1] = KIND == 1 ? __expf(cs1) : cs1; }
        __syncthreads();
        {
            const int r = lane & 15, g = lane >> 4;
            const int hl = KIND == 1 ? (wave >> 1) : wave; const int cbase = hl * DKH;
            f32x4 t0 = {0.f, 0.f, 0.f, 0.f}, t1 = t0, t2 = t0;
            const bool do02 = KIND == 1 ? ((wave & 1) == 0) : true, do1 = KIND == 1 ? ((wave & 1) == 1) : true;
#pragma unroll
            for (int sx = 0; sx < DKH / 32; ++sx) {
                const int cb2 = (cbase + 32 * sx + 8 * g) * 2;
                const bf16x8 k0 = ld_b128(KL + r * PL + cb2), q1 = ld_b128(QL + (16 + r) * PL + cb2);
                if (do02) { const bf16x8 q0 = ld_b128(QL + r * PL + cb2), k1 = ld_b128(KL + (16 + r) * PL + cb2); t0 = MFMA16(k0, q0, t0); t2 = MFMA16(k1, q1, t2); }
                if (do1) t1 = MFMA16(k0, q1, t1);
            }
#pragma unroll
            for (int e = 0; e < 4; ++e) { if (r < 4 * g + e) { t0[e] = 0.f; t2[e] = 0.f; } }
            unsigned* pg = PG + (((size_t)d * 512 + cidx) * NHT + cb_ * NHB + hl) * 384 + lane * 2;
            if (do02) { pg[0] = pk2(t0[0], t0[1]); pg[1] = pk2(t0[2], t0[3]); pg[256] = pk2(t2[0], t2[1]); pg[257] = pk2(t2[2], t2[3]); }
            if (do1) { pg[128] = pk2(t1[0], t1[1]); pg[129] = pk2(t1[2], t1[3]); }
        }
        __syncthreads();
    }
}

template <int KIND> __device__ __forceinline__ void gla_chunk_phase(const Params& P, LAS unsigned char* lds) {
    PHASE_IDS();
    constexpr int DK = KIND == 1 ? 256 : 128, DV = KIND == 1 ? 512 : 128, NH = KIND == 1 ? 4 : 16, NSL = DV / 128, NKT = DK / 16, NCH = NH * DK;
    constexpr int LDP = KIND == 1 ? GLA_NMAIN : HG_NIN, W = 2048;
    constexpr int PQ = DK * 2 + 16, PV = 256 + 16;
    constexpr int OFF_Q = 0, OFF_K = 32 * PQ, OFF_V = 2 * 32 * PQ, OFF_E = OFF_V + 32 * PV;
    constexpr int NPQ = 32 * DK / 8 / NT;
    const bf16* proj = (const bf16*)(P.ws + WS_BIG);
    const bf16* QT = (const bf16*)(P.ws + WS_QKV); const bf16* KT = QT + (size_t)2 * MROWS * NCH; const float* Eg = (const float*)(P.ws + WS_OF + 64 * MiB);
    bf16* OF = (bf16*)(P.ws + WS_OF); bf16* OB = (bf16*)(P.ws + WS_OB);
    const u32x2* PG = (const u32x2*)(P.ws + WS_OF + 72 * MiB);
    const int r = lane & 15, g = lane >> 4, q4 = (lane & 15) >> 2, p4 = lane & 3;
    constexpr int UL = 4 * NH * 2 * NSL  , UC = 32 * NH * 2 * NSL  ;
    const int G = gridDim.x, bx = blockIdx.x;
    const bool bal = (G == 2 * UL);
    const int nun = bal ? (bx < UL ? 1 : UC / UL) : (UL + UC - bx + G - 1) / G;
    for (int ui = 0; ui < nun; ++ui) {
        const int bxl = bx < UL ? bx : bx - UL;
        const int bxq = (bal && NSL == 4) ? (((bxl & 7) + 8 * (bxl >> 5)) * 4 + ((bxl >> 3) & 3)) : bxl;
        const int unit = bal ? (bx < UL ? bxq : UL + bxq + UL * ui) : bx + ui * G;
        const bool lat = unit < UL; int u2 = lat ? unit : unit - UL;
        const int sl = u2 % NSL; u2 /= NSL; const int d = u2 & 1; u2 >>= 1; const int h = u2 % NH; const int b = u2 / NH;
        const int T = lat ? 2048 : 256, row0 = lat ? MCTX + b * 2048 : b * 256, nchunk = T / 32;
        bf16* O = d ? OB : OF;
        f32x4 S[NKT];
        { const float* s0 = (KIND == 1 ? P.in[4] : P.in[5]) + ((((size_t)b * 2 + d) * NH + h) * DK) * DV + sl * 128 + 16 * wave + r;
#pragma unroll
          for (int kt = 0; kt < NKT; ++kt)
#pragma unroll
              for (int e = 0; e < 4; ++e) S[kt][e] = lat ? s0[(size_t)(16 * kt + 4 * g + e) * DV] : 0.f; }
        u32x4 rq[NPQ], rk[NPQ], rv; f32x4 re = {0.f, 0.f, 0.f, 0.f}; u32x2 rp0 = {0u, 0u}, rp1 = rp0, rp2 = rp0;
#define GLC_PREFETCH(c_) do { \
            _Pragma("unroll") for (int x = 0; x < NPQ; ++x) { const int pi = tid + x * NT, pr = pi / (DK / 8), pc = pi % (DK / 8); const int pp = (c_) * 32 + pr; const int t = d ? T - 1 - pp : pp; \
                const size_t o = ((size_t)d * MROWS + row0 + t) * NCH + h * DK + pc * 8; rq[x] = *(const u32x4*)(QT + o); rk[x] = *(const u32x4*)(KT + o); } \
            { const int pr = tid >> 4, pc = tid & 15; const int pp = (c_) * 32 + pr; const int t = d ? T - 1 - pp : pp; rv = *(const u32x4*)(proj + (size_t)(row0 + t) * LDP + 2048 + h * DV + sl * 128 + pc * 8); } \
            { const int cg = d ? (row0 + T) / 32 - 1 - (c_) : row0 / 32 + (c_); if (tid < DK / 4) re = *(const f32x4*)(Eg + ((size_t)d * 512 + cg) * NCH + h * DK + tid * 4); \
              const u32x2* pg = PG + (((size_t)d * 512 + cg) * NH + h) * 192 + lane; rp0 = pg[0]; rp1 = pg[64]; rp2 = pg[128]; } } while (0)
        GLC_PREFETCH(0);
        for (int c = 0; c < nchunk; ++c) {
            __syncthreads();
#pragma unroll
            for (int x = 0; x < NPQ; ++x) { const int pi = tid + x * NT, pr = pi / (DK / 8), pc = pi % (DK / 8);
                *(LAS u32x4*)(lds + OFF_Q + pr * PQ + pc * 16) = rq[x]; *(LAS u32x4*)(lds + OFF_K + pr * PQ + pc * 16) = rk[x]; }
            { const int pr = tid >> 4, pc = tid & 15; *(LAS u32x4*)(lds + OFF_V + pr * PV + pc * 16) = rv; }
            if (tid < DK / 4) *(LAS f32x4*)(lds + OFF_E + tid * 16) = re;
            __syncthreads();
            const u32x2 cp0 = rp0, cp1 = rp1, cp2 = rp2;
            if (c + 1 < nchunk) GLC_PREFETCH(c + 1);
            const f32x4 zero4 = {0.f, 0.f, 0.f, 0.f};
            const bf16x8 vpa = cat4(ld_tr(lds + OFF_V + (4 * g + q4) * PV + (16 * wave + 4 * p4) * 2), ld_tr(lds + OFF_V + (16 + 4 * g + q4) * PV + (16 * wave + 4 * p4) * 2));
            const bf16x8 pb0 = __builtin_bit_cast(bf16x8, (u32x4){cp0.x, cp0.y, 0u, 0u}), pb1 = __builtin_bit_cast(bf16x8, (u32x4){cp1.x, cp1.y, cp2.x, cp2.y});
            f32x4 o0 = MFMA16(vpa, pb0, zero4), o1 = MFMA16(vpa, pb1, zero4);
#pragma unroll
            for (int s = 0; s < DK / 32; ++s) {
                const bf16x8 sb = pack8(S[2 * s], S[2 * s + 1]);
                const bf16x8 a0 = cat4(ld_b64(lds + OFF_Q + r * PQ + (32 * s + 4 * g) * 2), ld_b64(lds + OFF_Q + r * PQ + (32 * s + 16 + 4 * g) * 2));
                const bf16x8 a1 = cat4(ld_b64(lds + OFF_Q + (16 + r) * PQ + (32 * s + 4 * g) * 2), ld_b64(lds + OFF_Q + (16 + r) * PQ + (32 * s + 16 + 4 * g) * 2));
                o0 = MFMA16(sb, a0, o0); o1 = MFMA16(sb, a1, o1);
                if (KIND == 1 && (s & 3) == 3) asm volatile("" ::: "memory");
            }
            { const int colo = h * DV + sl * 128 + 16 * wave + 4 * g; const int pp0 = c * 32 + r, pp1 = c * 32 + 16 + r; const int t0 = d ? T - 1 - pp0 : pp0, t1 = d ? T - 1 - pp1 : pp1;
              u32x2 w0, w1; w0.x = pk2(o0[0], o0[1]); w0.y = pk2(o0[2], o0[3]); w1.x = pk2(o1[0], o1[1]); w1.y = pk2(o1[2], o1[3]);
              *(u32x2*)(O + (size_t)(row0 + t0) * W + colo) = w0; *(u32x2*)(O + (size_t)(row0 + t1) * W + colo) = w1; }
            const bf16x8 vb = cat4(ld_tr(lds + OFF_V + (8 * g + q4) * PV + (16 * wave + 4 * p4) * 2), ld_tr(lds + OFF_V + (8 * g + 4 + q4) * PV + (16 * wave + 4 * p4) * 2));
#pragma unroll
            for (int kt = 0; kt < NKT; ++kt) {
                const bf16x8 ka = cat4(ld_tr(lds + OFF_K + (8 * g + q4) * PQ + (16 * kt + 4 * p4) * 2), ld_tr(lds + OFF_K + (8 * g + 4 + q4) * PQ + (16 * kt + 4 * p4) * 2));
                const f32x4 ev = *(const LAS f32x4*)(lds + OFF_E + (16 * kt + 4 * g) * 4);
                S[kt] = MFMA16(ka, vb, S[kt]) * ev;
                if (KIND == 1 && (kt & 7) == 7) asm volatile("" ::: "memory");
            }
        }
#undef GLC_PREFETCH
        if (!lat) { float* sd = P.out + (KIND == 1 ? OUT_SGLA : OUT_SHG) + ((((size_t)b * 2 + d) * NH + h) * DK) * DV + sl * 128 + 16 * wave + r;
#pragma unroll
            for (int kt = 0; kt < NKT; ++kt)
#pragma unroll
                for (int e = 0; e < 4; ++e) sd[(size_t)(16 * kt + 4 * g + e) * DV] = S[kt][e]; }
    }
}

#define MFMA4F(a, b, c) __builtin_amdgcn_mfma_f32_16x16x4f32((a), (b), (c), 0, 0, 0)
template <int I> __device__ __forceinline__ float row_share(float v) { return __builtin_bit_cast(float, __builtin_amdgcn_mov_dpp(__builtin_bit_cast(int, v), 0x150 + I, 0xf, 0xf, false)); }
template <int I> struct DiagStep {
    static __device__ __forceinline__ void run(const float (&Ld)[16], float (&x)[16], int cc) {
        DiagStep<I - 1>::run(Ld, x, cc);
        float a0 = 0.f, a1 = 0.f;
#pragma unroll
        for (int m = 0; m < I; ++m) { const float lv = row_share<I>(Ld[m]); if (m & 1) a1 += lv * x[m]; else a0 += lv * x[m]; }
        x[I] = ((I == cc) ? 1.f : 0.f) - (a0 + a1);
    }
};
template <> struct DiagStep<-1> { static __device__ __forceinline__ void run(const float (&)[16], float (&)[16], int) {} };
__device__ __forceinline__ void dn_wu_prep_phase(const Params& P, LAS unsigned char* lds) {
    PHASE_IDS();
    constexpr int PKQ = 272;
    constexpr int LP = 68;
    constexpr int OFF_K = 0, OFF_Q = 64 * PKQ, OFF_L = 0  , OFF_KK = 4 * 64 * LP * 4, OFF_QK = OFF_KK + 64 * LP * 4, OFF_G = OFF_QK + 64 * LP * 4;
    const bf16* QKV = (const bf16*)(P.ws + WS_QKV); const float* G = (const float*)(P.ws + WS_GATE);
    bf16* TA = (bf16*)(P.ws + WS_TA); float* GS = (float*)(P.ws + WS_GS);
    const int r = lane & 15, g = lane >> 4;
    LAS float* KKs = (LAS float*)(lds + OFF_KK); LAS float* QKs = (LAS float*)(lds + OFF_QK); LAS float* Gs = (LAS float*)(lds + OFF_G);
    u32x4 pq[2], pk[2]; float pgv = 0.f;
#define WU_PREFETCH(grp_) do { const int cidx_ = (grp_) >> 4, kh_ = (grp_) & 15, rb_ = cidx_ * 64; \
        _Pragma("unroll") for (int x = 0; x < 2; ++x) { const int pi = tid + x * NT, pr = pi >> 4, pc = pi & 15; const size_t o = (size_t)(rb_ + pr) * 8192 + kh_ * 128 + pc * 8; pq[x] = *(const u32x4*)(QKV + o); pk[x] = *(const u32x4*)(QKV + o + 2048); } \
        { const int c4 = tid >> 7, which = (tid >> 6) & 1, i = tid & 63, hv = c4 >> 1, d = c4 & 1, h = 2 * kh_ + hv; pgv = G[(size_t)(rb_ + i) * 128 + (which ? 0 : 64) + d * 32 + h]; } } while (0)
    if ((int)blockIdx.x < 256 * 16) WU_PREFETCH(blockIdx.x);
    for (int grp = blockIdx.x; grp < 256 * 16; grp += gridDim.x) {
        const int cidx = grp >> 4, kh = grp & 15;
        __syncthreads();
#pragma unroll
        for (int x = 0; x < 2; ++x) { const int pi = tid + x * NT, pr = pi >> 4, pc = pi & 15;
            *(LAS u32x4*)(lds + OFF_Q + pr * PKQ + pc * 16) = pq[x]; *(LAS u32x4*)(lds + OFF_K + pr * PKQ + pc * 16) = pk[x]; }
        Gs[tid] = pgv;
        __syncthreads();
        if (grp + (int)gridDim.x < 256 * 16) WU_PREFETCH(grp + (int)gridDim.x);
        {
            const int it = wave & 3; const int offx = (wave >> 2) ? OFF_Q : OFF_K; LAS float* dst = (wave >> 2) ? QKs : KKs;
            f32x4 acc[4];
#pragma unroll
            for (int jt = 0; jt < 4; ++jt) acc[jt] = (f32x4){0.f, 0.f, 0.f, 0.f};
#pragma unroll
            for (int sx = 0; sx < 4; ++sx) { const bf16x8 a = ld_b128(lds + offx + (16 * it + r) * PKQ + (32 * sx + 8 * g) * 2);
#pragma unroll
                for (int jt = 0; jt < 4; ++jt) acc[jt] = MFMA16(a, ld_b128(lds + OFF_K + (16 * jt + r) * PKQ + (32 * sx + 8 * g) * 2), acc[jt]); }
#pragma unroll
            for (int jt = 0; jt < 4; ++jt)
#pragma unroll
                for (int e = 0; e < 4; ++e) dst[(16 * it + 4 * g + e) * LP + 16 * jt + r] = acc[jt][e];
        }
        __syncthreads();
        {
            const int c4 = wave & 3, hv = c4 >> 1, d = c4 & 1, h = 2 * kh + hv;
            const int nl = d ? 63 - lane : lane;
            float gcv = Gs[(c4 * 2 + 0) * 64 + nl];
#pragma unroll
            for (int o = 1; o < 64; o <<= 1) { const float t = __shfl_up(gcv, o); if (lane >= o) gcv += t; }
            const float betav = Gs[(c4 * 2 + 1) * 64 + nl];
            const size_t item = ((size_t)(cidx * 32 + h) * 2 + d);
            LAS float* W = (LAS float*)(lds + OFF_L) + c4 * 64 * LP;
            {
                bf16* Ag = TA + item * 8192 + 4096;
                const int pb = (wave >> 2) * 32;
#define WU_LA_TRIPS(REV_) \
                _Pragma("unroll 1") for (int p0 = pb; p0 < pb + 32; p0 += 8) { \
                    const LAS float* kb_ = KKs + ((REV_) ? 56 - p0 : p0) * LP + nl; const LAS float* qb_ = QKs + ((REV_) ? 56 - p0 : p0) * LP + nl; \
                    LAS float* wb_ = W + p0 * LP + lane; bf16* ab_ = Ag + p0 * 64 + lane; const int lrel_ = lane - p0; \
                    float kkv[8], qkv[8]; \
                    _Pragma("unroll") for (int u = 0; u < 8; ++u) { kkv[u] = kb_[((REV_) ? 7 - u : u) * LP]; qkv[u] = qb_[((REV_) ? 7 - u : u) * LP]; } \
                    _Pragma("unroll") for (int u = 0; u < 8; ++u) { const int p = p0 + u; const float gp = rdlane(gcv, p), bp = rdlane(betav, p); const float ex = __expf(gp - gcv); \
                        float lv = bp * kkv[u] * ex, av = qkv[u] * ex; \
                        asm volatile("" : "+v"(lv), "+v"(av)); \
                        wb_[u * LP] = lrel_ < u ? lv : 0.f; \
                        ab_[u * 64] = (bf16)f2bf(lrel_ <= u ? av : 0.f); } \
                }
                if (d) { WU_LA_TRIPS(1) } else { WU_LA_TRIPS(0) }
#undef WU_LA_TRIPS
            }
            if (wave >= 4) {
                float* gs = GS + item * 192; const float gend = rdlane(gcv, 63);
                gs[lane] = __expf(gcv); gs[64 + lane] = betav; gs[128 + lane] = __expf(gend - gcv);
            }
            __syncthreads();
            if (wave < 4) {
                {
                    const int lane2 = opaque_v(lane); const int bb = lane2 >> 4, cc = lane2 & 15;
                    float Ld[16];
#pragma unroll
                    for (int m4 = 0; m4 < 4; ++m4) { const f32x4 v = *(const LAS f32x4*)(W + (16 * bb + cc) * LP + 16 * bb + 4 * m4); Ld[4 * m4] = v[0]; Ld[4 * m4 + 1] = v[1]; Ld[4 * m4 + 2] = v[2]; Ld[4 * m4 + 3] = v[3]; }
                    float x[16];
                    DiagStep<15>::run(Ld, x, cc);
#pragma unroll
                    for (int i = 0; i < 16; ++i) W[(16 * bb + i) * LP + 16 * bb + cc] = x[i];
                }
#define WU_PN(ar, ac, br, bc, acc_) do { _Pragma("unroll") for (int sx = 0; sx < 4; ++sx) acc_ = MFMA4F(W[((ar) + r) * LP + (ac) + 4 * sx + g], W[((br) + 4 * sx + g) * LP + (bc) + r], acc_); } while (0)
#define WU_PA(ar, ac, M_, acc_) do { _Pragma("unroll") for (int e = 0; e < 4; ++e) acc_ = MFMA4F(W[((ar) + r) * LP + (ac) + 4 * g + e], M_[e], acc_); } while (0)
#define WU_ST(r0, c0, acc_) do { _Pragma("unroll") for (int e = 0; e < 4; ++e) W[((r0) + 4 * g + e) * LP + (c0) + r] = -acc_[e]; } while (0)
                const f32x4 z4 = {0.f, 0.f, 0.f, 0.f};
                { f32x4 m1a = z4, m1b = z4; WU_PN(16, 0, 0, 0, m1a); WU_PN(48, 32, 32, 32, m1b);
                  f32x4 t10 = z4, t32 = z4; WU_PA(16, 16, m1a, t10); WU_PA(48, 48, m1b, t32);
                  WU_ST(16, 0, t10); WU_ST(48, 32, t32); }
                { f32x4 m00 = z4, m01 = z4, m10 = z4, m11 = z4;
                  WU_PN(32, 0, 0, 0, m00); WU_PN(32, 16, 16, 0, m00); WU_PN(32, 16, 16, 16, m01);
                  WU_PN(48, 0, 0, 0, m10); WU_PN(48, 16, 16, 0, m10); WU_PN(48, 16, 16, 16, m11);
                  f32x4 t00 = z4, t01 = z4, t10 = z4, t11 = z4;
                  WU_PA(32, 32, m00, t00); WU_PA(32, 32, m01, t01);
                  WU_PA(48, 32, m00, t10); WU_PA(48, 48, m10, t10); WU_PA(48, 32, m01, t11); WU_PA(48, 48, m11, t11);
                  WU_ST(32, 0, t00); WU_ST(32, 16, t01); WU_ST(48, 0, t10); WU_ST(48, 16, t11); }
#undef WU_PN
#undef WU_PA
#undef WU_ST
                bf16* Tg = TA + item * 8192;
#pragma unroll
                for (int x8 = 0; x8 < 8; ++x8) { const int piece = lane + 64 * x8, row = piece >> 3, pc = piece & 7;
                    const f32x4 v0 = *(const LAS f32x4*)(W + row * LP + pc * 8), v1 = *(const LAS f32x4*)(W + row * LP + pc * 8 + 4);
                    u32x4 o; o.x = pk2(v0[0], v0[1]); o.y = pk2(v0[2], v0[3]); o.z = pk2(v1[0], v1[1]); o.w = pk2(v1[2], v1[3]);
                    if (pc * 8 <= row) *(u32x4*)(Tg + row * 64 + pc * 8) = o; }
            }
        }
    }
#undef WU_PREFETCH
}

constexpr int DN_PQ = 272;
constexpr int DN_PXQ = 144, DN_XQ = 64 * DN_PXQ, DN_PXT = 80, DN_XT = 64 * DN_PXT;
constexpr int DN_OFF_Q = 0, DN_OFF_K = 2 * DN_XQ, DN_OFF_V = DN_OFF_K + 64 * DN_PQ, DN_OFF_T = DN_OFF_V + 64 * DN_PQ, DN_OFF_A = DN_OFF_T + 2 * DN_XT, DN_OFF_S = DN_OFF_A + 2 * DN_XT;
struct DnStage { u32x4 rq[2], rk[2], rv[2], rt, ra; f32x4 rs; };
__device__ __forceinline__ void dn_stage_load(DnStage& st, const bf16* QKV, const bf16* TA, const float* GS, int tid, int c, int d, int T, int row0, int kh, int h, int nchunk) {
#pragma unroll
    for (int x = 0; x < 2; ++x) { const int pi = tid + x * NT, pr = pi >> 4, pc = pi & 15; const int pp = c * 64 + pr; const int t = d ? T - 1 - pp : pp;
        const size_t o = (size_t)(row0 + t) * 8192 + pc * 8; st.rq[x] = *(const u32x4*)(QKV + o + kh * 128); st.rk[x] = *(const u32x4*)(QKV + o + 2048 + kh * 128); st.rv[x] = *(const u32x4*)(QKV + o + 4096 + h * 128); }
    const int nc = d ? nchunk - 1 - c : c; const size_t item = ((size_t)((row0 >> 6) + nc) * 32 + h) * 2 + d;
    const bool nz = ((tid & 7) * 8) <= (tid >> 3);
    st.rt = nz ? *(const u32x4*)(TA + item * 8192 + tid * 8) : (u32x4){0u, 0u, 0u, 0u}; st.ra = nz ? *(const u32x4*)(TA + item * 8192 + 4096 + tid * 8) : (u32x4){0u, 0u, 0u, 0u};
    st.rs = (f32x4){0.f, 0.f, 0.f, 0.f}; if (tid < 48) st.rs = *(const f32x4*)(GS + item * 192 + tid * 4);
}
__device__ __forceinline__ void dn_stage_store(const DnStage& st, LAS unsigned char* lds, int tid) {
#pragma unroll
    for (int x = 0; x < 2; ++x) { const int pi = tid + x * NT, pr = pi >> 4, pc = pi & 15;
        { LAS unsigned char* qd = lds + DN_OFF_Q + pr * DN_PXQ + (2 * (pc >> 2) + (pc & 1)) * 16 + ((pc >> 1) & 1) * 8;
          *(LAS u32x2*)qd = (u32x2){st.rq[x].x, st.rq[x].y}; *(LAS u32x2*)(qd + DN_XQ) = (u32x2){st.rq[x].z, st.rq[x].w}; }
        *(LAS u32x4*)(lds + DN_OFF_K + pr * DN_PQ + pc * 16) = st.rk[x]; *(LAS u32x4*)(lds + DN_OFF_V + pr * DN_PQ + pc * 16) = st.rv[x]; }
    { const int pr = tid >> 3, pc = tid & 7; const int o = pr * DN_PXT + (2 * (pc >> 2) + (pc & 1)) * 16 + ((pc >> 1) & 1) * 8;
      *(LAS u32x2*)(lds + DN_OFF_T + o) = (u32x2){st.rt.x, st.rt.y}; *(LAS u32x2*)(lds + DN_OFF_T + o + DN_XT) = (u32x2){st.rt.z, st.rt.w};
      *(LAS u32x2*)(lds + DN_OFF_A + o) = (u32x2){st.ra.x, st.ra.y}; *(LAS u32x2*)(lds + DN_OFF_A + o + DN_XT) = (u32x2){st.ra.z, st.ra.w}; }
    if (tid < 48) *(LAS f32x4*)(lds + DN_OFF_S + tid * 16) = st.rs;
}
__device__ __forceinline__ void dn_step_compute(f32x4 (&S)[8], LAS unsigned char* lds, bf16* O, int c, int d, int T, int row0, int h, int wave, int lane) {
    constexpr int PQ = DN_PQ, OFF_Q = DN_OFF_Q, OFF_K = DN_OFF_K, OFF_V = DN_OFF_V, OFF_T = DN_OFF_T, OFF_A = DN_OFF_A, OFF_S = DN_OFF_S;
    const int r = lane & 15, g = lane >> 4, q4 = (lane & 15) >> 2, p4 = lane & 3;
#define DN_PERMROW(off_, pitch_, row_, col_) cat4(ld_b64(lds + (off_) + (row_) * (pitch_) + ((col_) + 4 * g) * 2), ld_b64(lds + (off_) + (row_) * (pitch_) + ((col_) + 16 + 4 * g) * 2))
#define DN_CHUNK(off_, xsz_, pitch_, row_, sx_) ld_b128(lds + (off_) + (g & 1) * (xsz_) + (row_) * (pitch_) + (2 * (sx_) + (g >> 1)) * 16)
    const f32x4 zero4 = {0.f, 0.f, 0.f, 0.f};
    bf16x8 sb[4];
    f32x4 R[4];
    {
        bf16x8 kf[4][4];
#pragma unroll
        for (int jt = 0; jt < 4; ++jt)
#pragma unroll
            for (int sx = 0; sx < 4; ++sx) kf[jt][sx] = DN_PERMROW(OFF_K, PQ, 16 * jt + r, 32 * sx);
#pragma unroll
        for (int sx = 0; sx < 4; ++sx) sb[sx] = pack8(S[2 * sx], S[2 * sx + 1]);
#pragma unroll
        for (int jt = 0; jt < 4; ++jt) R[jt] = zero4;
#pragma unroll
        for (int sx = 0; sx < 4; ++sx)
#pragma unroll
            for (int jt = 0; jt < 4; ++jt) R[jt] = MFMA16(kf[jt][sx], sb[sx], R[jt]);
    }
    __builtin_amdgcn_sched_barrier(0);
    f32x4 U[4];
    {
        bf16x8 tf[4][2]; s16x4 vt[4]; f32x4 eg[4], bt[4];
#pragma unroll
        for (int jt = 0; jt < 4; ++jt) { vt[jt] = ld_tr(lds + OFF_V + (16 * jt + 4 * g + q4) * PQ + (16 * wave + 4 * p4) * 2);
            eg[jt] = *(const LAS f32x4*)(lds + OFF_S + (16 * jt + 4 * g) * 4); bt[jt] = *(const LAS f32x4*)(lds + OFF_S + 256 + (16 * jt + 4 * g) * 4); }
#pragma unroll
        for (int it = 0; it < 4; ++it) { tf[it][0] = DN_CHUNK(OFF_T, DN_XT, DN_PXT, 16 * it + r, 0); tf[it][1] = DN_CHUNK(OFF_T, DN_XT, DN_PXT, 16 * it + r, 1); }
#pragma unroll
        for (int jt = 0; jt < 4; ++jt)
#pragma unroll
            for (int e = 0; e < 4; ++e) R[jt][e] = bt[jt][e] * (bf2f((unsigned short)vt[jt][e]) - eg[jt][e] * R[jt][e]);
        const bf16x8 rb0 = pack8(R[0], R[1]), rb1 = pack8(R[2], R[3]);
#pragma unroll
        for (int it = 0; it < 4; ++it) U[it] = MFMA16(tf[it][0], rb0, zero4);
#pragma unroll
        for (int it = 0; it < 4; ++it) U[it] = MFMA16(tf[it][1], rb1, U[it]);
    }
    __builtin_amdgcn_sched_barrier(0);
    {
        f32x4 Ot[4];
#pragma unroll
        for (int it = 0; it < 4; ++it) Ot[it] = zero4;
#pragma unroll
        for (int hq = 0; hq < 2; ++hq) {
            bf16x8 qf[2][4];
#pragma unroll
            for (int i2 = 0; i2 < 2; ++i2)
#pragma unroll
                for (int sx = 0; sx < 4; ++sx) qf[i2][sx] = DN_CHUNK(OFF_Q, DN_XQ, DN_PXQ, 16 * (2 * hq + i2) + r, sx);
#pragma unroll
            for (int sx = 0; sx < 4; ++sx)
#pragma unroll
                for (int i2 = 0; i2 < 2; ++i2) Ot[2 * hq + i2] = MFMA16(sb[sx], qf[i2][sx], Ot[2 * hq + i2]);
        }
        bf16x8 af[4][2]; float egi[4];
#pragma unroll
        for (int it = 0; it < 4; ++it) { af[it][0] = DN_CHUNK(OFF_A, DN_XT, DN_PXT, 16 * it + r, 0); af[it][1] = DN_CHUNK(OFF_A, DN_XT, DN_PXT, 16 * it + r, 1); egi[it] = *(const LAS float*)(lds + OFF_S + (16 * it + r) * 4); }
        const bf16x8 ub0 = pack8(U[0], U[1]), ub1 = pack8(U[2], U[3]);
#pragma unroll
        for (int it = 0; it < 4; ++it) Ot[it] = Ot[it] * egi[it];
#pragma unroll
        for (int it = 0; it < 4; ++it) Ot[it] = MFMA16(ub0, af[it][0], Ot[it]);
#pragma unroll
        for (int it = 0; it < 4; ++it) Ot[it] = MFMA16(ub1, af[it][1], Ot[it]);
#pragma unroll
        for (int it = 0; it < 4; ++it) { const int pp = c * 64 + 16 * it + r; const int t = d ? T - 1 - pp : pp; u32x2 w; w.x = pk2(Ot[it][0], Ot[it][1]); w.y = pk2(Ot[it][2], Ot[it][3]);
            *(u32x2*)(O + (size_t)(row0 + t) * 4096 + h * 128 + 16 * wave + 4 * g) = w; }
    }
    __builtin_amdgcn_sched_barrier(0);
    {
#pragma unroll
        for (int jt = 0; jt < 4; ++jt) { const f32x4 dc = *(const LAS f32x4*)(lds + OFF_S + 512 + (16 * jt + 4 * g) * 4); U[jt] = U[jt] * dc; }
        const bf16x8 us0 = pack8(U[0], U[1]), us1 = pack8(U[2], U[3]);
        const float gend = *(const LAS float*)(lds + OFF_S + 63 * 4);
#pragma unroll
        for (int hk = 0; hk < 2; ++hk) {
            bf16x8 ktf[4][2];
#pragma unroll
            for (int k2 = 0; k2 < 4; ++k2) { const int kt = 4 * hk + k2;
                ktf[k2][0] = cat4(ld_tr(lds + OFF_K + (4 * g + q4) * PQ + (16 * kt + 4 * p4) * 2), ld_tr(lds + OFF_K + (16 + 4 * g + q4) * PQ + (16 * kt + 4 * p4) * 2));
                ktf[k2][1] = cat4(ld_tr(lds + OFF_K + (32 + 4 * g + q4) * PQ + (16 * kt + 4 * p4) * 2), ld_tr(lds + OFF_K + (48 + 4 * g + q4) * PQ + (16 * kt + 4 * p4) * 2)); }
#pragma unroll
            for (int k2 = 0; k2 < 4; ++k2) S[4 * hk + k2] = MFMA16(ktf[k2][0], us0, S[4 * hk + k2] * gend);
#pragma unroll
            for (int k2 = 0; k2 < 4; ++k2) S[4 * hk + k2] = MFMA16(ktf[k2][1], us1, S[4 * hk + k2]);
        }
    }
#undef DN_PERMROW
#undef DN_CHUNK
}
__device__ __forceinline__ void dn_chunk_phase(const Params& P, int j, LAS unsigned char* lds) {
    PHASE_IDS();
    const bf16* QKV = (const bf16*)(P.ws + WS_QKV); const bf16* TA = (const bf16*)(P.ws + WS_TA); const float* GS = (const float*)(P.ws + WS_GS);
    bf16* OF = (bf16*)(P.ws + WS_OF); bf16* OB = (bf16*)(P.ws + WS_OB);
    const int r = lane & 15, g = lane >> 4;
    const int bxp = (gridDim.x == 256) ? ({ const int x = blockIdx.x & 7, y = blockIdx.x >> 3, grp = x + 8 * (y >> 1), mem = y & 1; (grp >> 5) * 64 + (2 * ((grp >> 1) & 15) + mem) * 2 + (grp & 1); }) : (int)blockIdx.x;
    for (int unit0 = blockIdx.x; unit0 < 256 + 2048; unit0 += gridDim.x) {
        const int unit = (gridDim.x == 256) ? (unit0 - (int)blockIdx.x + bxp) : unit0;
        const bool lat = unit < 256; const int u2 = lat ? unit : unit - 256;
        const int b = u2 >> 6, h = (u2 >> 1) & 31, d = u2 & 1, T = lat ? 2048 : 256, row0 = lat ? MCTX + b * 2048 : b * 256, kh = h >> 1, nchunk = T / 64;
        bf16* O = d ? OB : OF;
        f32x4 S[8];
        { const float* s0 = P.in[3] + ((((size_t)b * 2 + j) * 2 + d) * 32 + h) * 128 * 128 + 16 * wave + r;
          if (lat) {
#pragma unroll
              for (int kt = 0; kt < 8; ++kt)
#pragma unroll
                  for (int e = 0; e < 4; ++e) S[kt][e] = s0[(size_t)(16 * kt + 4 * g + e) * 128];
          } else {
#pragma unroll
              for (int kt = 0; kt < 8; ++kt) S[kt] = (f32x4){0.f, 0.f, 0.f, 0.f};
          } }
        constexpr int DN_HSZ = DN_OFF_S + 768;
        DnStage sa;
        __syncthreads();
        dn_stage_load(sa, QKV, TA, GS, tid, 0, d, T, row0, kh, h, nchunk);
        dn_stage_store(sa, lds, tid);
        dn_stage_load(sa, QKV, TA, GS, tid, 1, d, T, row0, kh, h, nchunk);
        __syncthreads();
        for (int c = 0; c < nchunk; ++c) {
            LAS unsigned char* cur = lds + (c & 1) * DN_HSZ; LAS unsigned char* nxt = lds + ((c + 1) & 1) * DN_HSZ;
            if (c + 1 < nchunk) dn_stage_store(sa, nxt, tid);
            if (c + 2 < nchunk) dn_stage_load(sa, QKV, TA, GS, tid, c + 2, d, T, row0, kh, h, nchunk);
            dn_step_compute(S, cur, O, c, d, T, row0, h, wave, lane);
            __syncthreads();
        }
        if (!lat) { float* sd = P.out + OUT_SDN + ((((size_t)b * 2 + j) * 2 + d) * 32 + h) * 128 * 128 + 16 * wave + r;
#pragma unroll
            for (int kt = 0; kt < 8; ++kt)
#pragma unroll
                for (int e = 0; e < 4; ++e) sd[(size_t)(16 * kt + 4 * g + e) * 128] = S[kt][e]; }
    }
}


#ifndef R_CONV
#define R_CONV 1
#endif
#ifndef R_MOD
#define R_MOD 1
#endif
#ifndef R_NORM
#define R_NORM 1
#endif
#ifndef R_GATE
#define R_GATE 1
#endif
#ifndef R_DNPREP
#define R_DNPREP 1
#endif
#ifndef R_WU
#define R_WU 1
#endif
#ifndef R_GLAPREP
#define R_GLAPREP 1
#endif
#ifndef R_DNSCAN
#define R_DNSCAN 1
#endif
#ifndef R_GSCAN
#define R_GSCAN 1
#endif
#ifndef R_FINAL
#define R_FINAL 1
#endif
#ifndef R_BAR
#define R_BAR 1
#endif
#ifndef R_GEMM
#define R_GEMM 1
#endif
#define REPN(n_) for (int rep_ = 0; rep_ < (n_); ++rep_)
#ifndef REP_THIN
#define REP_THIN 1
#endif
#ifndef REP_SCAN
#define REP_SCAN 1
#endif
#ifndef REP_A
#define REP_A 1
#endif
#ifndef REP_B
#define REP_B 1
#endif
#ifndef REP_C
#define REP_C 1
#endif
#define RT for (int rep_ = 0; rep_ < REP_THIN; ++rep_)
#define RA for (int rep_ = 0; rep_ < REP_A; ++rep_)
#define RB for (int rep_ = 0; rep_ < REP_B; ++rep_)
#define RC for (int rep_ = 0; rep_ < REP_C; ++rep_)
#define RS for (int rep_ = 0; rep_ < REP_SCAN; ++rep_)
template <int LAYER> __device__ __forceinline__ void layer_body(const Params& P, LAS unsigned char* lds, const XcdBarrier& bar) {
    bf16* X = (bf16*)(P.ws + WS_X); bf16* H = (bf16*)(P.ws + WS_H); bf16* BIG = (bf16*)(P.ws + WS_BIG); float* GATE = (float*)(P.ws + WS_GATE);
    bf16* Y = (bf16*)(P.ws + WS_QKV); bf16* OF = (bf16*)(P.ws + WS_OF); bf16* OB = (bf16*)(P.ws + WS_OB);
    const float* MOD = (const float*)(P.ws + WS_MOD);
    const bf16* Tin = (const bf16*)(P.ws + WS_W + WOFF_IN); const bf16* Tout = (const bf16*)(P.ws + WS_W + WOFF_OUT); const bf16* Tup = (const bf16*)(P.ws + WS_W + WOFF_UP); const bf16* Tdn = (const bf16*)(P.ws + WS_W + WOFF_DOWN);

        constexpr int layer = LAYER, kind = LAYER % 3, j = LAYER / 3;
        const float* modl = MOD + (size_t)layer * 5 * MODW;
        const void* xc = layer == 0 ? (const void*)P.in[0] : (const void*)X; const void* xl = layer == 0 ? (const void*)P.in[1] : (const void*)X;
#ifndef NO_CONV
        REPN(R_CONV) convert_layer_weights(P, layer, lds);
#endif
        if (layer == 0) REPN(R_BAR) xcd_barrier(bar);
        REPN(R_NORM) norm_mod_phase<layer == 0>(xc, xl, P.in[9] + layer * D, modl, 0, 2048, H);
        REPN(R_BAR) xcd_barrier(bar);
        {
            constexpr int Npad = kind == 0 ? DN_NPAD : (kind == 1 ? GLA_NPAD : HG_NIN), nmain = kind == 0 ? DN_NMAIN : (kind == 1 ? GLA_NMAIN : HG_NIN);
            { pg8::Gemm g = pg8::mk_gemm(H, Tin, MROWS, nmain, D); pg8::StaticOrder S; S.init(MROWS, nmain, (int)gridDim.x, (int)blockIdx.x);
              pg8::EpiBf16<0> E{BIG, nmain, nmain, GATE};
              REPN(R_GEMM) pg8::gemm_phase<pg8::EpiBf16<0>, pg8::StaticOrder, true, true>(lds, g, S, E); }
            if constexpr (Npad > nmain) {
              pg8::Gemm g{H, Tin + (size_t)nmain * D, MROWS, 4 * 256, D, (size_t)512 * 2, (size_t)512 * 2, 8}; pg8::StaticOrder S; S.init(MROWS, 4 * 256, (int)gridDim.x, (int)blockIdx.x);
              pg8::EpiGateP E{(float*)(P.ws + WS_GP)};
              pg8::gemm_phase<pg8::EpiGateP, pg8::StaticOrder, true, true>(lds, g, S, E); }
        }
        REPN(R_BAR) xcd_barrier(bar);
        if constexpr (kind == 0) {
#ifndef NO_DNPREP
            REPN(R_DNPREP) dn_prep_phase(P, j, rep_ == 0);
#endif
            REPN(R_BAR) xcd_barrier(bar);
            REPN(R_WU) dn_wu_prep_phase(P, lds);
            REPN(R_BAR) xcd_barrier(bar);
            REPN(R_DNSCAN) dn_chunk_phase(P, j, lds);
            REPN(R_BAR) xcd_barrier(bar);
            REPN(R_GATE) gate_phase<128>(OF, OB, BIG, DN_NMAIN, 8192, P.in[18] + j * 128, Y, 4096);
        } else if constexpr (kind == 1) {
            REPN(R_GLAPREP) gla_prep_phase<1>(P, lds);
            REPN(R_BAR) xcd_barrier(bar);
            REPN(R_GSCAN) gla_chunk_phase<1>(P, lds);
            REPN(R_BAR) xcd_barrier(bar);
            REPN(R_GATE) gate_phase<512>(OF, OB, BIG, GLA_NMAIN, 4096, P.in[23] + j * 512, Y, 2048);
        } else {
            REPN(R_GLAPREP) gla_prep_phase<2>(P, lds);
            REPN(R_BAR) xcd_barrier(bar);
            REPN(R_GSCAN) gla_chunk_phase<2>(P, lds);
            REPN(R_BAR) xcd_barrier(bar);
            REPN(R_GATE) gate_phase<128>(OF, OB, BIG, HG_NIN, 4096, P.in[27] + j * 128, Y, 2048);
        }
        REPN(R_BAR) xcd_barrier(bar);
        {
            const int Kout = kind == 0 ? 4096 : 2048;
            pg8::Gemm g = pg8::mk_gemm(Y, Tout, MROWS, D, Kout); pg8::StaticOrder S; S.init(MROWS, D, (int)gridDim.x, (int)blockIdx.x);
            pg8::EpiRes<layer == 0> E{xc, xl, X, modl + 4096};
            pg8::gemm_phase<pg8::EpiRes<layer == 0>, pg8::StaticOrder, true, true>(lds, g, S, E);
        }
        REPN(R_BAR) xcd_barrier(bar);
        REPN(R_NORM) norm_mod_phase<false>(X, X, P.in[10] + layer * D, modl, 6144, 8192, H);
        REPN(R_BAR) xcd_barrier(bar);
#pragma unroll
        for (int hf = 0; hf < 2; ++hf) {
            {
                pg8::Gemm g = pg8::mk_gemm(H, Tup, MROWS / 2, DFF, D); pg8::StaticOrder S; S.init(MROWS / 2, DFF, (int)gridDim.x, (int)blockIdx.x, hf * 32);
                pg8::EpiBf16<1> E{BIG, DFF, DFF, nullptr};
                REPN(R_GEMM) pg8::gemm_phase<pg8::EpiBf16<1>, pg8::StaticOrder, true, true>(lds, g, S, E);
            }
            REPN(R_BAR) xcd_barrier(bar);
            {
                pg8::Gemm g = pg8::mk_gemm(BIG, Tdn, MROWS / 2, D, DFF); pg8::StaticOrder S; S.init(MROWS / 2, D, (int)gridDim.x, (int)blockIdx.x, hf * 32);
                pg8::EpiRes<false> E{X, X, X, modl + 10240};
                pg8::gemm_phase<pg8::EpiRes<false>, pg8::StaticOrder, true, true>(lds, g, S, E);
            }
            REPN(R_BAR) xcd_barrier(bar);
        }
    }

__global__ void __launch_bounds__(NT, 2) fwd_kernel(Params P) {
    extern __shared__ __attribute__((aligned(16))) unsigned char lds_raw[];
    LAS unsigned char* lds = (LAS unsigned char*)lds_raw;
    const int tid = threadIdx.x;
    volatile LAS unsigned* misc = (volatile LAS unsigned*)(lds + LDS_MISC);
    if (tid < 64) misc[tid] = 0u;
    __syncthreads();
    XcdBarrier bar = xcd_barrier_post((unsigned*)(P.ws + WS_CTL) + 1024, misc + 8);

#ifndef NO_MOD
    REPN(R_MOD) mod_phase(P, lds);
#endif
    __syncthreads();

    layer_body<0>(P, lds, bar);
    layer_body<1>(P, lds, bar);
    layer_body<2>(P, lds, bar);
    layer_body<3>(P, lds, bar);
    REPN(R_FINAL) final_norm_phase((const bf16*)(P.ws + WS_X), P.in[11], P.out + OUT_Y);
}

extern "C" void kernel_launch(void* const* d_in, const int* in_sizes, int n_in, void* d_out, int out_size, void* d_ws, size_t ws_size, hipStream_t stream) {
    static int grid = 0;
    if (grid == 0) {
        if (n_in != 29 || (size_t)out_size != OUT_END || ws_size < WS_END) {
            fprintf(stderr, "kernel_launch: unexpected shapes: n_in %d out %d (want %zu) ws %zu (want %zu)\n", n_in, out_size, (size_t)OUT_END, ws_size, (size_t)WS_END); grid = -1; return; }
        int dev = 0, cus = 0, per_cu = 0;
        if (hipGetDevice(&dev) != hipSuccess || hipDeviceGetAttribute(&cus, hipDeviceAttributeMultiprocessorCount, dev) != hipSuccess) { grid = -1; return; }
        if (hipFuncSetAttribute((const void*)fwd_kernel, hipFuncAttributeMaxDynamicSharedMemorySize, LDS_BYTES) != hipSuccess) { fprintf(stderr, "kernel_launch: hipFuncSetAttribute failed\n"); grid = -1; return; }
        if (hipOccupancyMaxActiveBlocksPerMultiprocessor(&per_cu, (const void*)fwd_kernel, NT, LDS_BYTES) != hipSuccess || per_cu < 1) { fprintf(stderr, "kernel_launch: occupancy query says %d\n", per_cu); }
        (void)hipGetLastError();
        grid = cus;
    }
    if (grid < 0) return;
    hipMemsetAsync((char*)d_ws + WS_CTL, 0, CTL_BYTES, stream);
    Params p{};
    for (int i = 0; i < 29; ++i) p.in[i] = (const float*)d_in[i];
    p.out = (float*)d_out; p.ws = (unsigned char*)d_ws;
    hipLaunchKernelGGL(fwd_kernel, dim3(grid), dim3(NT), LDS_BYTES, stream, p);
}
```

```cpp
#include <hip/hip_runtime.h>
#include <cstdio>
#include <cstdint>

__device__ __forceinline__ int opaque_v(int x) { asm volatile("" : "+v"(x)); return x; }
#define PHASE_IDS() const int tid = opaque_v((int)threadIdx.x), lane = tid & 63, wave = __builtin_amdgcn_readfirstlane(tid >> 6), gw = (int)blockIdx.x * 8 + wave, NGW = (int)gridDim.x * 8; (void)lane; (void)wave; (void)gw; (void)NGW
namespace pg8 {
#define PG8_LAS __attribute__((address_space(3)))
typedef unsigned short bf16_t;
typedef short bf16x8 __attribute__((ext_vector_type(8)));
typedef float f32x4 __attribute__((ext_vector_type(4)));
typedef unsigned u32x4 __attribute__((ext_vector_type(4)));
constexpr int BM = 256, BK = 64, HALF = 128, HTB = HALF * BK * 2, STAGE_BYTES = 8 * HTB, NXCD = 8, WGM = 8;

__host__ __device__ __forceinline__ int lds_byte(int r, int c) { const int st = (r >> 4) * 2 + (c >> 5), rr = r & 15, cc = c & 31, ob = rr * 64 + cc * 2; return st * 1024 + (ob ^ (((ob >> 9) & 1) << 5)); }
__host__ __device__ __forceinline__ void stage_rc(int b, int& R, int& C) { const int st = b / 1024, sb = b % 1024, swz = sb ^ (((sb >> 9) & 1) << 5); R = (st >> 1) * 16 + swz / 64; C = (st & 1) * 32 + (swz % 64) / 2; }
__host__ __device__ __forceinline__ int perm32(int rho) { const int n = rho >> 4, i = rho & 15; return 8 * (i >> 2) + 4 * n + (i & 3); }

struct Unit { int pm, pn; };
struct Gemm { const bf16_t* A; const bf16_t* Bt; int M, N, K; size_t a_pn_step, b_pn_step; int nt; };
__host__ __device__ __forceinline__ Gemm mk_gemm(const bf16_t* A, const bf16_t* Bt, int M, int N, int K) { return Gemm{A, Bt, M, N, K, 0, (size_t)256 * K * 2, K / 64}; }

struct StaticOrder {
    int nM, nN, nwg, G, c, pm0;
    __host__ __device__ void init(int M, int N, int G_, int c_, int pm0_ = 0) { nM = M / BM; nN = N / BM; nwg = nM * nN; G = G_; c = c_; pm0 = pm0_; }
    __host__ __device__ bool next(int i, Unit& u) const {
        const long L = (long)i * G + c; if (L >= nwg) return false;
        int wgid = (int)L; { const int q = nwg / NXCD, r = nwg % NXCD, xcd = wgid % NXCD, off = wgid / NXCD; wgid = (xcd < r ? xcd * (q + 1) : r * (q + 1) + (xcd - r) * q) + off; }
        const int nig = WGM * nN, gid = wgid / nig, fm = gid * WGM, gsz = (nM - fm) < WGM ? (nM - fm) : WGM;
        u.pm = pm0 + fm + ((wgid % nig) % gsz); u.pn = (wgid % nig) / gsz; return true;
    }
    __device__ __forceinline__ void a_ready(const Unit&) const {}
    __device__ __forceinline__ void done(const Unit&) const {}
};

__device__ __forceinline__ unsigned cvt_pk_bf16(float lo, float hi) { unsigned r; asm volatile("v_cvt_pk_bf16_f32 %0, %1, %2" : "=v"(r) : "v"(lo), "v"(hi)); return r; }

template <int ACT> struct EpiBf16 {
    static constexpr bool PERM = true, AFTER_DRAIN = false;
    bf16_t* O; int ldc; int n_main; float* G;
    __device__ __forceinline__ void operator()(const f32x4 (&acc)[2][2][4][2], const Unit& u, int wr, int wc, int fr, int fq) const {
        const int row0 = u.pm * BM + wr * 64 + fr; const int colt = u.pn * BM;
        const int col0 = colt + wc * 32 + 8 * fq;
#pragma unroll
        for (int ai = 0; ai < 2; ++ai)
#pragma unroll
            for (int m = 0; m < 4; ++m) { bf16_t* rowp = O + (size_t)(row0 + ai * HALF + m * 16) * ldc + col0;
#pragma unroll
                for (int bj = 0; bj < 2; ++bj) { f32x4 v0 = acc[ai][bj][m][0], v1 = acc[ai][bj][m][1];
                    if (ACT == 1) {
#pragma unroll
                        for (int j = 0; j < 4; ++j) { const float a = fmaxf(v0[j], 0.f), b = fmaxf(v1[j], 0.f); v0[j] = a * a; v1[j] = b * b; } }
                    u32x4 w; w.x = cvt_pk_bf16(v0[0], v0[1]); w.y = cvt_pk_bf16(v0[2], v0[3]); w.z = cvt_pk_bf16(v1[0], v1[1]); w.w = cvt_pk_bf16(v1[2], v1[3]);
                    *(u32x4*)(rowp + bj * HALF) = w;
#ifdef PROBE_DOUBLE_STORE
                    asm volatile("" ::: "memory"); *(u32x4*)(rowp + bj * HALF) = w; asm volatile("" ::: "memory");
#endif
                    } }
    }
};
struct EpiGateP {
    static constexpr bool PERM = true, AFTER_DRAIN = false;
    float* GP;
    __device__ __forceinline__ void operator()(const f32x4 (&acc)[2][2][4][2], const Unit& u, int wr, int wc, int fr, int fq) const {
        const int row0 = u.pm * BM + wr * 64 + fr; const int col0 = wc * 32 + 8 * fq; float* base = GP + (size_t)u.pn * 16384 * 128;
#pragma unroll
        for (int ai = 0; ai < 2; ++ai)
#pragma unroll
            for (int m = 0; m < 4; ++m) { float* rowp = base + (size_t)(row0 + ai * HALF + m * 16) * 128 + col0;
                *(f32x4*)(rowp) = acc[ai][0][m][0]; *(f32x4*)(rowp + 4) = acc[ai][0][m][1]; }
    }
};
template <bool BASE_F32> struct EpiRes {
    static constexpr bool PERM = true, AFTER_DRAIN = false;
    const void* base_ctx; const void* base_lat; bf16_t* out; const float* gate;
    __device__ __forceinline__ void operator()(const f32x4 (&acc)[2][2][4][2], const Unit& u, int wr, int wc, int fr, int fq) const {
        const int row0 = u.pm * BM + wr * 64 + fr, col0 = u.pn * BM + wc * 32 + 8 * fq;
        const bool ctx = u.pm < 32; const int grp = ctx ? 0 : 1 + ((u.pm - 32) >> 3);
        const float* gp = gate + (size_t)grp * 12288 + col0;
        const void* base = ctx ? base_ctx : base_lat; const int rsub = (BASE_F32 && !ctx) ? 8192 : 0;
        f32x4 gv[2][2];
#pragma unroll
        for (int bj = 0; bj < 2; ++bj)
#pragma unroll
            for (int n = 0; n < 2; ++n) gv[bj][n] = *(const f32x4*)(gp + bj * HALF + 4 * n);
#pragma unroll
        for (int ai = 0; ai < 2; ++ai) {
            f32x4 bs[4][2][2];
#pragma unroll
            for (int m = 0; m < 4; ++m) { const size_t offb = (size_t)(row0 + ai * HALF + m * 16 - rsub) * 2048 + col0;
#pragma unroll
                for (int bj = 0; bj < 2; ++bj) {
                    if (BASE_F32) { bs[m][bj][0] = *(const f32x4*)((const float*)base + offb + bj * HALF); bs[m][bj][1] = *(const f32x4*)((const float*)base + offb + bj * HALF + 4); }
                    else { const u32x4 w = *(const u32x4*)((const bf16_t*)base + offb + bj * HALF);
                        bs[m][bj][0] = (f32x4){__uint_as_float(w.x << 16), __uint_as_float(w.x & 0xffff0000u), __uint_as_float(w.y << 16), __uint_as_float(w.y & 0xffff0000u)};
                        bs[m][bj][1] = (f32x4){__uint_as_float(w.z << 16), __uint_as_float(w.z & 0xffff0000u), __uint_as_float(w.w << 16), __uint_as_float(w.w & 0xffff0000u)}; } } }
#pragma unroll
            for (int m = 0; m < 4; ++m) { const size_t offo = (size_t)(row0 + ai * HALF + m * 16) * 2048 + col0;
#pragma unroll
                for (int bj = 0; bj < 2; ++bj) { const f32x4 v0 = bs[m][bj][0] + gv[bj][0] * acc[ai][bj][m][0], v1 = bs[m][bj][1] + gv[bj][1] * acc[ai][bj][m][1];
                    u32x4 w; w.x = cvt_pk_bf16(v0[0], v0[1]); w.y = cvt_pk_bf16(v0[2], v0[3]); w.z = cvt_pk_bf16(v1[0], v1[1]); w.w = cvt_pk_bf16(v1[2], v1[3]);
                    *(u32x4*)(out + offo + bj * HALF) = w; } }
            asm volatile("" ::: "memory");
        }
    }
};

template <class Epi, class Sched, bool ALIGN_EPI = false, bool SP2 = false>
__device__ __forceinline__ void gemm_phase(PG8_LAS unsigned char* lds, const Gemm g, const Sched& S, const Epi& E) {
    const int tid = opaque_v((int)threadIdx.x), wid = __builtin_amdgcn_readfirstlane(tid >> 6), lane = tid & 63, wr = wid >> 2, wc = wid & 3, fr = lane & 15, fq = lane >> 4;
    const int K = g.K, nt = g.nt;
    unsigned voffA[2], voffB[2];
#pragma unroll
    for (int i = 0; i < 2; ++i) { int R, C; stage_rc(tid * 16 + i * 8192, R, C); const int Rb = Epi::PERM ? ((R & ~31) + perm32(R & 31)) : R;
        voffA[i] = (unsigned)(R * K + C) * 2u; voffB[i] = (unsigned)(Rb * K + C) * 2u; }
    const size_t kstep = (size_t)(BK * 2);
    const size_t hstep = (size_t)HALF * K * 2;
    const size_t tstep = 2 * hstep;
    const unsigned ldsw = (unsigned)wid * 1024u;
    const int aoff = lds_byte(wr * 64 + fr, fq * 8), boff = lds_byte(wc * 32 + fr, fq * 8);
#define PG8_SA(b, h) (((b) * 2 + (h)) * HTB)
#define PG8_SB(b, h) ((4 + (b) * 2 + (h)) * HTB)
#define PG8_STAGE(bufoff, gbase, voff) do { _Pragma("unroll") for (int _i = 0; _i < 2; ++_i) \
        __builtin_amdgcn_global_load_lds((const unsigned*)((const char*)(gbase) + (voff)[_i]), (PG8_LAS unsigned*)(lds + (bufoff) + ldsw + _i * 8192), 16, 0, 0); } while (0)
#define PG8_LDA(dst, b, h) do { _Pragma("unroll") for (int m = 0; m < 4; ++m) _Pragma("unroll") for (int k = 0; k < 2; ++k) dst[m][k] = *(const PG8_LAS bf16x8*)(lds + PG8_SA(b, h) + aoff + m * 2048 + k * 1024); } while (0)
#define PG8_LDB(dst, b, h) do { _Pragma("unroll") for (int n = 0; n < 2; ++n) _Pragma("unroll") for (int k = 0; k < 2; ++k) dst[n][k] = *(const PG8_LAS bf16x8*)(lds + PG8_SB(b, h) + boff + n * 2048 + k * 1024); } while (0)
#define PG8_MMA(ai, bj, At, Bt) do { __builtin_amdgcn_s_setprio(1); _Pragma("unroll") for (int m = 0; m < 4; ++m) _Pragma("unroll") for (int n = 0; n < 2; ++n) _Pragma("unroll") for (int k = 0; k < 2; ++k) \
        acc[ai][bj][m][n] = __builtin_amdgcn_mfma_f32_16x16x32_bf16(Bt[n][k], At[m][k], acc[ai][bj][m][n], 0, 0, 0); __builtin_amdgcn_s_setprio(0); } while (0)
#define PG8_WAIT_V(n) asm volatile("s_waitcnt vmcnt(" #n ")" ::: "memory")
#define PG8_WAIT_L(n) asm volatile("s_waitcnt lgkmcnt(" #n ")" ::: "memory")
#define PG8_BAR __builtin_amdgcn_s_barrier()
#define PG8_SCHED __builtin_amdgcn_sched_barrier(0)
    Unit cur, nxt; int ui = 0;
    if (!S.next(0, cur)) return;
    f32x4 acc[2][2][4][2];
#pragma unroll
    for (int a = 0; a < 2; ++a)
#pragma unroll
        for (int b = 0; b < 2; ++b)
#pragma unroll
            for (int m = 0; m < 4; ++m)
#pragma unroll
                for (int n = 0; n < 2; ++n) acc[a][b][m][n] = (f32x4){0.f, 0.f, 0.f, 0.f};
    bf16x8 At[4][2], B0[2][2], B1[2][2];
    const char* cA = (const char*)g.A + (size_t)cur.pm * tstep + (size_t)cur.pn * g.a_pn_step; const char* cB = (const char*)g.Bt + (size_t)cur.pn * g.b_pn_step;
    S.a_ready(cur);
    if constexpr (SP2) {
        PG8_STAGE(PG8_SB(0, 0), cB, voffB); PG8_STAGE(PG8_SB(0, 1), cB + hstep, voffB); PG8_STAGE(PG8_SA(0, 0), cA, voffA); PG8_STAGE(PG8_SA(0, 1), cA + hstep, voffA);
        if (wr == 1) PG8_BAR;
        PG8_WAIT_V(2); PG8_BAR;
        PG8_STAGE(PG8_SB(1, 0), cB + kstep, voffB); PG8_STAGE(PG8_SA(1, 0), cA + kstep, voffA); PG8_STAGE(PG8_SB(1, 1), cB + hstep + kstep, voffB);
        PG8_WAIT_V(6); PG8_BAR;
    } else {
        PG8_STAGE(PG8_SB(0, 0), cB, voffB); PG8_STAGE(PG8_SA(0, 0), cA, voffA); PG8_STAGE(PG8_SB(0, 1), cB + hstep, voffB); PG8_STAGE(PG8_SA(0, 1), cA + hstep, voffA);
        if (wr == 1) PG8_BAR;
        PG8_WAIT_V(4); PG8_BAR;
        PG8_STAGE(PG8_SB(1, 0), cB + kstep, voffB); PG8_STAGE(PG8_SA(1, 0), cA + kstep, voffA); PG8_STAGE(PG8_SB(1, 1), cB + hstep + kstep, voffB);
        PG8_WAIT_V(6); PG8_BAR;
    }
    for (;;) {
        const bool has_next = S.next(ui + 1, nxt);
        const char* nA = has_next ? (const char*)g.A + (size_t)nxt.pm * tstep + (size_t)nxt.pn * g.a_pn_step : cA; const char* nB = has_next ? (const char*)g.Bt + (size_t)nxt.pn * g.b_pn_step : cB;
        for (int t = 0; t < nt; t += 2) {
            const bool last = (t == nt - 2);
            const char* a1 = cA + (size_t)(t + 1) * kstep;
            const char* a2 = last ? nA : cA + (size_t)(t + 2) * kstep; const char* b2 = last ? nB : cB + (size_t)(t + 2) * kstep;
            const char* a3 = a2 + kstep; const char* b3 = b2 + kstep;
            if (last && has_next) S.a_ready(nxt);
            if constexpr (SP2) {
            PG8_LDB(B0, 0, 0); PG8_LDB(B1, 0, 1); PG8_SCHED; PG8_LDA(At, 0, 0); PG8_STAGE(PG8_SA(1, 1), a1 + hstep, voffA);
            PG8_WAIT_V(8); PG8_WAIT_L(0); PG8_BAR; PG8_MMA(0, 0, At, B0); PG8_MMA(0, 1, At, B1); PG8_BAR; PG8_SCHED;
            PG8_LDA(At, 0, 1); PG8_STAGE(PG8_SB(0, 0), b2, voffB); PG8_STAGE(PG8_SB(0, 1), b2 + hstep, voffB); PG8_STAGE(PG8_SA(0, 0), a2, voffA);
            PG8_WAIT_V(8); PG8_WAIT_L(0); PG8_BAR; PG8_MMA(1, 0, At, B0); PG8_MMA(1, 1, At, B1); PG8_BAR; PG8_SCHED;
            PG8_LDB(B0, 1, 0); PG8_LDB(B1, 1, 1); PG8_SCHED; PG8_LDA(At, 1, 0); PG8_STAGE(PG8_SA(0, 1), a2 + hstep, voffA);
            PG8_WAIT_V(8); PG8_WAIT_L(0); PG8_BAR; PG8_MMA(0, 0, At, B0); PG8_MMA(0, 1, At, B1); PG8_BAR; PG8_SCHED;
            PG8_LDA(At, 1, 1); PG8_STAGE(PG8_SB(1, 0), b3, voffB); PG8_STAGE(PG8_SB(1, 1), b3 + hstep, voffB); PG8_STAGE(PG8_SA(1, 0), a3, voffA);
            PG8_WAIT_V(8); PG8_WAIT_L(0); PG8_BAR; PG8_MMA(1, 0, At, B0); PG8_MMA(1, 1, At, B1); PG8_BAR; PG8_SCHED;
            } else {
            PG8_LDB(B0, 0, 0); PG8_SCHED; PG8_LDA(At, 0, 0); PG8_STAGE(PG8_SA(1, 1), a1 + hstep, voffA);
            PG8_WAIT_L(8); PG8_BAR; PG8_WAIT_L(0); PG8_MMA(0, 0, At, B0); PG8_BAR; PG8_SCHED;
            PG8_LDB(B1, 0, 1); PG8_STAGE(PG8_SB(0, 0), b2, voffB);
            PG8_BAR; PG8_WAIT_L(0); PG8_MMA(0, 1, At, B1); PG8_BAR;
            PG8_LDA(At, 0, 1); PG8_STAGE(PG8_SA(0, 0), a2, voffA);
            PG8_BAR; PG8_WAIT_L(0); PG8_MMA(1, 0, At, B0); PG8_BAR; PG8_SCHED;
            PG8_STAGE(PG8_SB(0, 1), b2 + hstep, voffB);
            PG8_WAIT_V(6); PG8_BAR; PG8_MMA(1, 1, At, B1); PG8_BAR;
            PG8_LDB(B0, 1, 0); PG8_SCHED; PG8_LDA(At, 1, 0); PG8_STAGE(PG8_SA(0, 1), a2 + hstep, voffA);
            PG8_WAIT_L(8); PG8_BAR; PG8_WAIT_L(0); PG8_MMA(0, 0, At, B0); PG8_BAR; PG8_SCHED;
            PG8_LDB(B1, 1, 1); PG8_STAGE(PG8_SB(1, 0), b3, voffB);
            PG8_BAR; PG8_WAIT_L(0); PG8_MMA(0, 1, At, B1); PG8_BAR;
            PG8_LDA(At, 1, 1); PG8_STAGE(PG8_SA(1, 0), a3, voffA);
            PG8_BAR; PG8_WAIT_L(0); PG8_MMA(1, 0, At, B0); PG8_BAR; PG8_SCHED;
            PG8_STAGE(PG8_SB(1, 1), b3 + hstep, voffB);
            PG8_WAIT_V(6); PG8_BAR; PG8_MMA(1, 1, At, B1); PG8_BAR;
            }
        }
        if constexpr (ALIGN_EPI) { if (wr == 0) PG8_BAR; }
        if constexpr (!Epi::AFTER_DRAIN) { E(acc, cur, wr, wc, fr, fq); S.done(cur); }
        if (!has_next) break;
#pragma unroll
        for (int a = 0; a < 2; ++a)
#pragma unroll
            for (int b = 0; b < 2; ++b)
#pragma unroll
                for (int m = 0; m < 4; ++m)
#pragma unroll
                    for (int n = 0; n < 2; ++n) acc[a][b][m][n] = (f32x4){0.f, 0.f, 0.f, 0.f};
        cur = nxt; cA = nA; cB = nB; ++ui;
        if constexpr (ALIGN_EPI) { if (wr == 1) PG8_BAR; }
    }
    PG8_WAIT_V(0);
    if constexpr (!ALIGN_EPI) { if (wr == 0) PG8_BAR; }
    PG8_BAR;
#undef PG8_SA
#undef PG8_SB
#undef PG8_STAGE
#undef PG8_LDA
#undef PG8_LDB
#undef PG8_MMA
#undef PG8_WAIT_V
#undef PG8_WAIT_L
#undef PG8_BAR
#undef PG8_SCHED
}
}

#define XB_TMO      128
#define XB_XCNT(j)  (256  + 64 * (j))
#define XB_XSUB(j)  (1280 + 64 * (j))
#define XB_XGEN(j)  (2304 + 64 * (j))
#define XB_TOP      3328
#define XB_TOPGEN   3392
#define XCD_BAR_WORDS 3456
#define XB_SPIN_CAP (1u << 21)
#define LAS __attribute__((address_space(3)))

__device__ __forceinline__ unsigned xb_ld(unsigned* p)              { return __hip_atomic_load(p, __ATOMIC_RELAXED, __HIP_MEMORY_SCOPE_AGENT); }
__device__ __forceinline__ unsigned xb_add(unsigned* p, unsigned v) { return __hip_atomic_fetch_add(p, v, __ATOMIC_RELAXED, __HIP_MEMORY_SCOPE_AGENT); }
__device__ __forceinline__ unsigned xb_xcc_id() { return (unsigned)__builtin_amdgcn_s_getreg((3 << 11) | 20) & 0xFu; }
#define XB_SPIN(cond, bar) do { unsigned _sp = 0; while (cond) { __builtin_amdgcn_s_sleep(1); \
    if ((++_sp & 255u) == 0u) { if (xb_ld(&(bar)[XB_TMO])) break; if (_sp > XB_SPIN_CAP) { atomicAdd(&(bar)[XB_TMO], 1u); break; } } } } while (0)

struct XcdBarrier { unsigned* bar; unsigned x; volatile LAS unsigned* st; };

__device__ __forceinline__ XcdBarrier xcd_barrier_post(unsigned* bar, volatile LAS unsigned* st) {
    XcdBarrier b; b.bar = bar; b.x = xb_xcc_id(); b.st = st;
    if (threadIdx.x == 0) (void)xb_add(&bar[XB_XCNT(b.x)], 1u);
    return b;
}
__device__ __forceinline__ void xcd_barrier_complete(unsigned* bar, unsigned x, unsigned& nloc, unsigned& nx) {
    const unsigned G = gridDim.x * gridDim.y * gridDim.z;
    unsigned sum, cnt, mine, sp = 0u;
    for (;;) {
        sum = 0u; cnt = 0u; mine = 0u;
#pragma unroll
        for (unsigned j = 0; j < 16; ++j) { const unsigned c = xb_ld(&bar[XB_XCNT(j)]); sum += c; cnt += (c > 0u) ? 1u : 0u; mine = (j == x) ? c : mine; }
        if (sum == G) break;
        __builtin_amdgcn_s_sleep(1);
        if ((++sp & 255u) == 0u) { if (xb_ld(&bar[XB_TMO])) break; if (sp > XB_SPIN_CAP) { atomicAdd(&bar[XB_TMO], 1u); break; } }
    }
    nloc = mine > 0u ? mine : 1u; nx = cnt > 0u ? cnt : 1u;
}
__device__ __forceinline__ void xcd_barrier(const XcdBarrier& b) {
    asm volatile("s_waitcnt vmcnt(0)" ::: "memory");
    __syncthreads();
    if (threadIdx.x == 0) {
        unsigned* bar = b.bar;
        __builtin_amdgcn_s_waitcnt(0);
        unsigned nloc = b.st[0], nx = b.st[1];
        if (nloc == 0u) { xcd_barrier_complete(bar, b.x, nloc, nx); b.st[0] = nloc; b.st[1] = nx; }
        const unsigned old = xb_add(&bar[XB_XSUB(b.x)], 1u);
        const unsigned gen = old / nloc;
        if (old + 1u == (gen + 1u) * nloc) {
            __builtin_amdgcn_fence(__ATOMIC_RELEASE, "agent");
            asm volatile("s_waitcnt vmcnt(0)" ::: "memory");
            const unsigned og = xb_add(&bar[XB_TOP], 1u);
            const unsigned tg = og / nx;
            if (og + 1u == (tg + 1u) * nx) xb_add(&bar[XB_TOPGEN], 1u);
            else XB_SPIN(xb_ld(&bar[XB_TOPGEN]) == tg, bar);
            __builtin_amdgcn_fence(__ATOMIC_ACQUIRE, "agent");
            xb_add(&bar[XB_XGEN(b.x)], 1u);
            asm volatile("s_waitcnt vmcnt(0)" ::: "memory");
        } else {
            XB_SPIN(xb_ld(&bar[XB_XGEN(b.x)]) == gen, bar);
            __builtin_amdgcn_fence(__ATOMIC_ACQUIRE, "agent");
            asm volatile("s_waitcnt vmcnt(0)" ::: "memory");
        }
    }
    __syncthreads();
}

typedef unsigned short bf16;
typedef float f32x4 __attribute__((ext_vector_type(4)));
typedef unsigned u32x4 __attribute__((ext_vector_type(4)));
typedef unsigned u32x2 __attribute__((ext_vector_type(2)));

constexpr int D = 2048, DFF = 8192, MROWS = 16384, MCTX = 8192;
constexpr int NT = 512;
constexpr float EPS = 1e-6f;
constexpr int DN_NIN = 12416, DN_NMAIN = 12288, DN_NPAD = 12544;
constexpr int GLA_NIN = 6176, GLA_NMAIN = 6144, GLA_NPAD = 6400;
constexpr int HG_NIN = 10240;
constexpr int MODW = 12288;

constexpr size_t MiB = 1u << 20;
constexpr size_t WS_CTL = 0, CTL_BYTES = 1 * MiB;
constexpr size_t WS_MOD = 1 * MiB;
constexpr size_t WS_X = 2 * MiB;
constexpr size_t WS_H = WS_X + 128 * MiB;
constexpr size_t WS_BIG = WS_H + 64 * MiB;
constexpr size_t WS_GATE = WS_BIG + 384 * MiB;
constexpr size_t WS_QKV = WS_GATE + 8 * MiB;
constexpr size_t WS_OF = WS_QKV + 256 * MiB;
constexpr size_t WS_OB = WS_OF + 128 * MiB;
constexpr size_t WS_W = WS_OB + 128 * MiB;
constexpr size_t WOFF_IN = 0, WOFF_OUT = (size_t)DN_NPAD * D * 2, WOFF_UP = WOFF_OUT + (size_t)D * 4096 * 2, WOFF_DOWN = WOFF_UP + (size_t)DFF * D * 2;
constexpr size_t WS_TA = ((WS_W + WOFF_DOWN + (size_t)D * DFF * 2 + MiB - 1) / MiB) * MiB;
constexpr size_t WS_GS = WS_TA + 256 * MiB;
constexpr size_t WS_GP = WS_GS + 12 * MiB;
constexpr size_t WS_END = WS_GP + 32 * MiB;

constexpr size_t OUT_Y = 0;
constexpr size_t OUT_SDN = (size_t)MROWS * D;
constexpr size_t OUT_SGLA = OUT_SDN + (size_t)32 * 2 * 2 * 32 * 128 * 128;
constexpr size_t OUT_SHG = OUT_SGLA + (size_t)32 * 2 * 4 * 256 * 512;
constexpr size_t OUT_END = OUT_SHG + (size_t)32 * 2 * 16 * 128 * 128;

constexpr int LDS_BYTES = 151552;
constexpr int LDS_MISC = 150528;

struct Params {
    const float* in[29];
    float* out;
    unsigned char* ws;
};

__device__ __forceinline__ float bf2f(unsigned short b) { return __uint_as_float(((unsigned)b) << 16); }
typedef __bf16 bfv2_ __attribute__((ext_vector_type(2)));
typedef float f32x2_ __attribute__((ext_vector_type(2)));
__device__ __forceinline__ unsigned f2bf(float f) { return (unsigned)__builtin_bit_cast(unsigned short, (__bf16)f); }
__device__ __forceinline__ unsigned pk2(float lo, float hi) { const f32x2_ v = {lo, hi}; return __builtin_bit_cast(unsigned, __builtin_convertvector(v, bfv2_)); }
__device__ __forceinline__ float bflo(unsigned w) { return __uint_as_float(w << 16); }
__device__ __forceinline__ float bfhi(unsigned w) { return __uint_as_float(w & 0xffff0000u); }
__device__ __forceinline__ float wave_sum(float v) {
#pragma unroll
    for (int o = 1; o < 64; o <<= 1) v += __shfl_xor(v, o);
    return v;
}
__device__ __forceinline__ float rdlane(float v, int l) { return __builtin_bit_cast(float, __builtin_amdgcn_readlane(__builtin_bit_cast(int, v), l)); }
__device__ __forceinline__ float sigmoidf_(float x) { return __builtin_amdgcn_rcpf(1.f + __expf(-x)); }
__device__ __forceinline__ float siluf_(float x) { return x * __builtin_amdgcn_rcpf(1.f + __expf(-x)); }
__device__ __forceinline__ float softplusf_(float x) { return fmaxf(x, 0.f) + log1pf(__expf(-fabsf(x))); }

__device__ __forceinline__ void transpose_item(const float* W, int K, int N, bf16* WT, LAS float* scr, int item, int lane) {
    const int nblk = N / 32, kb = item / nblk, nb = item % nblk, k0 = 64 * kb, n0 = 32 * nb;
    { f32x4 v[8]; const int kr = lane >> 3, c4 = (lane & 7) * 4;
#pragma unroll
      for (int i = 0; i < 8; ++i) v[i] = *(const f32x4*)(W + (size_t)(k0 + kr + 8 * i) * N + n0 + c4);
#pragma unroll
      for (int i = 0; i < 8; ++i) { LAS float* d = scr + (kr + 8 * i) * 33 + c4; d[0] = v[i].x; d[1] = v[i].y; d[2] = v[i].z; d[3] = v[i].w; } }
    asm volatile("s_waitcnt lgkmcnt(0)" ::: "memory");
    const int c = lane & 7;
#pragma unroll
    for (int j = 0; j < 4; ++j) { const int n = (lane >> 3) + 8 * j; const LAS float* s = scr + (8 * c) * 33 + n;
        u32x4 o; o.x = pk2(s[0 * 33], s[1 * 33]); o.y = pk2(s[2 * 33], s[3 * 33]); o.z = pk2(s[4 * 33], s[5 * 33]); o.w = pk2(s[6 * 33], s[7 * 33]);
        *(u32x4*)(WT + (size_t)(n0 + n) * K + k0 + 8 * c) = o; }
    asm volatile("s_waitcnt lgkmcnt(0)" ::: "memory");
}

__device__ __forceinline__ void convert_layer_weights(const Params& P, int layer, LAS unsigned char* lds) {
    PHASE_IDS();
    LAS float* scr = (LAS float*)(lds + wave * 16384);
    const int kind = layer % 3, j = layer / 3;
    const float* Win; int Nin, Npad; const float* Wout; int Kout;
    if (kind == 0) { Win = P.in[14] + (size_t)j * D * DN_NIN; Nin = DN_NIN; Npad = DN_NPAD; Wout = P.in[19] + (size_t)j * 4096 * D; Kout = 4096; }
    else if (kind == 1) { Win = P.in[20] + (size_t)j * D * GLA_NIN; Nin = GLA_NIN; Npad = GLA_NPAD; Wout = P.in[24] + (size_t)j * D * D; Kout = 2048; }
    else { Win = P.in[25] + (size_t)j * D * HG_NIN; Nin = HG_NIN; Npad = HG_NIN; Wout = P.in[28] + (size_t)j * D * D; Kout = 2048; }
    const float* Wup = P.in[12] + (size_t)layer * D * DFF; const float* Wdn = P.in[13] + (size_t)layer * DFF * D;
    bf16* Tin = (bf16*)(P.ws + WS_W + WOFF_IN); bf16* Tout = (bf16*)(P.ws + WS_W + WOFF_OUT); bf16* Tup = (bf16*)(P.ws + WS_W + WOFF_UP); bf16* Tdn = (bf16*)(P.ws + WS_W + WOFF_DOWN);
    const int I_in = (D / 64) * (Nin / 32), I_out = (Kout / 64) * (D / 32), I_up = (D / 64) * (DFF / 32), I_dn = (DFF / 64) * (D / 32);
    const int NI = I_in + I_out + I_up + I_dn;
    for (int it = gw; it < NI; it += NGW) {
        int r = it;
        if (r < I_in) { transpose_item(Win, D, Nin, Tin, scr, r, lane); continue; } r -= I_in;
        if (r < I_out) { transpose_item(Wout, Kout, D, Tout, scr, r, lane); continue; } r -= I_out;
        if (r < I_up) { transpose_item(Wup, D, DFF, Tup, scr, r, lane); continue; } r -= I_up;
        transpose_item(Wdn, DFF, D, Tdn, scr, r, lane);
    }
    const int npadrows = Npad - Nin;
    if (npadrows > 0) {
        u32x4* z = (u32x4*)(Tin + (size_t)Nin * D); const int n16 = npadrows * D / 8;
        for (int i = gw * 64 + lane; i < n16; i += NGW * 64) z[i] = (u32x4){0u, 0u, 0u, 0u};
    }
}

__device__ __forceinline__ void mod_phase(const Params& P, LAS unsigned char* lds) {
    PHASE_IDS();
    LAS float* scond = (LAS float*)lds;
    LAS float* red = (LAS float*)(lds + 40960 + 1024);
    for (int i = tid; i < 5 * 2048; i += NT) { const int g = i / 2048, k = i % 2048; const float v = g == 0 ? P.in[6][k] : P.in[2][(g - 1) * 2048 + k]; scond[k * 5 + g] = siluf_(v); }
    __syncthreads();
    float* mod = (float*)(P.ws + WS_MOD);
    const int c4 = tid & 15, kg = tid >> 4;
    for (int cg = blockIdx.x; cg < 4 * MODW / 64; cg += gridDim.x) {
        const int layer = cg / (MODW / 64), colbase = (cg % (MODW / 64)) * 64;
        const float* W = P.in[7] + (size_t)layer * D * MODW + colbase + c4 * 4;
        f32x4 acc[5];
#pragma unroll
        for (int g = 0; g < 5; ++g) acc[g] = (f32x4){0.f, 0.f, 0.f, 0.f};
#pragma unroll 8
        for (int kk = 0; kk < 64; ++kk) {
            const int k = kg * 64 + kk;
            const f32x4 w = *(const f32x4*)(W + (size_t)k * MODW);
#pragma unroll
            for (int g = 0; g < 5; ++g) acc[g] += w * scond[k * 5 + g];
        }
#pragma unroll
        for (int g = 0; g < 5; ++g)
#pragma unroll
            for (int e = 0; e < 4; ++e) red[(kg * 64 + c4 * 4 + e) * 5 + g] = acc[g][e];
        __syncthreads();
        if (tid < 64 * 5) { const int c = tid / 5, g = tid % 5; float sum = 0.f;
#pragma unroll 8
            for (int q = 0; q < 32; ++q) sum += red[(q * 64 + c) * 5 + g];
            mod[((size_t)layer * 5 + g) * MODW + colbase + c] = sum + P.in[8][(size_t)layer * MODW + colbase + c]; }
        __syncthreads();
    }
}

template <bool XF32> __device__ __forceinline__ void norm_mod_phase(const void* xc, const void* xl, const float* w, const float* mod, int sh_off, int sc_off, bf16* H) {
    PHASE_IDS();
    const int RPW = (MROWS + NGW - 1) / NGW;
    f32x4 ca[8], cb[8]; int cgrp = -1;
#pragma unroll
    for (int i = 0; i < 8; ++i) { ca[i] = (f32x4){0.f, 0.f, 0.f, 0.f}; cb[i] = ca[i]; }
    for (int kr = 0; kr < RPW; ++kr) {
        const int m = gw * RPW + kr; if (m >= MROWS) break;
        const bool ctx = m < MCTX; const int grp = ctx ? 0 : 1 + ((m - MCTX) >> 11);
        if (grp != cgrp) { cgrp = grp; const float* mg = mod + (size_t)grp * MODW;
#pragma unroll
            for (int jx = 0; jx < 4; ++jx) { const int c = 8 * (lane + 64 * jx);
                ca[2 * jx] = *(const f32x4*)(w + c) * (*(const f32x4*)(mg + sc_off + c) + 1.f); cb[2 * jx] = *(const f32x4*)(mg + sh_off + c);
                ca[2 * jx + 1] = *(const f32x4*)(w + c + 4) * (*(const f32x4*)(mg + sc_off + c + 4) + 1.f); cb[2 * jx + 1] = *(const f32x4*)(mg + sh_off + c + 4); } }
        f32x4 v[8]; float ss = 0.f;
        if (XF32) { const float* xr = ctx ? (const float*)xc + (size_t)m * D : (const float*)xl + (size_t)(m - MCTX) * D;
#pragma unroll
            for (int jx = 0; jx < 4; ++jx) { v[2 * jx] = *(const f32x4*)(xr + 8 * (lane + 64 * jx)); v[2 * jx + 1] = *(const f32x4*)(xr + 8 * (lane + 64 * jx) + 4); } }
        else { const bf16* xr = (const bf16*)xc + (size_t)m * D;
#pragma unroll
            for (int jx = 0; jx < 4; ++jx) { const u32x4 q = *(const u32x4*)(xr + 8 * (lane + 64 * jx));
                v[2 * jx] = (f32x4){bflo(q.x), bfhi(q.x), bflo(q.y), bfhi(q.y)}; v[2 * jx + 1] = (f32x4){bflo(q.z), bfhi(q.z), bflo(q.w), bfhi(q.w)}; } }
#pragma unroll
        for (int i = 0; i < 8; ++i) ss += (v[i].x * v[i].x + v[i].y * v[i].y) + (v[i].z * v[i].z + v[i].w * v[i].w);
        const float rstd = rsqrtf(wave_sum(ss) * (1.f / D) + EPS);
#pragma unroll
        for (int jx = 0; jx < 4; ++jx) { const int c = 8 * (lane + 64 * jx);
            const f32x4 y0 = v[2 * jx] * rstd * ca[2 * jx] + cb[2 * jx];
            const f32x4 y1 = v[2 * jx + 1] * rstd * ca[2 * jx + 1] + cb[2 * jx + 1];
            u32x4 o; o.x = pk2(y0.x, y0.y); o.y = pk2(y0.z, y0.w); o.z = pk2(y1.x, y1.y); o.w = pk2(y1.z, y1.w);
            *(u32x4*)(H + (size_t)m * D + c) = o; }
    }
}
__device__ __forceinline__ void final_norm_phase(const bf16* X, const float* w, float* out) {
    PHASE_IDS();
    f32x4 cw[8];
#pragma unroll
    for (int jx = 0; jx < 4; ++jx) { const int c = 8 * (lane + 64 * jx); cw[2 * jx] = *(const f32x4*)(w + c); cw[2 * jx + 1] = *(const f32x4*)(w + c + 4); }
    for (int m = gw; m < MROWS; m += NGW) {
        f32x4 v[8]; float ss = 0.f;
#pragma unroll
        for (int jx = 0; jx < 4; ++jx) { const u32x4 q = *(const u32x4*)(X + (size_t)m * D + 8 * (lane + 64 * jx));
            v[2 * jx] = (f32x4){bflo(q.x), bfhi(q.x), bflo(q.y), bfhi(q.y)}; v[2 * jx + 1] = (f32x4){bflo(q.z), bfhi(q.z), bflo(q.w), bfhi(q.w)}; }
#pragma unroll
        for (int i = 0; i < 8; ++i) ss += (v[i].x * v[i].x + v[i].y * v[i].y) + (v[i].z * v[i].z + v[i].w * v[i].w);
        const float rstd = rsqrtf(wave_sum(ss) * (1.f / D) + EPS);
#pragma unroll
        for (int jx = 0; jx < 4; ++jx) { const int c = 8 * (lane + 64 * jx);
            *(f32x4*)(out + (size_t)m * D + c) = v[2 * jx] * rstd * cw[2 * jx]; *(f32x4*)(out + (size_t)m * D + c + 4) = v[2 * jx + 1] * rstd * cw[2 * jx + 1]; }
    }
}

template <int DV> __device__ __forceinline__ void gate_phase(const bf16* OF, const bf16* OB, const bf16* proj, int ldp, int gcol0, const float* nw, bf16* Y, int W) {
    PHASE_IDS();
    const int ncg = W / 512;
    const int nitems = MROWS * ncg;
    f32x4 hw0, hw1;
    { const int cwl = (lane * 8) % DV; hw0 = *(const f32x4*)(nw + cwl); hw1 = *(const f32x4*)(nw + cwl + 4); }
    for (int it0 = gw; it0 < nitems; it0 += 2 * NGW) {
        u32x4 a[2], b[2], gz[2]; int mm[2], cc[2]; bool ok[2];
#pragma unroll
        for (int u = 0; u < 2; ++u) { const int it = it0 + u * NGW; ok[u] = it < nitems; const int itc = ok[u] ? it : it0; mm[u] = itc / ncg; cc[u] = (itc % ncg) * 512 + lane * 8;
            a[u] = *(const u32x4*)(OF + (size_t)mm[u] * W + cc[u]); b[u] = *(const u32x4*)(OB + (size_t)mm[u] * W + cc[u]); gz[u] = *(const u32x4*)(proj + (size_t)mm[u] * ldp + gcol0 + cc[u]); }
#pragma unroll
        for (int u = 0; u < 2; ++u) {
            float o[8], z[8];
            o[0] = bflo(a[u].x) + bflo(b[u].x); o[1] = bfhi(a[u].x) + bfhi(b[u].x); o[2] = bflo(a[u].y) + bflo(b[u].y); o[3] = bfhi(a[u].y) + bfhi(b[u].y);
            o[4] = bflo(a[u].z) + bflo(b[u].z); o[5] = bfhi(a[u].z) + bfhi(b[u].z); o[6] = bflo(a[u].w) + bflo(b[u].w); o[7] = bfhi(a[u].w) + bfhi(b[u].w);
            z[0] = bflo(gz[u].x); z[1] = bfhi(gz[u].x); z[2] = bflo(gz[u].y); z[3] = bfhi(gz[u].y); z[4] = bflo(gz[u].z); z[5] = bfhi(gz[u].z); z[6] = bflo(gz[u].w); z[7] = bfhi(gz[u].w);
            float ss = 0.f;
#pragma unroll
            for (int i = 0; i < 8; ++i) ss += o[i] * o[i];
#pragma unroll
            for (int sft = 1; sft < DV / 8; sft <<= 1) ss += __shfl_xor(ss, sft);
            const float rstd = rsqrtf(ss * (1.f / DV) + EPS);
            const f32x4 w0 = hw0, w1 = hw1;
            const float wv[8] = {w0.x, w0.y, w0.z, w0.w, w1.x, w1.y, w1.z, w1.w};
            float y[8];
#pragma unroll
            for (int i = 0; i < 8; ++i) y[i] = o[i] * rstd * wv[i] * siluf_(z[i]);
            u32x4 rr; rr.x = pk2(y[0], y[1]); rr.y = pk2(y[2], y[3]); rr.z = pk2(y[4], y[5]); rr.w = pk2(y[6], y[7]);
            if (ok[u]) *(u32x4*)(Y + (size_t)mm[u] * W + cc[u]) = rr;
        }
    }
}

__device__ __forceinline__ void dn_prep_phase(const Params& P, int j, bool do_gates = true) {
    PHASE_IDS();
    const bf16* proj = (const bf16*)(P.ws + WS_BIG); bf16* QKV = (bf16*)(P.ws + WS_QKV);
    const float* cw = P.in[15] + (size_t)j * 5 * 8192;
    for (int it = gw; it < 16 * 128; it += NGW) {
        const int cg = it & 15, chunk = it >> 4, c = cg * 512 + lane * 8;
        float w[5][8];
#pragma unroll
        for (int s = 0; s < 5; ++s) { const f32x4 a = *(const f32x4*)(cw + s * 8192 + c), b = *(const f32x4*)(cw + s * 8192 + c + 4);
            w[s][0] = a.x; w[s][1] = a.y; w[s][2] = a.z; w[s][3] = a.w; w[s][4] = b.x; w[s][5] = b.y; w[s][6] = b.z; w[s][7] = b.w; }
        const float qsc = cg < 4 ? 0.08838834764831845f : 1.f;
        for (int bt = 0; bt < 16; ++bt) {
            const int r0 = chunk * 128 + bt * 8;
            const int L = r0 < MCTX ? 256 : 64, pos0 = r0 < MCTX ? (r0 & 255) : ((r0 - MCTX) & 63);
            u32x4 xw[12];
#pragma unroll
            for (int i = 0; i < 12; ++i) { const int pp = pos0 + i - 2;
                xw[i] = (pp >= 0 && pp < L) ? *(const u32x4*)(proj + (size_t)(r0 + i - 2) * DN_NMAIN + c) : (u32x4){0u, 0u, 0u, 0u}; }
#pragma unroll
            for (int o = 0; o < 8; ++o) {
                float acc[8];
#pragma unroll
                for (int i = 0; i < 8; ++i) acc[i] = 0.f;
#pragma unroll
                for (int s = 0; s < 5; ++s) { const u32x4 x = xw[o + s];
                    acc[0] += bflo(x.x) * w[s][0]; acc[1] += bfhi(x.x) * w[s][1]; acc[2] += bflo(x.y) * w[s][2]; acc[3] += bfhi(x.y) * w[s][3];
                    acc[4] += bflo(x.z) * w[s][4]; acc[5] += bfhi(x.z) * w[s][5]; acc[6] += bflo(x.w) * w[s][6]; acc[7] += bfhi(x.w) * w[s][7]; }
                float ss = 0.f;
#pragma unroll
                for (int i = 0; i < 8; ++i) { acc[i] = siluf_(acc[i]); ss += acc[i] * acc[i]; }
                if (cg < 8) {
                    ss += __shfl_xor(ss, 1); ss += __shfl_xor(ss, 2); ss += __shfl_xor(ss, 4); ss += __shfl_xor(ss, 8);
                    const float sc = rsqrtf(ss + EPS) * qsc;
#pragma unroll
                    for (int i = 0; i < 8; ++i) acc[i] *= sc;
                }
                u32x4 ov; ov.x = pk2(acc[0], acc[1]); ov.y = pk2(acc[2], acc[3]); ov.z = pk2(acc[4], acc[5]); ov.w = pk2(acc[6], acc[7]);
                *(u32x4*)(QKV + (size_t)(r0 + o) * 8192 + c) = ov;
            }
        }
    }
    if (!do_gates) return;
    float* G = (float*)(P.ws + WS_GATE);
    const float* Alog = P.in[16] + j * 64; const float* dtb = P.in[17] + j * 64;
    const float* GPp = (const float*)(P.ws + WS_GP);
    for (int i = gw * 64 + lane; i < MROWS * 128; i += NGW * 64) {
        const int col = i & 127; const float x = (GPp[i] + GPp[i + (size_t)MROWS * 128]) + (GPp[i + (size_t)2 * MROWS * 128] + GPp[i + (size_t)3 * MROWS * 128]); float y;
        if (col < 64) y = sigmoidf_(x);
        else { const int dh = col - 64; y = -__expf(Alog[dh]) * softplusf_(x + dtb[dh]); }
        G[i] = y;
    }
}

typedef short bf16x8 __attribute__((ext_vector_type(8)));
typedef short s16x4 __attribute__((ext_vector_type(4)));
typedef __bf16 bfv8 __attribute__((ext_vector_type(8)));
typedef float f32x8 __attribute__((ext_vector_type(8)));
__device__ __forceinline__ bf16x8 pack8(f32x4 a, f32x4 b) { const f32x8 v = {a[0], a[1], a[2], a[3], b[0], b[1], b[2], b[3]}; return __builtin_bit_cast(bf16x8, __builtin_convertvector(v, bfv8)); }
__device__ __forceinline__ bf16x8 cat4(s16x4 a, s16x4 b) { return (bf16x8){a[0], a[1], a[2], a[3], b[0], b[1], b[2], b[3]}; }
__device__ __forceinline__ s16x4 ld_tr(const LAS unsigned char* p) { return __builtin_amdgcn_ds_read_tr16_b64_v4i16((LAS s16x4*)p); }
__device__ __forceinline__ s16x4 ld_b64(const LAS unsigned char* p) { return *(const volatile LAS s16x4*)p; }
__device__ __forceinline__ bf16x8 ld_b128(const LAS unsigned char* p) { return *(const LAS bf16x8*)p; }
#define MFMA16(a, b, c) __builtin_amdgcn_mfma_f32_16x16x32_bf16((a), (b), (c), 0, 0, 0)

template <int KIND> __device__ __forceinline__ void gla_prep_phase(const Params& P, LAS unsigned char* lds) {
    PHASE_IDS();
    constexpr int NCH = KIND == 1 ? 1024 : 2048, LDP = KIND == 1 ? GLA_NMAIN : HG_NIN, NCB = NCH / 1024;
    const bf16* proj = (const bf16*)(P.ws + WS_BIG); const float* G = (const float*)(P.ws + WS_GATE);
    bf16* QT = (bf16*)(P.ws + WS_QKV); bf16* KT = QT + (size_t)2 * MROWS * NCH; float* E = (float*)(P.ws + WS_OF + 64 * MiB);
    constexpr int DKH = KIND == 1 ? 256 : 128, NHB = 1024 / DKH  , NHT = NCH / DKH  , PL = 2064  ;
    LAS unsigned char* QL = lds; LAS unsigned char* KL = lds + 32 * PL;
    LAS float* sa1 = (LAS float*)(lds + 2 * 32 * PL);
    unsigned* PG = (unsigned*)(P.ws + WS_OF + 72 * MiB);
    for (int it = blockIdx.x; it < 2 * 512 * NCB; it += gridDim.x) {
        const int cb_ = it % NCB, cidx = (it / NCB) % 512, d = it / (NCB * 512);
        const int c0 = cb_ * 1024 + 2 * tid, rbase = cidx * 32;
        float w0[16], w1[16], b0 = 0.f, b1 = 0.f, lb0 = 0.f, lb1 = 0.f;
        if (KIND == 1) {
            __syncthreads();
            { const int p = tid >> 4, r = tid & 15; const int row = rbase + (d ? 31 - p : p); const size_t gi = (size_t)row * 128 + d * 16 + r; const float* GPp = (const float*)(P.ws + WS_GP); sa1[tid] = (GPp[gi] + GPp[gi + (size_t)MROWS * 128]) + (GPp[gi + (size_t)2 * MROWS * 128] + GPp[gi + (size_t)3 * MROWS * 128]); }
            __syncthreads();
            const float* w2 = P.in[21] + (size_t)d * 16 * 1024 + c0;
#pragma unroll
            for (int r = 0; r < 16; ++r) { w0[r] = w2[(size_t)r * 1024]; w1[r] = w2[(size_t)r * 1024 + 1]; }
            b0 = P.in[22][d * 1024 + c0]; b1 = P.in[22][d * 1024 + c0 + 1];
        } else {
            const float* lg = P.in[26];
            { const float l0 = lg[c0], l1 = lg[2048 + c0], l2 = lg[4096 + c0], l3 = lg[6144 + c0]; const float mx = fmaxf(fmaxf(l0, l1), fmaxf(l2, l3));
              const float e0 = __expf(l0 - mx), e1 = __expf(l1 - mx), e2 = __expf(l2 - mx), e3 = __expf(l3 - mx); lb0 = (e1 + e2) / ((e0 + e1) + (e2 + e3)); }
            { const float l0 = lg[c0 + 1], l1 = lg[2048 + c0 + 1], l2 = lg[4096 + c0 + 1], l3 = lg[6144 + c0 + 1]; const float mx = fmaxf(fmaxf(l0, l1), fmaxf(l2, l3));
              const float e0 = __expf(l0 - mx), e1 = __expf(l1 - mx), e2 = __expf(l2 - mx), e3 = __expf(l3 - mx); lb1 = (e1 + e2) / ((e0 + e1) + (e2 + e3)); }
        }
        float cs0 = KIND == 1 ? 0.f : 1.f, cs1 = cs0;
        constexpr int XOFF_G = 1024;
        const int xoff = KIND == 1 ? XOFF_G : (d ? 8192 : 6144);
        unsigned nq[8], nx[8];
#define GP_LOAD(pb_) do { _Pragma("unroll") for (int u = 0; u < 8; ++u) { const int pp_ = (pb_) + u; const bf16* pr_ = proj + (size_t)(rbase + (d ? 31 - pp_ : pp_)) * LDP + c0; nq[u] = *(const unsigned*)pr_; nx[u] = *(const unsigned*)(pr_ + xoff); } } while (0)
        GP_LOAD(0);
#pragma unroll 1
        for (int pb8 = 0; pb8 < 32; pb8 += 8) {
          unsigned cq[8], cx[8];
#pragma unroll
          for (int u = 0; u < 8; ++u) { cq[u] = nq[u]; cx[u] = nx[u]; }
          { const int pn = pb8 + 8 < 32 ? pb8 + 8 : pb8; GP_LOAD(pn); }
#pragma unroll
          for (int u = 0; u < 8; ++u) {
            const int p = pb8 + u;
            const int row = rbase + (d ? 31 - p : p);
            float q0, q1, k0, k1, la0, la1;
            if (KIND == 1) {
                const unsigned qw = cq[u], kw = cx[u];
                q0 = bflo(qw) * 0.0625f; q1 = bfhi(qw) * 0.0625f; k0 = bflo(kw); k1 = bfhi(kw);
                float x0 = b0, x1 = b1;
#pragma unroll
                for (int r = 0; r < 16; ++r) { const float a = sa1[p * 16 + r]; x0 = __builtin_fmaf(a, w0[r], x0); x1 = __builtin_fmaf(a, w1[r], x1); }
                la0 = (fminf(x0, 0.f) - 0.6931471805599453f * __builtin_amdgcn_logf(1.f + __expf(-fabsf(x0)))) * 0.0625f; la1 = (fminf(x1, 0.f) - 0.6931471805599453f * __builtin_amdgcn_logf(1.f + __expf(-fabsf(x1)))) * 0.0625f;
            } else {
                const unsigned qw = cq[u], fw = cx[u];
                q0 = siluf_(bflo(qw)) * 0.08838834764831845f; q1 = siluf_(bfhi(qw)) * 0.08838834764831845f;
                const float a0 = lb0 + (1.f - lb0) * sigmoidf_(bflo(fw)), a1 = lb1 + (1.f - lb1) * sigmoidf_(bfhi(fw));
                k0 = 1.f - a0; k1 = 1.f - a1; la0 = a0; la1 = a1;
            }
            float e0, e1, i0, i1;
            if (KIND == 1) { cs0 += la0; cs1 += la1; e0 = __expf(cs0); e1 = __expf(cs1); i0 = __builtin_amdgcn_rcpf(e0); i1 = __builtin_amdgcn_rcpf(e1); }
            else { cs0 *= la0; cs1 *= la1; e0 = cs0; e1 = cs1; i0 = __builtin_amdgcn_rcpf(cs0); i1 = __builtin_amdgcn_rcpf(cs1); }
            const size_t o = ((size_t)d * MROWS + row) * NCH + c0;
            const unsigned qb = pk2(q0 * e0, q1 * e1), kb = pk2(k0 * i0, k1 * i1);
            *(unsigned*)(QT + o) = qb; *(unsigned*)(KT + o) = kb;
            *(LAS unsigned*)(QL + p * PL + 4 * tid) = qb; *(LAS unsigned*)(KL + p * PL + 4 * tid) = kb;
          }
        }
#undef GP_LOAD
        { float* e = E + ((size_t)d * 512 + cidx) * NCH + c0; e[0] = KIND == 1 ? __expf(cs0) : cs0; e[1] = KIND == 1 ? __expf(cs1) : cs1; }
        __syncthreads();
        {
            const int r = lane & 15, g = lane >> 4;
            const int hl = KIND == 1 ? (wave >> 1) : wave; const int cbase = hl * DKH;
            f32x4 t0 = {0.f, 0.f, 0.f, 0.f}, t1 = t0, t2 = t0;
            const bool do02 = KIND == 1 ? ((wave & 1) == 0) : true, do1 = KIND == 1 ? ((wave & 1) == 1) : true;
#pragma unroll
            for (int sx = 0; sx < DKH / 32; ++sx) {
                const int cb2 = (cbase + 32 * sx + 8 * g) * 2;
                const bf16x8 k0 = ld_b128(KL + r * PL + cb2), q1 = ld_b128(QL + (16 + r) * PL + cb2);
                if (do02) { const bf16x8 q0 = ld_b128(QL + r * PL + cb2), k1 = ld_b128(KL + (16 + r) * PL + cb2); t0 = MFMA16(k0, q0, t0); t2 = MFMA16(k1, q1, t2); }
                if (do1) t1 = MFMA16(k0, q1, t1);
            }
#pragma unroll
            for (int e = 0; e < 4; ++e) { if (r < 4 * g + e) { t0[e] = 0.f; t2[e] = 0.f; } }
            unsigned* pg = PG + (((size_t)d * 512 + cidx) * NHT + cb_ * NHB + hl) * 384 + lane * 2;
            if (do02) { pg[0] = pk2(t0[0], t0[1]); pg[1] = pk2(t0[2], t0[3]); pg[256] = pk2(t2[0], t2[1]); pg[257] = pk2(t2[2], t2[3]); }
            if (do1) { pg[128] = pk2(t1[0], t1[1]); pg[129] = pk2(t1[2], t1[3]); }
        }
        __syncthreads();
    }
}

template <int KIND> __device__ __forceinline__ void gla_chunk_phase(const Params& P, LAS unsigned char* lds) {
    PHASE_IDS();
    constexpr int DK = KIND == 1 ? 256 : 128, DV = KIND == 1 ? 512 : 128, NH = KIND == 1 ? 4 : 16, NSL = DV / 128, NKT = DK / 16, NCH = NH * DK;
    constexpr int LDP = KIND == 1 ? GLA_NMAIN : HG_NIN, W = 2048;
    constexpr int PQ = DK * 2 + 16, PV = 256 + 16;
    constexpr int OFF_Q = 0, OFF_K = 32 * PQ, OFF_V = 2 * 32 * PQ, OFF_E = OFF_V + 32 * PV;
    constexpr int NPQ = 32 * DK / 8 / NT;
    const bf16* proj = (const bf16*)(P.ws + WS_BIG);
    const bf16* QT = (const bf16*)(P.ws + WS_QKV); const bf16* KT = QT + (size_t)2 * MROWS * NCH; const float* Eg = (const float*)(P.ws + WS_OF + 64 * MiB);
    bf16* OF = (bf16*)(P.ws + WS_OF); bf16* OB = (bf16*)(P.ws + WS_OB);
    const u32x2* PG = (const u32x2*)(P.ws + WS_OF + 72 * MiB);
    const int r = lane & 15, g = lane >> 4, q4 = (lane & 15) >> 2, p4 = lane & 3;
    constexpr int UL = 4 * NH * 2 * NSL  , UC = 32 * NH * 2 * NSL  ;
    const int G = gridDim.x, bx = blockIdx.x;
    const bool bal = (G == 2 * UL);
    const int nun = bal ? (bx < UL ? 1 : UC / UL) : (UL + UC - bx + G - 1) / G;
    for (int ui = 0; ui < nun; ++ui) {
        const int bxl = bx < UL ? bx : bx - UL;
        const int bxq = (bal && NSL == 4) ? (((bxl & 7) + 8 * (bxl >> 5)) * 4 + ((bxl >> 3) & 3)) : bxl;
        const int unit = bal ? (bx < UL ? bxq : UL + bxq + UL * ui) : bx + ui * G;
        const bool lat = unit < UL; int u2 = lat ? unit : unit - UL;
        const int sl = u2 % NSL; u2 /= NSL; const int d = u2 & 1; u2 >>= 1; const int h = u2 % NH; const int b = u2 / NH;
        const int T = lat ? 2048 : 256, row0 = lat ? MCTX + b * 2048 : b * 256, nchunk = T / 32;
        bf16* O = d ? OB : OF;
        f32x4 S[NKT];
        { const float* s0 = (KIND == 1 ? P.in[4] : P.in[5]) + ((((size_t)b * 2 + d) * NH + h) * DK) * DV + sl * 128 + 16 * wave + r;
#pragma unroll
          for (int kt = 0; kt < NKT; ++kt)
#pragma unroll
              for (int e = 0; e < 4; ++e) S[kt][e] = lat ? s0[(size_t)(16 * kt + 4 * g + e) * DV] : 0.f; }
        u32x4 rq[NPQ], rk[NPQ], rv; f32x4 re = {0.f, 0.f, 0.f, 0.f}; u32x2 rp0 = {0u, 0u}, rp1 = rp0, rp2 = rp0;
#define GLC_PREFETCH(c_) do { \
            _Pragma("unroll") for (int x = 0; x < NPQ; ++x) { const int pi = tid + x * NT, pr = pi / (DK / 8), pc = pi % (DK / 8); const int pp = (c_) * 32 + pr; const int t = d ? T - 1 - pp : pp; \
                const size_t o = ((size_t)d * MROWS + row0 + t) * NCH + h * DK + pc * 8; rq[x] = *(const u32x4*)(QT + o); rk[x] = *(const u32x4*)(KT + o); } \
            { const int pr = tid >> 4, pc = tid & 15; const int pp = (c_) * 32 + pr; const int t = d ? T - 1 - pp : pp; rv = *(const u32x4*)(proj + (size_t)(row0 + t) * LDP + 2048 + h * DV + sl * 128 + pc * 8); } \
            { const int cg = d ? (row0 + T) / 32 - 1 - (c_) : row0 / 32 + (c_); if (tid < DK / 4) re = *(const f32x4*)(Eg + ((size_t)d * 512 + cg) * NCH + h * DK + tid * 4); \
              const u32x2* pg = PG + (((size_t)d * 512 + cg) * NH + h) * 192 + lane; rp0 = pg[0]; rp1 = pg[64]; rp2 = pg[128]; } } while (0)
        GLC_PREFETCH(0);
        for (int c = 0; c < nchunk; ++c) {
            __syncthreads();
#pragma unroll
            for (int x = 0; x < NPQ; ++x) { const int pi = tid + x * NT, pr = pi / (DK / 8), pc = pi % (DK / 8);
                *(LAS u32x4*)(lds + OFF_Q + pr * PQ + pc * 16) = rq[x]; *(LAS u32x4*)(lds + OFF_K + pr * PQ + pc * 16) = rk[x]; }
            { const int pr = tid >> 4, pc = tid & 15; *(LAS u32x4*)(lds + OFF_V + pr * PV + pc * 16) = rv; }
            if (tid < DK / 4) *(LAS f32x4*)(lds + OFF_E + tid * 16) = re;
            __syncthreads();
            const u32x2 cp0 = rp0, cp1 = rp1, cp2 = rp2;
            if (c + 1 < nchunk) GLC_PREFETCH(c + 1);
            const f32x4 zero4 = {0.f, 0.f, 0.f, 0.f};
            const bf16x8 vpa = cat4(ld_tr(lds + OFF_V + (4 * g + q4) * PV + (16 * wave + 4 * p4) * 2), ld_tr(lds + OFF_V + (16 + 4 * g + q4) * PV + (16 * wave + 4 * p4) * 2));
            const bf16x8 pb0 = __builtin_bit_cast(bf16x8, (u32x4){cp0.x, cp0.y, 0u, 0u}), pb1 = __builtin_bit_cast(bf16x8, (u32x4){cp1.x, cp1.y, cp2.x, cp2.y});
            f32x4 o0 = MFMA16(vpa, pb0, zero4), o1 = MFMA16(vpa, pb1, zero4);
#pragma unroll
            for (int s = 0; s < DK / 32; ++s) {
                const bf16x8 sb = pack8(S[2 * s], S[2 * s + 1]);
                const bf16x8 a0 = cat4(ld_b64(lds + OFF_Q + r * PQ + (32 * s + 4 * g) * 2), ld_b64(lds + OFF_Q + r * PQ + (32 * s + 16 + 4 * g) * 2));
                const bf16x8 a1 = cat4(ld_b64(lds + OFF_Q + (16 + r) * PQ + (32 * s + 4 * g) * 2), ld_b64(lds + OFF_Q + (16 + r) * PQ + (32 * s + 16 + 4 * g) * 2));
                o0 = MFMA16(sb, a0, o0); o1 = MFMA16(sb, a1, o1);
                if (KIND == 1 && (s & 3) == 3) asm volatile("" ::: "memory");
            }
            { const int colo = h * DV + sl * 128 + 16 * wave + 4 * g; const int pp0 = c * 32 + r, pp1 = c * 32 + 16 + r; const int t0 = d ? T - 1 - pp0 : pp0, t1 = d ? T - 1 - pp1 : pp1;
              u32x2 w0, w1; w0.x = pk2(o0[0], o0[1]); w0.y = pk2(o0[2], o0[3]); w1.x = pk2(o1[0], o1[1]); w1.y = pk2(o1[2], o1[3]);
              *(u32x2*)(O + (size_t)(row0 + t0) * W + colo) = w0; *(u32x2*)(O + (size_t)(row0 + t1) * W + colo) = w1; }
            const bf16x8 vb = cat4(ld_tr(lds + OFF_V + (8 * g + q4) * PV + (16 * wave + 4 * p4) * 2), ld_tr(lds + OFF_V + (8 * g + 4 + q4) * PV + (16 * wave + 4 * p4) * 2));
#pragma unroll
            for (int kt = 0; kt < NKT; ++kt) {
                const bf16x8 ka = cat4(ld_tr(lds + OFF_K + (8 * g + q4) * PQ + (16 * kt + 4 * p4) * 2), ld_tr(lds + OFF_K + (8 * g + 4 + q4) * PQ + (16 * kt + 4 * p4) * 2));
                const f32x4 ev = *(const LAS f32x4*)(lds + OFF_E + (16 * kt + 4 * g) * 4);
                S[kt] = MFMA16(ka, vb, S[kt]) * ev;
                if (KIND == 1 && (kt & 7) == 7) asm volatile("" ::: "memory");
            }
        }
#undef GLC_PREFETCH
        if (!lat) { float* sd = P.out + (KIND == 1 ? OUT_SGLA : OUT_SHG) + ((((size_t)b * 2 + d) * NH + h) * DK) * DV + sl * 128 + 16 * wave + r;
#pragma unroll
            for (int kt = 0; kt < NKT; ++kt)
#pragma unroll
                for (int e = 0; e < 4; ++e) sd[(size_t)(16 * kt + 4 * g + e) * DV] = S[kt][e]; }
    }
}

#define MFMA4F(a, b, c) __builtin_amdgcn_mfma_f32_16x16x4f32((a), (b), (c), 0, 0, 0)
template <int I> __device__ __forceinline__ float row_share(float v) { return __builtin_bit_cast(float, __builtin_amdgcn_mov_dpp(__builtin_bit_cast(int, v), 0x150 + I, 0xf, 0xf, false)); }
template <int I> struct DiagStep {
    static __device__ __forceinline__ void run(const float (&Ld)[16], float (&x)[16], int cc) {
        DiagStep<I - 1>::run(Ld, x, cc);
        float a0 = 0.f, a1 = 0.f;
#pragma unroll
        for (int m = 0; m < I; ++m) { const float lv = row_share<I>(Ld[m]); if (m & 1) a1 += lv * x[m]; else a0 += lv * x[m]; }
        x[I] = ((I == cc) ? 1.f : 0.f) - (a0 + a1);
    }
};
template <> struct DiagStep<-1> { static __device__ __forceinline__ void run(const float (&)[16], float (&)[16], int) {} };
__device__ __forceinline__ void dn_wu_prep_phase(const Params& P, LAS unsigned char* lds) {
    PHASE_IDS();
    constexpr int PKQ = 272;
    constexpr int LP = 68;
    constexpr int OFF_K = 0, OFF_Q = 64 * PKQ, OFF_L = 0  , OFF_KK = 4 * 64 * LP * 4, OFF_QK = OFF_KK + 64 * LP * 4, OFF_G = OFF_QK + 64 * LP * 4;
    const bf16* QKV = (const bf16*)(P.ws + WS_QKV); const float* G = (const float*)(P.ws + WS_GATE);
    bf16* TA = (bf16*)(P.ws + WS_TA); float* GS = (float*)(P.ws + WS_GS);
    const int r = lane & 15, g = lane >> 4;
    LAS float* KKs = (LAS float*)(lds + OFF_KK); LAS float* QKs = (LAS float*)(lds + OFF_QK); LAS float* Gs = (LAS float*)(lds + OFF_G);
    u32x4 pq[2], pk[2]; float pgv = 0.f;
#define WU_PREFETCH(grp_) do { const int cidx_ = (grp_) >> 4, kh_ = (grp_) & 15, rb_ = cidx_ * 64; \
        _Pragma("unroll") for (int x = 0; x < 2; ++x) { const int pi = tid + x * NT, pr = pi >> 4, pc = pi & 15; const size_t o = (size_t)(rb_ + pr) * 8192 + kh_ * 128 + pc * 8; pq[x] = *(const u32x4*)(QKV + o); pk[x] = *(const u32x4*)(QKV + o + 2048); } \
        { const int c4 = tid >> 7, which = (tid >> 6) & 1, i = tid & 63, hv = c4 >> 1, d = c4 & 1, h = 2 * kh_ + hv; pgv = G[(size_t)(rb_ + i) * 128 + (which ? 0 : 64) + d * 32 + h]; } } while (0)
    if ((int)blockIdx.x < 256 * 16) WU_PREFETCH(blockIdx.x);
    for (int grp = blockIdx.x; grp < 256 * 16; grp += gridDim.x) {
        const int cidx = grp >> 4, kh = grp & 15;
        __syncthreads();
#pragma unroll
        for (int x = 0; x < 2; ++x) { const int pi = tid + x * NT, pr = pi >> 4, pc = pi & 15;
            *(LAS u32x4*)(lds + OFF_Q + pr * PKQ + pc * 16) = pq[x]; *(LAS u32x4*)(lds + OFF_K + pr * PKQ + pc * 16) = pk[x]; }
        Gs[tid] = pgv;
        __syncthreads();
        if (grp + (int)gridDim.x < 256 * 16) WU_PREFETCH(grp + (int)gridDim.x);
        {
            const int it = wave & 3; const int offx = (wave >> 2) ? OFF_Q : OFF_K; LAS float* dst = (wave >> 2) ? QKs : KKs;
            f32x4 acc[4];
#pragma unroll
            for (int jt = 0; jt < 4; ++jt) acc[jt] = (f32x4){0.f, 0.f, 0.f, 0.f};
#pragma unroll
            for (int sx = 0; sx < 4; ++sx) { const bf16x8 a = ld_b128(lds + offx + (16 * it + r) * PKQ + (32 * sx + 8 * g) * 2);
#pragma unroll
                for (int jt = 0; jt < 4; ++jt) acc[jt] = MFMA16(a, ld_b128(lds + OFF_K + (16 * jt + r) * PKQ + (32 * sx + 8 * g) * 2), acc[jt]); }
#pragma unroll
            for (int jt = 0; jt < 4; ++jt)
#pragma unroll
                for (int e = 0; e < 4; ++e) dst[(16 * it + 4 * g + e) * LP + 16 * jt + r] = acc[jt][e];
        }
        __syncthreads();
        {
            const int c4 = wave & 3, hv = c4 >> 1, d = c4 & 1, h = 2 * kh + hv;
            const int nl = d ? 63 - lane : lane;
            float gcv = Gs[(c4 * 2 + 0) * 64 + nl];
#pragma unroll
            for (int o = 1; o < 64; o <<= 1) { const float t = __shfl_up(gcv, o); if (lane >= o) gcv += t; }
            const float betav = Gs[(c4 * 2 + 1) * 64 + nl];
            const size_t item = ((size_t)(cidx * 32 + h) * 2 + d);
            LAS float* W = (LAS float*)(lds + OFF_L) + c4 * 64 * LP;
            {
                bf16* Ag = TA + item * 8192 + 4096;
                const int pb = (wave >> 2) * 32;
#define WU_LA_TRIPS(REV_) \
                _Pragma("unroll 1") for (int p0 = pb; p0 < pb + 32; p0 += 8) { \
                    const LAS float* kb_ = KKs + ((REV_) ? 56 - p0 : p0) * LP + nl; const LAS float* qb_ = QKs + ((REV_) ? 56 - p0 : p0) * LP + nl; \
                    LAS float* wb_ = W + p0 * LP + lane; bf16* ab_ = Ag + p0 * 64 + lane; const int lrel_ = lane - p0; \
                    float kkv[8], qkv[8]; \
                    _Pragma("unroll") for (int u = 0; u < 8; ++u) { kkv[u] = kb_[((REV_) ? 7 - u : u) * LP]; qkv[u] = qb_[((REV_) ? 7 - u : u) * LP]; } \
                    _Pragma("unroll") for (int u = 0; u < 8; ++u) { const int p = p0 + u; const float gp = rdlane(gcv, p), bp = rdlane(betav, p); const float ex = __expf(gp - gcv); \
                        float lv = bp * kkv[u] * ex, av = qkv[u] * ex; \
                        asm volatile("" : "+v"(lv), "+v"(av)); \
                        wb_[u * LP] = lrel_ < u ? lv : 0.f; \
                        ab_[u * 64] = (bf16)f2bf(lrel_ <= u ? av : 0.f); } \
                }
                if (d) { WU_LA_TRIPS(1) } else { WU_LA_TRIPS(0) }
#undef WU_LA_TRIPS
            }
            if (wave >= 4) {
                float* gs = GS + item * 192; const float gend = rdlane(gcv, 63);
                gs[lane] = __expf(gcv); gs[64 + lane] = betav; gs[128 + lane] = __expf(gend - gcv);
            }
            __syncthreads();
            if (wave < 4) {
                {
                    const int lane2 = opaque_v(lane); const int bb = lane2 >> 4, cc = lane2 & 15;
                    float Ld[16];
#pragma unroll
                    for (int m4 = 0; m4 < 4; ++m4) { const f32x4 v = *(const LAS f32x4*)(W + (16 * bb + cc) * LP + 16 * bb + 4 * m4); Ld[4 * m4] = v[0]; Ld[4 * m4 + 1] = v[1]; Ld[4 * m4 + 2] = v[2]; Ld[4 * m4 + 3] = v[3]; }
                    float x[16];
                    DiagStep<15>::run(Ld, x, cc);
#pragma unroll
                    for (int i = 0; i < 16; ++i) W[(16 * bb + i) * LP + 16 * bb + cc] = x[i];
                }
#define WU_PN(ar, ac, br, bc, acc_) do { _Pragma("unroll") for (int sx = 0; sx < 4; ++sx) acc_ = MFMA4F(W[((ar) + r) * LP + (ac) + 4 * sx + g], W[((br) + 4 * sx + g) * LP + (bc) + r], acc_); } while (0)
#define WU_PA(ar, ac, M_, acc_) do { _Pragma("unroll") for (int e = 0; e < 4; ++e) acc_ = MFMA4F(W[((ar) + r) * LP + (ac) + 4 * g + e], M_[e], acc_); } while (0)
#define WU_ST(r0, c0, acc_) do { _Pragma("unroll") for (int e = 0; e < 4; ++e) W[((r0) + 4 * g + e) * LP + (c0) + r] = -acc_[e]; } while (0)
                const f32x4 z4 = {0.f, 0.f, 0.f, 0.f};
                { f32x4 m1a = z4, m1b = z4; WU_PN(16, 0, 0, 0, m1a); WU_PN(48, 32, 32, 32, m1b);
                  f32x4 t10 = z4, t32 = z4; WU_PA(16, 16, m1a, t10); WU_PA(48, 48, m1b, t32);
                  WU_ST(16, 0, t10); WU_ST(48, 32, t32); }
                { f32x4 m00 = z4, m01 = z4, m10 = z4, m11 = z4;
                  WU_PN(32, 0, 0, 0, m00); WU_PN(32, 16, 16, 0, m00); WU_PN(32, 16, 16, 16, m01);
                  WU_PN(48, 0, 0, 0, m10); WU_PN(48, 16, 16, 0, m10); WU_PN(48, 16, 16, 16, m11);
                  f32x4 t00 = z4, t01 = z4, t10 = z4, t11 = z4;
                  WU_PA(32, 32, m00, t00); WU_PA(32, 32, m01, t01);
                  WU_PA(48, 32, m00, t10); WU_PA(48, 48, m10, t10); WU_PA(48, 32, m01, t11); WU_PA(48, 48, m11, t11);
                  WU_ST(32, 0, t00); WU_ST(32, 16, t01); WU_ST(48, 0, t10); WU_ST(48, 16, t11); }
#undef WU_PN
#undef WU_PA
#undef WU_ST
                bf16* Tg = TA + item * 8192;
#pragma unroll
                for (int x8 = 0; x8 < 8; ++x8) { const int piece = lane + 64 * x8, row = piece >> 3, pc = piece & 7;
                    const f32x4 v0 = *(const LAS f32x4*)(W + row * LP + pc * 8), v1 = *(const LAS f32x4*)(W + row * LP + pc * 8 + 4);
                    u32x4 o; o.x = pk2(v0[0], v0[1]); o.y = pk2(v0[2], v0[3]); o.z = pk2(v1[0], v1[1]); o.w = pk2(v1[2], v1[3]);
                    if (pc * 8 <= row) *(u32x4*)(Tg + row * 64 + pc * 8) = o; }
            }
        }
    }
#undef WU_PREFETCH
}

constexpr int DN_PQ = 272;
constexpr int DN_PXQ = 144, DN_XQ = 64 * DN_PXQ, DN_PXT = 80, DN_XT = 64 * DN_PXT;
constexpr int DN_OFF_Q = 0, DN_OFF_K = 2 * DN_XQ, DN_OFF_V = DN_OFF_K + 64 * DN_PQ, DN_OFF_T = DN_OFF_V + 64 * DN_PQ, DN_OFF_A = DN_OFF_T + 2 * DN_XT, DN_OFF_S = DN_OFF_A + 2 * DN_XT;
struct DnStage { u32x4 rq[2], rk[2], rv[2], rt, ra; f32x4 rs; };
__device__ __forceinline__ void dn_stage_load(DnStage& st, const bf16* QKV, const bf16* TA, const float* GS, int tid, int c, int d, int T, int row0, int kh, int h, int nchunk) {
#pragma unroll
    for (int x = 0; x < 2; ++x) { const int pi = tid + x * NT, pr = pi >> 4, pc = pi & 15; const int pp = c * 64 + pr; const int t = d ? T - 1 - pp : pp;
        const size_t o = (size_t)(row0 + t) * 8192 + pc * 8; st.rq[x] = *(const u32x4*)(QKV + o + kh * 128); st.rk[x] = *(const u32x4*)(QKV + o + 2048 + kh * 128); st.rv[x] = *(const u32x4*)(QKV + o + 4096 + h * 128); }
    const int nc = d ? nchunk - 1 - c : c; const size_t item = ((size_t)((row0 >> 6) + nc) * 32 + h) * 2 + d;
    const bool nz = ((tid & 7) * 8) <= (tid >> 3);
    st.rt = nz ? *(const u32x4*)(TA + item * 8192 + tid * 8) : (u32x4){0u, 0u, 0u, 0u}; st.ra = nz ? *(const u32x4*)(TA + item * 8192 + 4096 + tid * 8) : (u32x4){0u, 0u, 0u, 0u};
    st.rs = (f32x4){0.f, 0.f, 0.f, 0.f}; if (tid < 48) st.rs = *(const f32x4*)(GS + item * 192 + tid * 4);
}
__device__ __forceinline__ void dn_stage_store(const DnStage& st, LAS unsigned char* lds, int tid) {
#pragma unroll
    for (int x = 0; x < 2; ++x) { const int pi = tid + x * NT, pr = pi >> 4, pc = pi & 15;
        { LAS unsigned char* qd = lds + DN_OFF_Q + pr * DN_PXQ + (2 * (pc >> 2) + (pc & 1)) * 16 + ((pc >> 1) & 1) * 8;
          *(LAS u32x2*)qd = (u32x2){st.rq[x].x, st.rq[x].y}; *(LAS u32x2*)(qd + DN_XQ) = (u32x2){st.rq[x].z, st.rq[x].w}; }
        *(LAS u32x4*)(lds + DN_OFF_K + pr * DN_PQ + pc * 16) = st.rk[x]; *(LAS u32x4*)(lds + DN_OFF_V + pr * DN_PQ + pc * 16) = st.rv[x]; }
    { const int pr = tid >> 3, pc = tid & 7; const int o = pr * DN_PXT + (2 * (pc >> 2) + (pc & 1)) * 16 + ((pc >> 1) & 1) * 8;
      *(LAS u32x2*)(lds + DN_OFF_T + o) = (u32x2){st.rt.x, st.rt.y}; *(LAS u32x2*)(lds + DN_OFF_T + o + DN_XT) = (u32x2){st.rt.z, st.rt.w};
      *(LAS u32x2*)(lds + DN_OFF_A + o) = (u32x2){st.ra.x, st.ra.y}; *(LAS u32x2*)(lds + DN_OFF_A + o + DN_XT) = (u32x2){st.ra.z, st.ra.w}; }
    if (tid < 48) *(LAS f32x4*)(lds + DN_OFF_S + tid * 16) = st.rs;
}
__device__ __forceinline__ void dn_step_compute(f32x4 (&S)[8], LAS unsigned char* lds, bf16* O, int c, int d, int T, int row0, int h, int wave, int lane) {
    constexpr int PQ = DN_PQ, OFF_Q = DN_OFF_Q, OFF_K = DN_OFF_K, OFF_V = DN_OFF_V, OFF_T = DN_OFF_T, OFF_A = DN_OFF_A, OFF_S = DN_OFF_S;
    const int r = lane & 15, g = lane >> 4, q4 = (lane & 15) >> 2, p4 = lane & 3;
#define DN_PERMROW(off_, pitch_, row_, col_) cat4(ld_b64(lds + (off_) + (row_) * (pitch_) + ((col_) + 4 * g) * 2), ld_b64(lds + (off_) + (row_) * (pitch_) + ((col_) + 16 + 4 * g) * 2))
#define DN_CHUNK(off_, xsz_, pitch_, row_, sx_) ld_b128(lds + (off_) + (g & 1) * (xsz_) + (row_) * (pitch_) + (2 * (sx_) + (g >> 1)) * 16)
    const f32x4 zero4 = {0.f, 0.f, 0.f, 0.f};
    bf16x8 sb[4];
    f32x4 R[4];
    {
        bf16x8 kf[4][4];
#pragma unroll
        for (int jt = 0; jt < 4; ++jt)
#pragma unroll
            for (int sx = 0; sx < 4; ++sx) kf[jt][sx] = DN_PERMROW(OFF_K, PQ, 16 * jt + r, 32 * sx);
#pragma unroll
        for (int sx = 0; sx < 4; ++sx) sb[sx] = pack8(S[2 * sx], S[2 * sx + 1]);
#pragma unroll
        for (int jt = 0; jt < 4; ++jt) R[jt] = zero4;
#pragma unroll
        for (int sx = 0; sx < 4; ++sx)
#pragma unroll
            for (int jt = 0; jt < 4; ++jt) R[jt] = MFMA16(kf[jt][sx], sb[sx], R[jt]);
    }
    __builtin_amdgcn_sched_barrier(0);
    f32x4 U[4];
    {
        bf16x8 tf[4][2]; s16x4 vt[4]; f32x4 eg[4], bt[4];
#pragma unroll
        for (int jt = 0; jt < 4; ++jt) { vt[jt] = ld_tr(lds + OFF_V + (16 * jt + 4 * g + q4) * PQ + (16 * wave + 4 * p4) * 2);
            eg[jt] = *(const LAS f32x4*)(lds + OFF_S + (16 * jt + 4 * g) * 4); bt[jt] = *(const LAS f32x4*)(lds + OFF_S + 256 + (16 * jt + 4 * g) * 4); }
#pragma unroll
        for (int it = 0; it < 4; ++it) { tf[it][0] = DN_CHUNK(OFF_T, DN_XT, DN_PXT, 16 * it + r, 0); tf[it][1] = DN_CHUNK(OFF_T, DN_XT, DN_PXT, 16 * it + r, 1); }
#pragma unroll
        for (int jt = 0; jt < 4; ++jt)
#pragma unroll
            for (int e = 0; e < 4; ++e) R[jt][e] = bt[jt][e] * (bf2f((unsigned short)vt[jt][e]) - eg[jt][e] * R[jt][e]);
        const bf16x8 rb0 = pack8(R[0], R[1]), rb1 = pack8(R[2], R[3]);
#pragma unroll
        for (int it = 0; it < 4; ++it) U[it] = MFMA16(tf[it][0], rb0, zero4);
#pragma unroll
        for (int it = 0; it < 4; ++it) U[it] = MFMA16(tf[it][1], rb1, U[it]);
    }
    __builtin_amdgcn_sched_barrier(0);
    {
        f32x4 Ot[4];
#pragma unroll
        for (int it = 0; it < 4; ++it) Ot[it] = zero4;
#pragma unroll
        for (int hq = 0; hq < 2; ++hq) {
            bf16x8 qf[2][4];
#pragma unroll
            for (int i2 = 0; i2 < 2; ++i2)
#pragma unroll
                for (int sx = 0; sx < 4; ++sx) qf[i2][sx] = DN_CHUNK(OFF_Q, DN_XQ, DN_PXQ, 16 * (2 * hq + i2) + r, sx);
#pragma unroll
            for (int sx = 0; sx < 4; ++sx)
#pragma unroll
                for (int i2 = 0; i2 < 2; ++i2) Ot[2 * hq + i2] = MFMA16(sb[sx], qf[i2][sx], Ot[2 * hq + i2]);
        }
        bf16x8 af[4][2]; float egi[4];
#pragma unroll
        for (int it = 0; it < 4; ++it) { af[it][0] = DN_CHUNK(OFF_A, DN_XT, DN_PXT, 16 * it + r, 0); af[it][1] = DN_CHUNK(OFF_A, DN_XT, DN_PXT, 16 * it + r, 1); egi[it] = *(const LAS float*)(lds + OFF_S + (16 * it + r) * 4); }
        const bf16x8 ub0 = pack8(U[0], U[1]), ub1 = pack8(U[2], U[3]);
#pragma unroll
        for (int it = 0; it < 4; ++it) Ot[it] = Ot[it] * egi[it];
#pragma unroll
        for (int it = 0; it < 4; ++it) Ot[it] = MFMA16(ub0, af[it][0], Ot[it]);
#pragma unroll
        for (int it = 0; it < 4; ++it) Ot[it] = MFMA16(ub1, af[it][1], Ot[it]);
#pragma unroll
        for (int it = 0; it < 4; ++it) { const int pp = c * 64 + 16 * it + r; const int t = d ? T - 1 - pp : pp; u32x2 w; w.x = pk2(Ot[it][0], Ot[it][1]); w.y = pk2(Ot[it][2], Ot[it][3]);
            *(u32x2*)(O + (size_t)(row0 + t) * 4096 + h * 128 + 16 * wave + 4 * g) = w; }
    }
    __builtin_amdgcn_sched_barrier(0);
    {
#pragma unroll
        for (int jt = 0; jt < 4; ++jt) { const f32x4 dc = *(const LAS f32x4*)(lds + OFF_S + 512 + (16 * jt + 4 * g) * 4); U[jt] = U[jt] * dc; }
        const bf16x8 us0 = pack8(U[0], U[1]), us1 = pack8(U[2], U[3]);
        const float gend = *(const LAS float*)(lds + OFF_S + 63 * 4);
#pragma unroll
        for (int hk = 0; hk < 2; ++hk) {
            bf16x8 ktf[4][2];
#pragma unroll
            for (int k2 = 0; k2 < 4; ++k2) { const int kt = 4 * hk + k2;
                ktf[k2][0] = cat4(ld_tr(lds + OFF_K + (4 * g + q4) * PQ + (16 * kt + 4 * p4) * 2), ld_tr(lds + OFF_K + (16 + 4 * g + q4) * PQ + (16 * kt + 4 * p4) * 2));
                ktf[k2][1] = cat4(ld_tr(lds + OFF_K + (32 + 4 * g + q4) * PQ + (16 * kt + 4 * p4) * 2), ld_tr(lds + OFF_K + (48 + 4 * g + q4) * PQ + (16 * kt + 4 * p4) * 2)); }
#pragma unroll
            for (int k2 = 0; k2 < 4; ++k2) S[4 * hk + k2] = MFMA16(ktf[k2][0], us0, S[4 * hk + k2] * gend);
#pragma unroll
            for (int k2 = 0; k2 < 4; ++k2) S[4 * hk + k2] = MFMA16(ktf[k2][1], us1, S[4 * hk + k2]);
        }
    }
#undef DN_PERMROW
#undef DN_CHUNK
}
__device__ __forceinline__ void dn_chunk_phase(const Params& P, int j, LAS unsigned char* lds) {
    PHASE_IDS();
    const bf16* QKV = (const bf16*)(P.ws + WS_QKV); const bf16* TA = (const bf16*)(P.ws + WS_TA); const float* GS = (const float*)(P.ws + WS_GS);
    bf16* OF = (bf16*)(P.ws + WS_OF); bf16* OB = (bf16*)(P.ws + WS_OB);
    const int r = lane & 15, g = lane >> 4;
    const int bxp = (gridDim.x == 256) ? ({ const int x = blockIdx.x & 7, y = blockIdx.x >> 3, grp = x + 8 * (y >> 1), mem = y & 1; (grp >> 5) * 64 + (2 * ((grp >> 1) & 15) + mem) * 2 + (grp & 1); }) : (int)blockIdx.x;
    for (int unit0 = blockIdx.x; unit0 < 256 + 2048; unit0 += gridDim.x) {
        const int unit = (gridDim.x == 256) ? (unit0 - (int)blockIdx.x + bxp) : unit0;
        const bool lat = unit < 256; const int u2 = lat ? unit : unit - 256;
        const int b = u2 >> 6, h = (u2 >> 1) & 31, d = u2 & 1, T = lat ? 2048 : 256, row0 = lat ? MCTX + b * 2048 : b * 256, kh = h >> 1, nchunk = T / 64;
        bf16* O = d ? OB : OF;
        f32x4 S[8];
        { const float* s0 = P.in[3] + ((((size_t)b * 2 + j) * 2 + d) * 32 + h) * 128 * 128 + 16 * wave + r;
          if (lat) {
#pragma unroll
              for (int kt = 0; kt < 8; ++kt)
#pragma unroll
                  for (int e = 0; e < 4; ++e) S[kt][e] = s0[(size_t)(16 * kt + 4 * g + e) * 128];
          } else {
#pragma unroll
              for (int kt = 0; kt < 8; ++kt) S[kt] = (f32x4){0.f, 0.f, 0.f, 0.f};
          } }
        constexpr int DN_HSZ = DN_OFF_S + 768;
        DnStage sa;
        __syncthreads();
        dn_stage_load(sa, QKV, TA, GS, tid, 0, d, T, row0, kh, h, nchunk);
        dn_stage_store(sa, lds, tid);
        dn_stage_load(sa, QKV, TA, GS, tid, 1, d, T, row0, kh, h, nchunk);
        __syncthreads();
        for (int c = 0; c < nchunk; ++c) {
            LAS unsigned char* cur = lds + (c & 1) * DN_HSZ; LAS unsigned char* nxt = lds + ((c + 1) & 1) * DN_HSZ;
            if (c + 1 < nchunk) dn_stage_store(sa, nxt, tid);
            if (c + 2 < nchunk) dn_stage_load(sa, QKV, TA, GS, tid, c + 2, d, T, row0, kh, h, nchunk);
            dn_step_compute(S, cur, O, c, d, T, row0, h, wave, lane);
            __syncthreads();
        }
        if (!lat) { float* sd = P.out + OUT_SDN + ((((size_t)b * 2 + j) * 2 + d) * 32 + h) * 128 * 128 + 16 * wave + r;
#pragma unroll
            for (int kt = 0; kt < 8; ++kt)
#pragma unroll
                for (int e = 0; e < 4; ++e) sd[(size_t)(16 * kt + 4 * g + e) * 128] = S[kt][e]; }
    }
}


#ifndef R_CONV
#define R_CONV 1
#endif
#ifndef R_MOD
#define R_MOD 1
#endif
#ifndef R_NORM
#define R_NORM 1
#endif
#ifndef R_GATE
#define R_GATE 1
#endif
#ifndef R_DNPREP
#define R_DNPREP 1
#endif
#ifndef R_WU
#define R_WU 1
#endif
#ifndef R_GLAPREP
#define R_GLAPREP 1
#endif
#ifndef R_DNSCAN
#define R_DNSCAN 1
#endif
#ifndef R_GSCAN
#define R_GSCAN 1
#endif
#ifndef R_FINAL
#define R_FINAL 1
#endif
#ifndef R_BAR
#define R_BAR 1
#endif
#ifndef R_GEMM
#define R_GEMM 1
#endif
#define REPN(n_) for (int rep_ = 0; rep_ < (n_); ++rep_)
#ifndef REP_THIN
#define REP_THIN 1
#endif
#ifndef REP_SCAN
#define REP_SCAN 1
#endif
#ifndef REP_A
#define REP_A 1
#endif
#ifndef REP_B
#define REP_B 1
#endif
#ifndef REP_C
#define REP_C 1
#endif
#define RT for (int rep_ = 0; rep_ < REP_THIN; ++rep_)
#define RA for (int rep_ = 0; rep_ < REP_A; ++rep_)
#define RB for (int rep_ = 0; rep_ < REP_B; ++rep_)
#define RC for (int rep_ = 0; rep_ < REP_C; ++rep_)
#define RS for (int rep_ = 0; rep_ < REP_SCAN; ++rep_)
template <int LAYER> __device__ __forceinline__ void layer_body(const Params& P, LAS unsigned char* lds, const XcdBarrier& bar) {
    bf16* X = (bf16*)(P.ws + WS_X); bf16* H = (bf16*)(P.ws + WS_H); bf16* BIG = (bf16*)(P.ws + WS_BIG); float* GATE = (float*)(P.ws + WS_GATE);
    bf16* Y = (bf16*)(P.ws + WS_QKV); bf16* OF = (bf16*)(P.ws + WS_OF); bf16* OB = (bf16*)(P.ws + WS_OB);
    const float* MOD = (const float*)(P.ws + WS_MOD);
    const bf16* Tin = (const bf16*)(P.ws + WS_W + WOFF_IN); const bf16* Tout = (const bf16*)(P.ws + WS_W + WOFF_OUT); const bf16* Tup = (const bf16*)(P.ws + WS_W + WOFF_UP); const bf16* Tdn = (const bf16*)(P.ws + WS_W + WOFF_DOWN);

        constexpr int layer = LAYER, kind = LAYER % 3, j = LAYER / 3;
        const float* modl = MOD + (size_t)layer * 5 * MODW;
        const void* xc = layer == 0 ? (const void*)P.in[0] : (const void*)X; const void* xl = layer == 0 ? (const void*)P.in[1] : (const void*)X;
#ifndef NO_CONV
        REPN(R_CONV) convert_layer_weights(P, layer, lds);
#endif
        if (layer == 0) REPN(R_BAR) xcd_barrier(bar);
        REPN(R_NORM) norm_mod_phase<layer == 0>(xc, xl, P.in[9] + layer * D, modl, 0, 2048, H);
        REPN(R_BAR) xcd_barrier(bar);
        {
            constexpr int Npad = kind == 0 ? DN_NPAD : (kind == 1 ? GLA_NPAD : HG_NIN), nmain = kind == 0 ? DN_NMAIN : (kind == 1 ? GLA_NMAIN : HG_NIN);
            { pg8::Gemm g = pg8::mk_gemm(H, Tin, MROWS, nmain, D); pg8::StaticOrder S; S.init(MROWS, nmain, (int)gridDim.x, (int)blockIdx.x);
              pg8::EpiBf16<0> E{BIG, nmain, nmain, GATE};
              REPN(R_GEMM) pg8::gemm_phase<pg8::EpiBf16<0>, pg8::StaticOrder, true, true>(lds, g, S, E); }
            if constexpr (Npad > nmain) {
              pg8::Gemm g{H, Tin + (size_t)nmain * D, MROWS, 4 * 256, D, (size_t)512 * 2, (size_t)512 * 2, 8}; pg8::StaticOrder S; S.init(MROWS, 4 * 256, (int)gridDim.x, (int)blockIdx.x);
              pg8::EpiGateP E{(float*)(P.ws + WS_GP)};
              pg8::gemm_phase<pg8::EpiGateP, pg8::StaticOrder, true, true>(lds, g, S, E); }
        }
        REPN(R_BAR) xcd_barrier(bar);
        if constexpr (kind == 0) {
#ifndef NO_DNPREP
            REPN(R_DNPREP) dn_prep_phase(P, j, rep_ == 0);
#endif
            REPN(R_BAR) xcd_barrier(bar);
            REPN(R_WU) dn_wu_prep_phase(P, lds);
            REPN(R_BAR) xcd_barrier(bar);
            REPN(R_DNSCAN) dn_chunk_phase(P, j, lds);
            REPN(R_BAR) xcd_barrier(bar);
            REPN(R_GATE) gate_phase<128>(OF, OB, BIG, DN_NMAIN, 8192, P.in[18] + j * 128, Y, 4096);
        } else if constexpr (kind == 1) {
            REPN(R_GLAPREP) gla_prep_phase<1>(P, lds);
            REPN(R_BAR) xcd_barrier(bar);
            REPN(R_GSCAN) gla_chunk_phase<1>(P, lds);
            REPN(R_BAR) xcd_barrier(bar);
            REPN(R_GATE) gate_phase<512>(OF, OB, BIG, GLA_NMAIN, 4096, P.in[23] + j * 512, Y, 2048);
        } else {
            REPN(R_GLAPREP) gla_prep_phase<2>(P, lds);
            REPN(R_BAR) xcd_barrier(bar);
            REPN(R_GSCAN) gla_chunk_phase<2>(P, lds);
            REPN(R_BAR) xcd_barrier(bar);
            REPN(R_GATE) gate_phase<128>(OF, OB, BIG, HG_NIN, 4096, P.in[27] + j * 128, Y, 2048);
        }
        REPN(R_BAR) xcd_barrier(bar);
        {
            const int Kout = kind == 0 ? 4096 : 2048;
            pg8::Gemm g = pg8::mk_gemm(Y, Tout, MROWS, D, Kout); pg8::StaticOrder S; S.init(MROWS, D, (int)gridDim.x, (int)blockIdx.x);
            pg8::EpiRes<layer == 0> E{xc, xl, X, modl + 4096};
            pg8::gemm_phase<pg8::EpiRes<layer == 0>, pg8::StaticOrder, true, true>(lds, g, S, E);
        }
        REPN(R_BAR) xcd_barrier(bar);
        REPN(R_NORM) norm_mod_phase<false>(X, X, P.in[10] + layer * D, modl, 6144, 8192, H);
        REPN(R_BAR) xcd_barrier(bar);
#pragma unroll
        for (int hf = 0; hf < 2; ++hf) {
            {
                pg8::Gemm g = pg8::mk_gemm(H, Tup, MROWS / 2, DFF, D); pg8::StaticOrder S; S.init(MROWS / 2, DFF, (int)gridDim.x, (int)blockIdx.x, hf * 32);
                pg8::EpiBf16<1> E{BIG, DFF, DFF, nullptr};
                REPN(R_GEMM) pg8::gemm_phase<pg8::EpiBf16<1>, pg8::StaticOrder, true, true>(lds, g, S, E);
            }
            REPN(R_BAR) xcd_barrier(bar);
            {
                pg8::Gemm g = pg8::mk_gemm(BIG, Tdn, MROWS / 2, D, DFF); pg8::StaticOrder S; S.init(MROWS / 2, D, (int)gridDim.x, (int)blockIdx.x, hf * 32);
                pg8::EpiRes<false> E{X, X, X, modl + 10240};
                pg8::gemm_phase<pg8::EpiRes<false>, pg8::StaticOrder, true, true>(lds, g, S, E);
            }
            REPN(R_BAR) xcd_barrier(bar);
        }
    }

__global__ void __launch_bounds__(NT, 2) fwd_kernel(Params P) {
    extern __shared__ __attribute__((aligned(16))) unsigned char lds_raw[];
    LAS unsigned char* lds = (LAS unsigned char*)lds_raw;
    const int tid = threadIdx.x;
    volatile LAS unsigned* misc = (volatile LAS unsigned*)(lds + LDS_MISC);
    if (tid < 64) misc[tid] = 0u;
    __syncthreads();
    XcdBarrier bar = xcd_barrier_post((unsigned*)(P.ws + WS_CTL) + 1024, misc + 8);

#ifndef NO_MOD
    REPN(R_MOD) mod_phase(P, lds);
#endif
    __syncthreads();

    layer_body<0>(P, lds, bar);
    layer_body<1>(P, lds, bar);
    layer_body<2>(P, lds, bar);
    layer_body<3>(P, lds, bar);
    REPN(R_FINAL) final_norm_phase((const bf16*)(P.ws + WS_X), P.in[11], P.out + OUT_Y);
}

extern "C" void kernel_launch(void* const* d_in, const int* in_sizes, int n_in, void* d_out, int out_size, void* d_ws, size_t ws_size, hipStream_t stream) {
    static int grid = 0;
    if (grid == 0) {
        if (n_in != 29 || (size_t)out_size != OUT_END || ws_size < WS_END) {
            fprintf(stderr, "kernel_launch: unexpected shapes: n_in %d out %d (want %zu) ws %zu (want %zu)\n", n_in, out_size, (size_t)OUT_END, ws_size, (size_t)WS_END); grid = -1; return; }
        int dev = 0, cus = 0, per_cu = 0;
        if (hipGetDevice(&dev) != hipSuccess || hipDeviceGetAttribute(&cus, hipDeviceAttributeMultiprocessorCount, dev) != hipSuccess) { grid = -1; return; }
        if (hipFuncSetAttribute((const void*)fwd_kernel, hipFuncAttributeMaxDynamicSharedMemorySize, LDS_BYTES) != hipSuccess) { fprintf(stderr, "kernel_launch: hipFuncSetAttribute failed\n"); grid = -1; return; }
        if (hipOccupancyMaxActiveBlocksPerMultiprocessor(&per_cu, (const void*)fwd_kernel, NT, LDS_BYTES) != hipSuccess || per_cu < 1) { fprintf(stderr, "kernel_launch: occupancy query says %d\n", per_cu); }
        (void)hipGetLastError();
        grid = cus;
    }
    if (grid < 0) return;
    hipMemsetAsync((char*)d_ws + WS_CTL, 0, CTL_BYTES, stream);
    Params p{};
    for (int i = 0; i < 29; ++i) p.in[i] = (const float*)d_in[i];
    p.out = (float*)d_out; p.ws = (unsigned char*)d_ws;
    hipLaunchKernelGGL(fwd_kernel, dim3(grid), dim3(NT), LDS_BYTES, stream, p);
}
```
